# Optimizing an MI355X kernel written in HIP

```python
import math
import jax
import jax.numpy as jnp
from jax import lax
import numpy as np

D_MODEL = 1024
BATCH = 32
SEQ = 256
DEPTH = 2
DEC_BATCH = 2
DEC_SEQ = 2048
PAST_LEN = 512

GRID_W = 64
MIX_WIDTH = D_MODEL
A_WIDTH = MIX_WIDTH // 2
A_HEADS = 4
A_DV = A_WIDTH // A_HEADS
A_DK = A_DV
QK = A_HEADS * A_DK
CONV_K = 3
DELTA_CHUNK = 64
B_WIDTH = MIX_WIDTH // 4
B_GROUPS = 4
B_GC = B_WIDTH // B_GROUPS
SGU_CHUNK = 128
C_WIDTH = MIX_WIDTH - A_WIDTH - B_WIDTH
POOL_WINDOWS = (2, 4, 8, 16)
C_GC = C_WIDTH // len(POOL_WINDOWS)
IN_SPLITS = (QK, QK, A_WIDTH, A_WIDTH, 2 * A_HEADS, 2 * A_HEADS, B_WIDTH, B_WIDTH, C_WIDTH)
IN_COLS = sum(IN_SPLITS)
FF_HIDDEN = ((8 * D_MODEL // 3 + 255) // 256) * 256
N_MOD = 6
EPS = 1e-6

kernel_name = 'hybrid_delta_sgu_pool_dit_step'


def rmsnorm(x, g):
    xf = x.astype(jnp.float32)
    y = xf * lax.rsqrt(jnp.mean(xf * xf, axis=-1, keepdims=True) + EPS)
    return (y * g.astype(jnp.float32)).astype(x.dtype)


def l2norm(x):
    xf = x.astype(jnp.float32)
    return xf * lax.rsqrt(jnp.sum(xf * xf, axis=-1, keepdims=True) + EPS)


def short_conv(x, w):
    k = w.shape[0]
    pad = k // 2
    return lax.conv_general_dilated(
        x, w[:, None, :].astype(x.dtype), window_strides=(1,), padding=[(pad, k - 1 - pad)],
        dimension_numbers=('NWC', 'WIO', 'NWC'), feature_group_count=x.shape[-1])


def gated_delta_chunked(q, k, v, g, beta, s0):
    bsz, n, h, _ = q.shape
    dv = v.shape[-1]
    nc = n // DELTA_CHUNK
    cs = DELTA_CHUNK

    def chunks(t):
        t = t.reshape((bsz, nc, cs, h) + t.shape[3:])
        return jnp.moveaxis(jnp.moveaxis(t, 1, 0), 3, 2)

    q, k, v, g, beta = chunks(q), chunks(k), chunks(v), chunks(g), chunks(beta)
    gc = jnp.cumsum(g, axis=-1)
    idx = jnp.arange(cs)
    incl = idx[:, None] >= idx[None, :]
    strict = idx[:, None] > idx[None, :]
    decay = jnp.exp(jnp.where(incl, gc[..., :, None] - gc[..., None, :], -jnp.inf))
    kk = jnp.einsum('nbhid,nbhjd->nbhij', k, k)
    lower = jnp.where(strict, beta[..., :, None] * kk * decay, 0.0)
    eye = jnp.eye(cs, dtype=jnp.float32)
    t_mat = lax.linalg.triangular_solve(eye + lower, jnp.broadcast_to(eye, lower.shape),
                                        left_side=True, lower=True)
    u = jnp.einsum('nbhij,nbhjd->nbhid', t_mat, v * beta[..., None])
    w = jnp.einsum('nbhij,nbhjd->nbhid', t_mat, k * (beta * jnp.exp(gc))[..., None])
    qk = jnp.einsum('nbhid,nbhjd->nbhij', q, k) * decay
    q_dec = q * jnp.exp(gc)[..., None]
    k_dec = k * jnp.exp(gc[..., -1:] - gc)[..., None]
    g_tot = jnp.exp(gc[..., -1])

    def step(s, inp):
        qk_c, qd_c, kd_c, u_c, w_c, gt_c = inp
        v_new = u_c - jnp.einsum('bhid,bhde->bhie', w_c, s)
        o = jnp.einsum('bhid,bhde->bhie', qd_c, s) + jnp.einsum('bhij,bhje->bhie', qk_c, v_new)
        s = s * gt_c[..., None, None] + jnp.einsum('bhid,bhie->bhde', kd_c, v_new)
        return s, o

    s_fin, o = lax.scan(step, s0, (qk, q_dec, k_dec, u, w, g_tot))
    o = jnp.moveaxis(jnp.moveaxis(o, 2, 3), 0, 1).reshape(bsz, n, h, dv)
    return o, s_fin


def delta_mixer(q, k, v, z, beta_logit, alpha_logit, conv_w, a_log, dt_bias, norm_g, s0):
    bsz, n, _ = q.shape
    qkv = jax.nn.silu(short_conv(jnp.concatenate([q, k, v], axis=-1), conv_w))
    q, k, v = jnp.split(qkv, [QK, 2 * QK], axis=-1)
    q = l2norm(q.reshape(bsz, n, A_HEADS, A_DK)) * (A_DK ** -0.5)
    k = l2norm(k.reshape(bsz, n, A_HEADS, A_DK))
    v = v.reshape(bsz, n, A_HEADS, A_DV).astype(jnp.float32)
    outs = []
    states = []
    for d in range(2):
        hs = slice(d * A_HEADS, (d + 1) * A_HEADS)
        beta = jax.nn.sigmoid(beta_logit[..., hs].astype(jnp.float32))
        g = -jnp.exp(a_log[d].astype(jnp.float32)) * jax.nn.softplus(
            alpha_logit[..., hs].astype(jnp.float32) + dt_bias[d].astype(jnp.float32))
        args = (q, k, v, g, beta)
        if d == 1:
            args = tuple(jnp.flip(t, axis=1) for t in args)
        o, s = gated_delta_chunked(*args, s0[:, d].astype(jnp.float32))
        if d == 1:
            o = jnp.flip(o, axis=1)
        outs.append(o)
        states.append(s)
    o = outs[0] + outs[1]
    o = rmsnorm(o, norm_g) * jax.nn.silu(z.reshape(bsz, n, A_HEADS, A_DV).astype(jnp.float32))
    return o.reshape(bsz, n, A_WIDTH).astype(z.dtype), jnp.stack(states, axis=1)


def sgu_mixer(u, v, norm_g, w_s, b_s):
    bsz, n, _ = u.shape
    nch = n // SGU_CHUNK
    u = jax.nn.gelu(u)
    v = jax.nn.gelu(v).reshape(bsz, nch, SGU_CHUNK, B_GROUPS, B_GC)
    v = rmsnorm(v, norm_g.reshape(B_GROUPS, B_GC))
    s = jnp.einsum('gts,bnsgc->bntgc', w_s, v) + b_s.T[None, None, :, :, None]
    return u * s.reshape(bsz, n, B_WIDTH)


def pool_mixer(p, w_pool, scale, seg_len):
    bsz, n, _ = p.shape
    ps = p.reshape(bsz * (n // seg_len), seg_len, C_WIDTH).astype(jnp.float32)
    pos = jnp.arange(seg_len)
    outs = []
    for i, win in enumerate(POOL_WINDOWS):
        x = ps[..., i * C_GC:(i + 1) * C_GC]
        csum = jnp.pad(jnp.cumsum(x, axis=1), ((0, 0), (1, 0), (0, 0)))
        lo = jnp.clip(pos - win // 2, 0, seg_len)
        hi = jnp.clip(pos + win - win // 2, 0, seg_len)
        mean = (jnp.take(csum, hi, axis=1) - jnp.take(csum, lo, axis=1)) / \
            (hi - lo).astype(jnp.float32)[None, :, None]
        outs.append(jnp.einsum('bnc,cd->bnd', mean - x, w_pool[i].astype(jnp.float32)))
    y = jnp.concatenate(outs, axis=-1).reshape(bsz, n, C_WIDTH) * scale.astype(jnp.float32)
    return y.astype(p.dtype)


def grid_pos_embed(rows, d):
    quarter = d // 4
    omega = 1.0 / (10000.0 ** (jnp.arange(quarter, dtype=jnp.float32) / quarter))
    r = jnp.arange(rows, dtype=jnp.float32)[:, None] * omega
    cl = jnp.arange(GRID_W, dtype=jnp.float32)[:, None] * omega
    row_emb = jnp.concatenate([jnp.sin(r), jnp.cos(r)], axis=-1)
    col_emb = jnp.concatenate([jnp.sin(cl), jnp.cos(cl)], axis=-1)
    emb = jnp.concatenate([jnp.broadcast_to(row_emb[:, None, :], (rows, GRID_W, d // 2)),
                           jnp.broadcast_to(col_emb[None, :, :], (rows, GRID_W, d // 2))], axis=-1)
    return emb.reshape(rows * GRID_W, d)


def trunk_layer(x, mod, s0, prm, l, pool_seg):
    sh1, sc1, g1, sh2, sc2, g2 = jnp.split(mod, N_MOD, axis=-1)
    h = rmsnorm(x, prm['norm1_g'][l]) * (1 + sc1) + sh1
    cols = jnp.einsum('bnd,de->bne', h, prm['w_in'][l])
    split_idx = [int(i) for i in np.cumsum(IN_SPLITS)[:-1]]
    q, k, v, z, bl, al, u, vb, pp = jnp.split(cols, split_idx, axis=-1)
    ya, s_fin = delta_mixer(q, k, v, z, bl, al, prm['conv_w'][l], prm['a_log'][l],
                            prm['dt_bias'][l], prm['delta_norm_g'][l], s0)
    yb = sgu_mixer(u, vb, prm['sgu_norm_g'][l], prm['w_spatial'][l], prm['b_spatial'][l])
    yc = pool_mixer(pp, prm['w_pool'][l], prm['pool_scale'][l], pool_seg)
    mix = jnp.einsum('bne,ed->bnd', jnp.concatenate([ya, yb, yc], axis=-1), prm['w_out'][l])
    x = x + g1 * mix
    h = rmsnorm(x, prm['norm2_g'][l]) * (1 + sc2) + sh2
    gate, up = jnp.split(jnp.einsum('bnd,df->bnf', h, prm['w_gu'][l]), 2, axis=-1)
    x = x + g2 * jnp.einsum('bnf,fd->bnd', jax.nn.silu(gate) * up, prm['w_down'][l])
    return x, s_fin


def setup_inputs(seed: int = 0) -> dict:
    key = jax.random.key(seed)
    ks = jax.random.split(key, 24)
    f32 = jnp.float32

    def nrm(k, shape, scale):
        return jax.random.normal(k, shape, f32) * scale

    dt = jnp.exp(jax.random.uniform(ks[8], (DEPTH, 2, A_HEADS), f32, math.log(1e-3), math.log(1e-1)))
    return {
        'x_prompt': nrm(ks[0], (BATCH, SEQ, D_MODEL), 1.0),
        'x_sample': nrm(ks[1], (DEC_BATCH, DEC_SEQ, D_MODEL), 1.0),
        'state_delta': nrm(ks[2], (DEC_BATCH, DEPTH, 2, A_HEADS, A_DK, A_DV), 0.1),
        'c': nrm(ks[3], (DEC_BATCH, D_MODEL), 1.0),
        'c_ctx': nrm(ks[4], (D_MODEL,), 1.0),
        'w_in': nrm(ks[5], (DEPTH, D_MODEL, IN_COLS), D_MODEL ** -0.5),
        'conv_w': nrm(ks[6], (DEPTH, CONV_K, 2 * QK + A_WIDTH), CONV_K ** -0.5),
        'a_log': jnp.log(jax.random.uniform(ks[7], (DEPTH, 2, A_HEADS), f32, 1.0, 16.0)),
        'dt_bias': dt + jnp.log(-jnp.expm1(-dt)),
        'delta_norm_g': 1.0 + nrm(ks[9], (DEPTH, A_DV), 0.02),
        'sgu_norm_g': 1.0 + nrm(ks[10], (DEPTH, B_WIDTH), 0.02),
        'w_spatial': nrm(ks[11], (DEPTH, B_GROUPS, SGU_CHUNK, SGU_CHUNK), SGU_CHUNK ** -0.5),
        'b_spatial': 1.0 + nrm(ks[12], (DEPTH, B_GROUPS, SGU_CHUNK), 0.02),
        'w_pool': nrm(ks[13], (DEPTH, len(POOL_WINDOWS), C_GC, C_GC), C_GC ** -0.5),
        'pool_scale': 1.0 + nrm(ks[14], (DEPTH, C_WIDTH), 0.02),
        'w_out': nrm(ks[15], (DEPTH, MIX_WIDTH, D_MODEL), MIX_WIDTH ** -0.5),
        'norm1_g': 1.0 + nrm(ks[16], (DEPTH, D_MODEL), 0.02),
        'norm2_g': 1.0 + nrm(ks[17], (DEPTH, D_MODEL), 0.02),
        'w_mod': nrm(ks[18], (DEPTH, D_MODEL, N_MOD * D_MODEL), 0.5 * D_MODEL ** -0.5),
        'b_mod': nrm(ks[19], (DEPTH, N_MOD * D_MODEL), 0.02),
        'w_gu': nrm(ks[20], (DEPTH, D_MODEL, 2 * FF_HIDDEN), D_MODEL ** -0.5),
        'w_down': nrm(ks[21], (DEPTH, FF_HIDDEN, D_MODEL), FF_HIDDEN ** -0.5),
        'norm_f': 1.0 + nrm(ks[22], (D_MODEL,), 0.02),
    }


def reference(x_prompt, x_sample, state_delta, c, c_ctx, w_in, conv_w, a_log, dt_bias,
              delta_norm_g, sgu_norm_g, w_spatial, b_spatial, w_pool, pool_scale, w_out,
              norm1_g, norm2_g, w_mod, b_mod, w_gu, w_down, norm_f):
    prm = {'w_in': w_in, 'conv_w': conv_w, 'a_log': a_log, 'dt_bias': dt_bias,
           'delta_norm_g': delta_norm_g, 'sgu_norm_g': sgu_norm_g, 'w_spatial': w_spatial,
           'b_spatial': b_spatial, 'w_pool': w_pool, 'pool_scale': pool_scale, 'w_out': w_out,
           'norm1_g': norm1_g, 'norm2_g': norm2_g, 'w_gu': w_gu, 'w_down': w_down}

    xc = x_prompt
    zero_state = jnp.zeros((x_prompt.shape[0], 2, A_HEADS, A_DK, A_DV), jnp.float32)
    ctx_states = []
    for l in range(DEPTH):
        mod_ctx = (jnp.einsum('d,de->e', jax.nn.silu(c_ctx), w_mod[l]) + b_mod[l])[None, None, :]
        xc, s_ctx = trunk_layer(xc, mod_ctx, zero_state, prm, l, xc.shape[1])
        ctx_states.append(s_ctx)
    y_prompt = rmsnorm(xc, norm_f)
    new_state_delta = jnp.stack(ctx_states, axis=1).astype(x_prompt.dtype)

    rows = x_sample.shape[1] // GRID_W
    xs = x_sample + grid_pos_embed(rows, D_MODEL).astype(x_sample.dtype)[None]
    for l in range(DEPTH):
        mod_lat = (jnp.einsum('bd,de->be', jax.nn.silu(c), w_mod[l]) + b_mod[l])[:, None, :]
        xs, _ = trunk_layer(xs, mod_lat, state_delta[:, l], prm, l, GRID_W)
    y_sample = rmsnorm(xs, norm_f)

    return (y_prompt, y_sample, new_state_delta)
```

```cpp
#include <hip/hip_runtime.h>
#include <math.h>

#define NTOK 12288
#define NCTX 8192
#define DM 1024
#define INC 2832
#define FFH 2816
#define NQKV 1536
#define NREST 1296

__device__ __forceinline__ float silu_f(float x) { return x / (1.f + expf(-x)); }
__device__ __forceinline__ float sigmoid_f(float x) { return 1.f / (1.f + expf(-x)); }
__device__ __forceinline__ float gelu_f(float x) { return 0.5f * x * (1.f + tanhf(0.7978845608028654f * (x + 0.044715f * x * x * x))); }
__device__ __forceinline__ float softplus_f(float x) { return x > 20.f ? x : log1pf(expf(x)); }
__device__ __forceinline__ int seg_of_row(int r) { return r < NCTX ? 0 : 1 + ((r - NCTX) >> 11); }

__device__ __forceinline__ float wave_sum(float v) {
#pragma unroll
  for (int o = 32; o > 0; o >>= 1) v += __shfl_xor(v, o);
  return v;
}

__global__ __launch_bounds__(256) void k_mod(const float* __restrict__ c, const float* __restrict__ c_ctx,
                                             const float* __restrict__ w_mod, const float* __restrict__ b_mod,
                                             float* __restrict__ mods) {
  __shared__ float sv[3][1024];
  const int e = blockIdx.x * 256 + threadIdx.x, l = blockIdx.y;
  for (int i = threadIdx.x; i < 1024; i += 256) {
    sv[0][i] = silu_f(c_ctx[i]); sv[1][i] = silu_f(c[i]); sv[2][i] = silu_f(c[1024 + i]);
  }
  __syncthreads();
  const float* w = w_mod + (size_t)l * 1024 * 6144 + e;
  float a0 = 0.f, a1 = 0.f, a2 = 0.f;
#pragma unroll 8
  for (int d = 0; d < 1024; ++d) {
    const float wv = w[(size_t)d * 6144];
    a0 += sv[0][d] * wv; a1 += sv[1][d] * wv; a2 += sv[2][d] * wv;
  }
  const float b = b_mod[l * 6144 + e];
  mods[(l * 3 + 0) * 6144 + e] = a0 + b;
  mods[(l * 3 + 1) * 6144 + e] = a1 + b;
  mods[(l * 3 + 2) * 6144 + e] = a2 + b;
}

__global__ __launch_bounds__(256) void k_prepx(const float* __restrict__ xp, const float* __restrict__ xs, float* __restrict__ X) {
  const size_t i = (size_t)blockIdx.x * 256 + threadIdx.x;
  const int r = (int)(i >> 10), d = (int)(i & 1023);
  if (r < NCTX) { X[i] = xp[i]; return; }
  const int rl = r - NCTX, p = rl & 2047, row = p >> 6, col = p & 63, q = d >> 8, j = d & 255;
  const float omega = 1.0f / powf(10000.0f, (float)j / 256.0f);
  const float ang = (q < 2 ? (float)row : (float)col) * omega;
  const float e = (q & 1) ? cosf(ang) : sinf(ang);
  X[i] = xs[(size_t)rl * 1024 + d] + e;
}

__global__ __launch_bounds__(256) void k_norm_mod(const float* __restrict__ X, const float* __restrict__ g,
                                                  const float* __restrict__ mods, int sh_off, int sc_off,
                                                  float* __restrict__ H) {
  __shared__ float red[4];
  const int r = blockIdx.x, tid = threadIdx.x;
  const float* x = X + (size_t)r * 1024;
  float v[4]; float ss = 0.f;
#pragma unroll
  for (int i = 0; i < 4; ++i) { v[i] = x[tid + 256 * i]; ss += v[i] * v[i]; }
  ss = wave_sum(ss);
  if ((tid & 63) == 0) red[tid >> 6] = ss;
  __syncthreads();
  const float tot = red[0] + red[1] + red[2] + red[3];
  const float rinv = rsqrtf(tot * (1.0f / 1024.0f) + 1e-6f);
  if (sh_off >= 0) {
    const float* m = mods + seg_of_row(r) * 6144;
#pragma unroll
    for (int i = 0; i < 4; ++i) { const int d = tid + 256 * i; H[(size_t)r * 1024 + d] = v[i] * rinv * g[d] * (1.f + m[sc_off + d]) + m[sh_off + d]; }
  } else {
#pragma unroll
    for (int i = 0; i < 4; ++i) { const int d = tid + 256 * i; H[(size_t)r * 1024 + d] = v[i] * rinv * g[d]; }
  }
}

template <bool DUAL>
__global__ __launch_bounds__(256) void k_sgemm(const float* __restrict__ A, const float* __restrict__ B, const float* __restrict__ B2,
                                               float* __restrict__ C, int N, int K, int lda, int ldb, int ldc) {
  __shared__ float As[16][132];
  __shared__ float Bs[16][132];
  __shared__ float Bs2[DUAL ? 16 : 1][132];
  const int tid = threadIdx.x, tx = tid & 15, ty = tid >> 4;
  const int m0 = blockIdx.y * 128, n0 = blockIdx.x * 128;
  float acc[8][8], acc2[DUAL ? 8 : 1][8];
#pragma unroll
  for (int i = 0; i < 8; ++i)
#pragma unroll
    for (int j = 0; j < 8; ++j) { acc[i][j] = 0.f; if (DUAL) acc2[i][j] = 0.f; }
  for (int k0 = 0; k0 < K; k0 += 16) {
    __syncthreads();
#pragma unroll
    for (int i = 0; i < 2; ++i) {
      const int idx = tid + 256 * i;
      const int row = idx >> 2, kq = idx & 3;
      const float4 a = *(const float4*)(A + (size_t)(m0 + row) * lda + k0 + kq * 4);
      As[kq * 4 + 0][row] = a.x; As[kq * 4 + 1][row] = a.y; As[kq * 4 + 2][row] = a.z; As[kq * 4 + 3][row] = a.w;
      const int kk = idx >> 5, nq = idx & 31;
      const int n = n0 + nq * 4;
      float4 b = make_float4(0.f, 0.f, 0.f, 0.f), b2 = b;
      if (n < N) { b = *(const float4*)(B + (size_t)(k0 + kk) * ldb + n); if (DUAL) b2 = *(const float4*)(B2 + (size_t)(k0 + kk) * ldb + n); }
      *(float4*)&Bs[kk][nq * 4] = b;
      if (DUAL) *(float4*)&Bs2[kk][nq * 4] = b2;
    }
    __syncthreads();
#pragma unroll
    for (int k = 0; k < 16; ++k) {
      const float4 a0 = *(const float4*)&As[k][ty * 8], a1 = *(const float4*)&As[k][ty * 8 + 4];
      const float4 b0 = *(const float4*)&Bs[k][tx * 8], b1 = *(const float4*)&Bs[k][tx * 8 + 4];
      const float av[8] = {a0.x, a0.y, a0.z, a0.w, a1.x, a1.y, a1.z, a1.w};
      const float bv[8] = {b0.x, b0.y, b0.z, b0.w, b1.x, b1.y, b1.z, b1.w};
#pragma unroll
      for (int i = 0; i < 8; ++i)
#pragma unroll
        for (int j = 0; j < 8; ++j) acc[i][j] += av[i] * bv[j];
      if (DUAL) {
        const float4 c0 = *(const float4*)&Bs2[k][tx * 8], c1 = *(const float4*)&Bs2[k][tx * 8 + 4];
        const float cv[8] = {c0.x, c0.y, c0.z, c0.w, c1.x, c1.y, c1.z, c1.w};
#pragma unroll
        for (int i = 0; i < 8; ++i)
#pragma unroll
          for (int j = 0; j < 8; ++j) acc2[i][j] += av[i] * cv[j];
      }
    }
  }
#pragma unroll
  for (int i = 0; i < 8; ++i) {
    float* crow = C + (size_t)(m0 + ty * 8 + i) * ldc;
#pragma unroll
    for (int jq = 0; jq < 2; ++jq) {
      const int n = n0 + tx * 8 + jq * 4;
      if (n < N) {
        float4 o;
        if (DUAL) {
          o.x = silu_f(acc[i][jq * 4 + 0]) * acc2[i][jq * 4 + 0]; o.y = silu_f(acc[i][jq * 4 + 1]) * acc2[i][jq * 4 + 1];
          o.z = silu_f(acc[i][jq * 4 + 2]) * acc2[i][jq * 4 + 2]; o.w = silu_f(acc[i][jq * 4 + 3]) * acc2[i][jq * 4 + 3];
        } else { o.x = acc[i][jq * 4 + 0]; o.y = acc[i][jq * 4 + 1]; o.z = acc[i][jq * 4 + 2]; o.w = acc[i][jq * 4 + 3]; }
        *(float4*)(crow + n) = o;
      }
    }
  }
}

__global__ __launch_bounds__(256) void k_conv_prep(const float* __restrict__ QKV, const float* __restrict__ REST,
                                                   const float* __restrict__ conv_w, const float* __restrict__ a_log,
                                                   const float* __restrict__ dt_bias, float* __restrict__ Qn, float* __restrict__ Kn,
                                                   float* __restrict__ Vc, float* __restrict__ beta, float* __restrict__ gdec) {
  __shared__ float part[4][4];
  const int r = blockIdx.x, tid = threadIdx.x, w = tid >> 6;
  int s0, len;
  if (r < NCTX) { s0 = r & ~255; len = 256; } else { s0 = NCTX + ((r - NCTX) & ~2047); len = 2048; }
  const int t = r - s0;
  const bool hp = t > 0, hn = t < len - 1;
  float vals[6];
#pragma unroll
  for (int i = 0; i < 6; ++i) {
    const int c = tid + 256 * i;
    const float xm = hp ? QKV[(size_t)(r - 1) * NQKV + c] : 0.f;
    const float x0 = QKV[(size_t)r * NQKV + c];
    const float xp = hn ? QKV[(size_t)(r + 1) * NQKV + c] : 0.f;
    const float y = conv_w[c] * xm + conv_w[NQKV + c] * x0 + conv_w[2 * NQKV + c] * xp;
    vals[i] = silu_f(y);
  }
#pragma unroll
  for (int i = 0; i < 4; ++i) {
    const float s = wave_sum(vals[i] * vals[i]);
    if ((tid & 63) == 0) part[i][w] = s;
  }
  __syncthreads();
#pragma unroll
  for (int i = 0; i < 4; ++i) {
    const float s = part[i][w & ~1] + part[i][w | 1];
    const float rn = rsqrtf(s + 1e-6f);
    const int c = tid + 256 * i;
    if (i < 2) Qn[(size_t)r * 512 + c] = vals[i] * rn * 0.08838834764831845f;
    else Kn[(size_t)r * 512 + (c - 512)] = vals[i] * rn;
  }
  Vc[(size_t)r * 512 + tid] = vals[4];
  Vc[(size_t)r * 512 + tid + 256] = vals[5];
  if (tid < 8) {
    const float bl = REST[(size_t)r * NREST + 512 + tid];
    const float al = REST[(size_t)r * NREST + 520 + tid];
    beta[(size_t)r * 8 + tid] = sigmoid_f(bl);
    gdec[(size_t)r * 8 + tid] = -expf(a_log[tid]) * softplus_f(al + dt_bias[tid]);
  }
}

__global__ __launch_bounds__(128) void k_scan(const float* __restrict__ Qn, const float* __restrict__ Kn, const float* __restrict__ Vc,
                                              const float* __restrict__ beta, const float* __restrict__ gdec,
                                              const float* __restrict__ state_in, float* __restrict__ O, float* __restrict__ state_out, int layer) {
  __shared__ float sk[16][128];
  __shared__ float sq[16][128];
  __shared__ float sv[16][128];
  __shared__ float sb[16], sa[16];
  const int blk = blockIdx.x, e = threadIdx.x;
  int b, h, d, row0, len; const bool ctx = blk < 256;
  if (ctx) { b = blk >> 3; h = (blk >> 1) & 3; d = blk & 1; row0 = b * 256; len = 256; }
  else { const int q = blk - 256; b = q >> 3; h = (q >> 1) & 3; d = q & 1; row0 = NCTX + b * 2048; len = 2048; }
  float S[128];
  if (ctx) {
#pragma unroll
    for (int k = 0; k < 128; ++k) S[k] = 0.f;
  } else {
    const float* s0 = state_in + ((((size_t)b * 2 + layer) * 2 + d) * 4 + h) * 16384;
#pragma unroll
    for (int k = 0; k < 128; ++k) S[k] = s0[k * 128 + e];
  }
  for (int t0 = 0; t0 < len; t0 += 16) {
    __syncthreads();
    for (int j = 0; j < 16; ++j) {
      const int t = t0 + j; const int pos = d ? (len - 1 - t) : t; const size_t r = (size_t)(row0 + pos);
      sk[j][e] = Kn[r * 512 + h * 128 + e]; sq[j][e] = Qn[r * 512 + h * 128 + e]; sv[j][e] = Vc[r * 512 + h * 128 + e];
    }
    if (e < 16) {
      const int t = t0 + e; const int pos = d ? (len - 1 - t) : t; const size_t r = (size_t)(row0 + pos);
      sb[e] = beta[r * 8 + d * 4 + h]; sa[e] = expf(gdec[r * 8 + d * 4 + h]);
    }
    __syncthreads();
    for (int j = 0; j < 16; ++j) {
      const float a = sa[j], bt = sb[j];
      float ks = 0.f;
#pragma unroll
      for (int k = 0; k < 128; k += 4) {
        const float4 kv = *(const float4*)&sk[j][k];
        ks += kv.x * S[k] + kv.y * S[k + 1] + kv.z * S[k + 2] + kv.w * S[k + 3];
      }
      const float vn = bt * (sv[j][e] - a * ks);
      float o = 0.f;
#pragma unroll
      for (int k = 0; k < 128; k += 4) {
        const float4 kv = *(const float4*)&sk[j][k];
        const float4 qv = *(const float4*)&sq[j][k];
        S[k] = a * S[k] + kv.x * vn; S[k + 1] = a * S[k + 1] + kv.y * vn; S[k + 2] = a * S[k + 2] + kv.z * vn; S[k + 3] = a * S[k + 3] + kv.w * vn;
        o += qv.x * S[k] + qv.y * S[k + 1] + qv.z * S[k + 2] + qv.w * S[k + 3];
      }
      const int t = t0 + j; const int pos = d ? (len - 1 - t) : t; const size_t r = (size_t)(row0 + pos);
      O[((size_t)d * NTOK + r) * 512 + h * 128 + e] = o;
    }
  }
  if (ctx) {
    float* so = state_out + ((((size_t)b * 2 + layer) * 2 + d) * 4 + h) * 16384;
#pragma unroll
    for (int k = 0; k < 128; ++k) so[k * 128 + e] = S[k];
  }
}

__global__ __launch_bounds__(256) void k_delta_post(const float* __restrict__ O, const float* __restrict__ REST,
                                                    const float* __restrict__ norm_g, float* __restrict__ MIX) {
  __shared__ float part[2][4];
  const int r = blockIdx.x, tid = threadIdx.x, w = tid >> 6;
  float o[2];
#pragma unroll
  for (int i = 0; i < 2; ++i) {
    const int c = tid + 256 * i;
    o[i] = O[(size_t)r * 512 + c] + O[((size_t)NTOK + r) * 512 + c];
    const float s = wave_sum(o[i] * o[i]);
    if ((tid & 63) == 0) part[i][w] = s;
  }
  __syncthreads();
#pragma unroll
  for (int i = 0; i < 2; ++i) {
    const int c = tid + 256 * i;
    const float s = part[i][w & ~1] + part[i][w | 1];
    const float rn = rsqrtf(s * (1.0f / 128.0f) + 1e-6f);
    const float z = REST[(size_t)r * NREST + c];
    MIX[(size_t)r * 1024 + c] = o[i] * rn * norm_g[c & 127] * silu_f(z);
  }
}

__global__ __launch_bounds__(256) void k_sgu(const float* __restrict__ REST, const float* __restrict__ norm_g,
                                             const float* __restrict__ w_s, const float* __restrict__ b_s, float* __restrict__ MIX) {
  __shared__ float vn[128][65];
  const int ch = blockIdx.x, g = blockIdx.y, tid = threadIdx.x, r0 = ch * 128;
  {
    const int p = tid >> 1, hf = tid & 1;
    const float* vrow = REST + (size_t)(r0 + p) * NREST + 784 + g * 64 + hf * 32;
    float ss = 0.f;
    for (int c = 0; c < 32; ++c) { const float x = gelu_f(vrow[c]); ss += x * x; }
    ss += __shfl_xor(ss, 1);
    const float rinv = rsqrtf(ss * (1.0f / 64.0f) + 1e-6f);
    for (int c = 0; c < 32; ++c) vn[p][hf * 32 + c] = gelu_f(vrow[c]) * rinv * norm_g[g * 64 + hf * 32 + c];
  }
  __syncthreads();
  const int c = tid & 63;
  for (int t = tid >> 6; t < 128; t += 4) {
    float acc = b_s[g * 128 + t];
    const float* wr = w_s + (size_t)(g * 128 + t) * 128;
    for (int s = 0; s < 128; ++s) acc += wr[s] * vn[s][c];
    const float u = gelu_f(REST[(size_t)(r0 + t) * NREST + 528 + g * 64 + c]);
    MIX[(size_t)(r0 + t) * 1024 + 512 + g * 64 + c] = u * acc;
  }
}

__global__ __launch_bounds__(256) void k_pool(const float* __restrict__ REST, const float* __restrict__ w_pool,
                                              const float* __restrict__ scale, float* __restrict__ MIX) {
  __shared__ float dm[64][65];
  const int blk = blockIdx.x, i = blockIdx.y, tid = threadIdx.x, r0 = blk * 64, win = 2 << i;
  int seg0, seglen;
  if (r0 < NCTX) { seg0 = r0 & ~255; seglen = 256; } else { seg0 = r0; seglen = 64; }
  const int c = tid & 63;
  for (int p = tid >> 6; p < 64; p += 4) {
    const int pos = r0 + p - seg0;
    const int lo = max(pos - win / 2, 0), hi = min(pos + win - win / 2, seglen);
    float s = 0.f;
    for (int q = lo; q < hi; ++q) s += REST[(size_t)(seg0 + q) * NREST + 1040 + i * 64 + c];
    const float x = REST[(size_t)(r0 + p) * NREST + 1040 + i * 64 + c];
    dm[p][c] = s / (float)(hi - lo) - x;
  }
  __syncthreads();
  const int dd = tid & 63;
  for (int p = tid >> 6; p < 64; p += 4) {
    float acc = 0.f;
    for (int cc = 0; cc < 64; ++cc) acc += dm[p][cc] * w_pool[(size_t)(i * 64 + cc) * 64 + dd];
    MIX[(size_t)(r0 + p) * 1024 + 768 + i * 64 + dd] = acc * scale[i * 64 + dd];
  }
}

__global__ __launch_bounds__(256) void k_resid(float* __restrict__ X, const float* __restrict__ T, const float* __restrict__ mods, int g_off) {
  const size_t i = (size_t)blockIdx.x * 256 + threadIdx.x;
  const int r = (int)(i >> 10), d = (int)(i & 1023);
  X[i] += mods[seg_of_row(r) * 6144 + g_off + d] * T[i];
}

extern "C" void kernel_launch(void* const* d_in, const int* in_sizes, int n_in, void* d_out, int out_size, void* d_ws, size_t ws_size,
                              hipStream_t stream) {
  const float* x_prompt = (const float*)d_in[0];
  const float* x_sample = (const float*)d_in[1];
  const float* state_delta = (const float*)d_in[2];
  const float* c = (const float*)d_in[3];
  const float* c_ctx = (const float*)d_in[4];
  const float* w_in = (const float*)d_in[5];
  const float* conv_w = (const float*)d_in[6];
  const float* a_log = (const float*)d_in[7];
  const float* dt_bias = (const float*)d_in[8];
  const float* delta_norm_g = (const float*)d_in[9];
  const float* sgu_norm_g = (const float*)d_in[10];
  const float* w_spatial = (const float*)d_in[11];
  const float* b_spatial = (const float*)d_in[12];
  const float* w_pool = (const float*)d_in[13];
  const float* pool_scale = (const float*)d_in[14];
  const float* w_out = (const float*)d_in[15];
  const float* norm1_g = (const float*)d_in[16];
  const float* norm2_g = (const float*)d_in[17];
  const float* w_mod = (const float*)d_in[18];
  const float* b_mod = (const float*)d_in[19];
  const float* w_gu = (const float*)d_in[20];
  const float* w_down = (const float*)d_in[21];
  const float* norm_f = (const float*)d_in[22];
  float* out = (float*)d_out;
  char* ws = (char*)d_ws;
  float* X = (float*)ws;
  float* R1 = (float*)(ws + 50331648);
  float* R1a = R1;
  float* R1b = (float*)(ws + 50331648 + 75497472);
  float* R3 = (float*)(ws + 50331648 + 139198464);
  float* mods = (float*)(ws + 265027584);
  float* beta = mods + 2 * 3 * 6144;
  float* gdec = beta + NTOK * 8;
  float* states_out = out + (size_t)NTOK * 1024;

  k_mod<<<dim3(24, 2), 256, 0, stream>>>(c, c_ctx, w_mod, b_mod, mods);
  k_prepx<<<NTOK * 4, 256, 0, stream>>>(x_prompt, x_sample, X);
  for (int l = 0; l < 2; ++l) {
    const float* ml = mods + l * 3 * 6144;
    const float* w_in_l = w_in + (size_t)l * 1024 * INC;
    float* H = R3;
    k_norm_mod<<<NTOK, 256, 0, stream>>>(X, norm1_g + l * 1024, ml, 0, 1024, H);
    k_sgemm<false><<<dim3(12, 96), 256, 0, stream>>>(H, w_in_l, nullptr, R1a, NQKV, 1024, 1024, INC, NQKV);
    k_sgemm<false><<<dim3(11, 96), 256, 0, stream>>>(H, w_in_l + NQKV, nullptr, R1b, NREST, 1024, 1024, INC, NREST);
    float* Qn = R3; float* Kn = R3 + (size_t)NTOK * 512; float* Vc = R3 + (size_t)NTOK * 1024;
    k_conv_prep<<<NTOK, 256, 0, stream>>>(R1a, R1b, conv_w + (size_t)l * 3 * NQKV, a_log + l * 8, dt_bias + l * 8, Qn, Kn, Vc, beta, gdec);
    float* O = R1a;
    k_scan<<<272, 128, 0, stream>>>(Qn, Kn, Vc, beta, gdec, state_delta, O, states_out, l);
    float* MIX = R3;
    k_delta_post<<<NTOK, 256, 0, stream>>>(O, R1b, delta_norm_g + l * 128, MIX);
    k_sgu<<<dim3(NTOK / 128, 4), 256, 0, stream>>>(R1b, sgu_norm_g + l * 256, w_spatial + (size_t)l * 4 * 128 * 128, b_spatial + l * 4 * 128, MIX);
    k_pool<<<dim3(NTOK / 64, 4), 256, 0, stream>>>(R1b, w_pool + (size_t)l * 4 * 64 * 64, pool_scale + l * 256, MIX);
    float* T = R1a;
    k_sgemm<false><<<dim3(8, 96), 256, 0, stream>>>(MIX, w_out + (size_t)l * 1024 * 1024, nullptr, T, 1024, 1024, 1024, 1024, 1024);
    k_resid<<<NTOK * 4, 256, 0, stream>>>(X, T, ml, 2048);
    float* H2 = R3;
    k_norm_mod<<<NTOK, 256, 0, stream>>>(X, norm2_g + l * 1024, ml, 3072, 4096, H2);
    float* ACT = R1;
    const float* w_gu_l = w_gu + (size_t)l * 1024 * 2 * FFH;
    k_sgemm<true><<<dim3(22, 96), 256, 0, stream>>>(H2, w_gu_l, w_gu_l + FFH, ACT, FFH, 1024, 1024, 2 * FFH, FFH);
    float* T2 = R3;
    k_sgemm<false><<<dim3(8, 96), 256, 0, stream>>>(ACT, w_down + (size_t)l * FFH * 1024, nullptr, T2, 1024, FFH, FFH, 1024, 1024);
    k_resid<<<NTOK * 4, 256, 0, stream>>>(X, T2, ml, 5120);
  }
  k_norm_mod<<<NTOK, 256, 0, stream>>>(X, norm_f, nullptr, -1, -1, out);
}
```

```cpp
#include <hip/hip_runtime.h>
#include <math.h>
#include <cstdio>
#include <cstring>

#define NTOK 12288
#define NCTX 8192
#define DM 1024
#define INC 2832
#define FFH 2816
#define NQKV 1536
#define NREST 1280
#define NCOLS 2816

typedef unsigned short bf16_t;
__device__ __forceinline__ bf16_t f2bf(float f) { unsigned u = __float_as_uint(f); u += 0x7FFFu + ((u >> 16) & 1u); return (bf16_t)(u >> 16); }
__device__ __forceinline__ float bf2f(bf16_t b) { return __uint_as_float(((unsigned)b) << 16); }
__device__ __forceinline__ float silu_f(float x) { return x / (1.f + expf(-x)); }
__device__ __forceinline__ float sigmoid_f(float x) { return 1.f / (1.f + expf(-x)); }
__device__ __forceinline__ float gelu_f(float x) { return 0.5f * x * (1.f + tanhf(0.7978845608028654f * (x + 0.044715f * x * x * x))); }
__device__ __forceinline__ float softplus_f(float x) { return x > 20.f ? x : log1pf(expf(x)); }
__device__ __forceinline__ int seg_of_row(int r) { return r < NCTX ? 0 : 1 + ((r - NCTX) >> 11); }
__device__ __forceinline__ float wave_sum(float v) {
#pragma unroll
  for (int o = 32; o > 0; o >>= 1) v += __shfl_xor(v, o);
  return v;
}
namespace pg8 {
#define PG8_LAS __attribute__((address_space(3)))
typedef unsigned short bf16_t;
typedef short bf16x8 __attribute__((ext_vector_type(8)));
typedef float f32x4 __attribute__((ext_vector_type(4)));
typedef unsigned u32x4 __attribute__((ext_vector_type(4)));
constexpr int BM = 256, BK = 64, HALF = 128, HTB = HALF * BK * 2  , STAGE_BYTES = 8 * HTB, NXCD = 8, WGM = 8;

__host__ __device__ __forceinline__ int lds_byte(int r, int c) { const int st = (r >> 4) * 2 + (c >> 5), rr = r & 15, cc = c & 31, ob = rr * 64 + cc * 2; return st * 1024 + (ob ^ (((ob >> 9) & 1) << 5)); }
__host__ __device__ __forceinline__ void stage_rc(int b, int& R, int& C) { const int st = b / 1024, sb = b % 1024, swz = sb ^ (((sb >> 9) & 1) << 5); R = (st >> 1) * 16 + swz / 64; C = (st & 1) * 32 + (swz % 64) / 2; }
__host__ __device__ __forceinline__ int perm32(int rho) { const int n = rho >> 4, i = rho & 15; return 8 * (i >> 2) + 4 * n + (i & 3); }

struct Unit { int pm, pn; };
struct Gemm { const bf16_t* A; const bf16_t* Bt; int M, N, K; };

struct StaticOrder {
    int nM, nN, nwg, G, c;
    __host__ __device__ void init(int M, int N, int G_, int c_) { nM = M / BM; nN = N / BM; nwg = nM * nN; G = G_; c = c_; }
    __host__ __device__ bool next(int i, Unit& u) const {
        const long L = (long)i * G + c; if (L >= nwg) return false;
        int wgid = (int)L; { const int q = nwg / NXCD, r = nwg % NXCD, xcd = wgid % NXCD, off = wgid / NXCD; wgid = (xcd < r ? xcd * (q + 1) : r * (q + 1) + (xcd - r) * q) + off; }
        const int nig = WGM * nN, gid = wgid / nig, fm = gid * WGM, gsz = (nM - fm) < WGM ? (nM - fm) : WGM;
        u.pm = fm + ((wgid % nig) % gsz); u.pn = (wgid % nig) / gsz; return true;
    }
    __device__ __forceinline__ void a_ready(const Unit&) const {}
    __device__ __forceinline__ void done(const Unit&) const {}
};

__device__ __forceinline__ unsigned cvt_pk_bf16(float lo, float hi) { unsigned r; asm volatile("v_cvt_pk_bf16_f32 %0, %1, %2" : "=v"(r) : "v"(lo), "v"(hi)); return r; }
template <class Epi, class Sched, bool ALIGN_EPI = false, bool SP2 = false>
__device__ __forceinline__ void gemm_phase(PG8_LAS unsigned char* lds, const Gemm g, const Sched& S, const Epi& E) {
    const int tid = threadIdx.x, wid = __builtin_amdgcn_readfirstlane(tid >> 6), lane = tid & 63, wr = wid >> 2, wc = wid & 3, fr = lane & 15, fq = lane >> 4;
    const int K = g.K, nt = K / BK;
    unsigned voffA[2], voffB[2];
#pragma unroll
    for (int i = 0; i < 2; ++i) { int R, C; stage_rc(tid * 16 + i * 8192, R, C); const int Rb = Epi::PERM ? ((R & ~31) + perm32(R & 31)) : R;
        voffA[i] = (unsigned)(R * K + C) * 2u; voffB[i] = (unsigned)(Rb * K + C) * 2u; }
    const size_t kstep = (size_t)(BK * 2);
    const size_t hstep = (size_t)HALF * K * 2;
    const size_t tstep = 2 * hstep;
    const unsigned ldsw = (unsigned)wid * 1024u;
    const int aoff = lds_byte(wr * 64 + fr, fq * 8), boff = lds_byte(wc * 32 + fr, fq * 8);
#define PG8_SA(b, h) (((b) * 2 + (h)) * HTB)
#define PG8_SB(b, h) ((4 + (b) * 2 + (h)) * HTB)
#define PG8_STAGE(bufoff, gbase, voff) do { _Pragma("unroll") for (int _i = 0; _i < 2; ++_i) \
        __builtin_amdgcn_global_load_lds((const unsigned*)((const char*)(gbase) + (voff)[_i]), (PG8_LAS unsigned*)(lds + (bufoff) + ldsw + _i * 8192), 16, 0, 0); } while (0)
#define PG8_LDA(dst, b, h) do { _Pragma("unroll") for (int m = 0; m < 4; ++m) _Pragma("unroll") for (int k = 0; k < 2; ++k) dst[m][k] = *(const PG8_LAS bf16x8*)(lds + PG8_SA(b, h) + aoff + m * 2048 + k * 1024); } while (0)
#define PG8_LDB(dst, b, h) do { _Pragma("unroll") for (int n = 0; n < 2; ++n) _Pragma("unroll") for (int k = 0; k < 2; ++k) dst[n][k] = *(const PG8_LAS bf16x8*)(lds + PG8_SB(b, h) + boff + n * 2048 + k * 1024); } while (0)
#define PG8_MMA(ai, bj, At, Bt) do { __builtin_amdgcn_s_setprio(1); _Pragma("unroll") for (int m = 0; m < 4; ++m) _Pragma("unroll") for (int n = 0; n < 2; ++n) _Pragma("unroll") for (int k = 0; k < 2; ++k) \
        acc[ai][bj][m][n] = __builtin_amdgcn_mfma_f32_16x16x32_bf16(Bt[n][k], At[m][k], acc[ai][bj][m][n], 0, 0, 0); __builtin_amdgcn_s_setprio(0); } while (0)
#define PG8_WAIT_V(n) asm volatile("s_waitcnt vmcnt(" #n ")" ::: "memory")
#define PG8_WAIT_L(n) asm volatile("s_waitcnt lgkmcnt(" #n ")" ::: "memory")
#define PG8_BAR __builtin_amdgcn_s_barrier()
#define PG8_SCHED __builtin_amdgcn_sched_barrier(0)
    Unit cur, nxt; int ui = 0;
    if (!S.next(0, cur)) return;
    f32x4 acc[2][2][4][2];
#pragma unroll
    for (int a = 0; a < 2; ++a)
#pragma unroll
        for (int b = 0; b < 2; ++b)
#pragma unroll
            for (int m = 0; m < 4; ++m)
#pragma unroll
                for (int n = 0; n < 2; ++n) acc[a][b][m][n] = (f32x4){0.f, 0.f, 0.f, 0.f};
    bf16x8 At[4][2], B0[2][2], B1[2][2];
    const char* cA = (const char*)g.A + (size_t)cur.pm * tstep; const char* cB = (const char*)g.Bt + (size_t)cur.pn * tstep;
    S.a_ready(cur);
    if constexpr (SP2) {
        PG8_STAGE(PG8_SB(0, 0), cB, voffB); PG8_STAGE(PG8_SB(0, 1), cB + hstep, voffB); PG8_STAGE(PG8_SA(0, 0), cA, voffA); PG8_STAGE(PG8_SA(0, 1), cA + hstep, voffA);
        if (wr == 1) PG8_BAR;
        PG8_WAIT_V(2); PG8_BAR;
        PG8_STAGE(PG8_SB(1, 0), cB + kstep, voffB); PG8_STAGE(PG8_SA(1, 0), cA + kstep, voffA); PG8_STAGE(PG8_SB(1, 1), cB + hstep + kstep, voffB);
        PG8_WAIT_V(6); PG8_BAR;
    } else {
        PG8_STAGE(PG8_SB(0, 0), cB, voffB); PG8_STAGE(PG8_SA(0, 0), cA, voffA); PG8_STAGE(PG8_SB(0, 1), cB + hstep, voffB); PG8_STAGE(PG8_SA(0, 1), cA + hstep, voffA);
        if (wr == 1) PG8_BAR;
        PG8_WAIT_V(4); PG8_BAR;
        PG8_STAGE(PG8_SB(1, 0), cB + kstep, voffB); PG8_STAGE(PG8_SA(1, 0), cA + kstep, voffA); PG8_STAGE(PG8_SB(1, 1), cB + hstep + kstep, voffB);
        PG8_WAIT_V(6); PG8_BAR;
    }
    for (;;) {
        const bool has_next = S.next(ui + 1, nxt);
        const char* nA = has_next ? (const char*)g.A + (size_t)nxt.pm * tstep : cA; const char* nB = has_next ? (const char*)g.Bt + (size_t)nxt.pn * tstep : cB;
        for (int t = 0; t < nt; t += 2) {
            const bool last = (t == nt - 2);
            const char* a1 = cA + (size_t)(t + 1) * kstep;
            const char* a2 = last ? nA : cA + (size_t)(t + 2) * kstep; const char* b2 = last ? nB : cB + (size_t)(t + 2) * kstep;
            const char* a3 = a2 + kstep; const char* b3 = b2 + kstep;
            if (last && has_next) S.a_ready(nxt);
            if constexpr (SP2) {
            PG8_LDB(B0, 0, 0); PG8_LDB(B1, 0, 1); PG8_SCHED; PG8_LDA(At, 0, 0); PG8_STAGE(PG8_SA(1, 1), a1 + hstep, voffA);
            PG8_WAIT_V(8); PG8_WAIT_L(0); PG8_BAR; PG8_MMA(0, 0, At, B0); PG8_MMA(0, 1, At, B1); PG8_BAR; PG8_SCHED;
            PG8_LDA(At, 0, 1); PG8_STAGE(PG8_SB(0, 0), b2, voffB); PG8_STAGE(PG8_SB(0, 1), b2 + hstep, voffB); PG8_STAGE(PG8_SA(0, 0), a2, voffA);
            PG8_WAIT_V(8); PG8_WAIT_L(0); PG8_BAR; PG8_MMA(1, 0, At, B0); PG8_MMA(1, 1, At, B1); PG8_BAR; PG8_SCHED;
            PG8_LDB(B0, 1, 0); PG8_LDB(B1, 1, 1); PG8_SCHED; PG8_LDA(At, 1, 0); PG8_STAGE(PG8_SA(0, 1), a2 + hstep, voffA);
            PG8_WAIT_V(8); PG8_WAIT_L(0); PG8_BAR; PG8_MMA(0, 0, At, B0); PG8_MMA(0, 1, At, B1); PG8_BAR; PG8_SCHED;
            PG8_LDA(At, 1, 1); PG8_STAGE(PG8_SB(1, 0), b3, voffB); PG8_STAGE(PG8_SB(1, 1), b3 + hstep, voffB); PG8_STAGE(PG8_SA(1, 0), a3, voffA);
            PG8_WAIT_V(8); PG8_WAIT_L(0); PG8_BAR; PG8_MMA(1, 0, At, B0); PG8_MMA(1, 1, At, B1); PG8_BAR; PG8_SCHED;
            } else {
            PG8_LDB(B0, 0, 0); PG8_SCHED; PG8_LDA(At, 0, 0); PG8_STAGE(PG8_SA(1, 1), a1 + hstep, voffA);
            PG8_WAIT_L(8); PG8_BAR; PG8_WAIT_L(0); PG8_MMA(0, 0, At, B0); PG8_BAR; PG8_SCHED;
            PG8_LDB(B1, 0, 1); PG8_STAGE(PG8_SB(0, 0), b2, voffB);
            PG8_BAR; PG8_WAIT_L(0); PG8_MMA(0, 1, At, B1); PG8_BAR;
            PG8_LDA(At, 0, 1); PG8_STAGE(PG8_SA(0, 0), a2, voffA);
            PG8_BAR; PG8_WAIT_L(0); PG8_MMA(1, 0, At, B0); PG8_BAR; PG8_SCHED;
            PG8_STAGE(PG8_SB(0, 1), b2 + hstep, voffB);
            PG8_WAIT_V(6); PG8_BAR; PG8_MMA(1, 1, At, B1); PG8_BAR;
            PG8_LDB(B0, 1, 0); PG8_SCHED; PG8_LDA(At, 1, 0); PG8_STAGE(PG8_SA(0, 1), a2 + hstep, voffA);
            PG8_WAIT_L(8); PG8_BAR; PG8_WAIT_L(0); PG8_MMA(0, 0, At, B0); PG8_BAR; PG8_SCHED;
            PG8_LDB(B1, 1, 1); PG8_STAGE(PG8_SB(1, 0), b3, voffB);
            PG8_BAR; PG8_WAIT_L(0); PG8_MMA(0, 1, At, B1); PG8_BAR;
            PG8_LDA(At, 1, 1); PG8_STAGE(PG8_SA(1, 0), a3, voffA);
            PG8_BAR; PG8_WAIT_L(0); PG8_MMA(1, 0, At, B0); PG8_BAR; PG8_SCHED;
            PG8_STAGE(PG8_SB(1, 1), b3 + hstep, voffB);
            PG8_WAIT_V(6); PG8_BAR; PG8_MMA(1, 1, At, B1); PG8_BAR;
            }
        }
        if constexpr (ALIGN_EPI) { if (wr == 0) PG8_BAR; }
        if constexpr (!Epi::AFTER_DRAIN) { E(acc, cur, wr, wc, fr, fq); S.done(cur); }
        if (!has_next) break;
#pragma unroll
        for (int a = 0; a < 2; ++a)
#pragma unroll
            for (int b = 0; b < 2; ++b)
#pragma unroll
                for (int m = 0; m < 4; ++m)
#pragma unroll
                    for (int n = 0; n < 2; ++n) acc[a][b][m][n] = (f32x4){0.f, 0.f, 0.f, 0.f};
        cur = nxt; cA = nA; cB = nB; ++ui;
        if constexpr (ALIGN_EPI) { if (wr == 1) PG8_BAR; }
    }
    PG8_WAIT_V(0);
    if constexpr (!ALIGN_EPI) { if (wr == 0) PG8_BAR; }
    PG8_BAR;
    if constexpr (Epi::AFTER_DRAIN) { E.fused(acc, cur, wr, wc, fr, fq, lds, wid, lane); S.done(cur); }
#undef PG8_SA
#undef PG8_SB
#undef PG8_STAGE
#undef PG8_LDA
#undef PG8_LDB
#undef PG8_MMA
#undef PG8_WAIT_V
#undef PG8_WAIT_L
#undef PG8_BAR
#undef PG8_SCHED
}
}


using pg8::f32x4; using pg8::u32x4; using pg8::Unit; using pg8::HALF; using pg8::BM;
typedef unsigned u32x2 __attribute__((ext_vector_type(2)));

struct EpiIn {
  static constexpr bool PERM = true, AFTER_DRAIN = false;
  bf16_t* qkv; bf16_t* rest; const float* rowss; const float* bias;
  __device__ __forceinline__ void operator()(const f32x4 (&acc)[2][2][4][2], const Unit& u, int wr, int wc, int fr, int fq) const {
    const int row0 = u.pm * BM + wr * 64 + fr;
    const int seg = seg_of_row(u.pm * BM);
    int colt = u.pn * BM; bf16_t* base = qkv; int ldc = NQKV;
    if (colt >= NQKV) { base = rest; ldc = NREST; colt -= NQKV; }
    const int col0 = colt + wc * 32 + 8 * fq, bcol0 = seg * NCOLS + u.pn * BM + wc * 32 + 8 * fq;
    f32x4 bv[2][2];
#pragma unroll
    for (int bj = 0; bj < 2; ++bj)
#pragma unroll
      for (int n = 0; n < 2; ++n) bv[bj][n] = *(const f32x4*)(bias + bcol0 + bj * HALF + 4 * n);
#pragma unroll
    for (int ai = 0; ai < 2; ++ai)
#pragma unroll
      for (int m = 0; m < 4; ++m) {
        const int r = row0 + ai * HALF + m * 16;
        const float rinv = rsqrtf(rowss[r] * (1.0f / 1024.0f) + 1e-6f);
        bf16_t* rowp = base + (size_t)r * ldc + col0;
#pragma unroll
        for (int bj = 0; bj < 2; ++bj) {
          const f32x4 v0 = acc[ai][bj][m][0] * rinv + bv[bj][0], v1 = acc[ai][bj][m][1] * rinv + bv[bj][1];
          u32x4 w; w.x = pg8::cvt_pk_bf16(v0[0], v0[1]); w.y = pg8::cvt_pk_bf16(v0[2], v0[3]); w.z = pg8::cvt_pk_bf16(v1[0], v1[1]); w.w = pg8::cvt_pk_bf16(v1[2], v1[3]);
          *(u32x4*)(rowp + bj * HALF) = w;
        }
      }
  }
};

struct EpiRes {
  static constexpr bool PERM = false, AFTER_DRAIN = false;
  float* X; const float* gate; float* rowss; bf16_t* xa; const float* An;
  __device__ __forceinline__ void operator()(const f32x4 (&acc)[2][2][4][2], const Unit& u, int wr, int wc, int fr, int fq) const {
    const int row0 = u.pm * BM + wr * 64 + fr, col0 = u.pn * BM + wc * 32 + 4 * fq;
    const int seg = seg_of_row(u.pm * BM);
    f32x4 gv[2][2], av[2][2];
#pragma unroll
    for (int bj = 0; bj < 2; ++bj)
#pragma unroll
      for (int n = 0; n < 2; ++n) {
        gv[bj][n] = *(const f32x4*)(gate + seg * 6144 + col0 + bj * HALF + n * 16);
        av[bj][n] = xa ? *(const f32x4*)(An + seg * 1024 + col0 + bj * HALF + n * 16) : (f32x4){0.f, 0.f, 0.f, 0.f};
      }
#pragma unroll
    for (int ai = 0; ai < 2; ++ai)
#pragma unroll
      for (int m = 0; m < 4; ++m) {
        const int r = row0 + ai * HALF + m * 16;
        float* xrow = X + (size_t)r * 1024 + col0;
        float ss = 0.f;
#pragma unroll
        for (int bj = 0; bj < 2; ++bj)
#pragma unroll
          for (int n = 0; n < 2; ++n) {
            const f32x4 xo = *(const f32x4*)(xrow + bj * HALF + n * 16);
            const f32x4 xn = xo + gv[bj][n] * acc[ai][bj][m][n];
            *(f32x4*)(xrow + bj * HALF + n * 16) = xn;
            ss += (xn[0] * xn[0] + xn[1] * xn[1]) + (xn[2] * xn[2] + xn[3] * xn[3]);
            if (xa) {
              const f32x4 t = xn * av[bj][n];
              u32x2 w; w.x = pg8::cvt_pk_bf16(t[0], t[1]); w.y = pg8::cvt_pk_bf16(t[2], t[3]);
              *(u32x2*)(xa + (size_t)r * 1024 + col0 + bj * HALF + n * 16) = w;
            }
          }
        ss += __shfl_xor(ss, 16); ss += __shfl_xor(ss, 32);
        if (fq == 0) atomicAdd(rowss + r, ss);
      }
  }
};

struct EpiGu {
  static constexpr bool PERM = true, AFTER_DRAIN = false;
  bf16_t* act; const float* rowss; const float* bias;
  __device__ __forceinline__ void operator()(const f32x4 (&acc)[2][2][4][2], const Unit& u, int wr, int wc, int fr, int fq) const {
    const int row0 = u.pm * BM + wr * 64 + fr;
    const int seg = seg_of_row(u.pm * BM);
    const int hid0 = u.pn * HALF + wc * 32 + 8 * fq, bcol0 = seg * (2 * FFH) + u.pn * BM + wc * 32 + 8 * fq;
    f32x4 bv[2][2];
#pragma unroll
    for (int bj = 0; bj < 2; ++bj)
#pragma unroll
      for (int n = 0; n < 2; ++n) bv[bj][n] = *(const f32x4*)(bias + bcol0 + bj * HALF + 4 * n);
#pragma unroll
    for (int ai = 0; ai < 2; ++ai)
#pragma unroll
      for (int m = 0; m < 4; ++m) {
        const int r = row0 + ai * HALF + m * 16;
        const float rinv = rsqrtf(rowss[r] * (1.0f / 1024.0f) + 1e-6f);
        float o[8];
#pragma unroll
        for (int n = 0; n < 2; ++n) {
          const f32x4 g = acc[ai][0][m][n] * rinv + bv[0][n], up = acc[ai][1][m][n] * rinv + bv[1][n];
#pragma unroll
          for (int j = 0; j < 4; ++j) o[n * 4 + j] = g[j] / (1.f + __expf(-g[j])) * up[j];
        }
        u32x4 w; w.x = pg8::cvt_pk_bf16(o[0], o[1]); w.y = pg8::cvt_pk_bf16(o[2], o[3]); w.z = pg8::cvt_pk_bf16(o[4], o[5]); w.w = pg8::cvt_pk_bf16(o[6], o[7]);
        *(u32x4*)(act + (size_t)r * FFH + hid0) = w;
      }
  }
};

template <class Epi>
__global__ __launch_bounds__(512, 2) void k_gemm(pg8::Gemm g, Epi E) {
  extern __shared__ __attribute__((aligned(16))) unsigned char smem[];
  pg8::StaticOrder S; S.init(g.M, g.N, gridDim.x, blockIdx.x);
  pg8::gemm_phase<Epi, pg8::StaticOrder, true, true>((PG8_LAS unsigned char*)smem, g, S, E);
}

__global__ __launch_bounds__(256) void k_mod(const float* __restrict__ c, const float* __restrict__ c_ctx,
                                             const float* __restrict__ w_mod, const float* __restrict__ b_mod,
                                             float* __restrict__ mods) {
  __shared__ float sv[3][1024];
  const int e = blockIdx.x * 256 + threadIdx.x, l = blockIdx.y;
  for (int i = threadIdx.x; i < 1024; i += 256) {
    sv[0][i] = silu_f(c_ctx[i]); sv[1][i] = silu_f(c[i]); sv[2][i] = silu_f(c[1024 + i]);
  }
  __syncthreads();
  const float* w = w_mod + (size_t)l * 1024 * 6144 + e;
  float a0 = 0.f, a1 = 0.f, a2 = 0.f;
#pragma unroll 8
  for (int d = 0; d < 1024; ++d) {
    const float wv = w[(size_t)d * 6144];
    a0 += sv[0][d] * wv; a1 += sv[1][d] * wv; a2 += sv[2][d] * wv;
  }
  const float b = b_mod[l * 6144 + e];
  mods[(l * 3 + 0) * 6144 + e] = a0 + b;
  mods[(l * 3 + 1) * 6144 + e] = a1 + b;
  mods[(l * 3 + 2) * 6144 + e] = a2 + b;
}

__device__ __forceinline__ int win_srccol(int j) { return j < 2048 ? j : j + 16; }
__device__ __forceinline__ int wgu_srccol(int j) { const int pn = j >> 8, w = j & 255; return w < 128 ? pn * 128 + w : FFH + pn * 128 + (w - 128); }

__device__ __forceinline__ void transpose_tile(const float* __restrict__ src, int ldsrc, int srccol0, bf16_t* __restrict__ dst, int K, int j0, int k0, float* tile, int t) {
  const int jl = t & 63, kg = t >> 6;
#pragma unroll
  for (int i = 0; i < 16; ++i) { const int k = kg * 16 + i; tile[jl * 65 + k] = src[(size_t)(k0 + k) * ldsrc + srccol0 + jl]; }
  __syncthreads();
  const int j = t >> 2, kc = (t & 3) * 16;
  const float* s = tile + j * 65 + kc;
  u32x4 o0, o1;
  o0.x = (unsigned)f2bf(s[0]) | ((unsigned)f2bf(s[1]) << 16); o0.y = (unsigned)f2bf(s[2]) | ((unsigned)f2bf(s[3]) << 16);
  o0.z = (unsigned)f2bf(s[4]) | ((unsigned)f2bf(s[5]) << 16); o0.w = (unsigned)f2bf(s[6]) | ((unsigned)f2bf(s[7]) << 16);
  o1.x = (unsigned)f2bf(s[8]) | ((unsigned)f2bf(s[9]) << 16); o1.y = (unsigned)f2bf(s[10]) | ((unsigned)f2bf(s[11]) << 16);
  o1.z = (unsigned)f2bf(s[12]) | ((unsigned)f2bf(s[13]) << 16); o1.w = (unsigned)f2bf(s[14]) | ((unsigned)f2bf(s[15]) << 16);
  bf16_t* d = dst + (size_t)(j0 + j) * K + k0 + kc;
  *(u32x4*)d = o0; *(u32x4*)(d + 8) = o1;
  __syncthreads();
}

#define WT_IN 0
#define WT_OUT (2816 * 1024)
#define WT_GU (WT_OUT + 1024 * 1024)
#define WT_DOWN (WT_GU + 5632 * 1024)
#define WT_LAYER (WT_DOWN + 1024 * 2816)

__global__ __launch_bounds__(256) void k_wconv(const float* __restrict__ w_in, const float* __restrict__ w_out, const float* __restrict__ w_gu,
                                               const float* __restrict__ w_down, bf16_t* __restrict__ WT) {
  __shared__ float tile[64 * 65];
  const int t = threadIdx.x;
  for (int it = blockIdx.x; it < 2 * 3072; it += gridDim.x) {
    const int l = it / 3072; int r = it % 3072;
    bf16_t* wt = WT + (size_t)l * WT_LAYER;
    if (r < 704) { const int kt = r / 44, jt = r % 44; transpose_tile(w_in + (size_t)l * 1024 * INC, INC, win_srccol(jt * 64), wt + WT_IN, 1024, jt * 64, kt * 64, tile, t); continue; }
    r -= 704;
    if (r < 256) { const int kt = r / 16, jt = r % 16; transpose_tile(w_out + (size_t)l * 1024 * 1024, 1024, jt * 64, wt + WT_OUT, 1024, jt * 64, kt * 64, tile, t); continue; }
    r -= 256;
    if (r < 1408) { const int kt = r / 88, jt = r % 88; transpose_tile(w_gu + (size_t)l * 1024 * 2 * FFH, 2 * FFH, wgu_srccol(jt * 64), wt + WT_GU, 1024, jt * 64, kt * 64, tile, t); continue; }
    r -= 1408;
    { const int kt = r / 16, jt = r % 16; transpose_tile(w_down + (size_t)l * FFH * 1024, 1024, jt * 64, wt + WT_DOWN, FFH, jt * 64, kt * 64, tile, t); }
  }
}

__global__ __launch_bounds__(256) void k_vecs(const float* __restrict__ mods, const float* __restrict__ norm1_g, const float* __restrict__ norm2_g,
                                              const float* __restrict__ w_in, const float* __restrict__ w_gu,
                                              float* __restrict__ AV, float* __restrict__ BIN, float* __restrict__ BGU, float* __restrict__ BLOG) {
  __shared__ float sh[3][1024];
  const int l = blockIdx.y, t = threadIdx.x;
  const int NB_IN = 11, NB_GU = 22, NB_LOG = 1, NB_A = 8;
  int b = blockIdx.x;
  if (b >= NB_IN + NB_GU + NB_LOG) {
    const int idx = (b - (NB_IN + NB_GU + NB_LOG)) * 256 + t; const int n = idx >> 10, d = idx & 1023;
    const float g = n ? norm2_g[l * 1024 + d] : norm1_g[l * 1024 + d];
#pragma unroll
    for (int s = 0; s < 3; ++s) AV[((l * 2 + n) * 3 + s) * 1024 + d] = g * (1.f + mods[(l * 3 + s) * 6144 + (n ? 4096 : 1024) + d]);
    return;
  }
  const bool is_gu = (b >= NB_IN && b < NB_IN + NB_GU);
  const int sh_off = is_gu ? 3072 : 0;
  for (int i = t; i < 1024; i += 256) {
#pragma unroll
    for (int s = 0; s < 3; ++s) sh[s][i] = mods[(l * 3 + s) * 6144 + sh_off + i];
  }
  __syncthreads();
  const float* w; int ld; float* outp; int ostride;
  if (b < NB_IN) { const int j = b * 256 + t; w = w_in + (size_t)l * 1024 * INC + win_srccol(j); ld = INC; outp = BIN + l * 3 * NCOLS + j; ostride = NCOLS; }
  else if (is_gu) { const int j = (b - NB_IN) * 256 + t; w = w_gu + (size_t)l * 1024 * 2 * FFH + wgu_srccol(j); ld = 2 * FFH; outp = BGU + l * 3 * 2 * FFH + j; ostride = 2 * FFH; }
  else { if (t >= 16) return; w = w_in + (size_t)l * 1024 * INC + 2048 + t; ld = INC; outp = BLOG + l * 3 * 16 + t; ostride = 16; }
  float a0 = 0.f, a1 = 0.f, a2 = 0.f;
#pragma unroll 8
  for (int d = 0; d < 1024; ++d) { const float wv = w[(size_t)d * ld]; a0 += sh[0][d] * wv; a1 += sh[1][d] * wv; a2 += sh[2][d] * wv; }
  outp[0] = a0; outp[ostride] = a1; outp[2 * ostride] = a2;
}

__global__ __launch_bounds__(256) void k_prepx(const float* __restrict__ xp, const float* __restrict__ xs, const float* __restrict__ AV0,
                                               float* __restrict__ X, float* __restrict__ rowss0, bf16_t* __restrict__ XA) {
  const int r = blockIdx.x * 4 + (threadIdx.x >> 6), lane = threadIdx.x & 63;
  const int seg = seg_of_row(r);
  float ss = 0.f;
#pragma unroll
  for (int i = 0; i < 4; ++i) {
    const int d = i * 256 + lane * 4;
    f32x4 v;
    if (r < NCTX) v = *(const f32x4*)(xp + (size_t)r * 1024 + d);
    else {
      const int rl = r - NCTX, p = rl & 2047, row = p >> 6, col = p & 63;
      v = *(const f32x4*)(xs + (size_t)rl * 1024 + d);
#pragma unroll
      for (int j = 0; j < 4; ++j) {
        const int dd = d + j, q = dd >> 8, jj = dd & 255;
        const float omega = 1.0f / powf(10000.0f, (float)jj / 256.0f);
        const float ang = (q < 2 ? (float)row : (float)col) * omega;
        v[j] += (q & 1) ? cosf(ang) : sinf(ang);
      }
    }
    *(f32x4*)(X + (size_t)r * 1024 + d) = v;
    ss += (v[0] * v[0] + v[1] * v[1]) + (v[2] * v[2] + v[3] * v[3]);
    const f32x4 a = *(const f32x4*)(AV0 + seg * 1024 + d);
    u32x2 w; w.x = (unsigned)f2bf(v[0] * a[0]) | ((unsigned)f2bf(v[1] * a[1]) << 16); w.y = (unsigned)f2bf(v[2] * a[2]) | ((unsigned)f2bf(v[3] * a[3]) << 16);
    *(u32x2*)(XA + (size_t)r * 1024 + d) = w;
  }
  ss = wave_sum(ss);
  if (lane == 0) rowss0[r] = ss;
}

__global__ __launch_bounds__(256) void k_logits(const float* __restrict__ X, const float* __restrict__ rowss, const float* __restrict__ A1,
                                                const float* __restrict__ w_in_l, const float* __restrict__ blog, float* __restrict__ LOG) {
  const int r = blockIdx.x * 4 + (threadIdx.x >> 6), lane = threadIdx.x & 63;
  const int seg = seg_of_row(r);
  float acc[16];
#pragma unroll
  for (int j = 0; j < 16; ++j) acc[j] = 0.f;
#pragma unroll 4
  for (int i = 0; i < 16; ++i) {
    const int d = lane + 64 * i;
    const float xv = X[(size_t)r * 1024 + d] * A1[seg * 1024 + d];
    const float* w = w_in_l + (size_t)d * INC + 2048;
#pragma unroll
    for (int q = 0; q < 4; ++q) { const f32x4 wv = *(const f32x4*)(w + 4 * q); acc[4 * q] += xv * wv[0]; acc[4 * q + 1] += xv * wv[1]; acc[4 * q + 2] += xv * wv[2]; acc[4 * q + 3] += xv * wv[3]; }
  }
  float mine = 0.f;
#pragma unroll
  for (int j = 0; j < 16; ++j) { const float s = wave_sum(acc[j]); if (lane == j) mine = s; }
  if (lane < 16) {
    const float rinv = rsqrtf(rowss[r] * (1.0f / 1024.0f) + 1e-6f);
    LOG[(size_t)r * 16 + lane] = mine * rinv + blog[seg * 16 + lane];
  }
}

__global__ __launch_bounds__(256) void k_final(const float* __restrict__ X, const float* __restrict__ rowss, const float* __restrict__ g, float* __restrict__ out) {
  const size_t i = ((size_t)blockIdx.x * 256 + threadIdx.x) * 4;
  const int r = (int)(i >> 10), d = (int)(i & 1023);
  const float rinv = rsqrtf(rowss[r] * (1.0f / 1024.0f) + 1e-6f);
  const f32x4 v = *(const f32x4*)(X + i), gg = *(const f32x4*)(g + d);
  *(f32x4*)(out + i) = v * rinv * gg;
}

__global__ __launch_bounds__(256) void k_conv_prep(const bf16_t* __restrict__ QKV, const float* __restrict__ LOG,
                                                   const float* __restrict__ conv_w, const float* __restrict__ a_log,
                                                   const float* __restrict__ dt_bias, bf16_t* __restrict__ Qn, bf16_t* __restrict__ Kn,
                                                   bf16_t* __restrict__ Vc, float* __restrict__ beta, float* __restrict__ gdec) {
  __shared__ float part[4][4];
  const int r = blockIdx.x, tid = threadIdx.x, w = tid >> 6;
  int s0, len;
  if (r < NCTX) { s0 = r & ~255; len = 256; } else { s0 = NCTX + ((r - NCTX) & ~2047); len = 2048; }
  const int t = r - s0;
  const bool hp = t > 0, hn = t < len - 1;
  float vals[6];
#pragma unroll
  for (int i = 0; i < 6; ++i) {
    const int c = tid + 256 * i;
    const float xm = hp ? bf2f(QKV[(size_t)(r - 1) * NQKV + c]) : 0.f;
    const float x0 = bf2f(QKV[(size_t)r * NQKV + c]);
    const float xp = hn ? bf2f(QKV[(size_t)(r + 1) * NQKV + c]) : 0.f;
    const float y = conv_w[c] * xm + conv_w[NQKV + c] * x0 + conv_w[2 * NQKV + c] * xp;
    vals[i] = silu_f(y);
  }
#pragma unroll
  for (int i = 0; i < 4; ++i) {
    const float s = wave_sum(vals[i] * vals[i]);
    if ((tid & 63) == 0) part[i][w] = s;
  }
  __syncthreads();
#pragma unroll
  for (int i = 0; i < 4; ++i) {
    const float s = part[i][w & ~1] + part[i][w | 1];
    const float rn = rsqrtf(s + 1e-6f);
    const int c = tid + 256 * i;
    if (i < 2) Qn[(size_t)r * 512 + c] = f2bf(vals[i] * rn * 0.08838834764831845f);
    else Kn[(size_t)r * 512 + (c - 512)] = f2bf(vals[i] * rn);
  }
  Vc[(size_t)r * 512 + tid] = f2bf(vals[4]);
  Vc[(size_t)r * 512 + tid + 256] = f2bf(vals[5]);
  if (tid < 8) {
    const float bl = LOG[(size_t)r * 16 + tid];
    const float al = LOG[(size_t)r * 16 + 8 + tid];
    beta[(size_t)r * 8 + tid] = sigmoid_f(bl);
    gdec[(size_t)r * 8 + tid] = -expf(a_log[tid]) * softplus_f(al + dt_bias[tid]);
  }
}

__global__ __launch_bounds__(128) void k_scan(const bf16_t* __restrict__ Qn, const bf16_t* __restrict__ Kn, const bf16_t* __restrict__ Vc,
                                              const float* __restrict__ beta, const float* __restrict__ gdec,
                                              const float* __restrict__ state_in, bf16_t* __restrict__ O, float* __restrict__ state_out, int layer) {
  __shared__ float sk[16][128];
  __shared__ float sq[16][128];
  __shared__ float sv[16][128];
  __shared__ float sb[16], sa[16];
  const int blk = blockIdx.x, e = threadIdx.x;
  int b, h, d, row0, len; const bool ctx = blk < 256;
  if (ctx) { b = blk >> 3; h = (blk >> 1) & 3; d = blk & 1; row0 = b * 256; len = 256; }
  else { const int q = blk - 256; b = q >> 3; h = (q >> 1) & 3; d = q & 1; row0 = NCTX + b * 2048; len = 2048; }
  float S[128];
  if (ctx) {
#pragma unroll
    for (int k = 0; k < 128; ++k) S[k] = 0.f;
  } else {
    const float* s0 = state_in + ((((size_t)b * 2 + layer) * 2 + d) * 4 + h) * 16384;
#pragma unroll
    for (int k = 0; k < 128; ++k) S[k] = s0[k * 128 + e];
  }
  for (int t0 = 0; t0 < len; t0 += 16) {
    __syncthreads();
    for (int j = 0; j < 16; ++j) {
      const int t = t0 + j; const int pos = d ? (len - 1 - t) : t; const size_t r = (size_t)(row0 + pos);
      sk[j][e] = bf2f(Kn[r * 512 + h * 128 + e]); sq[j][e] = bf2f(Qn[r * 512 + h * 128 + e]); sv[j][e] = bf2f(Vc[r * 512 + h * 128 + e]);
    }
    if (e < 16) {
      const int t = t0 + e; const int pos = d ? (len - 1 - t) : t; const size_t r = (size_t)(row0 + pos);
      sb[e] = beta[r * 8 + d * 4 + h]; sa[e] = expf(gdec[r * 8 + d * 4 + h]);
    }
    __syncthreads();
    for (int j = 0; j < 16; ++j) {
      const float a = sa[j], bt = sb[j];
      float ks = 0.f;
#pragma unroll
      for (int k = 0; k < 128; k += 4) {
        const float4 kv = *(const float4*)&sk[j][k];
        ks += kv.x * S[k] + kv.y * S[k + 1] + kv.z * S[k + 2] + kv.w * S[k + 3];
      }
      const float vn = bt * (sv[j][e] - a * ks);
      float o = 0.f;
#pragma unroll
      for (int k = 0; k < 128; k += 4) {
        const float4 kv = *(const float4*)&sk[j][k];
        const float4 qv = *(const float4*)&sq[j][k];
        S[k] = a * S[k] + kv.x * vn; S[k + 1] = a * S[k + 1] + kv.y * vn; S[k + 2] = a * S[k + 2] + kv.z * vn; S[k + 3] = a * S[k + 3] + kv.w * vn;
        o += qv.x * S[k] + qv.y * S[k + 1] + qv.z * S[k + 2] + qv.w * S[k + 3];
      }
      const int t = t0 + j; const int pos = d ? (len - 1 - t) : t; const size_t r = (size_t)(row0 + pos);
      O[((size_t)d * NTOK + r) * 512 + h * 128 + e] = f2bf(o);
    }
  }
  if (ctx) {
    float* so = state_out + ((((size_t)b * 2 + layer) * 2 + d) * 4 + h) * 16384;
#pragma unroll
    for (int k = 0; k < 128; ++k) so[k * 128 + e] = S[k];
  }
}

__global__ __launch_bounds__(256) void k_delta_post(const bf16_t* __restrict__ O, const bf16_t* __restrict__ REST,
                                                    const float* __restrict__ norm_g, bf16_t* __restrict__ MIX) {
  __shared__ float part[2][4];
  const int r = blockIdx.x, tid = threadIdx.x, w = tid >> 6;
  float o[2];
#pragma unroll
  for (int i = 0; i < 2; ++i) {
    const int c = tid + 256 * i;
    o[i] = bf2f(O[(size_t)r * 512 + c]) + bf2f(O[((size_t)NTOK + r) * 512 + c]);
    const float s = wave_sum(o[i] * o[i]);
    if ((tid & 63) == 0) part[i][w] = s;
  }
  __syncthreads();
#pragma unroll
  for (int i = 0; i < 2; ++i) {
    const int c = tid + 256 * i;
    const float s = part[i][w & ~1] + part[i][w | 1];
    const float rn = rsqrtf(s * (1.0f / 128.0f) + 1e-6f);
    const float z = bf2f(REST[(size_t)r * NREST + c]);
    MIX[(size_t)r * 1024 + c] = f2bf(o[i] * rn * norm_g[c & 127] * silu_f(z));
  }
}

__global__ __launch_bounds__(256) void k_sgu(const bf16_t* __restrict__ REST, const float* __restrict__ norm_g,
                                             const float* __restrict__ w_s, const float* __restrict__ b_s, bf16_t* __restrict__ MIX) {
  __shared__ float vn[128][65];
  const int ch = blockIdx.x, g = blockIdx.y, tid = threadIdx.x, r0 = ch * 128;
  {
    const int p = tid >> 1, hf = tid & 1;
    const bf16_t* vrow = REST + (size_t)(r0 + p) * NREST + 768 + g * 64 + hf * 32;
    float ss = 0.f;
    for (int c = 0; c < 32; ++c) { const float x = gelu_f(bf2f(vrow[c])); ss += x * x; }
    ss += __shfl_xor(ss, 1);
    const float rinv = rsqrtf(ss * (1.0f / 64.0f) + 1e-6f);
    for (int c = 0; c < 32; ++c) vn[p][hf * 32 + c] = gelu_f(bf2f(vrow[c])) * rinv * norm_g[g * 64 + hf * 32 + c];
  }
  __syncthreads();
  const int c = tid & 63;
  for (int t = tid >> 6; t < 128; t += 4) {
    float acc = b_s[g * 128 + t];
    const float* wr = w_s + (size_t)(g * 128 + t) * 128;
    for (int s = 0; s < 128; ++s) acc += wr[s] * vn[s][c];
    const float u = gelu_f(bf2f(REST[(size_t)(r0 + t) * NREST + 512 + g * 64 + c]));
    MIX[(size_t)(r0 + t) * 1024 + 512 + g * 64 + c] = f2bf(u * acc);
  }
}

__global__ __launch_bounds__(256) void k_pool(const bf16_t* __restrict__ REST, const float* __restrict__ w_pool,
                                              const float* __restrict__ scale, bf16_t* __restrict__ MIX) {
  __shared__ float dm[64][65];
  const int blk = blockIdx.x, i = blockIdx.y, tid = threadIdx.x, r0 = blk * 64, win = 2 << i;
  int seg0, seglen;
  if (r0 < NCTX) { seg0 = r0 & ~255; seglen = 256; } else { seg0 = r0; seglen = 64; }
  const int c = tid & 63;
  for (int p = tid >> 6; p < 64; p += 4) {
    const int pos = r0 + p - seg0;
    const int lo = max(pos - win / 2, 0), hi = min(pos + win - win / 2, seglen);
    float s = 0.f;
    for (int q = lo; q < hi; ++q) s += bf2f(REST[(size_t)(seg0 + q) * NREST + 1024 + i * 64 + c]);
    const float x = bf2f(REST[(size_t)(r0 + p) * NREST + 1024 + i * 64 + c]);
    dm[p][c] = s / (float)(hi - lo) - x;
  }
  __syncthreads();
  const int dd = tid & 63;
  for (int p = tid >> 6; p < 64; p += 4) {
    float acc = 0.f;
    for (int cc = 0; cc < 64; ++cc) acc += dm[p][cc] * w_pool[(size_t)(i * 64 + cc) * 64 + dd];
    MIX[(size_t)(r0 + p) * 1024 + 768 + i * 64 + dd] = f2bf(acc * scale[i * 64 + dd]);
  }
}

static pg8::Gemm make_gemm(const bf16_t* A, const bf16_t* Bt, int M, int N, int K) { pg8::Gemm g; memset(&g, 0, sizeof g); g.A = A; g.Bt = Bt; g.M = M; g.N = N; g.K = K; return g; }
template <class Epi> static void launch_gemm(const pg8::Gemm& g, const Epi& E, hipStream_t stream) {
  static bool attr_done = false;
  if (!attr_done) { (void)hipFuncSetAttribute((const void*)k_gemm<Epi>, hipFuncAttributeMaxDynamicSharedMemorySize, pg8::STAGE_BYTES); attr_done = true; }
  hipLaunchKernelGGL(k_gemm<Epi>, dim3(256), dim3(512), pg8::STAGE_BYTES, stream, g, E);
}

extern "C" void kernel_launch(void* const* d_in, const int* in_sizes, int n_in, void* d_out, int out_size, void* d_ws, size_t ws_size,
                              hipStream_t stream) {
  const float* x_prompt = (const float*)d_in[0];
  const float* x_sample = (const float*)d_in[1];
  const float* state_delta = (const float*)d_in[2];
  const float* c = (const float*)d_in[3];
  const float* c_ctx = (const float*)d_in[4];
  const float* w_in = (const float*)d_in[5];
  const float* conv_w = (const float*)d_in[6];
  const float* a_log = (const float*)d_in[7];
  const float* dt_bias = (const float*)d_in[8];
  const float* delta_norm_g = (const float*)d_in[9];
  const float* sgu_norm_g = (const float*)d_in[10];
  const float* w_spatial = (const float*)d_in[11];
  const float* b_spatial = (const float*)d_in[12];
  const float* w_pool = (const float*)d_in[13];
  const float* pool_scale = (const float*)d_in[14];
  const float* w_out = (const float*)d_in[15];
  const float* norm1_g = (const float*)d_in[16];
  const float* norm2_g = (const float*)d_in[17];
  const float* w_mod = (const float*)d_in[18];
  const float* b_mod = (const float*)d_in[19];
  const float* w_gu = (const float*)d_in[20];
  const float* w_down = (const float*)d_in[21];
  const float* norm_f = (const float*)d_in[22];
  float* out = (float*)d_out;
  char* ws = (char*)d_ws;
  size_t off = 0;
  float* X = (float*)(ws + off); off += (size_t)NTOK * 1024 * 4;
  bf16_t* WT = (bf16_t*)(ws + off); off += (size_t)2 * WT_LAYER * 2;
  bf16_t* QKV = (bf16_t*)(ws + off); off += (size_t)NTOK * NQKV * 2;
  bf16_t* REST = (bf16_t*)(ws + off); off += (size_t)NTOK * NREST * 2;
  bf16_t* ACT = QKV;
  bf16_t* OB = QKV;
  bf16_t* XA = (bf16_t*)(ws + off);
  bf16_t* Qn = XA; bf16_t* Kn = Qn + (size_t)NTOK * 512; bf16_t* Vc = Kn + (size_t)NTOK * 512;
  off += (size_t)NTOK * 1536 * 2;
  bf16_t* MIXB = (bf16_t*)(ws + off); off += (size_t)NTOK * 1024 * 2;
  float* mods = (float*)(ws + off); off += 2 * 3 * 6144 * 4;
  float* AV = (float*)(ws + off); off += 2 * 2 * 3 * 1024 * 4;
  float* BIN = (float*)(ws + off); off += 2 * 3 * NCOLS * 4;
  float* BGU = (float*)(ws + off); off += 2 * 3 * 2 * FFH * 4;
  float* BLOG = (float*)(ws + off); off += 2 * 3 * 16 * 4 + 128;
  float* rowss = (float*)(ws + off); off += 5 * NTOK * 4;
  float* LOG = (float*)(ws + off); off += (size_t)NTOK * 16 * 4;
  float* beta = (float*)(ws + off); off += (size_t)NTOK * 8 * 4;
  float* gdec = (float*)(ws + off); off += (size_t)NTOK * 8 * 4;
  float* states_out = out + (size_t)NTOK * 1024;
  if (off > ws_size) { fprintf(stderr, "workspace too small: need %zu have %zu\n", off, ws_size); return; }

  (void)hipMemsetAsync(rowss, 0, 5 * NTOK * 4, stream);
  k_wconv<<<1024, 256, 0, stream>>>(w_in, w_out, w_gu, w_down, WT);
  k_mod<<<dim3(24, 2), 256, 0, stream>>>(c, c_ctx, w_mod, b_mod, mods);
  k_vecs<<<dim3(11 + 22 + 1 + 8, 2), 256, 0, stream>>>(mods, norm1_g, norm2_g, w_in, w_gu, AV, BIN, BGU, BLOG);
  k_prepx<<<NTOK / 4, 256, 0, stream>>>(x_prompt, x_sample, AV, X, rowss, XA);
  for (int l = 0; l < 2; ++l) {
    const float* ml = mods + l * 3 * 6144;
    const bf16_t* wt = WT + (size_t)l * WT_LAYER;
    float* rs1 = rowss + (2 * l) * NTOK; float* rs2 = rowss + (2 * l + 1) * NTOK; float* rs3 = rowss + (2 * l + 2) * NTOK;
    const float* A1 = AV + (l * 2 + 0) * 3 * 1024; const float* A2 = AV + (l * 2 + 1) * 3 * 1024;
    const float* A1n = AV + ((l + 1) * 2 + 0) * 3 * 1024;
    k_logits<<<NTOK / 4, 256, 0, stream>>>(X, rs1, A1, w_in + (size_t)l * 1024 * INC, BLOG + l * 3 * 16, LOG);
    { pg8::Gemm g = make_gemm(XA, wt + WT_IN, NTOK, NCOLS, 1024); EpiIn E{QKV, REST, rs1, BIN + l * 3 * NCOLS}; launch_gemm(g, E, stream); }
    k_conv_prep<<<NTOK, 256, 0, stream>>>(QKV, LOG, conv_w + (size_t)l * 3 * NQKV, a_log + l * 8, dt_bias + l * 8, Qn, Kn, Vc, beta, gdec);
    k_scan<<<272, 128, 0, stream>>>(Qn, Kn, Vc, beta, gdec, state_delta, OB, states_out, l);
    k_delta_post<<<NTOK, 256, 0, stream>>>(OB, REST, delta_norm_g + l * 128, MIXB);
    k_sgu<<<dim3(NTOK / 128, 4), 256, 0, stream>>>(REST, sgu_norm_g + l * 256, w_spatial + (size_t)l * 4 * 128 * 128, b_spatial + l * 4 * 128, MIXB);
    k_pool<<<dim3(NTOK / 64, 4), 256, 0, stream>>>(REST, w_pool + (size_t)l * 4 * 64 * 64, pool_scale + l * 256, MIXB);
    { pg8::Gemm g = make_gemm(MIXB, wt + WT_OUT, NTOK, 1024, 1024); EpiRes E{X, ml + 2048, rs2, XA, A2}; launch_gemm(g, E, stream); }
    { pg8::Gemm g = make_gemm(XA, wt + WT_GU, NTOK, 2 * FFH, 1024); EpiGu E{ACT, rs2, BGU + l * 3 * 2 * FFH}; launch_gemm(g, E, stream); }
    { pg8::Gemm g = make_gemm(ACT, wt + WT_DOWN, NTOK, 1024, FFH); EpiRes E{X, ml + 5120, rs3, l == 0 ? XA : (bf16_t*)nullptr, l == 0 ? A1n : A1}; launch_gemm(g, E, stream); }
  }
  k_final<<<NTOK, 256, 0, stream>>>(X, rowss + 4 * NTOK, norm_f, out);
}
```

```cpp
#include <hip/hip_runtime.h>
#include <math.h>
#include <cstdio>
#include <cstring>

#define NTOK 12288
#define NCTX 8192
#define DM 1024
#define INC 2832
#define FFH 2816
#define NQKV 1536
#define NREST 1280
#define NCOLS 2816

typedef unsigned short bf16_t;
__device__ __forceinline__ bf16_t f2bf(float f) { unsigned u = __float_as_uint(f); u += 0x7FFFu + ((u >> 16) & 1u); return (bf16_t)(u >> 16); }
__device__ __forceinline__ float bf2f(bf16_t b) { return __uint_as_float(((unsigned)b) << 16); }
__device__ __forceinline__ float silu_f(float x) { return x / (1.f + expf(-x)); }
__device__ __forceinline__ float sigmoid_f(float x) { return 1.f / (1.f + expf(-x)); }
__device__ __forceinline__ float gelu_f(float x) { return 0.5f * x * (1.f + tanhf(0.7978845608028654f * (x + 0.044715f * x * x * x))); }
__device__ __forceinline__ float softplus_f(float x) { return x > 20.f ? x : log1pf(expf(x)); }
__device__ __forceinline__ int seg_of_row(int r) { return r < NCTX ? 0 : 1 + ((r - NCTX) >> 11); }
__device__ __forceinline__ float wave_sum(float v) {
#pragma unroll
  for (int o = 32; o > 0; o >>= 1) v += __shfl_xor(v, o);
  return v;
}
namespace pg8 {
#define PG8_LAS __attribute__((address_space(3)))
typedef unsigned short bf16_t;
typedef short bf16x8 __attribute__((ext_vector_type(8)));
typedef float f32x4 __attribute__((ext_vector_type(4)));
typedef unsigned u32x4 __attribute__((ext_vector_type(4)));
constexpr int BM = 256, BK = 64, HALF = 128, HTB = HALF * BK * 2  , STAGE_BYTES = 8 * HTB, NXCD = 8, WGM = 8;

__host__ __device__ __forceinline__ int lds_byte(int r, int c) { const int st = (r >> 4) * 2 + (c >> 5), rr = r & 15, cc = c & 31, ob = rr * 64 + cc * 2; return st * 1024 + (ob ^ (((ob >> 9) & 1) << 5)); }
__host__ __device__ __forceinline__ void stage_rc(int b, int& R, int& C) { const int st = b / 1024, sb = b % 1024, swz = sb ^ (((sb >> 9) & 1) << 5); R = (st >> 1) * 16 + swz / 64; C = (st & 1) * 32 + (swz % 64) / 2; }
__host__ __device__ __forceinline__ int perm32(int rho) { const int n = rho >> 4, i = rho & 15; return 8 * (i >> 2) + 4 * n + (i & 3); }

struct Unit { int pm, pn; };
struct Gemm { const bf16_t* A; const bf16_t* Bt; int M, N, K; };

struct StaticOrder {
    int nM, nN, nwg, G, c;
    __host__ __device__ void init(int M, int N, int G_, int c_) { nM = M / BM; nN = N / BM; nwg = nM * nN; G = G_; c = c_; }
    __host__ __device__ bool next(int i, Unit& u) const {
        const long L = (long)i * G + c; if (L >= nwg) return false;
        int wgid = (int)L; { const int q = nwg / NXCD, r = nwg % NXCD, xcd = wgid % NXCD, off = wgid / NXCD; wgid = (xcd < r ? xcd * (q + 1) : r * (q + 1) + (xcd - r) * q) + off; }
        const int nig = WGM * nN, gid = wgid / nig, fm = gid * WGM, gsz = (nM - fm) < WGM ? (nM - fm) : WGM;
        u.pm = fm + ((wgid % nig) % gsz); u.pn = (wgid % nig) / gsz; return true;
    }
    __device__ __forceinline__ void a_ready(const Unit&) const {}
    __device__ __forceinline__ void done(const Unit&) const {}
};

__device__ __forceinline__ unsigned cvt_pk_bf16(float lo, float hi) { unsigned r; asm volatile("v_cvt_pk_bf16_f32 %0, %1, %2" : "=v"(r) : "v"(lo), "v"(hi)); return r; }
template <class Epi, class Sched, bool ALIGN_EPI = false, bool SP2 = false>
__device__ __forceinline__ void gemm_phase(PG8_LAS unsigned char* lds, const Gemm g, const Sched& S, const Epi& E) {
    const int tid = threadIdx.x, wid = __builtin_amdgcn_readfirstlane(tid >> 6), lane = tid & 63, wr = wid >> 2, wc = wid & 3, fr = lane & 15, fq = lane >> 4;
    const int K = g.K, nt = K / BK;
    unsigned voffA[2], voffB[2];
#pragma unroll
    for (int i = 0; i < 2; ++i) { int R, C; stage_rc(tid * 16 + i * 8192, R, C); const int Rb = Epi::PERM ? ((R & ~31) + perm32(R & 31)) : R;
        voffA[i] = (unsigned)(R * K + C) * 2u; voffB[i] = (unsigned)(Rb * K + C) * 2u; }
    const size_t kstep = (size_t)(BK * 2);
    const size_t hstep = (size_t)HALF * K * 2;
    const size_t tstep = 2 * hstep;
    const unsigned ldsw = (unsigned)wid * 1024u;
    const int aoff = lds_byte(wr * 64 + fr, fq * 8), boff = lds_byte(wc * 32 + fr, fq * 8);
#define PG8_SA(b, h) (((b) * 2 + (h)) * HTB)
#define PG8_SB(b, h) ((4 + (b) * 2 + (h)) * HTB)
#define PG8_STAGE(bufoff, gbase, voff) do { _Pragma("unroll") for (int _i = 0; _i < 2; ++_i) \
        __builtin_amdgcn_global_load_lds((const unsigned*)((const char*)(gbase) + (voff)[_i]), (PG8_LAS unsigned*)(lds + (bufoff) + ldsw + _i * 8192), 16, 0, 0); } while (0)
#define PG8_LDA(dst, b, h) do { _Pragma("unroll") for (int m = 0; m < 4; ++m) _Pragma("unroll") for (int k = 0; k < 2; ++k) dst[m][k] = *(const PG8_LAS bf16x8*)(lds + PG8_SA(b, h) + aoff + m * 2048 + k * 1024); } while (0)
#define PG8_LDB(dst, b, h) do { _Pragma("unroll") for (int n = 0; n < 2; ++n) _Pragma("unroll") for (int k = 0; k < 2; ++k) dst[n][k] = *(const PG8_LAS bf16x8*)(lds + PG8_SB(b, h) + boff + n * 2048 + k * 1024); } while (0)
#define PG8_MMA(ai, bj, At, Bt) do { __builtin_amdgcn_s_setprio(1); _Pragma("unroll") for (int m = 0; m < 4; ++m) _Pragma("unroll") for (int n = 0; n < 2; ++n) _Pragma("unroll") for (int k = 0; k < 2; ++k) \
        acc[ai][bj][m][n] = __builtin_amdgcn_mfma_f32_16x16x32_bf16(Bt[n][k], At[m][k], acc[ai][bj][m][n], 0, 0, 0); __builtin_amdgcn_s_setprio(0); } while (0)
#define PG8_WAIT_V(n) asm volatile("s_waitcnt vmcnt(" #n ")" ::: "memory")
#define PG8_WAIT_L(n) asm volatile("s_waitcnt lgkmcnt(" #n ")" ::: "memory")
#define PG8_BAR __builtin_amdgcn_s_barrier()
#define PG8_SCHED __builtin_amdgcn_sched_barrier(0)
    Unit cur, nxt; int ui = 0;
    if (!S.next(0, cur)) return;
    f32x4 acc[2][2][4][2];
#pragma unroll
    for (int a = 0; a < 2; ++a)
#pragma unroll
        for (int b = 0; b < 2; ++b)
#pragma unroll
            for (int m = 0; m < 4; ++m)
#pragma unroll
                for (int n = 0; n < 2; ++n) acc[a][b][m][n] = (f32x4){0.f, 0.f, 0.f, 0.f};
    bf16x8 At[4][2], B0[2][2], B1[2][2];
    const char* cA = (const char*)g.A + (size_t)cur.pm * tstep; const char* cB = (const char*)g.Bt + (size_t)cur.pn * tstep;
    S.a_ready(cur);
    if constexpr (SP2) {
        PG8_STAGE(PG8_SB(0, 0), cB, voffB); PG8_STAGE(PG8_SB(0, 1), cB + hstep, voffB); PG8_STAGE(PG8_SA(0, 0), cA, voffA); PG8_STAGE(PG8_SA(0, 1), cA + hstep, voffA);
        if (wr == 1) PG8_BAR;
        PG8_WAIT_V(2); PG8_BAR;
        PG8_STAGE(PG8_SB(1, 0), cB + kstep, voffB); PG8_STAGE(PG8_SA(1, 0), cA + kstep, voffA); PG8_STAGE(PG8_SB(1, 1), cB + hstep + kstep, voffB);
        PG8_WAIT_V(6); PG8_BAR;
    } else {
        PG8_STAGE(PG8_SB(0, 0), cB, voffB); PG8_STAGE(PG8_SA(0, 0), cA, voffA); PG8_STAGE(PG8_SB(0, 1), cB + hstep, voffB); PG8_STAGE(PG8_SA(0, 1), cA + hstep, voffA);
        if (wr == 1) PG8_BAR;
        PG8_WAIT_V(4); PG8_BAR;
        PG8_STAGE(PG8_SB(1, 0), cB + kstep, voffB); PG8_STAGE(PG8_SA(1, 0), cA + kstep, voffA); PG8_STAGE(PG8_SB(1, 1), cB + hstep + kstep, voffB);
        PG8_WAIT_V(6); PG8_BAR;
    }
    for (;;) {
        const bool has_next = S.next(ui + 1, nxt);
        const char* nA = has_next ? (const char*)g.A + (size_t)nxt.pm * tstep : cA; const char* nB = has_next ? (const char*)g.Bt + (size_t)nxt.pn * tstep : cB;
        for (int t = 0; t < nt; t += 2) {
            const bool last = (t == nt - 2);
            const char* a1 = cA + (size_t)(t + 1) * kstep;
            const char* a2 = last ? nA : cA + (size_t)(t + 2) * kstep; const char* b2 = last ? nB : cB + (size_t)(t + 2) * kstep;
            const char* a3 = a2 + kstep; const char* b3 = b2 + kstep;
            if (last && has_next) S.a_ready(nxt);
            if constexpr (SP2) {
            PG8_LDB(B0, 0, 0); PG8_LDB(B1, 0, 1); PG8_SCHED; PG8_LDA(At, 0, 0); PG8_STAGE(PG8_SA(1, 1), a1 + hstep, voffA);
            PG8_WAIT_V(8); PG8_WAIT_L(0); PG8_BAR; PG8_MMA(0, 0, At, B0); PG8_MMA(0, 1, At, B1); PG8_BAR; PG8_SCHED;
            PG8_LDA(At, 0, 1); PG8_STAGE(PG8_SB(0, 0), b2, voffB); PG8_STAGE(PG8_SB(0, 1), b2 + hstep, voffB); PG8_STAGE(PG8_SA(0, 0), a2, voffA);
            PG8_WAIT_V(8); PG8_WAIT_L(0); PG8_BAR; PG8_MMA(1, 0, At, B0); PG8_MMA(1, 1, At, B1); PG8_BAR; PG8_SCHED;
            PG8_LDB(B0, 1, 0); PG8_LDB(B1, 1, 1); PG8_SCHED; PG8_LDA(At, 1, 0); PG8_STAGE(PG8_SA(0, 1), a2 + hstep, voffA);
            PG8_WAIT_V(8); PG8_WAIT_L(0); PG8_BAR; PG8_MMA(0, 0, At, B0); PG8_MMA(0, 1, At, B1); PG8_BAR; PG8_SCHED;
            PG8_LDA(At, 1, 1); PG8_STAGE(PG8_SB(1, 0), b3, voffB); PG8_STAGE(PG8_SB(1, 1), b3 + hstep, voffB); PG8_STAGE(PG8_SA(1, 0), a3, voffA);
            PG8_WAIT_V(8); PG8_WAIT_L(0); PG8_BAR; PG8_MMA(1, 0, At, B0); PG8_MMA(1, 1, At, B1); PG8_BAR; PG8_SCHED;
            } else {
            PG8_LDB(B0, 0, 0); PG8_SCHED; PG8_LDA(At, 0, 0); PG8_STAGE(PG8_SA(1, 1), a1 + hstep, voffA);
            PG8_WAIT_L(8); PG8_BAR; PG8_WAIT_L(0); PG8_MMA(0, 0, At, B0); PG8_BAR; PG8_SCHED;
            PG8_LDB(B1, 0, 1); PG8_STAGE(PG8_SB(0, 0), b2, voffB);
            PG8_BAR; PG8_WAIT_L(0); PG8_MMA(0, 1, At, B1); PG8_BAR;
            PG8_LDA(At, 0, 1); PG8_STAGE(PG8_SA(0, 0), a2, voffA);
            PG8_BAR; PG8_WAIT_L(0); PG8_MMA(1, 0, At, B0); PG8_BAR; PG8_SCHED;
            PG8_STAGE(PG8_SB(0, 1), b2 + hstep, voffB);
            PG8_WAIT_V(6); PG8_BAR; PG8_MMA(1, 1, At, B1); PG8_BAR;
            PG8_LDB(B0, 1, 0); PG8_SCHED; PG8_LDA(At, 1, 0); PG8_STAGE(PG8_SA(0, 1), a2 + hstep, voffA);
            PG8_WAIT_L(8); PG8_BAR; PG8_WAIT_L(0); PG8_MMA(0, 0, At, B0); PG8_BAR; PG8_SCHED;
            PG8_LDB(B1, 1, 1); PG8_STAGE(PG8_SB(1, 0), b3, voffB);
            PG8_BAR; PG8_WAIT_L(0); PG8_MMA(0, 1, At, B1); PG8_BAR;
            PG8_LDA(At, 1, 1); PG8_STAGE(PG8_SA(1, 0), a3, voffA);
            PG8_BAR; PG8_WAIT_L(0); PG8_MMA(1, 0, At, B0); PG8_BAR; PG8_SCHED;
            PG8_STAGE(PG8_SB(1, 1), b3 + hstep, voffB);
            PG8_WAIT_V(6); PG8_BAR; PG8_MMA(1, 1, At, B1); PG8_BAR;
            }
        }
        if constexpr (ALIGN_EPI) { if (wr == 0) PG8_BAR; }
        if constexpr (!Epi::AFTER_DRAIN) { E(acc, cur, wr, wc, fr, fq); S.done(cur); }
        if (!has_next) break;
#pragma unroll
        for (int a = 0; a < 2; ++a)
#pragma unroll
            for (int b = 0; b < 2; ++b)
#pragma unroll
                for (int m = 0; m < 4; ++m)
#pragma unroll
                    for (int n = 0; n < 2; ++n) acc[a][b][m][n] = (f32x4){0.f, 0.f, 0.f, 0.f};
        cur = nxt; cA = nA; cB = nB; ++ui;
        if constexpr (ALIGN_EPI) { if (wr == 1) PG8_BAR; }
    }
    PG8_WAIT_V(0);
    if constexpr (!ALIGN_EPI) { if (wr == 0) PG8_BAR; }
    PG8_BAR;
    if constexpr (Epi::AFTER_DRAIN) { E.fused(acc, cur, wr, wc, fr, fq, lds, wid, lane); S.done(cur); }
#undef PG8_SA
#undef PG8_SB
#undef PG8_STAGE
#undef PG8_LDA
#undef PG8_LDB
#undef PG8_MMA
#undef PG8_WAIT_V
#undef PG8_WAIT_L
#undef PG8_BAR
#undef PG8_SCHED
}
}


using pg8::f32x4; using pg8::u32x4; using pg8::Unit; using pg8::HALF; using pg8::BM;
typedef unsigned u32x2 __attribute__((ext_vector_type(2)));

struct EpiIn {
  static constexpr bool PERM = true, AFTER_DRAIN = false;
  bf16_t* qkv; bf16_t* rest; const float* rowss; const float* bias;
  __device__ __forceinline__ void operator()(const f32x4 (&acc)[2][2][4][2], const Unit& u, int wr, int wc, int fr, int fq) const {
    const int row0 = u.pm * BM + wr * 64 + fr;
    const int seg = seg_of_row(u.pm * BM);
    int colt = u.pn * BM; bf16_t* base = qkv; int ldc = NQKV;
    if (colt >= NQKV) { base = rest; ldc = NREST; colt -= NQKV; }
    const int col0 = colt + wc * 32 + 8 * fq, bcol0 = seg * NCOLS + u.pn * BM + wc * 32 + 8 * fq;
    f32x4 bv[2][2];
#pragma unroll
    for (int bj = 0; bj < 2; ++bj)
#pragma unroll
      for (int n = 0; n < 2; ++n) bv[bj][n] = *(const f32x4*)(bias + bcol0 + bj * HALF + 4 * n);
#pragma unroll
    for (int ai = 0; ai < 2; ++ai)
#pragma unroll
      for (int m = 0; m < 4; ++m) {
        const int r = row0 + ai * HALF + m * 16;
        const float rinv = rsqrtf(rowss[r] * (1.0f / 1024.0f) + 1e-6f);
        bf16_t* rowp = base + (size_t)r * ldc + col0;
#pragma unroll
        for (int bj = 0; bj < 2; ++bj) {
          const f32x4 v0 = acc[ai][bj][m][0] * rinv + bv[bj][0], v1 = acc[ai][bj][m][1] * rinv + bv[bj][1];
          u32x4 w; w.x = pg8::cvt_pk_bf16(v0[0], v0[1]); w.y = pg8::cvt_pk_bf16(v0[2], v0[3]); w.z = pg8::cvt_pk_bf16(v1[0], v1[1]); w.w = pg8::cvt_pk_bf16(v1[2], v1[3]);
          *(u32x4*)(rowp + bj * HALF) = w;
        }
      }
  }
};

struct EpiRes {
  static constexpr bool PERM = false, AFTER_DRAIN = false;
  float* X; const float* gate; float* rowss; bf16_t* xa; const float* An;
  __device__ __forceinline__ void operator()(const f32x4 (&acc)[2][2][4][2], const Unit& u, int wr, int wc, int fr, int fq) const {
    const int row0 = u.pm * BM + wr * 64 + fr, col0 = u.pn * BM + wc * 32 + 4 * fq;
    const int seg = seg_of_row(u.pm * BM);
    f32x4 gv[2][2], av[2][2];
#pragma unroll
    for (int bj = 0; bj < 2; ++bj)
#pragma unroll
      for (int n = 0; n < 2; ++n) {
        gv[bj][n] = *(const f32x4*)(gate + seg * 6144 + col0 + bj * HALF + n * 16);
        av[bj][n] = xa ? *(const f32x4*)(An + seg * 1024 + col0 + bj * HALF + n * 16) : (f32x4){0.f, 0.f, 0.f, 0.f};
      }
#pragma unroll
    for (int ai = 0; ai < 2; ++ai)
#pragma unroll
      for (int m = 0; m < 4; ++m) {
        const int r = row0 + ai * HALF + m * 16;
        float* xrow = X + (size_t)r * 1024 + col0;
        float ss = 0.f;
#pragma unroll
        for (int bj = 0; bj < 2; ++bj)
#pragma unroll
          for (int n = 0; n < 2; ++n) {
            const f32x4 xo = *(const f32x4*)(xrow + bj * HALF + n * 16);
            const f32x4 xn = xo + gv[bj][n] * acc[ai][bj][m][n];
            *(f32x4*)(xrow + bj * HALF + n * 16) = xn;
            ss += (xn[0] * xn[0] + xn[1] * xn[1]) + (xn[2] * xn[2] + xn[3] * xn[3]);
            if (xa) {
              const f32x4 t = xn * av[bj][n];
              u32x2 w; w.x = pg8::cvt_pk_bf16(t[0], t[1]); w.y = pg8::cvt_pk_bf16(t[2], t[3]);
              *(u32x2*)(xa + (size_t)r * 1024 + col0 + bj * HALF + n * 16) = w;
            }
          }
        ss += __shfl_xor(ss, 16); ss += __shfl_xor(ss, 32);
        if (fq == 0) atomicAdd(rowss + r, ss);
      }
  }
};

struct EpiGu {
  static constexpr bool PERM = true, AFTER_DRAIN = false;
  bf16_t* act; const float* rowss; const float* bias;
  __device__ __forceinline__ void operator()(const f32x4 (&acc)[2][2][4][2], const Unit& u, int wr, int wc, int fr, int fq) const {
    const int row0 = u.pm * BM + wr * 64 + fr;
    const int seg = seg_of_row(u.pm * BM);
    const int hid0 = u.pn * HALF + wc * 32 + 8 * fq, bcol0 = seg * (2 * FFH) + u.pn * BM + wc * 32 + 8 * fq;
    f32x4 bv[2][2];
#pragma unroll
    for (int bj = 0; bj < 2; ++bj)
#pragma unroll
      for (int n = 0; n < 2; ++n) bv[bj][n] = *(const f32x4*)(bias + bcol0 + bj * HALF + 4 * n);
#pragma unroll
    for (int ai = 0; ai < 2; ++ai)
#pragma unroll
      for (int m = 0; m < 4; ++m) {
        const int r = row0 + ai * HALF + m * 16;
        const float rinv = rsqrtf(rowss[r] * (1.0f / 1024.0f) + 1e-6f);
        float o[8];
#pragma unroll
        for (int n = 0; n < 2; ++n) {
          const f32x4 g = acc[ai][0][m][n] * rinv + bv[0][n], up = acc[ai][1][m][n] * rinv + bv[1][n];
#pragma unroll
          for (int j = 0; j < 4; ++j) o[n * 4 + j] = g[j] / (1.f + __expf(-g[j])) * up[j];
        }
        u32x4 w; w.x = pg8::cvt_pk_bf16(o[0], o[1]); w.y = pg8::cvt_pk_bf16(o[2], o[3]); w.z = pg8::cvt_pk_bf16(o[4], o[5]); w.w = pg8::cvt_pk_bf16(o[6], o[7]);
        *(u32x4*)(act + (size_t)r * FFH + hid0) = w;
      }
  }
};

template <class Epi>
__global__ __launch_bounds__(512, 2) void k_gemm(pg8::Gemm g, Epi E) {
  extern __shared__ __attribute__((aligned(16))) unsigned char smem[];
  pg8::StaticOrder S; S.init(g.M, g.N, gridDim.x, blockIdx.x);
  pg8::gemm_phase<Epi, pg8::StaticOrder, true, true>((PG8_LAS unsigned char*)smem, g, S, E);
}

__global__ __launch_bounds__(256) void k_mod(const float* __restrict__ c, const float* __restrict__ c_ctx,
                                             const float* __restrict__ w_mod, const float* __restrict__ b_mod,
                                             float* __restrict__ mods) {
  __shared__ float sv[3][1024];
  const int e = blockIdx.x * 256 + threadIdx.x, l = blockIdx.y;
  for (int i = threadIdx.x; i < 1024; i += 256) {
    sv[0][i] = silu_f(c_ctx[i]); sv[1][i] = silu_f(c[i]); sv[2][i] = silu_f(c[1024 + i]);
  }
  __syncthreads();
  const float* w = w_mod + (size_t)l * 1024 * 6144 + e;
  float a0 = 0.f, a1 = 0.f, a2 = 0.f;
#pragma unroll 8
  for (int d = 0; d < 1024; ++d) {
    const float wv = w[(size_t)d * 6144];
    a0 += sv[0][d] * wv; a1 += sv[1][d] * wv; a2 += sv[2][d] * wv;
  }
  const float b = b_mod[l * 6144 + e];
  mods[(l * 3 + 0) * 6144 + e] = a0 + b;
  mods[(l * 3 + 1) * 6144 + e] = a1 + b;
  mods[(l * 3 + 2) * 6144 + e] = a2 + b;
}

__device__ __forceinline__ int win_srccol(int j) { return j < 2048 ? j : j + 16; }
__device__ __forceinline__ int wgu_srccol(int j) { const int pn = j >> 8, w = j & 255; return w < 128 ? pn * 128 + w : FFH + pn * 128 + (w - 128); }

__device__ __forceinline__ void transpose_tile(const float* __restrict__ src, int ldsrc, int srccol0, bf16_t* __restrict__ dst, int K, int j0, int k0, float* tile, int t) {
  const int jl = t & 63, kg = t >> 6;
#pragma unroll
  for (int i = 0; i < 16; ++i) { const int k = kg * 16 + i; tile[jl * 65 + k] = src[(size_t)(k0 + k) * ldsrc + srccol0 + jl]; }
  __syncthreads();
  const int j = t >> 2, kc = (t & 3) * 16;
  const float* s = tile + j * 65 + kc;
  u32x4 o0, o1;
  o0.x = (unsigned)f2bf(s[0]) | ((unsigned)f2bf(s[1]) << 16); o0.y = (unsigned)f2bf(s[2]) | ((unsigned)f2bf(s[3]) << 16);
  o0.z = (unsigned)f2bf(s[4]) | ((unsigned)f2bf(s[5]) << 16); o0.w = (unsigned)f2bf(s[6]) | ((unsigned)f2bf(s[7]) << 16);
  o1.x = (unsigned)f2bf(s[8]) | ((unsigned)f2bf(s[9]) << 16); o1.y = (unsigned)f2bf(s[10]) | ((unsigned)f2bf(s[11]) << 16);
  o1.z = (unsigned)f2bf(s[12]) | ((unsigned)f2bf(s[13]) << 16); o1.w = (unsigned)f2bf(s[14]) | ((unsigned)f2bf(s[15]) << 16);
  bf16_t* d = dst + (size_t)(j0 + j) * K + k0 + kc;
  *(u32x4*)d = o0; *(u32x4*)(d + 8) = o1;
  __syncthreads();
}

#define WT_IN 0
#define WT_OUT (2816 * 1024)
#define WT_GU (WT_OUT + 1024 * 1024)
#define WT_DOWN (WT_GU + 5632 * 1024)
#define WT_LAYER (WT_DOWN + 1024 * 2816)

__global__ __launch_bounds__(256) void k_wconv(const float* __restrict__ w_in, const float* __restrict__ w_out, const float* __restrict__ w_gu,
                                               const float* __restrict__ w_down, bf16_t* __restrict__ WT, int l) {
  __shared__ float tile[64 * 65];
  const int t = threadIdx.x;
  for (int it = blockIdx.x; it < 3072; it += gridDim.x) {
    int r = it;
    bf16_t* wt = WT;
    if (r < 704) { const int kt = r / 44, jt = r % 44; transpose_tile(w_in + (size_t)l * 1024 * INC, INC, win_srccol(jt * 64), wt + WT_IN, 1024, jt * 64, kt * 64, tile, t); continue; }
    r -= 704;
    if (r < 256) { const int kt = r / 16, jt = r % 16; transpose_tile(w_out + (size_t)l * 1024 * 1024, 1024, jt * 64, wt + WT_OUT, 1024, jt * 64, kt * 64, tile, t); continue; }
    r -= 256;
    if (r < 1408) { const int kt = r / 88, jt = r % 88; transpose_tile(w_gu + (size_t)l * 1024 * 2 * FFH, 2 * FFH, wgu_srccol(jt * 64), wt + WT_GU, 1024, jt * 64, kt * 64, tile, t); continue; }
    r -= 1408;
    { const int kt = r / 16, jt = r % 16; transpose_tile(w_down + (size_t)l * FFH * 1024, 1024, jt * 64, wt + WT_DOWN, FFH, jt * 64, kt * 64, tile, t); }
  }
}

__global__ __launch_bounds__(256) void k_vecs(const float* __restrict__ mods, const float* __restrict__ norm1_g, const float* __restrict__ norm2_g,
                                              const float* __restrict__ w_in, const float* __restrict__ w_gu,
                                              float* __restrict__ AV, float* __restrict__ BIN, float* __restrict__ BGU, float* __restrict__ BLOG) {
  __shared__ float sh[3][1024];
  const int l = blockIdx.y, t = threadIdx.x;
  const int NB_IN = 11, NB_GU = 22, NB_LOG = 1, NB_A = 8;
  int b = blockIdx.x;
  if (b >= NB_IN + NB_GU + NB_LOG) {
    const int idx = (b - (NB_IN + NB_GU + NB_LOG)) * 256 + t; const int n = idx >> 10, d = idx & 1023;
    const float g = n ? norm2_g[l * 1024 + d] : norm1_g[l * 1024 + d];
#pragma unroll
    for (int s = 0; s < 3; ++s) AV[((l * 2 + n) * 3 + s) * 1024 + d] = g * (1.f + mods[(l * 3 + s) * 6144 + (n ? 4096 : 1024) + d]);
    return;
  }
  const bool is_gu = (b >= NB_IN && b < NB_IN + NB_GU);
  const int sh_off = is_gu ? 3072 : 0;
  for (int i = t; i < 1024; i += 256) {
#pragma unroll
    for (int s = 0; s < 3; ++s) sh[s][i] = mods[(l * 3 + s) * 6144 + sh_off + i];
  }
  __syncthreads();
  const float* w; int ld; float* outp; int ostride;
  if (b < NB_IN) { const int j = b * 256 + t; w = w_in + (size_t)l * 1024 * INC + win_srccol(j); ld = INC; outp = BIN + l * 3 * NCOLS + j; ostride = NCOLS; }
  else if (is_gu) { const int j = (b - NB_IN) * 256 + t; w = w_gu + (size_t)l * 1024 * 2 * FFH + wgu_srccol(j); ld = 2 * FFH; outp = BGU + l * 3 * 2 * FFH + j; ostride = 2 * FFH; }
  else { if (t >= 16) return; w = w_in + (size_t)l * 1024 * INC + 2048 + t; ld = INC; outp = BLOG + l * 3 * 16 + t; ostride = 16; }
  float a0 = 0.f, a1 = 0.f, a2 = 0.f;
#pragma unroll 8
  for (int d = 0; d < 1024; ++d) { const float wv = w[(size_t)d * ld]; a0 += sh[0][d] * wv; a1 += sh[1][d] * wv; a2 += sh[2][d] * wv; }
  outp[0] = a0; outp[ostride] = a1; outp[2 * ostride] = a2;
}

__global__ __launch_bounds__(256) void k_prepx(const float* __restrict__ xp, const float* __restrict__ xs, const float* __restrict__ AV0,
                                               float* __restrict__ X, float* __restrict__ rowss0, bf16_t* __restrict__ XA) {
  const int r = blockIdx.x * 4 + (threadIdx.x >> 6), lane = threadIdx.x & 63;
  const int seg = seg_of_row(r);
  float ss = 0.f;
#pragma unroll
  for (int i = 0; i < 4; ++i) {
    const int d = i * 256 + lane * 4;
    f32x4 v;
    if (r < NCTX) v = *(const f32x4*)(xp + (size_t)r * 1024 + d);
    else {
      const int rl = r - NCTX, p = rl & 2047, row = p >> 6, col = p & 63;
      v = *(const f32x4*)(xs + (size_t)rl * 1024 + d);
#pragma unroll
      for (int j = 0; j < 4; ++j) {
        const int dd = d + j, q = dd >> 8, jj = dd & 255;
        const float omega = 1.0f / powf(10000.0f, (float)jj / 256.0f);
        const float ang = (q < 2 ? (float)row : (float)col) * omega;
        v[j] += (q & 1) ? cosf(ang) : sinf(ang);
      }
    }
    *(f32x4*)(X + (size_t)r * 1024 + d) = v;
    ss += (v[0] * v[0] + v[1] * v[1]) + (v[2] * v[2] + v[3] * v[3]);
    const f32x4 a = *(const f32x4*)(AV0 + seg * 1024 + d);
    u32x2 w; w.x = (unsigned)f2bf(v[0] * a[0]) | ((unsigned)f2bf(v[1] * a[1]) << 16); w.y = (unsigned)f2bf(v[2] * a[2]) | ((unsigned)f2bf(v[3] * a[3]) << 16);
    *(u32x2*)(XA + (size_t)r * 1024 + d) = w;
  }
  ss = wave_sum(ss);
  if (lane == 0) rowss0[r] = ss;
}

__global__ __launch_bounds__(256) void k_logits(const float* __restrict__ X, const float* __restrict__ rowss, const float* __restrict__ A1,
                                                const float* __restrict__ w_in_l, const float* __restrict__ blog, float* __restrict__ LOG) {
  const int r = blockIdx.x * 4 + (threadIdx.x >> 6), lane = threadIdx.x & 63;
  const int seg = seg_of_row(r);
  float acc[16];
#pragma unroll
  for (int j = 0; j < 16; ++j) acc[j] = 0.f;
#pragma unroll 4
  for (int i = 0; i < 16; ++i) {
    const int d = lane + 64 * i;
    const float xv = X[(size_t)r * 1024 + d] * A1[seg * 1024 + d];
    const float* w = w_in_l + (size_t)d * INC + 2048;
#pragma unroll
    for (int q = 0; q < 4; ++q) { const f32x4 wv = *(const f32x4*)(w + 4 * q); acc[4 * q] += xv * wv[0]; acc[4 * q + 1] += xv * wv[1]; acc[4 * q + 2] += xv * wv[2]; acc[4 * q + 3] += xv * wv[3]; }
  }
  float mine = 0.f;
#pragma unroll
  for (int j = 0; j < 16; ++j) { const float s = wave_sum(acc[j]); if (lane == j) mine = s; }
  if (lane < 16) {
    const float rinv = rsqrtf(rowss[r] * (1.0f / 1024.0f) + 1e-6f);
    LOG[(size_t)r * 16 + lane] = mine * rinv + blog[seg * 16 + lane];
  }
}

__global__ __launch_bounds__(256) void k_final(const float* __restrict__ X, const float* __restrict__ rowss, const float* __restrict__ g, float* __restrict__ out) {
  const size_t i = ((size_t)blockIdx.x * 256 + threadIdx.x) * 4;
  const int r = (int)(i >> 10), d = (int)(i & 1023);
  const float rinv = rsqrtf(rowss[r] * (1.0f / 1024.0f) + 1e-6f);
  const f32x4 v = *(const f32x4*)(X + i), gg = *(const f32x4*)(g + d);
  *(f32x4*)(out + i) = v * rinv * gg;
}

__global__ __launch_bounds__(256) void k_conv_prep(const bf16_t* __restrict__ QKV, const float* __restrict__ LOG,
                                                   const float* __restrict__ conv_w, const float* __restrict__ a_log,
                                                   const float* __restrict__ dt_bias, bf16_t* __restrict__ Qn, bf16_t* __restrict__ Kn,
                                                   bf16_t* __restrict__ Vc, float* __restrict__ beta, float* __restrict__ gdec) {
  __shared__ float part[4][4];
  const int r = blockIdx.x, tid = threadIdx.x, w = tid >> 6;
  int s0, len;
  if (r < NCTX) { s0 = r & ~255; len = 256; } else { s0 = NCTX + ((r - NCTX) & ~2047); len = 2048; }
  const int t = r - s0;
  const bool hp = t > 0, hn = t < len - 1;
  float vals[6];
#pragma unroll
  for (int i = 0; i < 6; ++i) {
    const int c = tid + 256 * i;
    const float xm = hp ? bf2f(QKV[(size_t)(r - 1) * NQKV + c]) : 0.f;
    const float x0 = bf2f(QKV[(size_t)r * NQKV + c]);
    const float xp = hn ? bf2f(QKV[(size_t)(r + 1) * NQKV + c]) : 0.f;
    const float y = conv_w[c] * xm + conv_w[NQKV + c] * x0 + conv_w[2 * NQKV + c] * xp;
    vals[i] = silu_f(y);
  }
#pragma unroll
  for (int i = 0; i < 4; ++i) {
    const float s = wave_sum(vals[i] * vals[i]);
    if ((tid & 63) == 0) part[i][w] = s;
  }
  __syncthreads();
#pragma unroll
  for (int i = 0; i < 4; ++i) {
    const float s = part[i][w & ~1] + part[i][w | 1];
    const float rn = rsqrtf(s + 1e-6f);
    const int c = tid + 256 * i;
    if (i < 2) Qn[(size_t)r * 512 + c] = f2bf(vals[i] * rn * 0.08838834764831845f);
    else Kn[(size_t)r * 512 + (c - 512)] = f2bf(vals[i] * rn);
  }
  Vc[(size_t)r * 512 + tid] = f2bf(vals[4]);
  Vc[(size_t)r * 512 + tid + 256] = f2bf(vals[5]);
  if (tid < 8) {
    const float bl = LOG[(size_t)r * 16 + tid];
    const float al = LOG[(size_t)r * 16 + 8 + tid];
    beta[(size_t)r * 8 + tid] = sigmoid_f(bl);
    gdec[(size_t)r * 8 + tid] = -expf(a_log[tid]) * softplus_f(al + dt_bias[tid]);
  }
}

__global__ __launch_bounds__(128) void k_scan(const bf16_t* __restrict__ Qn, const bf16_t* __restrict__ Kn, const bf16_t* __restrict__ Vc,
                                              const float* __restrict__ beta, const float* __restrict__ gdec,
                                              const float* __restrict__ state_in, bf16_t* __restrict__ O, float* __restrict__ state_out, int layer) {
  __shared__ float sk[16][128];
  __shared__ float sq[16][128];
  __shared__ float sv[16][128];
  __shared__ float sb[16], sa[16];
  const int blk = blockIdx.x, e = threadIdx.x;
  int b, h, d, row0, len; const bool ctx = blk < 256;
  if (ctx) { b = blk >> 3; h = (blk >> 1) & 3; d = blk & 1; row0 = b * 256; len = 256; }
  else { const int q = blk - 256; b = q >> 3; h = (q >> 1) & 3; d = q & 1; row0 = NCTX + b * 2048; len = 2048; }
  float S[128];
  if (ctx) {
#pragma unroll
    for (int k = 0; k < 128; ++k) S[k] = 0.f;
  } else {
    const float* s0 = state_in + ((((size_t)b * 2 + layer) * 2 + d) * 4 + h) * 16384;
#pragma unroll
    for (int k = 0; k < 128; ++k) S[k] = s0[k * 128 + e];
  }
  for (int t0 = 0; t0 < len; t0 += 16) {
    __syncthreads();
    for (int j = 0; j < 16; ++j) {
      const int t = t0 + j; const int pos = d ? (len - 1 - t) : t; const size_t r = (size_t)(row0 + pos);
      sk[j][e] = bf2f(Kn[r * 512 + h * 128 + e]); sq[j][e] = bf2f(Qn[r * 512 + h * 128 + e]); sv[j][e] = bf2f(Vc[r * 512 + h * 128 + e]);
    }
    if (e < 16) {
      const int t = t0 + e; const int pos = d ? (len - 1 - t) : t; const size_t r = (size_t)(row0 + pos);
      sb[e] = beta[r * 8 + d * 4 + h]; sa[e] = expf(gdec[r * 8 + d * 4 + h]);
    }
    __syncthreads();
    for (int j = 0; j < 16; ++j) {
      const float a = sa[j], bt = sb[j];
      float ks = 0.f;
#pragma unroll
      for (int k = 0; k < 128; k += 4) {
        const float4 kv = *(const float4*)&sk[j][k];
        ks += kv.x * S[k] + kv.y * S[k + 1] + kv.z * S[k + 2] + kv.w * S[k + 3];
      }
      const float vn = bt * (sv[j][e] - a * ks);
      float o = 0.f;
#pragma unroll
      for (int k = 0; k < 128; k += 4) {
        const float4 kv = *(const float4*)&sk[j][k];
        const float4 qv = *(const float4*)&sq[j][k];
        S[k] = a * S[k] + kv.x * vn; S[k + 1] = a * S[k + 1] + kv.y * vn; S[k + 2] = a * S[k + 2] + kv.z * vn; S[k + 3] = a * S[k + 3] + kv.w * vn;
        o += qv.x * S[k] + qv.y * S[k + 1] + qv.z * S[k + 2] + qv.w * S[k + 3];
      }
      const int t = t0 + j; const int pos = d ? (len - 1 - t) : t; const size_t r = (size_t)(row0 + pos);
      O[((size_t)d * NTOK + r) * 512 + h * 128 + e] = f2bf(o);
    }
  }
  if (ctx) {
    float* so = state_out + ((((size_t)b * 2 + layer) * 2 + d) * 4 + h) * 16384;
#pragma unroll
    for (int k = 0; k < 128; ++k) so[k * 128 + e] = S[k];
  }
}

__global__ __launch_bounds__(256) void k_delta_post(const bf16_t* __restrict__ O, const bf16_t* __restrict__ REST,
                                                    const float* __restrict__ norm_g, bf16_t* __restrict__ MIX) {
  __shared__ float part[2][4];
  const int r = blockIdx.x, tid = threadIdx.x, w = tid >> 6;
  float o[2];
#pragma unroll
  for (int i = 0; i < 2; ++i) {
    const int c = tid + 256 * i;
    o[i] = bf2f(O[(size_t)r * 512 + c]) + bf2f(O[((size_t)NTOK + r) * 512 + c]);
    const float s = wave_sum(o[i] * o[i]);
    if ((tid & 63) == 0) part[i][w] = s;
  }
  __syncthreads();
#pragma unroll
  for (int i = 0; i < 2; ++i) {
    const int c = tid + 256 * i;
    const float s = part[i][w & ~1] + part[i][w | 1];
    const float rn = rsqrtf(s * (1.0f / 128.0f) + 1e-6f);
    const float z = bf2f(REST[(size_t)r * NREST + c]);
    MIX[(size_t)r * 1024 + c] = f2bf(o[i] * rn * norm_g[c & 127] * silu_f(z));
  }
}

__global__ __launch_bounds__(256) void k_sgu(const bf16_t* __restrict__ REST, const float* __restrict__ norm_g,
                                             const float* __restrict__ w_s, const float* __restrict__ b_s, bf16_t* __restrict__ MIX) {
  __shared__ float vn[128][65];
  const int ch = blockIdx.x, g = blockIdx.y, tid = threadIdx.x, r0 = ch * 128;
  {
    const int p = tid >> 1, hf = tid & 1;
    const bf16_t* vrow = REST + (size_t)(r0 + p) * NREST + 768 + g * 64 + hf * 32;
    float ss = 0.f;
    for (int c = 0; c < 32; ++c) { const float x = gelu_f(bf2f(vrow[c])); ss += x * x; }
    ss += __shfl_xor(ss, 1);
    const float rinv = rsqrtf(ss * (1.0f / 64.0f) + 1e-6f);
    for (int c = 0; c < 32; ++c) vn[p][hf * 32 + c] = gelu_f(bf2f(vrow[c])) * rinv * norm_g[g * 64 + hf * 32 + c];
  }
  __syncthreads();
  const int c = tid & 63;
  for (int t = tid >> 6; t < 128; t += 4) {
    float acc = b_s[g * 128 + t];
    const float* wr = w_s + (size_t)(g * 128 + t) * 128;
    for (int s = 0; s < 128; ++s) acc += wr[s] * vn[s][c];
    const float u = gelu_f(bf2f(REST[(size_t)(r0 + t) * NREST + 512 + g * 64 + c]));
    MIX[(size_t)(r0 + t) * 1024 + 512 + g * 64 + c] = f2bf(u * acc);
  }
}

__global__ __launch_bounds__(256) void k_pool(const bf16_t* __restrict__ REST, const float* __restrict__ w_pool,
                                              const float* __restrict__ scale, bf16_t* __restrict__ MIX) {
  __shared__ float dm[64][65];
  const int blk = blockIdx.x, i = blockIdx.y, tid = threadIdx.x, r0 = blk * 64, win = 2 << i;
  int seg0, seglen;
  if (r0 < NCTX) { seg0 = r0 & ~255; seglen = 256; } else { seg0 = r0; seglen = 64; }
  const int c = tid & 63;
  for (int p = tid >> 6; p < 64; p += 4) {
    const int pos = r0 + p - seg0;
    const int lo = max(pos - win / 2, 0), hi = min(pos + win - win / 2, seglen);
    float s = 0.f;
    for (int q = lo; q < hi; ++q) s += bf2f(REST[(size_t)(seg0 + q) * NREST + 1024 + i * 64 + c]);
    const float x = bf2f(REST[(size_t)(r0 + p) * NREST + 1024 + i * 64 + c]);
    dm[p][c] = s / (float)(hi - lo) - x;
  }
  __syncthreads();
  const int dd = tid & 63;
  for (int p = tid >> 6; p < 64; p += 4) {
    float acc = 0.f;
    for (int cc = 0; cc < 64; ++cc) acc += dm[p][cc] * w_pool[(size_t)(i * 64 + cc) * 64 + dd];
    MIX[(size_t)(r0 + p) * 1024 + 768 + i * 64 + dd] = f2bf(acc * scale[i * 64 + dd]);
  }
}


#define PRE_QP 0
#define PRE_KTP 16384
#define PRE_DIR0 32768
#define PRE_DIRSZ 41984
#define PRE_NW 0
#define PRE_UP 16384
#define PRE_QKP 32768
#define PRE_SC 40960
#define PRE_ITEM 116736
#define PRE_LDS 118784
#define SCAN_BUF 63232
#define SCAN_LDS (2 * SCAN_BUF)

using pg8::bf16x8;
__device__ __forceinline__ int perm_inv(int x) { return (x & ~31) | (((x >> 2) & 3) << 3) | (((x >> 4) & 1) << 2) | (x & 3); }
__device__ __forceinline__ unsigned pack_bf16(float lo, float hi) { return (unsigned)f2bf(lo) | ((unsigned)f2bf(hi) << 16); }
__device__ __forceinline__ bf16x8 pack8(const f32x4& x, const f32x4& y) {
  u32x4 w; w.x = pg8::cvt_pk_bf16(x[0], x[1]); w.y = pg8::cvt_pk_bf16(x[2], x[3]); w.z = pg8::cvt_pk_bf16(y[0], y[1]); w.w = pg8::cvt_pk_bf16(y[2], y[3]);
  return __builtin_bit_cast(bf16x8, w);
}

__device__ __forceinline__ void pre_item(int item, const bf16_t* __restrict__ QKV, const float* __restrict__ LOG, const float* __restrict__ cw,
                                         const float* __restrict__ a_log, const float* __restrict__ dt_bias, unsigned char* __restrict__ PRE,
                                         unsigned char* lds) {
  int t_ = threadIdx.x; asm volatile("" : "+v"(t_));
  const int t = t_, lane = t & 63, w = t >> 6;
  const int c = item >> 2, h = item & 3, r0 = c * 64;
  bf16_t* qb = (bf16_t*)lds; bf16_t* kb = (bf16_t*)(lds + 17408); float* vf = (float*)(lds + 34816);
  float* Lf = (float*)(lds + 67584); float* Lb = (float*)(lds + 83968); float* sc = (float*)(lds + 100352);
  unsigned char* pre = PRE + (size_t)item * PRE_ITEM;
  {
    const int i = t >> 3, cg = t & 7, r = r0 + i;
    int s0, len;
    if (r < NCTX) { s0 = r & ~255; len = 256; } else { s0 = NCTX + ((r - NCTX) & ~2047); len = 2048; }
    const int tt = r - s0; const bool hp = tt > 0, hn = tt < len - 1;
#pragma unroll
    for (int x = 0; x < 3; ++x) {
      const int cb = x * 512 + h * 128 + cg * 16;
      const bf16_t* p0 = QKV + (size_t)r * NQKV + cb;
      u32x4 m0 = (u32x4){0u, 0u, 0u, 0u}, m1 = m0, n0 = m0, n1 = m0;
      const u32x4 c0 = *(const u32x4*)p0, c1 = *(const u32x4*)(p0 + 8);
      if (hp) { m0 = *(const u32x4*)(p0 - NQKV); m1 = *(const u32x4*)(p0 - NQKV + 8); }
      if (hn) { n0 = *(const u32x4*)(p0 + NQKV); n1 = *(const u32x4*)(p0 + NQKV + 8); }
      float val[16]; float ss = 0.f;
#pragma unroll
      for (int e = 0; e < 16; ++e) {
        const unsigned wm = (e < 8 ? m0 : m1)[(e & 7) >> 1], wc = (e < 8 ? c0 : c1)[(e & 7) >> 1], wn = (e < 8 ? n0 : n1)[(e & 7) >> 1];
        const float xm = __uint_as_float((e & 1) ? (wm & 0xffff0000u) : (wm << 16));
        const float xc = __uint_as_float((e & 1) ? (wc & 0xffff0000u) : (wc << 16));
        const float xn = __uint_as_float((e & 1) ? (wn & 0xffff0000u) : (wn << 16));
        const float y = cw[cb + e] * xm + cw[NQKV + cb + e] * xc + cw[2 * NQKV + cb + e] * xn;
        val[e] = silu_f(y); ss += val[e] * val[e];
      }
      if (x < 2) {
        ss += __shfl_xor(ss, 1); ss += __shfl_xor(ss, 2); ss += __shfl_xor(ss, 4);
        const float rn = rsqrtf(ss + 1e-6f) * (x == 0 ? 0.08838834764831845f : 1.0f);
        bf16_t* dst = (x == 0 ? qb : kb) + i * 136 + cg * 16;
        u32x4 o0, o1;
        o0.x = pack_bf16(val[0] * rn, val[1] * rn); o0.y = pack_bf16(val[2] * rn, val[3] * rn); o0.z = pack_bf16(val[4] * rn, val[5] * rn); o0.w = pack_bf16(val[6] * rn, val[7] * rn);
        o1.x = pack_bf16(val[8] * rn, val[9] * rn); o1.y = pack_bf16(val[10] * rn, val[11] * rn); o1.z = pack_bf16(val[12] * rn, val[13] * rn); o1.w = pack_bf16(val[14] * rn, val[15] * rn);
        *(u32x4*)dst = o0; *(u32x4*)(dst + 8) = o1;
      } else {
        float* dst = vf + i * 128 + cg * 16;
#pragma unroll
        for (int e = 0; e < 16; e += 4) *(f32x4*)(dst + e) = (f32x4){val[e], val[e + 1], val[e + 2], val[e + 3]};
      }
    }
  }
  if (w == 0) {
    const int i = lane, r = r0 + i;
#pragma unroll
    for (int d = 0; d < 2; ++d) {
      const float bl = LOG[(size_t)r * 16 + d * 4 + h], al = LOG[(size_t)r * 16 + 8 + d * 4 + h];
      const float beta = sigmoid_f(bl);
      const float g = -expf(a_log[d * 4 + h]) * softplus_f(al + dt_bias[d * 4 + h]);
      float s = g;
#pragma unroll
      for (int o = 1; o < 64; o <<= 1) {
        const float nb = d == 0 ? __shfl_up(s, o) : __shfl_down(s, o);
        const bool ok = d == 0 ? (lane >= o) : (lane + o < 64);
        if (ok) s += nb;
      }
      sc[d * 64 + i] = beta; sc[128 + d * 64 + i] = s; sc[256 + d * 64 + i] = beta * expf(s);
    }
  }
  __syncthreads();
  {
    const int p = w >> 2, it = w & 3, fr = lane & 15, g = lane >> 4;
    const bf16_t* Ab = p ? qb : kb;
    bf16x8 af[4];
#pragma unroll
    for (int ks = 0; ks < 4; ++ks) af[ks] = *(const bf16x8*)(Ab + (it * 16 + fr) * 136 + ks * 32 + 8 * g);
    bf16_t* qkf = (bf16_t*)(lds + 102400);
    bf16_t* qkb = (bf16_t*)(lds + 102400 + 8192);
#pragma unroll
    for (int jt = 0; jt < 4; ++jt) {
      f32x4 acc = (f32x4){0.f, 0.f, 0.f, 0.f};
#pragma unroll
      for (int ks = 0; ks < 4; ++ks) {
        const bf16x8 bfr = *(const bf16x8*)(kb + (jt * 16 + fr) * 136 + ks * 32 + 8 * g);
        acc = __builtin_amdgcn_mfma_f32_16x16x32_bf16(af[ks], bfr, acc, 0, 0, 0);
      }
      const int j = jt * 16 + fr;
      const float gfj = sc[128 + j], gbj = sc[192 + j];
#pragma unroll
      for (int r = 0; r < 4; ++r) {
        const int i = it * 16 + 4 * g + r;
        const float val = acc[r];
        const float ef = expf(fminf(sc[128 + i] - gfj, 0.f)), eb = expf(fminf(sc[192 + i] - gbj, 0.f));
        if (p == 0) {
          Lf[i * 64 + j] = (j < i) ? sc[i] * val * ef : 0.f;
          Lb[(63 - i) * 64 + (63 - j)] = (j > i) ? sc[64 + i] * val * eb : 0.f;
        } else {
          const int jp = perm_inv(j);
          qkf[i * 64 + jp] = f2bf((j <= i) ? val * ef : 0.f);
          qkb[i * 64 + jp] = f2bf((j >= i) ? val * eb : 0.f);
        }
      }
    }
  }
  __syncthreads();
#pragma unroll
  for (int it2 = 0; it2 < 2; ++it2) {
    const int q = t + 512 * it2;
    { const int i = q >> 4, s = (q >> 2) & 3, g = q & 3;
      const u32x2 lo = *(const u32x2*)(qb + i * 136 + 32 * s + 4 * g), hi = *(const u32x2*)(qb + i * 136 + 32 * s + 16 + 4 * g);
      *(u32x4*)(pre + PRE_QP + (size_t)(i * 128 + 32 * s + 8 * g) * 2) = (u32x4){lo.x, lo.y, hi.x, hi.y}; }
    { const int dk = q >> 3, s2 = (q >> 2) & 1, g = q & 3;
      unsigned short e[8];
#pragma unroll
      for (int jj = 0; jj < 8; ++jj) e[jj] = kb[(32 * s2 + 16 * (jj >> 2) + 4 * g + (jj & 3)) * 136 + dk];
      u32x4 o; o.x = (unsigned)e[0] | ((unsigned)e[1] << 16); o.y = (unsigned)e[2] | ((unsigned)e[3] << 16); o.z = (unsigned)e[4] | ((unsigned)e[5] << 16); o.w = (unsigned)e[6] | ((unsigned)e[7] << 16);
      *(u32x4*)(pre + PRE_KTP + (size_t)(dk * 64 + 32 * s2 + 8 * g) * 2) = o; }
  }
  if (t < 384) {
    const int d = t / 192, rem = t % 192, k3 = rem >> 6, i = rem & 63;
    const float glast = d ? sc[192] : sc[128 + 63], gci = sc[128 + d * 64 + i];
    const float v = k3 == 0 ? expf(gci) : (k3 == 1 ? expf(glast - gci) : expf(glast));
    ((float*)(pre + PRE_DIR0 + d * PRE_DIRSZ + PRE_SC))[k3 * 64 + i] = v;
  }
  {
    const int d = w >> 2, kind = (w >> 1) & 1, cc = t & 127;
    int rowsel = d ? 63 : 0, rstep = d ? -1 : 1; unsigned Loff = d ? 83968u : 67584u;
    asm volatile("" : "+v"(rowsel), "+v"(rstep), "+v"(Loff));
    const float* L = (const float*)(lds + Loff);
    float x[64];
    if (kind == 0) {
#pragma unroll
      for (int ip = 0; ip < 64; ++ip) { const int i = rowsel + rstep * ip; x[ip] = sc[d * 64 + i] * vf[i * 128 + cc]; }
    } else {
#pragma unroll
      for (int ip = 0; ip < 64; ++ip) { const int i = rowsel + rstep * ip; x[ip] = sc[256 + d * 64 + i] * bf2f(kb[i * 136 + cc]); }
    }
#pragma unroll
    for (int ip = 1; ip < 64; ++ip) {
      float a = x[ip];
#pragma unroll
      for (int jp = 0; jp < ip; ++jp) a -= L[ip * 64 + jp] * x[jp];
      x[ip] = a;
      asm volatile("" ::: "memory");
    }
    __syncthreads();
    unsigned char* outd = lds + 34816 + d * 32768;
    if (kind == 0) {
      const int dv = cc, wv = dv >> 4;
      unsigned char* ub = outd + 16384 + ((wv * 4) * 64 + (dv & 15)) * 8;
#pragma unroll
      for (int qp = 0; qp < 16; ++qp) {
        const int q = (rowsel >> 2) + rstep * qp;
        const float v0 = d ? x[4 * qp + 3] : x[4 * qp], v1 = d ? x[4 * qp + 2] : x[4 * qp + 1], v2 = d ? x[4 * qp + 1] : x[4 * qp + 2], v3 = d ? x[4 * qp] : x[4 * qp + 3];
        u32x2 pk; pk.x = pack_bf16(v0, v1); pk.y = pack_bf16(v2, v3);
        *(u32x2*)(ub + q * 128) = pk;
      }
    } else {
      const int kp = perm_inv(cc);
      bf16_t* nw = (bf16_t*)outd + kp;
#pragma unroll
      for (int ip = 0; ip < 64; ++ip) { const int i = rowsel + rstep * ip; nw[i * 128] = f2bf(-x[ip]); }
    }
  }
  __syncthreads();
  for (int k = 0; k < 8; ++k) {
    const int q = t + 512 * k, d = q >> 11, wi = q & 2047;
    *(u32x4*)(pre + PRE_DIR0 + d * PRE_DIRSZ + wi * 16) = *(const u32x4*)(lds + 34816 + q * 16);
  }
  for (int k = 0; k < 2; ++k) {
    const int q = t + 512 * k, d = q >> 9, wi = q & 511;
    *(u32x4*)(pre + PRE_DIR0 + d * PRE_DIRSZ + PRE_QKP + wi * 16) = *(const u32x4*)(lds + 102400 + q * 16);
  }
  __syncthreads();
}

__global__ __launch_bounds__(512, 2) void k_pre(const bf16_t* __restrict__ QKV, const float* __restrict__ LOG, const float* __restrict__ cw,
                                                const float* __restrict__ a_log, const float* __restrict__ dt_bias, unsigned char* __restrict__ PRE) {
  extern __shared__ __attribute__((aligned(16))) unsigned char smem[];
  for (int item = blockIdx.x; item < 768; item += gridDim.x) pre_item(item, QKV, LOG, cw, a_log, dt_bias, PRE, smem);
}

__device__ __forceinline__ void scan_item(int sid, const unsigned char* __restrict__ PRE, const float* __restrict__ state_in, bf16_t* __restrict__ OB,
                                          float* __restrict__ state_out, int layer, unsigned char* lds) {
  int t_ = threadIdx.x; asm volatile("" : "+v"(t_));
  const int t = t_, lane = t & 63, w = t >> 6, fr = lane & 15, g = lane >> 4, dv = 16 * w + fr;
  int b, h, d, chunk0, nc; const bool ctx = sid < 256;
  if (ctx) { b = sid >> 3; h = (sid >> 1) & 3; d = sid & 1; chunk0 = b * 4; nc = 4; }
  else { const int q = sid - 256; b = q >> 3; h = (q >> 1) & 3; d = q & 1; chunk0 = 128 + b * 32; nc = 32; }
  f32x4 S[8];
  if (ctx) {
#pragma unroll
    for (int m = 0; m < 8; ++m) S[m] = (f32x4){0.f, 0.f, 0.f, 0.f};
  } else {
    const float* s0 = state_in + ((((size_t)b * 2 + layer) * 2 + d) * 4 + h) * 16384;
#pragma unroll
    for (int m = 0; m < 8; ++m)
#pragma unroll
      for (int r = 0; r < 4; ++r) S[m][r] = s0[(16 * m + 4 * g + r) * 128 + dv];
  }
  unsigned soff[7], doff[7];
#pragma unroll
  for (int k = 0; k < 7; ++k) {
    const int q = t + 512 * k;
    if (k < 2) { soff[k] = PRE_DIR0 + PRE_NW + q * 16; doff[k] = (q >> 4) * 272 + (q & 15) * 16; }
    else if (k < 4) { const int q2 = q - 1024; soff[k] = PRE_QP + q2 * 16; doff[k] = 17408 + (q2 >> 4) * 272 + (q2 & 15) * 16; }
    else if (k < 5) { const int q2 = q - 2048; soff[k] = PRE_DIR0 + PRE_QKP + q2 * 16; doff[k] = 34816 + (q2 >> 3) * 144 + (q2 & 7) * 16; }
    else { const int q2 = q - 2560; soff[k] = PRE_KTP + q2 * 16; doff[k] = 44032 + (q2 >> 3) * 144 + (q2 & 7) * 16; }
    if (k < 2 || k == 4) soff[k] += d * PRE_DIRSZ;
  }
  const unsigned soff7 = PRE_DIR0 + d * PRE_DIRSZ + PRE_SC + t * 16, doff7 = 62464 + t * 16;
  const unsigned upoff = PRE_DIR0 + d * PRE_DIRSZ + PRE_UP + ((w * 4) * 64 + lane) * 8;
  u32x4 st[7]; u32x4 st7 = (u32x4){0u, 0u, 0u, 0u}; u32x2 up[4];
  {
    const int cidx = chunk0 + (d ? nc - 1 : 0);
    const unsigned char* pre = PRE + (size_t)(cidx * 4 + h) * PRE_ITEM;
#pragma unroll
    for (int k = 0; k < 7; ++k) st[k] = *(const u32x4*)(pre + soff[k]);
    if (t < 48) st7 = *(const u32x4*)(pre + soff7);
#pragma unroll
    for (int m = 0; m < 4; ++m) up[m] = *(const u32x2*)(pre + upoff + m * 512);
#pragma unroll
    for (int k = 0; k < 7; ++k) *(u32x4*)(lds + doff[k]) = st[k];
    if (t < 48) *(u32x4*)(lds + doff7) = st7;
  }
  __syncthreads();
  for (int step = 0; step < nc; ++step) {
    const int cidx = chunk0 + (d ? nc - 1 - step : step);
    const unsigned char* B = lds + (step & 1) * SCAN_BUF;
    const bool more = step + 1 < nc;
    bf16x8 Sb[4];
#pragma unroll
    for (int s = 0; s < 4; ++s) Sb[s] = pack8(S[2 * s], S[2 * s + 1]);
    f32x4 a1[4], a2[4];
#pragma unroll
    for (int m = 0; m < 4; ++m) {
      a1[m] = (f32x4){__uint_as_float(up[m].x << 16), __uint_as_float(up[m].x & 0xffff0000u), __uint_as_float(up[m].y << 16), __uint_as_float(up[m].y & 0xffff0000u)};
      a2[m] = (f32x4){0.f, 0.f, 0.f, 0.f};
    }
    if (more) {
      const int cn = chunk0 + (d ? nc - 2 - step : step + 1);
      const unsigned char* pre = PRE + (size_t)(cn * 4 + h) * PRE_ITEM;
#pragma unroll
      for (int k = 0; k < 7; ++k) st[k] = *(const u32x4*)(pre + soff[k]);
      if (t < 48) st7 = *(const u32x4*)(pre + soff7);
#pragma unroll
      for (int m = 0; m < 4; ++m) up[m] = *(const u32x2*)(pre + upoff + m * 512);
    }
#pragma unroll
    for (int m = 0; m < 4; ++m)
#pragma unroll
      for (int s = 0; s < 4; ++s) {
        const bf16x8 fa = *(const bf16x8*)(B + (16 * m + fr) * 272 + (32 * s + 8 * g) * 2);
        a1[m] = __builtin_amdgcn_mfma_f32_16x16x32_bf16(fa, Sb[s], a1[m], 0, 0, 0);
        const bf16x8 fq = *(const bf16x8*)(B + 17408 + (16 * m + fr) * 272 + (32 * s + 8 * g) * 2);
        a2[m] = __builtin_amdgcn_mfma_f32_16x16x32_bf16(fq, Sb[s], a2[m], 0, 0, 0);
      }
    const float* SC = (const float*)(B + 62464);
#pragma unroll
    for (int m = 0; m < 4; ++m) { const f32x4 e = *(const f32x4*)(SC + 16 * m + 4 * g); a2[m] = a2[m] * e; }
    bf16x8 Vb[2];
#pragma unroll
    for (int s = 0; s < 2; ++s) Vb[s] = pack8(a1[2 * s], a1[2 * s + 1]);
#pragma unroll
    for (int m = 0; m < 4; ++m)
#pragma unroll
      for (int s = 0; s < 2; ++s) {
        const bf16x8 fa = *(const bf16x8*)(B + 34816 + (16 * m + fr) * 144 + (32 * s + 8 * g) * 2);
        a2[m] = __builtin_amdgcn_mfma_f32_16x16x32_bf16(fa, Vb[s], a2[m], 0, 0, 0);
      }
    {
      bf16_t* op = OB + ((size_t)d * NTOK + (size_t)cidx * 64) * 512 + h * 128 + dv;
#pragma unroll
      for (int m = 0; m < 4; ++m)
#pragma unroll
        for (int r = 0; r < 4; ++r) op[(size_t)(16 * m + 4 * g + r) * 512] = f2bf(a2[m][r]);
    }
#pragma unroll
    for (int m = 0; m < 4; ++m) { const f32x4 e = *(const f32x4*)(SC + 64 + 16 * m + 4 * g); a1[m] = a1[m] * e; }
    bf16x8 Vs[2];
#pragma unroll
    for (int s = 0; s < 2; ++s) Vs[s] = pack8(a1[2 * s], a1[2 * s + 1]);
    const float gt = SC[128];
#pragma unroll
    for (int m = 0; m < 8; ++m) {
      S[m] = S[m] * gt;
#pragma unroll
      for (int s = 0; s < 2; ++s) {
        const bf16x8 fa = *(const bf16x8*)(B + 44032 + (16 * m + fr) * 144 + (32 * s + 8 * g) * 2);
        S[m] = __builtin_amdgcn_mfma_f32_16x16x32_bf16(fa, Vs[s], S[m], 0, 0, 0);
      }
    }
    if (more) {
      unsigned char* Bn = lds + ((step + 1) & 1) * SCAN_BUF;
#pragma unroll
      for (int k = 0; k < 7; ++k) *(u32x4*)(Bn + doff[k]) = st[k];
      if (t < 48) *(u32x4*)(Bn + doff7) = st7;
    }
    __syncthreads();
  }
  if (ctx) {
    float* so = state_out + ((((size_t)b * 2 + layer) * 2 + d) * 4 + h) * 16384;
#pragma unroll
    for (int m = 0; m < 8; ++m)
#pragma unroll
      for (int r = 0; r < 4; ++r) so[(16 * m + 4 * g + r) * 128 + dv] = S[m][r];
  }
}

__global__ __launch_bounds__(512, 2) void k_scan2(const unsigned char* __restrict__ PRE, const float* __restrict__ state_in, bf16_t* __restrict__ OB,
                                                  float* __restrict__ state_out, int layer) {
  extern __shared__ __attribute__((aligned(16))) unsigned char smem[];
  for (int i = blockIdx.x; i < 272; i += gridDim.x) { const int sid = i < 16 ? 256 + i : i - 16; scan_item(sid, PRE, state_in, OB, state_out, layer, smem); }
}
static pg8::Gemm make_gemm(const bf16_t* A, const bf16_t* Bt, int M, int N, int K) { pg8::Gemm g; memset(&g, 0, sizeof g); g.A = A; g.Bt = Bt; g.M = M; g.N = N; g.K = K; return g; }
template <class Epi> static void launch_gemm(const pg8::Gemm& g, const Epi& E, hipStream_t stream) {
  static bool attr_done = false;
  if (!attr_done) { (void)hipFuncSetAttribute((const void*)k_gemm<Epi>, hipFuncAttributeMaxDynamicSharedMemorySize, pg8::STAGE_BYTES); attr_done = true; }
  hipLaunchKernelGGL(k_gemm<Epi>, dim3(256), dim3(512), pg8::STAGE_BYTES, stream, g, E);
}

extern "C" void kernel_launch(void* const* d_in, const int* in_sizes, int n_in, void* d_out, int out_size, void* d_ws, size_t ws_size,
                              hipStream_t stream) {
  const float* x_prompt = (const float*)d_in[0];
  const float* x_sample = (const float*)d_in[1];
  const float* state_delta = (const float*)d_in[2];
  const float* c = (const float*)d_in[3];
  const float* c_ctx = (const float*)d_in[4];
  const float* w_in = (const float*)d_in[5];
  const float* conv_w = (const float*)d_in[6];
  const float* a_log = (const float*)d_in[7];
  const float* dt_bias = (const float*)d_in[8];
  const float* delta_norm_g = (const float*)d_in[9];
  const float* sgu_norm_g = (const float*)d_in[10];
  const float* w_spatial = (const float*)d_in[11];
  const float* b_spatial = (const float*)d_in[12];
  const float* w_pool = (const float*)d_in[13];
  const float* pool_scale = (const float*)d_in[14];
  const float* w_out = (const float*)d_in[15];
  const float* norm1_g = (const float*)d_in[16];
  const float* norm2_g = (const float*)d_in[17];
  const float* w_mod = (const float*)d_in[18];
  const float* b_mod = (const float*)d_in[19];
  const float* w_gu = (const float*)d_in[20];
  const float* w_down = (const float*)d_in[21];
  const float* norm_f = (const float*)d_in[22];
  float* out = (float*)d_out;
  char* ws = (char*)d_ws;
  size_t off = 0;
  float* X = (float*)(ws + off); off += (size_t)NTOK * 1024 * 4;
  bf16_t* WT = (bf16_t*)(ws + off); off += (size_t)WT_LAYER * 2;
  bf16_t* QKV = (bf16_t*)(ws + off); off += (size_t)NTOK * NQKV * 2;
  bf16_t* REST = (bf16_t*)(ws + off); off += (size_t)NTOK * NREST * 2;
  bf16_t* ACT = QKV;
  bf16_t* OB = QKV;
  bf16_t* XA = (bf16_t*)(ws + off);
  unsigned char* PRE = (unsigned char*)(ws + off);
  off += (size_t)768 * PRE_ITEM;
  bf16_t* MIXB = (bf16_t*)(ws + off); off += (size_t)NTOK * 1024 * 2;
  float* mods = (float*)(ws + off); off += 2 * 3 * 6144 * 4;
  float* AV = (float*)(ws + off); off += 2 * 2 * 3 * 1024 * 4;
  float* BIN = (float*)(ws + off); off += 2 * 3 * NCOLS * 4;
  float* BGU = (float*)(ws + off); off += 2 * 3 * 2 * FFH * 4;
  float* BLOG = (float*)(ws + off); off += 2 * 3 * 16 * 4 + 128;
  float* rowss = (float*)(ws + off); off += 5 * NTOK * 4;
  float* LOG = (float*)(ws + off); off += (size_t)NTOK * 16 * 4;
  float* beta = (float*)(ws + off); off += (size_t)NTOK * 8 * 4;
  float* gdec = (float*)(ws + off); off += (size_t)NTOK * 8 * 4;
  float* states_out = out + (size_t)NTOK * 1024;
  if (off > ws_size) { fprintf(stderr, "workspace too small: need %zu have %zu\n", off, ws_size); return; }

  (void)hipMemsetAsync(rowss, 0, 5 * NTOK * 4, stream);
  k_mod<<<dim3(24, 2), 256, 0, stream>>>(c, c_ctx, w_mod, b_mod, mods);
  k_vecs<<<dim3(11 + 22 + 1 + 8, 2), 256, 0, stream>>>(mods, norm1_g, norm2_g, w_in, w_gu, AV, BIN, BGU, BLOG);
  k_prepx<<<NTOK / 4, 256, 0, stream>>>(x_prompt, x_sample, AV, X, rowss, XA);
  for (int l = 0; l < 2; ++l) {
    const float* ml = mods + l * 3 * 6144;
    const bf16_t* wt = WT;
    k_wconv<<<1024, 256, 0, stream>>>(w_in, w_out, w_gu, w_down, WT, l);
    float* rs1 = rowss + (2 * l) * NTOK; float* rs2 = rowss + (2 * l + 1) * NTOK; float* rs3 = rowss + (2 * l + 2) * NTOK;
    const float* A1 = AV + (l * 2 + 0) * 3 * 1024; const float* A2 = AV + (l * 2 + 1) * 3 * 1024;
    const float* A1n = AV + ((l + 1) * 2 + 0) * 3 * 1024;
    k_logits<<<NTOK / 4, 256, 0, stream>>>(X, rs1, A1, w_in + (size_t)l * 1024 * INC, BLOG + l * 3 * 16, LOG);
    { pg8::Gemm g = make_gemm(XA, wt + WT_IN, NTOK, NCOLS, 1024); EpiIn E{QKV, REST, rs1, BIN + l * 3 * NCOLS}; launch_gemm(g, E, stream); }
    k_pre<<<256, 512, PRE_LDS, stream>>>(QKV, LOG, conv_w + (size_t)l * 3 * NQKV, a_log + l * 8, dt_bias + l * 8, PRE);
    k_scan2<<<256, 512, SCAN_LDS, stream>>>(PRE, state_delta, OB, states_out, l);
    k_delta_post<<<NTOK, 256, 0, stream>>>(OB, REST, delta_norm_g + l * 128, MIXB);
    k_sgu<<<dim3(NTOK / 128, 4), 256, 0, stream>>>(REST, sgu_norm_g + l * 256, w_spatial + (size_t)l * 4 * 128 * 128, b_spatial + l * 4 * 128, MIXB);
    k_pool<<<dim3(NTOK / 64, 4), 256, 0, stream>>>(REST, w_pool + (size_t)l * 4 * 64 * 64, pool_scale + l * 256, MIXB);
    { pg8::Gemm g = make_gemm(MIXB, wt + WT_OUT, NTOK, 1024, 1024); EpiRes E{X, ml + 2048, rs2, XA, A2}; launch_gemm(g, E, stream); }
    { pg8::Gemm g = make_gemm(XA, wt + WT_GU, NTOK, 2 * FFH, 1024); EpiGu E{ACT, rs2, BGU + l * 3 * 2 * FFH}; launch_gemm(g, E, stream); }
    { pg8::Gemm g = make_gemm(ACT, wt + WT_DOWN, NTOK, 1024, FFH); EpiRes E{X, ml + 5120, rs3, l == 0 ? XA : (bf16_t*)nullptr, l == 0 ? A1n : A1}; launch_gemm(g, E, stream); }
  }
  k_final<<<NTOK, 256, 0, stream>>>(X, rowss + 4 * NTOK, norm_f, out);
}
```

```cpp
#include <hip/hip_runtime.h>
#include <math.h>
#include <cstdio>
#include <cstring>

#define NTOK 12288
#define NCTX 8192
#define DM 1024
#define INC 2832
#define FFH 2816
#define NQKV 1536
#define NREST 1280
#define NCOLS 2816

typedef unsigned short bf16_t;
typedef float f32x2_cv __attribute__((ext_vector_type(2)));
typedef __bf16 bf16x2_cv __attribute__((ext_vector_type(2)));
__device__ __forceinline__ unsigned pack_bf16(float lo, float hi) { return __builtin_bit_cast(unsigned, __builtin_convertvector((f32x2_cv){lo, hi}, bf16x2_cv)); }
__device__ __forceinline__ bf16_t f2bf(float f) { return (bf16_t)(pack_bf16(f, 0.f) & 0xffffu); }
__device__ __forceinline__ float bf2f(bf16_t b) { return __uint_as_float(((unsigned)b) << 16); }
__device__ __forceinline__ float silu_f(float x) { return x / (1.f + expf(-x)); }
__device__ __forceinline__ float silu_fast(float x) { return x * __builtin_amdgcn_rcpf(1.f + __expf(-x)); }
__device__ __forceinline__ float gelu_fast(float x) { const float u = 1.5957691216057308f * (x + 0.044715f * x * x * x); return x * __builtin_amdgcn_rcpf(1.f + __expf(-u)); }
__device__ __forceinline__ float sigmoid_f(float x) { return 1.f / (1.f + expf(-x)); }
__device__ __forceinline__ float gelu_f(float x) { return 0.5f * x * (1.f + tanhf(0.7978845608028654f * (x + 0.044715f * x * x * x))); }
__device__ __forceinline__ float softplus_f(float x) { return x > 20.f ? x : log1pf(expf(x)); }
__device__ __forceinline__ int seg_of_row(int r) { return r < NCTX ? 0 : 1 + ((r - NCTX) >> 11); }
__device__ __forceinline__ float wave_sum(float v) {
#pragma unroll
  for (int o = 32; o > 0; o >>= 1) v += __shfl_xor(v, o);
  return v;
}
namespace pg8 {
#define PG8_LAS __attribute__((address_space(3)))
typedef unsigned short bf16_t;
typedef short bf16x8 __attribute__((ext_vector_type(8)));
typedef float f32x4 __attribute__((ext_vector_type(4)));
typedef unsigned u32x4 __attribute__((ext_vector_type(4)));
constexpr int BM = 256, BK = 64, HALF = 128, HTB = HALF * BK * 2  , STAGE_BYTES = 8 * HTB, NXCD = 8, WGM = 8;

__host__ __device__ __forceinline__ int lds_byte(int r, int c) { const int st = (r >> 4) * 2 + (c >> 5), rr = r & 15, cc = c & 31, ob = rr * 64 + cc * 2; return st * 1024 + (ob ^ (((ob >> 9) & 1) << 5)); }
__host__ __device__ __forceinline__ void stage_rc(int b, int& R, int& C) { const int st = b / 1024, sb = b % 1024, swz = sb ^ (((sb >> 9) & 1) << 5); R = (st >> 1) * 16 + swz / 64; C = (st & 1) * 32 + (swz % 64) / 2; }
__host__ __device__ __forceinline__ int perm32(int rho) { const int n = rho >> 4, i = rho & 15; return 8 * (i >> 2) + 4 * n + (i & 3); }

struct Unit { int pm, pn; };
struct Gemm { const bf16_t* A; const bf16_t* Bt; int M, N, K; };

struct StaticOrder {
    int nM, nN, nwg, G, c;
    __host__ __device__ void init(int M, int N, int G_, int c_) { nM = M / BM; nN = N / BM; nwg = nM * nN; G = G_; c = c_; }
    __host__ __device__ bool next(int i, Unit& u) const {
        const long L = (long)i * G + c; if (L >= nwg) return false;
        int wgid = (int)L; { const int q = nwg / NXCD, r = nwg % NXCD, xcd = wgid % NXCD, off = wgid / NXCD; wgid = (xcd < r ? xcd * (q + 1) : r * (q + 1) + (xcd - r) * q) + off; }
        const int nig = WGM * nN, gid = wgid / nig, fm = gid * WGM, gsz = (nM - fm) < WGM ? (nM - fm) : WGM;
        u.pm = fm + ((wgid % nig) % gsz); u.pn = (wgid % nig) / gsz; return true;
    }
    __device__ __forceinline__ void a_ready(const Unit&) const {}
    __device__ __forceinline__ void done(const Unit&) const {}
};

__device__ __forceinline__ unsigned cvt_pk_bf16(float lo, float hi) { return ::pack_bf16(lo, hi); }
template <class Epi, class Sched, bool ALIGN_EPI = false, bool SP2 = false>
__device__ __forceinline__ void gemm_phase(PG8_LAS unsigned char* lds, const Gemm g, const Sched& S, const Epi& E) {
    int tid_ = threadIdx.x; asm volatile("" : "+v"(tid_));
    const int tid = tid_, wid = __builtin_amdgcn_readfirstlane(tid >> 6), lane = tid & 63, wr = wid >> 2, wc = wid & 3, fr = lane & 15, fq = lane >> 4;
    const int K = g.K, nt = K / BK;
    unsigned voffA[2], voffB[2];
#pragma unroll
    for (int i = 0; i < 2; ++i) { int R, C; stage_rc(tid * 16 + i * 8192, R, C); const int Rb = Epi::PERM ? ((R & ~31) + perm32(R & 31)) : R;
        voffA[i] = (unsigned)(R * K + C) * 2u; voffB[i] = (unsigned)(Rb * K + C) * 2u; }
    const size_t kstep = (size_t)(BK * 2);
    const size_t hstep = (size_t)HALF * K * 2;
    const size_t tstep = 2 * hstep;
    const unsigned ldsw = (unsigned)wid * 1024u;
    const int aoff = lds_byte(wr * 64 + fr, fq * 8), boff = lds_byte(wc * 32 + fr, fq * 8);
#define PG8_SA(b, h) (((b) * 2 + (h)) * HTB)
#define PG8_SB(b, h) ((4 + (b) * 2 + (h)) * HTB)
#define PG8_STAGE(bufoff, gbase, voff) do { _Pragma("unroll") for (int _i = 0; _i < 2; ++_i) \
        __builtin_amdgcn_global_load_lds((const unsigned*)((const char*)(gbase) + (voff)[_i]), (PG8_LAS unsigned*)(lds + (bufoff) + ldsw + _i * 8192), 16, 0, 0); } while (0)
#define PG8_LDA(dst, b, h) do { _Pragma("unroll") for (int m = 0; m < 4; ++m) _Pragma("unroll") for (int k = 0; k < 2; ++k) dst[m][k] = *(const PG8_LAS bf16x8*)(lds + PG8_SA(b, h) + aoff + m * 2048 + k * 1024); } while (0)
#define PG8_LDB(dst, b, h) do { _Pragma("unroll") for (int n = 0; n < 2; ++n) _Pragma("unroll") for (int k = 0; k < 2; ++k) dst[n][k] = *(const PG8_LAS bf16x8*)(lds + PG8_SB(b, h) + boff + n * 2048 + k * 1024); } while (0)
#define PG8_MMA(ai, bj, At, Bt) do { __builtin_amdgcn_s_setprio(1); _Pragma("unroll") for (int m = 0; m < 4; ++m) _Pragma("unroll") for (int n = 0; n < 2; ++n) _Pragma("unroll") for (int k = 0; k < 2; ++k) \
        acc[ai][bj][m][n] = __builtin_amdgcn_mfma_f32_16x16x32_bf16(Bt[n][k], At[m][k], acc[ai][bj][m][n], 0, 0, 0); __builtin_amdgcn_s_setprio(0); } while (0)
#define PG8_WAIT_V(n) asm volatile("s_waitcnt vmcnt(" #n ")" ::: "memory")
#define PG8_WAIT_L(n) asm volatile("s_waitcnt lgkmcnt(" #n ")" ::: "memory")
#define PG8_BAR __builtin_amdgcn_s_barrier()
#define PG8_SCHED __builtin_amdgcn_sched_barrier(0)
    Unit cur, nxt; int ui = 0;
    if (!S.next(0, cur)) return;
    f32x4 acc[2][2][4][2];
#pragma unroll
    for (int a = 0; a < 2; ++a)
#pragma unroll
        for (int b = 0; b < 2; ++b)
#pragma unroll
            for (int m = 0; m < 4; ++m)
#pragma unroll
                for (int n = 0; n < 2; ++n) acc[a][b][m][n] = (f32x4){0.f, 0.f, 0.f, 0.f};
    bf16x8 At[4][2], B0[2][2], B1[2][2];
    const char* cA = (const char*)g.A + (size_t)cur.pm * tstep; const char* cB = (const char*)g.Bt + (size_t)cur.pn * tstep;
    S.a_ready(cur);
    if constexpr (SP2) {
        PG8_STAGE(PG8_SB(0, 0), cB, voffB); PG8_STAGE(PG8_SB(0, 1), cB + hstep, voffB); PG8_STAGE(PG8_SA(0, 0), cA, voffA); PG8_STAGE(PG8_SA(0, 1), cA + hstep, voffA);
        if (wr == 1) PG8_BAR;
        PG8_WAIT_V(2); PG8_BAR;
        PG8_STAGE(PG8_SB(1, 0), cB + kstep, voffB); PG8_STAGE(PG8_SA(1, 0), cA + kstep, voffA); PG8_STAGE(PG8_SB(1, 1), cB + hstep + kstep, voffB);
        PG8_WAIT_V(6); PG8_BAR;
    } else {
        PG8_STAGE(PG8_SB(0, 0), cB, voffB); PG8_STAGE(PG8_SA(0, 0), cA, voffA); PG8_STAGE(PG8_SB(0, 1), cB + hstep, voffB); PG8_STAGE(PG8_SA(0, 1), cA + hstep, voffA);
        if (wr == 1) PG8_BAR;
        PG8_WAIT_V(4); PG8_BAR;
        PG8_STAGE(PG8_SB(1, 0), cB + kstep, voffB); PG8_STAGE(PG8_SA(1, 0), cA + kstep, voffA); PG8_STAGE(PG8_SB(1, 1), cB + hstep + kstep, voffB);
        PG8_WAIT_V(6); PG8_BAR;
    }
    for (;;) {
        const bool has_next = S.next(ui + 1, nxt);
        const char* nA = has_next ? (const char*)g.A + (size_t)nxt.pm * tstep : cA; const char* nB = has_next ? (const char*)g.Bt + (size_t)nxt.pn * tstep : cB;
        for (int t = 0; t < nt; t += 2) {
            const bool last = (t == nt - 2);
            const char* a1 = cA + (size_t)(t + 1) * kstep;
            const char* a2 = last ? nA : cA + (size_t)(t + 2) * kstep; const char* b2 = last ? nB : cB + (size_t)(t + 2) * kstep;
            const char* a3 = a2 + kstep; const char* b3 = b2 + kstep;
            if (last && has_next) S.a_ready(nxt);
            if constexpr (SP2) {
            PG8_LDB(B0, 0, 0); PG8_LDB(B1, 0, 1); PG8_SCHED; PG8_LDA(At, 0, 0); PG8_STAGE(PG8_SA(1, 1), a1 + hstep, voffA);
            PG8_WAIT_V(8); PG8_WAIT_L(0); PG8_BAR; PG8_MMA(0, 0, At, B0); PG8_MMA(0, 1, At, B1); PG8_BAR; PG8_SCHED;
            PG8_LDA(At, 0, 1); PG8_STAGE(PG8_SB(0, 0), b2, voffB); PG8_STAGE(PG8_SB(0, 1), b2 + hstep, voffB); PG8_STAGE(PG8_SA(0, 0), a2, voffA);
            PG8_WAIT_V(8); PG8_WAIT_L(0); PG8_BAR; PG8_MMA(1, 0, At, B0); PG8_MMA(1, 1, At, B1); PG8_BAR; PG8_SCHED;
            PG8_LDB(B0, 1, 0); PG8_LDB(B1, 1, 1); PG8_SCHED; PG8_LDA(At, 1, 0); PG8_STAGE(PG8_SA(0, 1), a2 + hstep, voffA);
            PG8_WAIT_V(8); PG8_WAIT_L(0); PG8_BAR; PG8_MMA(0, 0, At, B0); PG8_MMA(0, 1, At, B1); PG8_BAR; PG8_SCHED;
            PG8_LDA(At, 1, 1); PG8_STAGE(PG8_SB(1, 0), b3, voffB); PG8_STAGE(PG8_SB(1, 1), b3 + hstep, voffB); PG8_STAGE(PG8_SA(1, 0), a3, voffA);
            PG8_WAIT_V(8); PG8_WAIT_L(0); PG8_BAR; PG8_MMA(1, 0, At, B0); PG8_MMA(1, 1, At, B1); PG8_BAR; PG8_SCHED;
            } else {
            PG8_LDB(B0, 0, 0); PG8_SCHED; PG8_LDA(At, 0, 0); PG8_STAGE(PG8_SA(1, 1), a1 + hstep, voffA);
            PG8_WAIT_L(8); PG8_BAR; PG8_WAIT_L(0); PG8_MMA(0, 0, At, B0); PG8_BAR; PG8_SCHED;
            PG8_LDB(B1, 0, 1); PG8_STAGE(PG8_SB(0, 0), b2, voffB);
            PG8_BAR; PG8_WAIT_L(0); PG8_MMA(0, 1, At, B1); PG8_BAR;
            PG8_LDA(At, 0, 1); PG8_STAGE(PG8_SA(0, 0), a2, voffA);
            PG8_BAR; PG8_WAIT_L(0); PG8_MMA(1, 0, At, B0); PG8_BAR; PG8_SCHED;
            PG8_STAGE(PG8_SB(0, 1), b2 + hstep, voffB);
            PG8_WAIT_V(6); PG8_BAR; PG8_MMA(1, 1, At, B1); PG8_BAR;
            PG8_LDB(B0, 1, 0); PG8_SCHED; PG8_LDA(At, 1, 0); PG8_STAGE(PG8_SA(0, 1), a2 + hstep, voffA);
            PG8_WAIT_L(8); PG8_BAR; PG8_WAIT_L(0); PG8_MMA(0, 0, At, B0); PG8_BAR; PG8_SCHED;
            PG8_LDB(B1, 1, 1); PG8_STAGE(PG8_SB(1, 0), b3, voffB);
            PG8_BAR; PG8_WAIT_L(0); PG8_MMA(0, 1, At, B1); PG8_BAR;
            PG8_LDA(At, 1, 1); PG8_STAGE(PG8_SA(1, 0), a3, voffA);
            PG8_BAR; PG8_WAIT_L(0); PG8_MMA(1, 0, At, B0); PG8_BAR; PG8_SCHED;
            PG8_STAGE(PG8_SB(1, 1), b3 + hstep, voffB);
            PG8_WAIT_V(6); PG8_BAR; PG8_MMA(1, 1, At, B1); PG8_BAR;
            }
        }
        if constexpr (ALIGN_EPI) { if (wr == 0) PG8_BAR; }
        if constexpr (!Epi::AFTER_DRAIN) { E(acc, cur, wr, wc, fr, fq); S.done(cur); }
        if (!has_next) break;
#pragma unroll
        for (int a = 0; a < 2; ++a)
#pragma unroll
            for (int b = 0; b < 2; ++b)
#pragma unroll
                for (int m = 0; m < 4; ++m)
#pragma unroll
                    for (int n = 0; n < 2; ++n) acc[a][b][m][n] = (f32x4){0.f, 0.f, 0.f, 0.f};
        cur = nxt; cA = nA; cB = nB; ++ui;
        if constexpr (ALIGN_EPI) { if (wr == 1) PG8_BAR; }
    }
    PG8_WAIT_V(0);
    if constexpr (!ALIGN_EPI) { if (wr == 0) PG8_BAR; }
    PG8_BAR;
    if constexpr (Epi::AFTER_DRAIN) { E.fused(acc, cur, wr, wc, fr, fq, lds, wid, lane); S.done(cur); }
#undef PG8_SA
#undef PG8_SB
#undef PG8_STAGE
#undef PG8_LDA
#undef PG8_LDB
#undef PG8_MMA
#undef PG8_WAIT_V
#undef PG8_WAIT_L
#undef PG8_BAR
#undef PG8_SCHED
}
}

using pg8::f32x4; using pg8::u32x4; using pg8::Unit; using pg8::HALF; using pg8::BM;
typedef unsigned u32x2 __attribute__((ext_vector_type(2)));

struct EpiIn {
  static constexpr bool PERM = true, AFTER_DRAIN = false;
  bf16_t* qkv; bf16_t* rest; const float* rowss; const float* bias;
  __device__ __forceinline__ void operator()(const f32x4 (&acc)[2][2][4][2], const Unit& u, int wr, int wc, int fr, int fq) const {
    const int row0 = u.pm * BM + wr * 64 + fr;
    const int seg = seg_of_row(u.pm * BM);
    int colt = u.pn * BM; bf16_t* base = qkv; int ldc = NQKV;
    if (colt >= NQKV) { base = rest; ldc = NREST; colt -= NQKV; }
    const int col0 = colt + wc * 32 + 8 * fq, bcol0 = seg * NCOLS + u.pn * BM + wc * 32 + 8 * fq;
    f32x4 bv[2][2];
#pragma unroll
    for (int bj = 0; bj < 2; ++bj)
#pragma unroll
      for (int n = 0; n < 2; ++n) bv[bj][n] = *(const f32x4*)(bias + bcol0 + bj * HALF + 4 * n);
#pragma unroll
    for (int ai = 0; ai < 2; ++ai)
#pragma unroll
      for (int m = 0; m < 4; ++m) {
        const int r = row0 + ai * HALF + m * 16;
        const float rinv = rsqrtf(rowss[r] * (1.0f / 1024.0f) + 1e-6f);
        bf16_t* rowp = base + (size_t)r * ldc + col0;
#pragma unroll
        for (int bj = 0; bj < 2; ++bj) {
          const f32x4 v0 = acc[ai][bj][m][0] * rinv + bv[bj][0], v1 = acc[ai][bj][m][1] * rinv + bv[bj][1];
          u32x4 w; w.x = pg8::cvt_pk_bf16(v0[0], v0[1]); w.y = pg8::cvt_pk_bf16(v0[2], v0[3]); w.z = pg8::cvt_pk_bf16(v1[0], v1[1]); w.w = pg8::cvt_pk_bf16(v1[2], v1[3]);
          *(u32x4*)(rowp + bj * HALF) = w;
        }
      }
  }
};

struct EpiRes {
  static constexpr bool PERM = false, AFTER_DRAIN = false;
  float* X; const float* gate; float* rowss; bf16_t* xa; const float* An;
  __device__ __forceinline__ void operator()(const f32x4 (&acc)[2][2][4][2], const Unit& u, int wr, int wc, int fr, int fq) const {
    const int row0 = u.pm * BM + wr * 64 + fr, col0 = u.pn * BM + wc * 32 + 4 * fq;
    const int seg = seg_of_row(u.pm * BM);
    f32x4 gv[2][2], av[2][2];
#pragma unroll
    for (int bj = 0; bj < 2; ++bj)
#pragma unroll
      for (int n = 0; n < 2; ++n) {
        gv[bj][n] = *(const f32x4*)(gate + seg * 6144 + col0 + bj * HALF + n * 16);
        av[bj][n] = xa ? *(const f32x4*)(An + seg * 1024 + col0 + bj * HALF + n * 16) : (f32x4){0.f, 0.f, 0.f, 0.f};
      }
#pragma unroll
    for (int ai = 0; ai < 2; ++ai)
#pragma unroll
      for (int m = 0; m < 4; ++m) {
        const int r = row0 + ai * HALF + m * 16;
        float* xrow = X + (size_t)r * 1024 + col0;
        float ss = 0.f;
#pragma unroll
        for (int bj = 0; bj < 2; ++bj)
#pragma unroll
          for (int n = 0; n < 2; ++n) {
            const f32x4 xo = *(const f32x4*)(xrow + bj * HALF + n * 16);
            const f32x4 xn = xo + gv[bj][n] * acc[ai][bj][m][n];
            *(f32x4*)(xrow + bj * HALF + n * 16) = xn;
            ss += (xn[0] * xn[0] + xn[1] * xn[1]) + (xn[2] * xn[2] + xn[3] * xn[3]);
            if (xa) {
              const f32x4 t = xn * av[bj][n];
              u32x2 w; w.x = pg8::cvt_pk_bf16(t[0], t[1]); w.y = pg8::cvt_pk_bf16(t[2], t[3]);
              *(u32x2*)(xa + (size_t)r * 1024 + col0 + bj * HALF + n * 16) = w;
            }
          }
        ss += __shfl_xor(ss, 16); ss += __shfl_xor(ss, 32);
        if (fq == 0) atomicAdd(rowss + r, ss);
      }
  }
};

struct EpiGu {
  static constexpr bool PERM = true, AFTER_DRAIN = false;
  bf16_t* act; const float* rowss; const float* bias;
  __device__ __forceinline__ void operator()(const f32x4 (&acc)[2][2][4][2], const Unit& u, int wr, int wc, int fr, int fq) const {
    const int row0 = u.pm * BM + wr * 64 + fr;
    const int seg = seg_of_row(u.pm * BM);
    const int hid0 = u.pn * HALF + wc * 32 + 8 * fq, bcol0 = seg * (2 * FFH) + u.pn * BM + wc * 32 + 8 * fq;
    f32x4 bv[2][2];
#pragma unroll
    for (int bj = 0; bj < 2; ++bj)
#pragma unroll
      for (int n = 0; n < 2; ++n) bv[bj][n] = *(const f32x4*)(bias + bcol0 + bj * HALF + 4 * n);
#pragma unroll
    for (int ai = 0; ai < 2; ++ai)
#pragma unroll
      for (int m = 0; m < 4; ++m) {
        const int r = row0 + ai * HALF + m * 16;
        const float rinv = rsqrtf(rowss[r] * (1.0f / 1024.0f) + 1e-6f);
        float o[8];
#pragma unroll
        for (int n = 0; n < 2; ++n) {
          const f32x4 g = acc[ai][0][m][n] * rinv + bv[0][n], up = acc[ai][1][m][n] * rinv + bv[1][n];
#pragma unroll
          for (int j = 0; j < 4; ++j) o[n * 4 + j] = g[j] * __builtin_amdgcn_rcpf(1.f + __expf(-g[j])) * up[j];
        }
        u32x4 w; w.x = pg8::cvt_pk_bf16(o[0], o[1]); w.y = pg8::cvt_pk_bf16(o[2], o[3]); w.z = pg8::cvt_pk_bf16(o[4], o[5]); w.w = pg8::cvt_pk_bf16(o[6], o[7]);
        *(u32x4*)(act + (size_t)r * FFH + hid0) = w;
      }
  }
};


__device__ __forceinline__ int win_srccol(int j) { return j < 2048 ? j : j + 16; }
__device__ __forceinline__ int wgu_srccol(int j) { const int pn = j >> 8, w = j & 255; return w < 128 ? pn * 128 + w : FFH + pn * 128 + (w - 128); }

__device__ __forceinline__ void transpose_tile(const float* __restrict__ src, int ldsrc, int srccol0, bf16_t* __restrict__ dst, int K, int j0, int k0, float* tile, int t,
                                               const float* __restrict__ shv, float* __restrict__ bias, int bstride) {
  const int jl = t & 63, kg = t >> 6;
#pragma unroll
  for (int i = 0; i < 16; ++i) { const int k = kg * 16 + i; tile[jl * 65 + k] = src[(size_t)(k0 + k) * ldsrc + srccol0 + jl]; }
  __syncthreads();
  if (shv) {
    float a0 = 0.f, a1 = 0.f, a2 = 0.f;
#pragma unroll
    for (int i = 0; i < 16; ++i) { const int k = kg * 16 + i; const float wv = tile[jl * 65 + k]; a0 += shv[k0 + k] * wv; a1 += shv[6144 + k0 + k] * wv; a2 += shv[2 * 6144 + k0 + k] * wv; }
    atomicAdd(bias + j0 + jl, a0); atomicAdd(bias + bstride + j0 + jl, a1); atomicAdd(bias + 2 * bstride + j0 + jl, a2);
  }
  const int j = t >> 2, kc = (t & 3) * 16;
  const float* s = tile + j * 65 + kc;
  u32x4 o0, o1;
  o0.x = pack_bf16(s[0], s[1]); o0.y = pack_bf16(s[2], s[3]); o0.z = pack_bf16(s[4], s[5]); o0.w = pack_bf16(s[6], s[7]);
  o1.x = pack_bf16(s[8], s[9]); o1.y = pack_bf16(s[10], s[11]); o1.z = pack_bf16(s[12], s[13]); o1.w = pack_bf16(s[14], s[15]);
  bf16_t* d = dst + (size_t)(j0 + j) * K + k0 + kc;
  *(u32x4*)d = o0; *(u32x4*)(d + 8) = o1;
  __syncthreads();
}

#define WT_IN 0
#define WT_OUT (2816 * 1024)
#define WT_GU (WT_OUT + 1024 * 1024)
#define WT_DOWN (WT_GU + 5632 * 1024)
#define WT_LAYER (WT_DOWN + 1024 * 2816)


#define PRE_QP 0
#define PRE_KTP 16384
#define PRE_DIR0 32768
#define PRE_DIRSZ 41984
#define PRE_NW 0
#define PRE_UP 16384
#define PRE_QKP 32768
#define PRE_SC 40960
#define PRE_ITEM 116736
#define PRE_LDS 118784
#define SCAN_BUF 58368
#define SCAN_LDS (2 * SCAN_BUF)

using pg8::bf16x8;
__device__ __forceinline__ int perm_inv(int x) { return (x & ~31) | (((x >> 2) & 3) << 3) | (((x >> 4) & 1) << 2) | (x & 3); }
__device__ __forceinline__ bf16x8 pack8(const f32x4& x, const f32x4& y) {
  u32x4 w; w.x = pg8::cvt_pk_bf16(x[0], x[1]); w.y = pg8::cvt_pk_bf16(x[2], x[3]); w.z = pg8::cvt_pk_bf16(y[0], y[1]); w.w = pg8::cvt_pk_bf16(y[2], y[3]);
  return __builtin_bit_cast(bf16x8, w);
}

__device__ __forceinline__ void pre_item(int item, const bf16_t* __restrict__ QKV, const float* __restrict__ LOG, const float* __restrict__ cw,
                                         const float* __restrict__ a_log, const float* __restrict__ dt_bias, unsigned char* __restrict__ PRE,
                                         unsigned char* lds) {
  int t_ = threadIdx.x; asm volatile("" : "+v"(t_));
  const int t = t_, lane = t & 63, w = t >> 6;
  const int c = item >> 2, h = item & 3, r0 = c * 64;
  bf16_t* qb = (bf16_t*)lds; bf16_t* kb = (bf16_t*)(lds + 17408); float* vf = (float*)(lds + 34816);
  float* Lf = (float*)(lds + 67584); float* Lb = (float*)(lds + 83968); float* sc = (float*)(lds + 100352);
  unsigned char* pre = PRE + (size_t)item * PRE_ITEM;
  {
    const int i = t >> 3, cg = t & 7, r = r0 + i;
    int s0, len;
    if (r < NCTX) { s0 = r & ~255; len = 256; } else { s0 = NCTX + ((r - NCTX) & ~2047); len = 2048; }
    const int tt = r - s0; const bool hp = tt > 0, hn = tt < len - 1;
#pragma unroll
    for (int x = 0; x < 3; ++x) {
      const int cb = x * 512 + h * 128 + cg * 16;
      const bf16_t* p0 = QKV + (size_t)r * NQKV + cb;
      u32x4 m0 = (u32x4){0u, 0u, 0u, 0u}, m1 = m0, n0 = m0, n1 = m0;
      const u32x4 c0 = *(const u32x4*)p0, c1 = *(const u32x4*)(p0 + 8);
      if (hp) { m0 = *(const u32x4*)(p0 - NQKV); m1 = *(const u32x4*)(p0 - NQKV + 8); }
      if (hn) { n0 = *(const u32x4*)(p0 + NQKV); n1 = *(const u32x4*)(p0 + NQKV + 8); }
      float val[16]; float ss = 0.f;
#pragma unroll
      for (int e = 0; e < 16; ++e) {
        const unsigned wm = (e < 8 ? m0 : m1)[(e & 7) >> 1], wc = (e < 8 ? c0 : c1)[(e & 7) >> 1], wn = (e < 8 ? n0 : n1)[(e & 7) >> 1];
        const float xm = __uint_as_float((e & 1) ? (wm & 0xffff0000u) : (wm << 16));
        const float xc = __uint_as_float((e & 1) ? (wc & 0xffff0000u) : (wc << 16));
        const float xn = __uint_as_float((e & 1) ? (wn & 0xffff0000u) : (wn << 16));
        const float y = cw[cb + e] * xm + cw[NQKV + cb + e] * xc + cw[2 * NQKV + cb + e] * xn;
        val[e] = silu_fast(y); ss += val[e] * val[e];
      }
      if (x < 2) {
        ss += __shfl_xor(ss, 1); ss += __shfl_xor(ss, 2); ss += __shfl_xor(ss, 4);
        const float rn = rsqrtf(ss + 1e-6f) * (x == 0 ? 0.08838834764831845f : 1.0f);
        bf16_t* dst = (x == 0 ? qb : kb) + i * 136 + cg * 16;
        u32x4 o0, o1;
        o0.x = pack_bf16(val[0] * rn, val[1] * rn); o0.y = pack_bf16(val[2] * rn, val[3] * rn); o0.z = pack_bf16(val[4] * rn, val[5] * rn); o0.w = pack_bf16(val[6] * rn, val[7] * rn);
        o1.x = pack_bf16(val[8] * rn, val[9] * rn); o1.y = pack_bf16(val[10] * rn, val[11] * rn); o1.z = pack_bf16(val[12] * rn, val[13] * rn); o1.w = pack_bf16(val[14] * rn, val[15] * rn);
        *(u32x4*)dst = o0; *(u32x4*)(dst + 8) = o1;
      } else {
        float* dst = vf + i * 128 + cg * 16;
#pragma unroll
        for (int e = 0; e < 16; e += 4) *(f32x4*)(dst + e) = (f32x4){val[e], val[e + 1], val[e + 2], val[e + 3]};
      }
    }
  }
  if (w == 0) {
    const int i = lane, r = r0 + i;
#pragma unroll
    for (int d = 0; d < 2; ++d) {
      const float bl = LOG[(size_t)r * 16 + d * 4 + h], al = LOG[(size_t)r * 16 + 8 + d * 4 + h];
      const float beta = sigmoid_f(bl);
      const float g = -expf(a_log[d * 4 + h]) * softplus_f(al + dt_bias[d * 4 + h]);
      float s = g;
#pragma unroll
      for (int o = 1; o < 64; o <<= 1) {
        const float nb = d == 0 ? __shfl_up(s, o) : __shfl_down(s, o);
        const bool ok = d == 0 ? (lane >= o) : (lane + o < 64);
        if (ok) s += nb;
      }
      sc[d * 64 + i] = beta; sc[128 + d * 64 + i] = s; sc[256 + d * 64 + i] = beta * expf(s);
    }
  }
  __syncthreads();
  {
    const int p = w >> 2, it = w & 3, fr = lane & 15, g = lane >> 4;
    const bf16_t* Ab = p ? qb : kb;
    bf16x8 af[4];
#pragma unroll
    for (int ks = 0; ks < 4; ++ks) af[ks] = *(const bf16x8*)(Ab + (it * 16 + fr) * 136 + ks * 32 + 8 * g);
    bf16_t* qkf = (bf16_t*)(lds + 102400);
    bf16_t* qkb = (bf16_t*)(lds + 102400 + 8192);
#pragma unroll
    for (int jt = 0; jt < 4; ++jt) {
      f32x4 acc = (f32x4){0.f, 0.f, 0.f, 0.f};
#pragma unroll
      for (int ks = 0; ks < 4; ++ks) {
        const bf16x8 bfr = *(const bf16x8*)(kb + (jt * 16 + fr) * 136 + ks * 32 + 8 * g);
        acc = __builtin_amdgcn_mfma_f32_16x16x32_bf16(af[ks], bfr, acc, 0, 0, 0);
      }
      const int j = jt * 16 + fr;
      const float gfj = sc[128 + j], gbj = sc[192 + j];
#pragma unroll
      for (int r = 0; r < 4; ++r) {
        const int i = it * 16 + 4 * g + r;
        const float val = acc[r];
        const float ef = __expf(fminf(sc[128 + i] - gfj, 0.f)), eb = __expf(fminf(sc[192 + i] - gbj, 0.f));
        if (p == 0) {
          Lf[i * 64 + j] = (j < i) ? sc[i] * val * ef : 0.f;
          Lb[(63 - i) * 64 + (63 - j)] = (j > i) ? sc[64 + i] * val * eb : 0.f;
        } else {
          const int jp = perm_inv(j);
          qkf[i * 64 + jp] = f2bf((j <= i) ? val * ef : 0.f);
          qkb[i * 64 + jp] = f2bf((j >= i) ? val * eb : 0.f);
        }
      }
    }
  }
  __syncthreads();
#pragma unroll
  for (int it2 = 0; it2 < 2; ++it2) {
    const int q = t + 512 * it2;
    { const int i = q >> 4, s = (q >> 2) & 3, g = q & 3;
      const u32x2 lo = *(const u32x2*)(qb + i * 136 + 32 * s + 4 * g), hi = *(const u32x2*)(qb + i * 136 + 32 * s + 16 + 4 * g);
      *(u32x4*)(pre + PRE_QP + (size_t)(i * 128 + 32 * s + 8 * g) * 2) = (u32x4){lo.x, lo.y, hi.x, hi.y}; }
    { const int dk = q >> 3, s2 = (q >> 2) & 1, g = q & 3;
      unsigned short e[8];
#pragma unroll
      for (int jj = 0; jj < 8; ++jj) e[jj] = kb[(32 * s2 + 16 * (jj >> 2) + 4 * g + (jj & 3)) * 136 + dk];
      u32x4 o; o.x = (unsigned)e[0] | ((unsigned)e[1] << 16); o.y = (unsigned)e[2] | ((unsigned)e[3] << 16); o.z = (unsigned)e[4] | ((unsigned)e[5] << 16); o.w = (unsigned)e[6] | ((unsigned)e[7] << 16);
      *(u32x4*)(pre + PRE_KTP + (size_t)(dk * 64 + 32 * s2 + 8 * g) * 2) = o; }
  }
  if (t < 384) {
    const int d = t / 192, rem = t % 192, k3 = rem >> 6, i = rem & 63;
    const float glast = d ? sc[192] : sc[128 + 63], gci = sc[128 + d * 64 + i];
    const float v = k3 == 0 ? expf(gci) : (k3 == 1 ? expf(glast - gci) : expf(glast));
    ((float*)(pre + PRE_DIR0 + d * PRE_DIRSZ + PRE_SC))[k3 * 64 + i] = v;
  }
  {
    const int d = w >> 2, kind = (w >> 1) & 1, cc = t & 127;
    int rowsel = d ? 63 : 0, rstep = d ? -1 : 1; unsigned Loff = d ? 83968u : 67584u;
    asm volatile("" : "+v"(rowsel), "+v"(rstep), "+v"(Loff));
    const float* L = (const float*)(lds + Loff);
    float x[64];
    if (kind == 0) {
#pragma unroll
      for (int ip = 0; ip < 64; ++ip) { const int i = rowsel + rstep * ip; x[ip] = sc[d * 64 + i] * vf[i * 128 + cc]; }
    } else {
#pragma unroll
      for (int ip = 0; ip < 64; ++ip) { const int i = rowsel + rstep * ip; x[ip] = sc[256 + d * 64 + i] * bf2f(kb[i * 136 + cc]); }
    }
    const f32x4* L4 = (const f32x4*)__builtin_assume_aligned(L, 16);
#pragma unroll
    for (int ip = 1; ip < 64; ++ip) {
      float a0 = 0.f, a1 = 0.f, a2 = 0.f, a3 = 0.f;
#pragma unroll
      for (int q = 0; q < (ip + 3) / 4; ++q) {
        const f32x4 lv = L4[ip * 16 + q];
        a0 += lv[0] * x[4 * q]; a1 += lv[1] * x[4 * q + 1]; a2 += lv[2] * x[4 * q + 2]; a3 += lv[3] * x[4 * q + 3];
      }
      x[ip] -= (a0 + a1) + (a2 + a3);
    }
    __syncthreads();
    unsigned char* outd = lds + 34816 + d * 32768;
    if (kind == 0) {
      const int dv = cc, wv = dv >> 4;
      unsigned char* ub = outd + 16384 + ((wv * 4) * 64 + (dv & 15)) * 8;
#pragma unroll
      for (int qp = 0; qp < 16; ++qp) {
        const int q = (rowsel >> 2) + rstep * qp;
        const float v0 = d ? x[4 * qp + 3] : x[4 * qp], v1 = d ? x[4 * qp + 2] : x[4 * qp + 1], v2 = d ? x[4 * qp + 1] : x[4 * qp + 2], v3 = d ? x[4 * qp] : x[4 * qp + 3];
        u32x2 pk; pk.x = pack_bf16(v0, v1); pk.y = pack_bf16(v2, v3);
        *(u32x2*)(ub + q * 128) = pk;
      }
    } else {
      const int kp = perm_inv(cc);
      bf16_t* nw = (bf16_t*)outd + kp;
#pragma unroll
      for (int ip = 0; ip < 64; ++ip) { const int i = rowsel + rstep * ip; nw[i * 128] = f2bf(-x[ip]); }
    }
  }
  __syncthreads();
  for (int k = 0; k < 8; ++k) {
    const int q = t + 512 * k, d = q >> 11, wi = q & 2047;
    *(u32x4*)(pre + PRE_DIR0 + d * PRE_DIRSZ + wi * 16) = *(const u32x4*)(lds + 34816 + q * 16);
  }
  for (int k = 0; k < 2; ++k) {
    const int q = t + 512 * k, d = q >> 9, wi = q & 511;
    *(u32x4*)(pre + PRE_DIR0 + d * PRE_DIRSZ + PRE_QKP + wi * 16) = *(const u32x4*)(lds + 102400 + q * 16);
  }
  __syncthreads();
}

__global__ __launch_bounds__(512, 2) void k_pre(const bf16_t* __restrict__ QKV, const float* __restrict__ LOG, const float* __restrict__ cw,
                                                const float* __restrict__ a_log, const float* __restrict__ dt_bias, unsigned char* __restrict__ PRE) {
  extern __shared__ __attribute__((aligned(16))) unsigned char smem[];
  for (int item = blockIdx.x; item < 768; item += gridDim.x) pre_item(item, QKV, LOG, cw, a_log, dt_bias, PRE, smem);
}

#define SCAN_OT (2 * SCAN_BUF)
#undef SCAN_LDS
#define SCAN_LDS (2 * SCAN_BUF + 8 * 2048)
__device__ __forceinline__ void scan_item(int b, int h, int d, int chunk0, int nc, int half, bool write_state, const unsigned char* __restrict__ PRE, const float* __restrict__ s_in,
                                          bf16_t* __restrict__ OB, float* __restrict__ s_out, unsigned char* lds) {
  int t_ = threadIdx.x; asm volatile("" : "+v"(t_));
  const int t = t_, lane = t & 63, w = t >> 6, fr = lane & 15, g = lane >> 4;
  const bool active = half < 0 || w < 4;
  const int dvw = half < 0 ? w : half * 4 + (w & 3), dv = 16 * dvw + fr;
  f32x4 S[8];
  if (s_in == nullptr) {
#pragma unroll
    for (int m = 0; m < 8; ++m) S[m] = (f32x4){0.f, 0.f, 0.f, 0.f};
  } else {
#pragma unroll
    for (int m = 0; m < 8; ++m)
#pragma unroll
      for (int r = 0; r < 4; ++r) S[m][r] = s_in[(16 * m + 4 * g + r) * 128 + dv];
  }
  unsigned soff[7], doff[7];
#pragma unroll
  for (int k = 0; k < 7; ++k) {
    const int q = t + 512 * k;
    if (k < 2) { const int row = q >> 4, c = q & 15; soff[k] = PRE_DIR0 + PRE_NW + q * 16; doff[k] = row * 256 + ((c ^ (row & 15)) << 4); }
    else if (k < 4) { const int q2 = q - 1024, row = q2 >> 4, c = q2 & 15; soff[k] = PRE_QP + q2 * 16; doff[k] = 16384 + row * 256 + ((c ^ (row & 15)) << 4); }
    else if (k < 5) { const int q2 = q - 2048, row = q2 >> 3, c = q2 & 7; soff[k] = PRE_DIR0 + PRE_QKP + q2 * 16; doff[k] = 32768 + row * 128 + ((c ^ ((row >> 1) & 7)) << 4); }
    else { const int q2 = q - 2560, row = q2 >> 3, c = q2 & 7; soff[k] = PRE_KTP + q2 * 16; doff[k] = 40960 + row * 128 + ((c ^ ((row >> 1) & 7)) << 4); }
    if (k < 2 || k == 4) soff[k] += d * PRE_DIRSZ;
  }
  const unsigned soff7 = PRE_DIR0 + d * PRE_DIRSZ + PRE_SC + t * 16, doff7 = 57344 + t * 16;
  const unsigned upoff = PRE_DIR0 + d * PRE_DIRSZ + PRE_UP + ((dvw * 4) * 64 + lane) * 8;
  u32x4 st[7]; u32x4 st7 = (u32x4){0u, 0u, 0u, 0u}; u32x2 up[4];
  {
    const int cidx = chunk0 + (d ? nc - 1 : 0);
    const unsigned char* pre = PRE + (size_t)(cidx * 4 + h) * PRE_ITEM;
#pragma unroll
    for (int k = 0; k < 7; ++k) st[k] = *(const u32x4*)(pre + soff[k]);
    if (t < 48) st7 = *(const u32x4*)(pre + soff7);
#pragma unroll
    for (int m = 0; m < 4; ++m) up[m] = *(const u32x2*)(pre + upoff + m * 512);
#pragma unroll
    for (int k = 0; k < 7; ++k) *(u32x4*)(lds + doff[k]) = st[k];
    if (t < 48) *(u32x4*)(lds + doff7) = st7;
  }
  __syncthreads();
  bf16_t* ot = (bf16_t*)(lds + SCAN_OT + w * 2048);
  for (int step = 0; step < nc; ++step) {
    const int cidx = chunk0 + (d ? nc - 1 - step : step);
    const unsigned char* B = lds + (step & 1) * SCAN_BUF;
    const bool more = step + 1 < nc;
    f32x4 a1[4], a2[4];
#pragma unroll
    for (int m = 0; m < 4; ++m) {
      a1[m] = (f32x4){__uint_as_float(up[m].x << 16), __uint_as_float(up[m].x & 0xffff0000u), __uint_as_float(up[m].y << 16), __uint_as_float(up[m].y & 0xffff0000u)};
      a2[m] = (f32x4){0.f, 0.f, 0.f, 0.f};
    }
    if (more) {
      const int cn = chunk0 + (d ? nc - 2 - step : step + 1);
      const unsigned char* pre = PRE + (size_t)(cn * 4 + h) * PRE_ITEM;
#pragma unroll
      for (int k = 0; k < 7; ++k) st[k] = *(const u32x4*)(pre + soff[k]);
      if (t < 48) st7 = *(const u32x4*)(pre + soff7);
#pragma unroll
      for (int m = 0; m < 4; ++m) up[m] = *(const u32x2*)(pre + upoff + m * 512);
    }
    if (active) {
      const float* SC = (const float*)(B + 57344);
      const float gt = SC[128];
      bf16x8 Sb[4];
#pragma unroll
      for (int s = 0; s < 4; ++s) Sb[s] = pack8(S[2 * s], S[2 * s + 1]);
#pragma unroll
      for (int m = 0; m < 8; ++m) S[m] = S[m] * gt;
      {
        bf16x8 fa[2][4], fq[2][4];
#pragma unroll
        for (int m = 0; m < 4; ++m) {
          fa[0][m] = *(const bf16x8*)(B + (16 * m + fr) * 256 + (((0 + g) ^ fr) << 4));
          fq[0][m] = *(const bf16x8*)(B + 16384 + (16 * m + fr) * 256 + (((0 + g) ^ fr) << 4));
        }
#pragma unroll
        for (int s = 0; s < 4; ++s) {
          if (s < 3) {
#pragma unroll
            for (int m = 0; m < 4; ++m) {
              fa[(s + 1) & 1][m] = *(const bf16x8*)(B + (16 * m + fr) * 256 + (((4 * (s + 1) + g) ^ fr) << 4));
              fq[(s + 1) & 1][m] = *(const bf16x8*)(B + 16384 + (16 * m + fr) * 256 + (((4 * (s + 1) + g) ^ fr) << 4));
            }
          }
#pragma unroll
          for (int m = 0; m < 4; ++m) a1[m] = __builtin_amdgcn_mfma_f32_16x16x32_bf16(fa[s & 1][m], Sb[s], a1[m], 0, 0, 0);
#pragma unroll
          for (int m = 0; m < 4; ++m) a2[m] = __builtin_amdgcn_mfma_f32_16x16x32_bf16(fq[s & 1][m], Sb[s], a2[m], 0, 0, 0);
        }
      }
      bf16x8 Vb[2], Vs[2];
#pragma unroll
      for (int s = 0; s < 2; ++s) Vb[s] = pack8(a1[2 * s], a1[2 * s + 1]);
#pragma unroll
      for (int m = 0; m < 4; ++m) { const f32x4 e = *(const f32x4*)(SC + 64 + 16 * m + 4 * g); a1[m] = a1[m] * e; }
#pragma unroll
      for (int s = 0; s < 2; ++s) Vs[s] = pack8(a1[2 * s], a1[2 * s + 1]);
      {
        bf16x8 fk[2][8];
#pragma unroll
        for (int s = 0; s < 2; ++s)
#pragma unroll
          for (int m = 0; m < 8; ++m) fk[s][m] = *(const bf16x8*)(B + 40960 + (16 * m + fr) * 128 + (((4 * s + g) ^ (fr >> 1)) << 4));
#pragma unroll
        for (int s = 0; s < 2; ++s)
#pragma unroll
          for (int m = 0; m < 8; ++m) S[m] = __builtin_amdgcn_mfma_f32_16x16x32_bf16(fk[s][m], Vs[s], S[m], 0, 0, 0);
      }
#pragma unroll
      for (int m = 0; m < 4; ++m) { const f32x4 e = *(const f32x4*)(SC + 16 * m + 4 * g); a2[m] = a2[m] * e; }
#pragma unroll
      for (int s = 0; s < 2; ++s)
#pragma unroll
        for (int m = 0; m < 4; ++m) {
          const bf16x8 fa = *(const bf16x8*)(B + 32768 + (16 * m + fr) * 128 + (((4 * s + g) ^ (fr >> 1)) << 4));
          a2[m] = __builtin_amdgcn_mfma_f32_16x16x32_bf16(fa, Vb[s], a2[m], 0, 0, 0);
        }
#pragma unroll
      for (int m = 0; m < 4; ++m)
#pragma unroll
        for (int r = 0; r < 4; ++r) ot[(16 * m + 4 * g + r) * 16 + fr] = f2bf(a2[m][r]);
      {
        bf16_t* op = OB + ((size_t)d * NTOK + (size_t)cidx * 64) * 512 + h * 128 + 16 * dvw;
#pragma unroll
        for (int k = 0; k < 2; ++k) {
          const int q = lane + 64 * k, row = q >> 1, hf = q & 1;
          *(u32x4*)(op + (size_t)row * 512 + hf * 8) = *(const u32x4*)(ot + row * 16 + hf * 8);
        }
      }
    }
    if (more) {
      unsigned char* Bn = lds + ((step + 1) & 1) * SCAN_BUF;
#pragma unroll
      for (int k = 0; k < 7; ++k) *(u32x4*)(Bn + doff[k]) = st[k];
      if (t < 48) *(u32x4*)(Bn + doff7) = st7;
    }
    __syncthreads();
  }
  if (write_state && active) {
#pragma unroll
    for (int m = 0; m < 8; ++m)
#pragma unroll
      for (int r = 0; r < 4; ++r) s_out[(16 * m + 4 * g + r) * 128 + dv] = S[m][r];
  }
}

__device__ __forceinline__ void scan_dispatch(int i, const unsigned char* PRE, const float* state_in, bf16_t* OB, float* state_out, int layer, unsigned char* lds) {
#ifdef LAT_FULL
  if (i < 32) {
    if (i >= 16) return;
    const int q = i, half = -1, b = q >> 3, h = (q >> 1) & 3, d = q & 1;
#else
  if (i < 32) {
    const int q = i >> 1, half = i & 1, b = q >> 3, h = (q >> 1) & 3, d = q & 1;
#endif
    scan_item(b, h, d, 128 + b * 32, 32, half, false, PRE, state_in + ((((size_t)b * 2 + layer) * 2 + d) * 4 + h) * 16384, OB, nullptr, lds);
  } else {
    const int sid = i - 32, b = sid >> 3, h = (sid >> 1) & 3, d = sid & 1;
    scan_item(b, h, d, b * 4, 4, -1, true, PRE, nullptr, OB, state_out + ((((size_t)b * 2 + layer) * 2 + d) * 4 + h) * 16384, lds);
  }
}

__global__ __launch_bounds__(512, 2) void k_scan2(const unsigned char* __restrict__ PRE, const float* __restrict__ state_in, bf16_t* __restrict__ OB,
                                                  float* __restrict__ state_out, int layer) {
  extern __shared__ __attribute__((aligned(16))) unsigned char smem[];
  for (int i = blockIdx.x; i < 288; i += gridDim.x) scan_dispatch(i, PRE, state_in, OB, state_out, layer, smem);
}
#define XB_TMO      128
#define XB_XCNT(j)  (256  + 64 * (j))
#define XB_XSUB(j)  (1280 + 64 * (j))
#define XB_XGEN(j)  (2304 + 64 * (j))
#define XB_TOP      3328
#define XB_TOPGEN   3392
#define XCD_BAR_WORDS 3456
#define XB_SPIN_CAP (1u << 18)
#define LAS __attribute__((address_space(3)))

__device__ __forceinline__ unsigned xb_ld(unsigned* p)              { return __hip_atomic_load(p, __ATOMIC_RELAXED, __HIP_MEMORY_SCOPE_AGENT); }
__device__ __forceinline__ unsigned xb_add(unsigned* p, unsigned v) { return __hip_atomic_fetch_add(p, v, __ATOMIC_RELAXED, __HIP_MEMORY_SCOPE_AGENT); }
__device__ __forceinline__ unsigned xb_xcc_id() { return (unsigned)__builtin_amdgcn_s_getreg((3 << 11) | 20) & 0xFu; }
#define XB_SPIN(cond, bar) do { unsigned _sp = 0; while (cond) { __builtin_amdgcn_s_sleep(1); \
    if ((++_sp & 255u) == 0u) { if (xb_ld(&(bar)[XB_TMO])) break; if (_sp > XB_SPIN_CAP) { atomicAdd(&(bar)[XB_TMO], 1u); break; } } } } while (0)

struct XcdBarrier {
    unsigned* bar; unsigned x;
    volatile LAS unsigned* st;
};

__device__ __forceinline__ XcdBarrier xcd_barrier_post(unsigned* bar, volatile LAS unsigned* st) {
    XcdBarrier b; b.bar = bar; b.x = xb_xcc_id(); b.st = st;
    if (threadIdx.x == 0) (void)xb_add(&bar[XB_XCNT(b.x)], 1u);
    return b;
}
__device__ __forceinline__ void xcd_barrier_complete(unsigned* bar, unsigned x, unsigned& nloc, unsigned& nx) {
    const unsigned G = gridDim.x * gridDim.y * gridDim.z;
    unsigned sum, cnt, mine, sp = 0u;
    for (;;) {
        sum = 0u; cnt = 0u; mine = 0u;
#pragma unroll
        for (unsigned j = 0; j < 16; ++j) { const unsigned c = xb_ld(&bar[XB_XCNT(j)]); sum += c; cnt += (c > 0u) ? 1u : 0u; mine = (j == x) ? c : mine; }
        if (sum == G) break;
        __builtin_amdgcn_s_sleep(1);
        if ((++sp & 255u) == 0u) { if (xb_ld(&bar[XB_TMO])) break; if (sp > XB_SPIN_CAP) { atomicAdd(&bar[XB_TMO], 1u); break; } }
    }
    nloc = mine > 0u ? mine : 1u; nx = cnt > 0u ? cnt : 1u;
}

__device__ __forceinline__ void xcd_barrier(const XcdBarrier& b) {
    asm volatile("s_waitcnt vmcnt(0)" ::: "memory");
    __syncthreads();
    if (threadIdx.x == 0) {
        unsigned* bar = b.bar;
        __builtin_amdgcn_s_waitcnt(0);
        unsigned nloc = b.st[0], nx = b.st[1];
        if (nloc == 0u) { xcd_barrier_complete(bar, b.x, nloc, nx); b.st[0] = nloc; b.st[1] = nx; }
        const unsigned old = xb_add(&bar[XB_XSUB(b.x)], 1u);
        const unsigned gen = old / nloc;
        if (old + 1u == (gen + 1u) * nloc) {
            __builtin_amdgcn_fence(__ATOMIC_RELEASE, "agent");
            asm volatile("s_waitcnt vmcnt(0)" ::: "memory");
            const unsigned og = xb_add(&bar[XB_TOP], 1u);
            const unsigned tg = og / nx;
            if (og + 1u == (tg + 1u) * nx) xb_add(&bar[XB_TOPGEN], 1u);
            else XB_SPIN(xb_ld(&bar[XB_TOPGEN]) == tg, bar);
            __builtin_amdgcn_fence(__ATOMIC_ACQUIRE, "agent");
            xb_add(&bar[XB_XGEN(b.x)], 1u);
            asm volatile("s_waitcnt vmcnt(0)" ::: "memory");
        } else {
            XB_SPIN(xb_ld(&bar[XB_XGEN(b.x)]) == gen, bar);
            __builtin_amdgcn_fence(__ATOMIC_ACQUIRE, "agent");
            asm volatile("s_waitcnt vmcnt(0)" ::: "memory");
        }
    }
    __syncthreads();
}


#include <hip/hip_cooperative_groups.h>
namespace cg = cooperative_groups;

#define MEGA_LDS_MAIN 143360
#define MEGA_LDS (MEGA_LDS_MAIN + 16)
#define WS_X 0ull
#define WS_WTA (WS_X + (size_t)NTOK * 1024 * 4)
#define WS_WTB (WS_WTA + (size_t)WT_LAYER * 2)
#define WS_QKV (WS_WTB + (size_t)2816 * 1024 * 2)
#define WS_REST (WS_QKV + (size_t)NTOK * NQKV * 2)
#define WS_PRE (WS_REST + (size_t)NTOK * NREST * 2)
#define WS_MIXB (WS_PRE + (size_t)768 * PRE_ITEM)
#define WS_MODS (WS_MIXB + (size_t)NTOK * 1024 * 2)
#define WS_AV (WS_MODS + 2 * 3 * 6144 * 4)
#define WS_BIN (WS_AV + 2 * 2 * 3 * 1024 * 4)
#define WS_BGU (WS_BIN + 2 * 3 * NCOLS * 4)
#define WS_BLOG (WS_BGU + 2 * 3 * 2 * FFH * 4)
#define WS_ROWSS (WS_BLOG + 2 * 3 * 16 * 4 + 128)
#define WS_LOG (WS_ROWSS + 5 * NTOK * 4)
#define WS_BAR (WS_LOG + (size_t)NTOK * 16 * 4)
#define WS_WLT (WS_BAR + 16384)
#define WS_POS (WS_WLT + 2 * 16 * 1024 * 2)
#define WS_END (WS_POS + 96 * 512 * 4)
struct MP {
  const float *x_prompt, *x_sample, *state_delta, *c, *c_ctx, *w_in, *conv_w, *a_log, *dt_bias, *delta_norm_g, *sgu_norm_g, *w_spatial, *b_spatial,
      *w_pool, *pool_scale, *w_out, *norm1_g, *norm2_g, *w_mod, *b_mod, *w_gu, *w_down, *norm_f;
  float* out; unsigned char* ws;
  __device__ __forceinline__ float* X_() const { return (float*)(ws + WS_X); }
  __device__ __forceinline__ bf16_t* WTA_() const { return (bf16_t*)(ws + WS_WTA); }
  __device__ __forceinline__ bf16_t* WTB_() const { return (bf16_t*)(ws + WS_WTB); }
  __device__ __forceinline__ bf16_t* QKV_() const { return (bf16_t*)(ws + WS_QKV); }
  __device__ __forceinline__ bf16_t* REST_() const { return (bf16_t*)(ws + WS_REST); }
  __device__ __forceinline__ unsigned char* PRE_() const { return ws + WS_PRE; }
  __device__ __forceinline__ bf16_t* MIXB_() const { return (bf16_t*)(ws + WS_MIXB); }
  __device__ __forceinline__ float* mods_() const { return (float*)(ws + WS_MODS); }
  __device__ __forceinline__ float* AV_() const { return (float*)(ws + WS_AV); }
  __device__ __forceinline__ float* BIN_() const { return (float*)(ws + WS_BIN); }
  __device__ __forceinline__ float* BGU_() const { return (float*)(ws + WS_BGU); }
  __device__ __forceinline__ float* BLOG_() const { return (float*)(ws + WS_BLOG); }
  __device__ __forceinline__ float* rowss_() const { return (float*)(ws + WS_ROWSS); }
  __device__ __forceinline__ float* LOG_() const { return (float*)(ws + WS_LOG); }
  __device__ __forceinline__ unsigned* bar_() const { return (unsigned*)(ws + WS_BAR); }
  __device__ __forceinline__ bf16_t* WLT_() const { return (bf16_t*)(ws + WS_WLT); }
  __device__ __forceinline__ float* POS_() const { return (float*)(ws + WS_POS); }
};

__device__ __forceinline__ void gemv3_item(const float* __restrict__ W, int ld, int ncols, const float* vec  , float* red  ,
                                           const float* __restrict__ bias, float* __restrict__ o0, float* __restrict__ o1, float* __restrict__ o2, int t) {
  const int col = t & 63, ds = t >> 6;
  float a0 = 0.f, a1 = 0.f, a2 = 0.f;
  if (col < ncols) {
    const float* w = W + (size_t)(ds * 128) * ld + col;
#pragma unroll 16
    for (int d = 0; d < 128; ++d) { const float wv = w[(size_t)d * ld]; const int dd = ds * 128 + d; a0 += vec[dd] * wv; a1 += vec[1024 + dd] * wv; a2 += vec[2048 + dd] * wv; }
  }
  red[(ds * 3 + 0) * 64 + col] = a0; red[(ds * 3 + 1) * 64 + col] = a1; red[(ds * 3 + 2) * 64 + col] = a2;
  __syncthreads();
  if (t < 192) {
    const int s = t >> 6, cc = t & 63;
    float v = 0.f;
#pragma unroll
    for (int k = 0; k < 8; ++k) v += red[(k * 3 + s) * 64 + cc];
    if (cc < ncols) { v += bias ? bias[cc] : 0.f; (s == 0 ? o0 : (s == 1 ? o1 : o2))[cc] = v; }
  }
  __syncthreads();
}

__device__ __forceinline__ void wtile(const MP& p, int l, int r  , bf16_t* wt_in, bf16_t* wt_rest, float* tile, int tt) {
  const float* ml = p.mods_() + l * 3 * 6144;
  if (r < 704) { const int kt = r / 44, jt = r % 44; transpose_tile(p.w_in + (size_t)l * 1024 * INC, INC, win_srccol(jt * 64), wt_in, 1024, jt * 64, kt * 64, tile, tt, ml, p.BIN_() + l * 3 * NCOLS, NCOLS); return; }
  r -= 704;
  if (r < 256) { const int kt = r / 16, jt = r % 16; transpose_tile(p.w_out + (size_t)l * 1024 * 1024, 1024, jt * 64, wt_rest + WT_OUT, 1024, jt * 64, kt * 64, tile, tt, nullptr, nullptr, 0); return; }
  r -= 256;
  if (r < 1408) { const int kt = r / 88, jt = r % 88; transpose_tile(p.w_gu + (size_t)l * 1024 * 2 * FFH, 2 * FFH, wgu_srccol(jt * 64), wt_rest + WT_GU, 1024, jt * 64, kt * 64, tile, tt, ml + 3072, p.BGU_() + l * 3 * 2 * FFH, 2 * FFH); return; }
  r -= 1408;
  { const int kt = r / 16, jt = r % 16; transpose_tile(p.w_down + (size_t)l * FFH * 1024, 1024, jt * 64, wt_rest + WT_DOWN, FFH, jt * 64, kt * 64, tile, tt, nullptr, nullptr, 0); }
}

__device__ __forceinline__ void phase_prep0(const MP& p, int bid, int nb, unsigned char* smem, bool tiles) {
  int t_ = threadIdx.x; asm volatile("" : "+v"(t_)); const int t = t_;
  if (!tiles) for (int i = bid * 512 + t; i < 4 * NTOK; i += nb * 512) p.rowss_()[NTOK + i] = 0.f;
  if (!tiles) for (int i = bid * 512 + t; i < 2 * 3 * NCOLS + 2 * 3 * 2 * FFH; i += nb * 512) p.BIN_()[i] = 0.f;
  if (!tiles) for (int i = bid * 512 + t; i < 96 * 512; i += nb * 512) {
    const int rc = i >> 9, dd = i & 511, jj = dd & 255;
    const float omega = 1.0f / powf(10000.0f, (float)jj / 256.0f);
    const float ang = (float)(rc < 32 ? rc : rc - 32) * omega;
    p.POS_()[i] = (dd & 256) ? cosf(ang) : sinf(ang);
  }
  if (!tiles) for (int i = bid * 512 + t; i < 2 * 16 * 1024; i += nb * 512) { const int l = i >> 14, j = (i >> 10) & 15, d = i & 1023; p.WLT_()[i] = f2bf(p.w_in[((size_t)l * 1024 + d) * INC + 2048 + j]); }
  float* vec = (float*)smem; float* red = vec + 3072; float* tile = (float*)(smem + 32768) + (t >> 8) * (64 * 65);
  const int NMOD = 192, NPAIR = (3072 + 704) / 2;
  for (int it = bid; it < (tiles ? NMOD + NPAIR : NMOD); it += nb) {
    if (it < NMOD) { if (tiles) continue;
      const int l = it / 96, cgp = it % 96;
      for (int i = t; i < 1024; i += 512) { vec[i] = silu_f(p.c_ctx[i]); vec[1024 + i] = silu_f(p.c[i]); vec[2048 + i] = silu_f(p.c[1024 + i]); }
      __syncthreads();
      float* m = p.mods_() + l * 3 * 6144 + cgp * 64;
      gemv3_item(p.w_mod + (size_t)l * 1024 * 6144 + cgp * 64, 6144, 64, vec, red, p.b_mod + l * 6144 + cgp * 64, m, m + 6144, m + 2 * 6144, t);
    } else {
      const int r = (it - NMOD) * 2 + (t >> 8);
      if (r < 3072) wtile(p, 0, r, p.WTA_() + WT_IN, p.WTA_(), tile, t & 255);
      else wtile(p, 1, r - 3072, p.WTB_(), p.WTA_(), tile, t & 255);
    }
  }
}

__device__ __forceinline__ void phase_vecs(const MP& p, int bid, int nb, unsigned char* smem) {
  int t_ = threadIdx.x; asm volatile("" : "+v"(t_)); const int t = t_;
  float* vec = (float*)smem; float* red = vec + 3072;
  for (int i = bid * 512 + t; i < 2 * 2 * 1024; i += nb * 512) {
    const int l = i >> 11, n = (i >> 10) & 1, d = i & 1023;
    const float g = n ? p.norm2_g[l * 1024 + d] : p.norm1_g[l * 1024 + d];
#pragma unroll
    for (int s = 0; s < 3; ++s) p.AV_()[((l * 2 + n) * 3 + s) * 1024 + d] = g * (1.f + p.mods_()[(l * 3 + s) * 6144 + (n ? 4096 : 1024) + d]);
  }
  const int N_IN = 44, N_GU = 88;
  for (int it = bid; it < 2; it += nb) {
    const int l = it, r = N_IN + N_GU;
    const int sh_off = (r >= N_IN && r < N_IN + N_GU) ? 3072 : 0;
    for (int i = t; i < 1024; i += 512) {
#pragma unroll
      for (int s = 0; s < 3; ++s) vec[s * 1024 + i] = p.mods_()[(l * 3 + s) * 6144 + sh_off + i];
    }
    __syncthreads();
    if (r < N_IN) { float* o = p.BIN_() + l * 3 * NCOLS + r * 64; gemv3_item(p.w_in + (size_t)l * 1024 * INC + win_srccol(r * 64), INC, 64, vec, red, nullptr, o, o + NCOLS, o + 2 * NCOLS, t); }
    else if (r < N_IN + N_GU) { const int j0 = (r - N_IN) * 64; float* o = p.BGU_() + l * 3 * 2 * FFH + j0; gemv3_item(p.w_gu + (size_t)l * 1024 * 2 * FFH + wgu_srccol(j0), 2 * FFH, 64, vec, red, nullptr, o, o + 2 * FFH, o + 4 * FFH, t); }
    else { float* o = p.BLOG_() + l * 3 * 16; gemv3_item(p.w_in + (size_t)l * 1024 * INC + 2048, INC, 16, vec, red, nullptr, o, o + 16, o + 32, t); }
  }
}

__device__ __forceinline__ void prepx_row(const MP& p, int r, int lane) {
  const int seg = seg_of_row(r);
  float ss = 0.f;
#pragma unroll
  for (int i = 0; i < 4; ++i) {
    const int d = i * 256 + lane * 4;
    f32x4 v;
    if (r < NCTX) v = *(const f32x4*)(p.x_prompt + (size_t)r * 1024 + d);
    else {
      const int rl = r - NCTX, pp = rl & 2047, row = pp >> 6, col = pp & 63;
      v = *(const f32x4*)(p.x_sample + (size_t)rl * 1024 + d);
      const f32x4 e = *(const f32x4*)(p.POS_() + (d < 512 ? row * 512 + d : (32 + col) * 512 + (d - 512)));
      v = v + e;
    }
    *(f32x4*)(p.X_() + (size_t)r * 1024 + d) = v;
    ss += (v[0] * v[0] + v[1] * v[1]) + (v[2] * v[2] + v[3] * v[3]);
    const f32x4 g1 = *(const f32x4*)(p.norm1_g + d), sc1 = *(const f32x4*)(p.mods_() + seg * 6144 + 1024 + d);
    const f32x4 a = g1 * (1.f + sc1);
    u32x2 w; w.x = pack_bf16(v[0] * a[0], v[1] * a[1]); w.y = pack_bf16(v[2] * a[2], v[3] * a[3]);
    *(u32x2*)((bf16_t*)p.PRE_() + (size_t)r * 1024 + d) = w;
  }
  ss = wave_sum(ss);
  if (lane == 0) p.rowss_()[r] = ss;
}

__device__ __forceinline__ void phase_logits(const MP& p, int l, int bid, int nb, unsigned char* smem) {
  int tl = threadIdx.x; asm volatile("" : "+v"(tl)); const int t = tl, lane = tl & 63, w = tl >> 6, fr = lane & 15, g = lane >> 4;
  bf16_t* wl = (bf16_t*)smem;
  const bf16_t* XA = (const bf16_t*)p.PRE_();
  for (int q = t; q < 2048; q += 512) { const int j = q >> 7, c = q & 127; *(u32x4*)(wl + j * 1032 + c * 8) = *(const u32x4*)(p.WLT_() + (size_t)l * 16 * 1024 + j * 1024 + c * 8); }
  __syncthreads();
  for (int rg = bid * 8 + w; rg < NTOK / 16; rg += nb * 8) {
    const int row0 = rg * 16;
    const bf16_t* arow = XA + (size_t)(row0 + fr) * 1024 + 8 * g;
    bf16x8 af[32];
#pragma unroll
    for (int ks = 0; ks < 32; ++ks) af[ks] = *(const bf16x8*)(arow + 32 * ks);
    f32x4 acc0 = (f32x4){0.f, 0.f, 0.f, 0.f}, acc1 = acc0;
#pragma unroll
    for (int ks = 0; ks < 32; ks += 2) {
      const bf16x8 b0 = *(const bf16x8*)(wl + fr * 1032 + 32 * ks + 8 * g), b1 = *(const bf16x8*)(wl + fr * 1032 + 32 * (ks + 1) + 8 * g);
      acc0 = __builtin_amdgcn_mfma_f32_16x16x32_bf16(af[ks], b0, acc0, 0, 0, 0);
      acc1 = __builtin_amdgcn_mfma_f32_16x16x32_bf16(af[ks + 1], b1, acc1, 0, 0, 0);
    }
    const int seg = seg_of_row(row0);
    const float bias = p.BLOG_()[l * 3 * 16 + seg * 16 + fr];
#pragma unroll
    for (int r = 0; r < 4; ++r) {
      const int row = row0 + 4 * g + r;
      const float rinv = rsqrtf(p.rowss_()[(2 * l) * NTOK + row] * (1.0f / 1024.0f) + 1e-6f);
      p.LOG_()[(size_t)row * 16 + fr] = (acc0[r] + acc1[r]) * rinv + bias;
    }
  }
  __syncthreads();
}

__device__ __forceinline__ void delta_post_row(const MP& p, int l, int r, int lane) {
  const bf16_t* OB = p.QKV_();
  const u32x4 of = *(const u32x4*)(OB + (size_t)r * 512 + lane * 8), ob = *(const u32x4*)(OB + ((size_t)NTOK + r) * 512 + lane * 8);
  const u32x4 zz = *(const u32x4*)(p.REST_() + (size_t)r * NREST + lane * 8);
  float o[8]; float ss = 0.f;
#pragma unroll
  for (int e = 0; e < 8; ++e) {
    const unsigned wf = of[e >> 1], wb = ob[e >> 1];
    o[e] = __uint_as_float((e & 1) ? (wf & 0xffff0000u) : (wf << 16)) + __uint_as_float((e & 1) ? (wb & 0xffff0000u) : (wb << 16));
    ss += o[e] * o[e];
  }
  ss += __shfl_xor(ss, 1); ss += __shfl_xor(ss, 2); ss += __shfl_xor(ss, 4); ss += __shfl_xor(ss, 8);
  const float rn = rsqrtf(ss * (1.0f / 128.0f) + 1e-6f);
  const float* ng = p.delta_norm_g + l * 128 + (lane & 15) * 8;
  float y[8];
#pragma unroll
  for (int e = 0; e < 8; ++e) {
    const unsigned wz = zz[e >> 1];
    const float z = __uint_as_float((e & 1) ? (wz & 0xffff0000u) : (wz << 16));
    y[e] = o[e] * rn * ng[e] * silu_fast(z);
  }
  u32x4 w; w.x = pack_bf16(y[0], y[1]); w.y = pack_bf16(y[2], y[3]); w.z = pack_bf16(y[4], y[5]); w.w = pack_bf16(y[6], y[7]);
  *(u32x4*)(p.MIXB_() + (size_t)r * 1024 + lane * 8) = w;
}

__device__ __forceinline__ void sgu_item(const MP& p, int l, int ch, int g, unsigned char* smem) {
  int tl = threadIdx.x; asm volatile("" : "+v"(tl)); const int t = tl, lane = tl & 63, w = __builtin_amdgcn_readfirstlane(tl >> 6), fr = lane & 15, g4 = lane >> 4;
  const bf16_t* REST = p.REST_(); const float* norm_g = p.sgu_norm_g + l * 256 + g * 64;
  const float* w_s = p.w_spatial + ((size_t)l * 4 + g) * 128 * 128; const float* b_s = p.b_spatial + (l * 4 + g) * 128;
  const int r0 = ch * 128;
  bf16_t* vnT = (bf16_t*)smem;
  bf16_t* ut = (bf16_t*)(smem + 17408);
  const int s_ = t >> 2, q4 = t & 3;
  const bf16_t* vrow = REST + (size_t)(r0 + s_) * NREST + 768 + g * 64 + q4 * 16;
  const u32x4 v0 = *(const u32x4*)vrow, v1 = *(const u32x4*)(vrow + 8);
  u32x4 uu[2];
#pragma unroll
  for (int k = 0; k < 2; ++k) { const int q = t + 512 * k, row = q >> 3, c8 = q & 7; uu[k] = *(const u32x4*)(REST + (size_t)(r0 + row) * NREST + 512 + g * 64 + c8 * 8); }
  f32x4 wa[4][2];
  { const float* wrow = w_s + (size_t)(w * 16 + fr) * 128 + 8 * g4;
#pragma unroll
    for (int ks = 0; ks < 4; ++ks) { wa[ks][0] = *(const f32x4*)(wrow + 32 * ks); wa[ks][1] = *(const f32x4*)(wrow + 32 * ks + 4); } }
  {
    float val[16]; float ss = 0.f;
#pragma unroll
    for (int e = 0; e < 16; ++e) {
      const unsigned wv = (e < 8 ? v0 : v1)[(e & 7) >> 1];
      val[e] = gelu_fast(__uint_as_float((e & 1) ? (wv & 0xffff0000u) : (wv << 16))); ss += val[e] * val[e];
    }
    ss += __shfl_xor(ss, 1); ss += __shfl_xor(ss, 2);
    const float rinv = rsqrtf(ss * (1.0f / 64.0f) + 1e-6f);
#pragma unroll
    for (int e = 0; e < 16; ++e) vnT[(q4 * 16 + e) * 136 + s_] = f2bf(val[e] * rinv * norm_g[q4 * 16 + e]);
#pragma unroll
    for (int k = 0; k < 2; ++k) { const int q = t + 512 * k, row = q >> 3, c8 = q & 7; *(u32x4*)(ut + row * 72 + c8 * 8) = uu[k]; }
  }
  __syncthreads();
  {
    bf16x8 af[4];
#pragma unroll
    for (int ks = 0; ks < 4; ++ks) af[ks] = pack8(wa[ks][0], wa[ks][1]);
    f32x4 acc[4];
#pragma unroll
    for (int nt = 0; nt < 4; ++nt) {
      acc[nt] = (f32x4){0.f, 0.f, 0.f, 0.f};
#pragma unroll
      for (int ks = 0; ks < 4; ++ks) {
        const bf16x8 bfr = *(const bf16x8*)(vnT + (nt * 16 + fr) * 136 + 32 * ks + 8 * g4);
        acc[nt] = __builtin_amdgcn_mfma_f32_16x16x32_bf16(af[ks], bfr, acc[nt], 0, 0, 0);
      }
    }
#pragma unroll
    for (int r = 0; r < 4; ++r) {
      const int tt = w * 16 + 4 * g4 + r;
      const float bb = b_s[tt];
#pragma unroll
      for (int nt = 0; nt < 4; ++nt) { bf16_t* e = ut + tt * 72 + nt * 16 + fr; *e = f2bf(gelu_fast(bf2f(*e)) * (acc[nt][r] + bb)); }
    }
  }
  __syncthreads();
#pragma unroll
  for (int k = 0; k < 2; ++k) { const int q = t + 512 * k, row = q >> 3, c8 = q & 7; *(u32x4*)(p.MIXB_() + (size_t)(r0 + row) * 1024 + 512 + g * 64 + c8 * 8) = *(const u32x4*)(ut + row * 72 + c8 * 8); }
  __syncthreads();
}

__device__ __forceinline__ void pool_item(const MP& p, int l, int blk, unsigned char* smem) {
  int tl = threadIdx.x; asm volatile("" : "+v"(tl)); const int t = tl, lane = tl & 63, w = __builtin_amdgcn_readfirstlane(tl >> 6), fr = lane & 15, g4 = lane >> 4;
  const bf16_t* REST = p.REST_(); const float* w_pool = p.w_pool + (size_t)l * 4 * 64 * 64; const float* scale = p.pool_scale + l * 256;
  const int r0 = blk * 64;
  int seg0, seglen;
  if (r0 < NCTX) { seg0 = r0 & ~255; seglen = 256; } else { seg0 = r0; seglen = 64; }
  bf16_t* xs = (bf16_t*)smem;
  bf16_t* dm = (bf16_t*)(smem + 42240);
  bf16_t* wT = (bf16_t*)(smem + 42240 + 36864);
  u32x4 xv[5];
#pragma unroll
  for (int k = 0; k < 5; ++k) {
    const int q = t + 512 * k, lr = q >> 5, c8 = q & 31, row = r0 - 8 + lr;
    xv[k] = (u32x4){0u, 0u, 0u, 0u};
    if (row >= seg0 && row < seg0 + seglen) xv[k] = *(const u32x4*)(REST + (size_t)row * NREST + 1024 + c8 * 8);
  }
  f32x4 wv[8];
#pragma unroll
  for (int k = 0; k < 8; ++k) wv[k] = *(const f32x4*)(w_pool + (size_t)(t + 512 * k) * 4);
#pragma unroll
  for (int k = 0; k < 5; ++k) { const int q = t + 512 * k, lr = q >> 5, c8 = q & 31; *(u32x4*)(xs + lr * 264 + c8 * 8) = xv[k]; }
#pragma unroll
  for (int k = 0; k < 8; ++k) {
    const int q = t + 512 * k, i = q >> 10, c = (q >> 4) & 63, d4 = (q & 15) * 4;
#pragma unroll
    for (int e = 0; e < 4; ++e) wT[(i * 64 + d4 + e) * 72 + c] = f2bf(wv[k][e]);
  }
  __syncthreads();
  {
    const int c = t & 255, i = c >> 6, win = 2 << i, ph = t >> 8;
    for (int pp = ph * 32; pp < ph * 32 + 32; ++pp) {
      const int pos = r0 + pp - seg0;
      const int lo = max(pos - win / 2, 0), hi = min(pos + win - win / 2, seglen);
      float s = 0.f;
      for (int q = lo; q < hi; ++q) s += bf2f(xs[(q + seg0 - r0 + 8) * 264 + c]);
      dm[(i * 64 + pp) * 72 + (c & 63)] = f2bf(s * __builtin_amdgcn_rcpf((float)(hi - lo)) - bf2f(xs[(pp + 8) * 264 + c]));
    }
  }
  __syncthreads();
  {
    const int i = w >> 1;
    bf16x8 bfr[4][2];
#pragma unroll
    for (int nt = 0; nt < 4; ++nt)
#pragma unroll
      for (int ks = 0; ks < 2; ++ks) bfr[nt][ks] = *(const bf16x8*)(wT + (i * 64 + nt * 16 + fr) * 72 + 32 * ks + 8 * g4);
#pragma unroll
    for (int pt2 = 0; pt2 < 2; ++pt2) {
      const int pt = (w & 1) * 2 + pt2;
      bf16x8 af[2];
#pragma unroll
      for (int ks = 0; ks < 2; ++ks) af[ks] = *(const bf16x8*)(dm + (i * 64 + pt * 16 + fr) * 72 + 32 * ks + 8 * g4);
#pragma unroll
      for (int nt = 0; nt < 4; ++nt) {
        f32x4 acc = (f32x4){0.f, 0.f, 0.f, 0.f};
#pragma unroll
        for (int ks = 0; ks < 2; ++ks) acc = __builtin_amdgcn_mfma_f32_16x16x32_bf16(af[ks], bfr[nt][ks], acc, 0, 0, 0);
        const float sc = scale[i * 64 + nt * 16 + fr];
#pragma unroll
        for (int r = 0; r < 4; ++r) xs[(pt * 16 + 4 * g4 + r) * 264 + i * 64 + nt * 16 + fr] = f2bf(acc[r] * sc);
      }
    }
  }
  __syncthreads();
#pragma unroll
  for (int k = 0; k < 4; ++k) { const int q = t + 512 * k, row = q >> 5, c8 = q & 31; *(u32x4*)(p.MIXB_() + (size_t)(r0 + row) * 1024 + 768 + c8 * 8) = *(const u32x4*)(xs + row * 264 + c8 * 8); }
  __syncthreads();
}

__device__ __forceinline__ void final_row(const MP& p, int r, int lane) {
  const float rinv = rsqrtf(p.rowss_()[4 * NTOK + r] * (1.0f / 1024.0f) + 1e-6f);
#pragma unroll
  for (int i = 0; i < 4; ++i) {
    const int d = i * 256 + lane * 4;
    const f32x4 v = *(const f32x4*)(p.X_() + (size_t)r * 1024 + d), gg = *(const f32x4*)(p.norm_f + d);
    *(f32x4*)(p.out + (size_t)r * 1024 + d) = v * rinv * gg;
  }
}

#ifndef REPEAT
#define REPEAT 0
#endif
#define REP_CAT2(a, b) a##b
#define REP_CAT(a, b) REP_CAT2(a, b)
#define REP(k) for (int REP_CAT(rep_, __LINE__) = 0; REP_CAT(rep_, __LINE__) < 1 + ((REPEAT >> (k)) & 1); ++REP_CAT(rep_, __LINE__))
#ifndef USE_CG_SYNC
#define USE_CG_SYNC 0
#endif
#if USE_CG_SYNC
#define GRID_SYNC() grid.sync()
#else
#define GRID_SYNC() do { REP(21) { XcdBarrier xb2; xb2.bar = p.bar_(); xb2.x = xb_xcc_id(); xb2.st = xst; xcd_barrier(xb2); } } while (0)
#endif

__global__ __launch_bounds__(512, 2) void mega(MP p) {
  extern __shared__ __attribute__((aligned(16))) unsigned char smem[];
#if USE_CG_SYNC
  cg::grid_group grid = cg::this_grid();
#else
  volatile LAS unsigned* xst = (volatile LAS unsigned*)((LAS unsigned char*)smem + MEGA_LDS_MAIN);
  if (threadIdx.x == 0) { xst[0] = 0u; xst[1] = 0u; }
  __syncthreads();
  (void)xcd_barrier_post(p.bar_(), xst);
#endif
  const int bid = blockIdx.x, nb = gridDim.x;
  bf16_t* XA = (bf16_t*)p.PRE_(); bf16_t* ACT = p.QKV_(); bf16_t* OB = p.QKV_();
  float* states_out = p.out + (size_t)NTOK * 1024;

  REP(0) phase_prep0(p, bid, nb, smem, false);
  GRID_SYNC();
  REP(1) { phase_prep0(p, bid, nb, smem, true); phase_vecs(p, bid, nb, smem); }
  REP(2) { int tl = threadIdx.x; asm volatile("" : "+v"(tl)); const int lane = tl & 63, w = tl >> 6;
    for (int r = bid * 8 + w; r < NTOK; r += nb * 8) prepx_row(p, r, lane); }
  GRID_SYNC();
  for (int l = 0; l < 2; ++l) {
#define TL_DECL int tl = threadIdx.x; asm volatile("" : "+v"(tl)); const int t = tl, lane = tl & 63, w = tl >> 6; (void)t; (void)lane; (void)w
    const float* ml = p.mods_() + l * 3 * 6144;
    float* rs1 = p.rowss_() + (2 * l) * NTOK; float* rs2 = p.rowss_() + (2 * l + 1) * NTOK; float* rs3 = p.rowss_() + (2 * l + 2) * NTOK;
    const float* A2 = p.AV_() + (l * 2 + 1) * 3 * 1024; const float* A1n = p.AV_() + (2 + 0) * 3 * 1024;
    REP(4) {
      pg8::Gemm g; g.A = XA; g.Bt = l ? p.WTB_() : p.WTA_() + WT_IN; g.M = NTOK; g.N = NCOLS; g.K = 1024;
      EpiIn E{p.QKV_(), p.REST_(), rs1, p.BIN_() + l * 3 * NCOLS};
      pg8::StaticOrder S; S.init(g.M, g.N, nb, bid);
      pg8::gemm_phase<EpiIn, pg8::StaticOrder, true, true>((PG8_LAS unsigned char*)smem, g, S, E);
    }
    REP(3) if (bid >= 16) phase_logits(p, l, bid - 16, nb - 16, smem);
    GRID_SYNC();
    REP(5) for (int item = bid; item < 768; item += nb) pre_item(item, p.QKV_(), p.LOG_(), p.conv_w + (size_t)l * 3 * NQKV, p.a_log + l * 8, p.dt_bias + l * 8, p.PRE_(), smem);
    if (l == 1) {
      TL_DECL;
      float* tile = (float*)smem + (t >> 8) * (64 * 65);
      for (int it = bid; it < (3072 - 704) / 2; it += nb) wtile(p, 1, 704 + it * 2 + (t >> 8), p.WTB_(), p.WTA_(), tile, t & 255);
    }
    GRID_SYNC();
    REP(6) { if (bid < 32) { REP(13) scan_dispatch(bid, p.PRE_(), p.state_delta, OB, states_out, l, smem); }
             else { REP(14) for (int i = bid - 32; i < 256; i += nb - 32) scan_dispatch(32 + i, p.PRE_(), p.state_delta, OB, states_out, l, smem); } }
    REP(12) if (bid >= 32) {
      for (int it = bid - 32; it < 384; it += nb - 32) sgu_item(p, l, it >> 2, it & 3, smem);
      for (int it = bid - 32; it < 192; it += nb - 32) pool_item(p, l, it, smem);
    }
    GRID_SYNC();
    REP(7) { TL_DECL; for (int r = bid * 8 + w; r < NTOK; r += nb * 8) delta_post_row(p, l, r, lane); }
    GRID_SYNC();
    {
      pg8::Gemm g; g.A = p.MIXB_(); g.Bt = p.WTA_() + WT_OUT; g.M = NTOK; g.N = 1024; g.K = 1024;
      EpiRes E{p.X_(), ml + 2048, rs2, XA, A2};
      pg8::StaticOrder S; S.init(g.M, g.N, nb, bid);
      pg8::gemm_phase<EpiRes, pg8::StaticOrder, true, true>((PG8_LAS unsigned char*)smem, g, S, E);
    }
    GRID_SYNC();
    REP(9) {
      pg8::Gemm g; g.A = XA; g.Bt = p.WTA_() + WT_GU; g.M = NTOK; g.N = 2 * FFH; g.K = 1024;
      EpiGu E{ACT, rs2, p.BGU_() + l * 3 * 2 * FFH};
      pg8::StaticOrder S; S.init(g.M, g.N, nb, bid);
      pg8::gemm_phase<EpiGu, pg8::StaticOrder, true, true>((PG8_LAS unsigned char*)smem, g, S, E);
    }
    GRID_SYNC();
    {
      pg8::Gemm g; g.A = ACT; g.Bt = p.WTA_() + WT_DOWN; g.M = NTOK; g.N = 1024; g.K = FFH;
      EpiRes E{p.X_(), ml + 5120, rs3, l == 0 ? XA : (bf16_t*)nullptr, A1n};
      pg8::StaticOrder S; S.init(g.M, g.N, nb, bid);
      pg8::gemm_phase<EpiRes, pg8::StaticOrder, true, true>((PG8_LAS unsigned char*)smem, g, S, E);
    }
    GRID_SYNC();
  }
  REP(11) { int tl = threadIdx.x; asm volatile("" : "+v"(tl)); const int lane = tl & 63, w = tl >> 6;
    for (int r = bid * 8 + w; r < NTOK; r += nb * 8) final_row(p, r, lane); }
}

extern "C" void kernel_launch(void* const* d_in, const int* in_sizes, int n_in, void* d_out, int out_size, void* d_ws, size_t ws_size,
                              hipStream_t stream) {
  static int grid_blocks = 0;
  if (!grid_blocks) {
    int dev = 0, cus = 0, per_cu = 0;
    (void)hipGetDevice(&dev);
    (void)hipDeviceGetAttribute(&cus, hipDeviceAttributeMultiprocessorCount, dev);
    (void)hipFuncSetAttribute((const void*)mega, hipFuncAttributeMaxDynamicSharedMemorySize, MEGA_LDS);
    (void)hipOccupancyMaxActiveBlocksPerMultiprocessor(&per_cu, (const void*)mega, 512, MEGA_LDS);
    if (per_cu < 1) { fprintf(stderr, "occupancy query says %d blocks per CU\n", per_cu); per_cu = 1; }
    if (per_cu > 1) per_cu = 1;
    grid_blocks = cus * per_cu;
    if (grid_blocks > 256) grid_blocks = 256;
  }
  MP p; memset(&p, 0, sizeof p);
  const float** ins = (const float**)&p;
  for (int i = 0; i < 23; ++i) ins[i] = (const float*)d_in[i];
  p.out = (float*)d_out;
  p.ws = (unsigned char*)d_ws;
  if (WS_END > ws_size) { fprintf(stderr, "workspace too small: need %zu have %zu\n", (size_t)WS_END, ws_size); return; }
  (void)hipMemsetAsync((char*)d_ws + WS_BAR, 0, 16384, stream);
  void* args[] = {&p};
  hipError_t e = hipLaunchCooperativeKernel((const void*)mega, dim3(grid_blocks), dim3(512), args, MEGA_LDS, stream);
  if (e != hipSuccess) fprintf(stderr, "cooperative launch failed: %s (grid %d)\n", hipGetErrorString(e), grid_blocks);
}
```

```cpp
#include <hip/hip_runtime.h>
#include <math.h>
#include <cstdio>
#include <cstring>

#define NTOK 12288
#define NCTX 8192
#define DM 1024
#define INC 2832
#define FFH 2816
#define NQKV 1536
#define NREST 1280
#define NCOLS 2816

typedef unsigned short bf16_t;
typedef float f32x2_cv __attribute__((ext_vector_type(2)));
typedef __bf16 bf16x2_cv __attribute__((ext_vector_type(2)));
__device__ __forceinline__ unsigned pack_bf16(float lo, float hi) { return __builtin_bit_cast(unsigned, __builtin_convertvector((f32x2_cv){lo, hi}, bf16x2_cv)); }
__device__ __forceinline__ bf16_t f2bf(float f) { return (bf16_t)(pack_bf16(f, 0.f) & 0xffffu); }
__device__ __forceinline__ float bf2f(bf16_t b) { return __uint_as_float(((unsigned)b) << 16); }
__device__ __forceinline__ float silu_f(float x) { return x / (1.f + expf(-x)); }
__device__ __forceinline__ float silu_fast(float x) { return x * __builtin_amdgcn_rcpf(1.f + __expf(-x)); }
__device__ __forceinline__ float gelu_fast(float x) { const float u = 1.5957691216057308f * (x + 0.044715f * x * x * x); return x * __builtin_amdgcn_rcpf(1.f + __expf(-u)); }
__device__ __forceinline__ float sigmoid_f(float x) { return 1.f / (1.f + expf(-x)); }
__device__ __forceinline__ float gelu_f(float x) { return 0.5f * x * (1.f + tanhf(0.7978845608028654f * (x + 0.044715f * x * x * x))); }
__device__ __forceinline__ float softplus_f(float x) { return x > 20.f ? x : log1pf(expf(x)); }
__device__ __forceinline__ int seg_of_row(int r) { return r < NCTX ? 0 : 1 + ((r - NCTX) >> 11); }
__device__ __forceinline__ float wave_sum(float v) {
#pragma unroll
  for (int o = 32; o > 0; o >>= 1) v += __shfl_xor(v, o);
  return v;
}
namespace pg8 {
#define PG8_LAS __attribute__((address_space(3)))
typedef unsigned short bf16_t;
typedef short bf16x8 __attribute__((ext_vector_type(8)));
typedef float f32x4 __attribute__((ext_vector_type(4)));
typedef unsigned u32x4 __attribute__((ext_vector_type(4)));
constexpr int BM = 256, BK = 64, HALF = 128, HTB = HALF * BK * 2  , STAGE_BYTES = 8 * HTB, NXCD = 8, WGM = 8;

__host__ __device__ __forceinline__ int lds_byte(int r, int c) { const int st = (r >> 4) * 2 + (c >> 5), rr = r & 15, cc = c & 31, ob = rr * 64 + cc * 2; return st * 1024 + (ob ^ (((ob >> 9) & 1) << 5)); }
__host__ __device__ __forceinline__ void stage_rc(int b, int& R, int& C) { const int st = b / 1024, sb = b % 1024, swz = sb ^ (((sb >> 9) & 1) << 5); R = (st >> 1) * 16 + swz / 64; C = (st & 1) * 32 + (swz % 64) / 2; }
__host__ __device__ __forceinline__ int perm32(int rho) { const int n = rho >> 4, i = rho & 15; return 8 * (i >> 2) + 4 * n + (i & 3); }

struct Unit { int pm, pn; };
struct Gemm { const bf16_t* A; const bf16_t* Bt; int M, N, K; };

struct StaticOrder {
    int nM, nN, nwg, G, c;
    __host__ __device__ void init(int M, int N, int G_, int c_) { nM = M / BM; nN = N / BM; nwg = nM * nN; G = G_; c = c_; }
    __host__ __device__ bool next(int i, Unit& u) const {
        const long L = (long)i * G + c; if (L >= nwg) return false;
        int wgid = (int)L; { const int q = nwg / NXCD, r = nwg % NXCD, xcd = wgid % NXCD, off = wgid / NXCD; wgid = (xcd < r ? xcd * (q + 1) : r * (q + 1) + (xcd - r) * q) + off; }
        const int nig = WGM * nN, gid = wgid / nig, fm = gid * WGM, gsz = (nM - fm) < WGM ? (nM - fm) : WGM;
        u.pm = fm + ((wgid % nig) % gsz); u.pn = (wgid % nig) / gsz; return true;
    }
    __device__ __forceinline__ void a_ready(const Unit&) const {}
    __device__ __forceinline__ void done(const Unit&) const {}
};

__device__ __forceinline__ unsigned cvt_pk_bf16(float lo, float hi) { return ::pack_bf16(lo, hi); }
template <class Epi, class Sched, bool ALIGN_EPI = false, bool SP2 = false>
__device__ __forceinline__ void gemm_phase(PG8_LAS unsigned char* lds, const Gemm g, const Sched& S, const Epi& E) {
    int tid_ = threadIdx.x; asm volatile("" : "+v"(tid_));
    const int tid = tid_, wid = __builtin_amdgcn_readfirstlane(tid >> 6), lane = tid & 63, wr = wid >> 2, wc = wid & 3, fr = lane & 15, fq = lane >> 4;
    const int K = g.K, nt = K / BK;
    unsigned voffA[2], voffB[2];
#pragma unroll
    for (int i = 0; i < 2; ++i) { int R, C; stage_rc(tid * 16 + i * 8192, R, C); const int Rb = Epi::PERM ? ((R & ~31) + perm32(R & 31)) : R;
        voffA[i] = (unsigned)(R * K + C) * 2u; voffB[i] = (unsigned)(Rb * K + C) * 2u; }
    const size_t kstep = (size_t)(BK * 2);
    const size_t hstep = (size_t)HALF * K * 2;
    const size_t tstep = 2 * hstep;
    const unsigned ldsw = (unsigned)wid * 1024u;
    const int aoff = lds_byte(wr * 64 + fr, fq * 8), boff = lds_byte(wc * 32 + fr, fq * 8);
#define PG8_SA(b, h) (((b) * 2 + (h)) * HTB)
#define PG8_SB(b, h) ((4 + (b) * 2 + (h)) * HTB)
#define PG8_STAGE(bufoff, gbase, voff) do { _Pragma("unroll") for (int _i = 0; _i < 2; ++_i) \
        __builtin_amdgcn_global_load_lds((const unsigned*)((const char*)(gbase) + (voff)[_i]), (PG8_LAS unsigned*)(lds + (bufoff) + ldsw + _i * 8192), 16, 0, 0); } while (0)
#define PG8_LDA(dst, b, h) do { _Pragma("unroll") for (int m = 0; m < 4; ++m) _Pragma("unroll") for (int k = 0; k < 2; ++k) dst[m][k] = *(const PG8_LAS bf16x8*)(lds + PG8_SA(b, h) + aoff + m * 2048 + k * 1024); } while (0)
#define PG8_LDB(dst, b, h) do { _Pragma("unroll") for (int n = 0; n < 2; ++n) _Pragma("unroll") for (int k = 0; k < 2; ++k) dst[n][k] = *(const PG8_LAS bf16x8*)(lds + PG8_SB(b, h) + boff + n * 2048 + k * 1024); } while (0)
#define PG8_MMA(ai, bj, At, Bt) do { __builtin_amdgcn_s_setprio(1); _Pragma("unroll") for (int m = 0; m < 4; ++m) _Pragma("unroll") for (int n = 0; n < 2; ++n) _Pragma("unroll") for (int k = 0; k < 2; ++k) \
        acc[ai][bj][m][n] = __builtin_amdgcn_mfma_f32_16x16x32_bf16(Bt[n][k], At[m][k], acc[ai][bj][m][n], 0, 0, 0); __builtin_amdgcn_s_setprio(0); } while (0)
#define PG8_WAIT_V(n) asm volatile("s_waitcnt vmcnt(" #n ")" ::: "memory")
#define PG8_WAIT_L(n) asm volatile("s_waitcnt lgkmcnt(" #n ")" ::: "memory")
#define PG8_BAR __builtin_amdgcn_s_barrier()
#define PG8_SCHED __builtin_amdgcn_sched_barrier(0)
    Unit cur, nxt; int ui = 0;
    if (!S.next(0, cur)) return;
    f32x4 acc[2][2][4][2];
#pragma unroll
    for (int a = 0; a < 2; ++a)
#pragma unroll
        for (int b = 0; b < 2; ++b)
#pragma unroll
            for (int m = 0; m < 4; ++m)
#pragma unroll
                for (int n = 0; n < 2; ++n) acc[a][b][m][n] = (f32x4){0.f, 0.f, 0.f, 0.f};
    bf16x8 At[4][2], B0[2][2], B1[2][2];
    const char* cA = (const char*)g.A + (size_t)cur.pm * tstep; const char* cB = (const char*)g.Bt + (size_t)cur.pn * tstep;
    S.a_ready(cur);
    if constexpr (SP2) {
        PG8_STAGE(PG8_SB(0, 0), cB, voffB); PG8_STAGE(PG8_SB(0, 1), cB + hstep, voffB); PG8_STAGE(PG8_SA(0, 0), cA, voffA); PG8_STAGE(PG8_SA(0, 1), cA + hstep, voffA);
        if (wr == 1) PG8_BAR;
        PG8_WAIT_V(2); PG8_BAR;
        PG8_STAGE(PG8_SB(1, 0), cB + kstep, voffB); PG8_STAGE(PG8_SA(1, 0), cA + kstep, voffA); PG8_STAGE(PG8_SB(1, 1), cB + hstep + kstep, voffB);
        PG8_WAIT_V(6); PG8_BAR;
    } else {
        PG8_STAGE(PG8_SB(0, 0), cB, voffB); PG8_STAGE(PG8_SA(0, 0), cA, voffA); PG8_STAGE(PG8_SB(0, 1), cB + hstep, voffB); PG8_STAGE(PG8_SA(0, 1), cA + hstep, voffA);
        if (wr == 1) PG8_BAR;
        PG8_WAIT_V(4); PG8_BAR;
        PG8_STAGE(PG8_SB(1, 0), cB + kstep, voffB); PG8_STAGE(PG8_SA(1, 0), cA + kstep, voffA); PG8_STAGE(PG8_SB(1, 1), cB + hstep + kstep, voffB);
        PG8_WAIT_V(6); PG8_BAR;
    }
    for (;;) {
        const bool has_next = S.next(ui + 1, nxt);
        const char* nA = has_next ? (const char*)g.A + (size_t)nxt.pm * tstep : cA; const char* nB = has_next ? (const char*)g.Bt + (size_t)nxt.pn * tstep : cB;
        for (int t = 0; t < nt; t += 2) {
            const bool last = (t == nt - 2);
            const char* a1 = cA + (size_t)(t + 1) * kstep;
            const char* a2 = last ? nA : cA + (size_t)(t + 2) * kstep; const char* b2 = last ? nB : cB + (size_t)(t + 2) * kstep;
            const char* a3 = a2 + kstep; const char* b3 = b2 + kstep;
            if (last && has_next) S.a_ready(nxt);
            if constexpr (SP2) {
            PG8_LDB(B0, 0, 0); PG8_LDB(B1, 0, 1); PG8_SCHED; PG8_LDA(At, 0, 0); PG8_STAGE(PG8_SA(1, 1), a1 + hstep, voffA);
            PG8_WAIT_V(8); PG8_WAIT_L(0); PG8_BAR; PG8_MMA(0, 0, At, B0); PG8_MMA(0, 1, At, B1); PG8_BAR; PG8_SCHED;
            PG8_LDA(At, 0, 1); PG8_STAGE(PG8_SB(0, 0), b2, voffB); PG8_STAGE(PG8_SB(0, 1), b2 + hstep, voffB); PG8_STAGE(PG8_SA(0, 0), a2, voffA);
            PG8_WAIT_V(8); PG8_WAIT_L(0); PG8_BAR; PG8_MMA(1, 0, At, B0); PG8_MMA(1, 1, At, B1); PG8_BAR; PG8_SCHED;
            PG8_LDB(B0, 1, 0); PG8_LDB(B1, 1, 1); PG8_SCHED; PG8_LDA(At, 1, 0); PG8_STAGE(PG8_SA(0, 1), a2 + hstep, voffA);
            PG8_WAIT_V(8); PG8_WAIT_L(0); PG8_BAR; PG8_MMA(0, 0, At, B0); PG8_MMA(0, 1, At, B1); PG8_BAR; PG8_SCHED;
            PG8_LDA(At, 1, 1); PG8_STAGE(PG8_SB(1, 0), b3, voffB); PG8_STAGE(PG8_SB(1, 1), b3 + hstep, voffB); PG8_STAGE(PG8_SA(1, 0), a3, voffA);
            PG8_WAIT_V(8); PG8_WAIT_L(0); PG8_BAR; PG8_MMA(1, 0, At, B0); PG8_MMA(1, 1, At, B1); PG8_BAR; PG8_SCHED;
            } else {
            PG8_LDB(B0, 0, 0); PG8_SCHED; PG8_LDA(At, 0, 0); PG8_STAGE(PG8_SA(1, 1), a1 + hstep, voffA);
            PG8_WAIT_L(8); PG8_BAR; PG8_WAIT_L(0); PG8_MMA(0, 0, At, B0); PG8_BAR; PG8_SCHED;
            PG8_LDB(B1, 0, 1); PG8_STAGE(PG8_SB(0, 0), b2, voffB);
            PG8_BAR; PG8_WAIT_L(0); PG8_MMA(0, 1, At, B1); PG8_BAR;
            PG8_LDA(At, 0, 1); PG8_STAGE(PG8_SA(0, 0), a2, voffA);
            PG8_BAR; PG8_WAIT_L(0); PG8_MMA(1, 0, At, B0); PG8_BAR; PG8_SCHED;
            PG8_STAGE(PG8_SB(0, 1), b2 + hstep, voffB);
            PG8_WAIT_V(6); PG8_BAR; PG8_MMA(1, 1, At, B1); PG8_BAR;
            PG8_LDB(B0, 1, 0); PG8_SCHED; PG8_LDA(At, 1, 0); PG8_STAGE(PG8_SA(0, 1), a2 + hstep, voffA);
            PG8_WAIT_L(8); PG8_BAR; PG8_WAIT_L(0); PG8_MMA(0, 0, At, B0); PG8_BAR; PG8_SCHED;
            PG8_LDB(B1, 1, 1); PG8_STAGE(PG8_SB(1, 0), b3, voffB);
            PG8_BAR; PG8_WAIT_L(0); PG8_MMA(0, 1, At, B1); PG8_BAR;
            PG8_LDA(At, 1, 1); PG8_STAGE(PG8_SA(1, 0), a3, voffA);
            PG8_BAR; PG8_WAIT_L(0); PG8_MMA(1, 0, At, B0); PG8_BAR; PG8_SCHED;
            PG8_STAGE(PG8_SB(1, 1), b3 + hstep, voffB);
            PG8_WAIT_V(6); PG8_BAR; PG8_MMA(1, 1, At, B1); PG8_BAR;
            }
        }
        if constexpr (ALIGN_EPI) { if (wr == 0) PG8_BAR; }
        if constexpr (!Epi::AFTER_DRAIN) { E(acc, cur, wr, wc, fr, fq); S.done(cur); }
        if (!has_next) break;
#pragma unroll
        for (int a = 0; a < 2; ++a)
#pragma unroll
            for (int b = 0; b < 2; ++b)
#pragma unroll
                for (int m = 0; m < 4; ++m)
#pragma unroll
                    for (int n = 0; n < 2; ++n) acc[a][b][m][n] = (f32x4){0.f, 0.f, 0.f, 0.f};
        cur = nxt; cA = nA; cB = nB; ++ui;
        if constexpr (ALIGN_EPI) { if (wr == 1) PG8_BAR; }
    }
    PG8_WAIT_V(0);
    if constexpr (!ALIGN_EPI) { if (wr == 0) PG8_BAR; }
    PG8_BAR;
    if constexpr (Epi::AFTER_DRAIN) { E.fused(acc, cur, wr, wc, fr, fq, lds, wid, lane); S.done(cur); }
#undef PG8_SA
#undef PG8_SB
#undef PG8_STAGE
#undef PG8_LDA
#undef PG8_LDB
#undef PG8_MMA
#undef PG8_WAIT_V
#undef PG8_WAIT_L
#undef PG8_BAR
#undef PG8_SCHED
}
}

using pg8::f32x4; using pg8::u32x4; using pg8::Unit; using pg8::HALF; using pg8::BM;
typedef unsigned u32x2 __attribute__((ext_vector_type(2)));

struct EpiIn {
  static constexpr bool PERM = true, AFTER_DRAIN = false;
  bf16_t* qkv; bf16_t* rest; const float* rowss; const float* bias;
  __device__ __forceinline__ void operator()(const f32x4 (&acc)[2][2][4][2], const Unit& u, int wr, int wc, int fr, int fq) const {
    const int row0 = u.pm * BM + wr * 64 + fr;
    const int seg = seg_of_row(u.pm * BM);
    int colt = u.pn * BM; bf16_t* base = qkv; int ldc = NQKV;
    if (colt >= NQKV) { base = rest; ldc = NREST; colt -= NQKV; }
    const int col0 = colt + wc * 32 + 8 * fq, bcol0 = seg * NCOLS + u.pn * BM + wc * 32 + 8 * fq;
    f32x4 bv[2][2];
#pragma unroll
    for (int bj = 0; bj < 2; ++bj)
#pragma unroll
      for (int n = 0; n < 2; ++n) bv[bj][n] = *(const f32x4*)(bias + bcol0 + bj * HALF + 4 * n);
#pragma unroll
    for (int ai = 0; ai < 2; ++ai)
#pragma unroll
      for (int m = 0; m < 4; ++m) {
        const int r = row0 + ai * HALF + m * 16;
        const float rinv = rsqrtf(rowss[r] * (1.0f / 1024.0f) + 1e-6f);
        bf16_t* rowp = base + (size_t)r * ldc + col0;
#pragma unroll
        for (int bj = 0; bj < 2; ++bj) {
          const f32x4 v0 = acc[ai][bj][m][0] * rinv + bv[bj][0], v1 = acc[ai][bj][m][1] * rinv + bv[bj][1];
          u32x4 w; w.x = pg8::cvt_pk_bf16(v0[0], v0[1]); w.y = pg8::cvt_pk_bf16(v0[2], v0[3]); w.z = pg8::cvt_pk_bf16(v1[0], v1[1]); w.w = pg8::cvt_pk_bf16(v1[2], v1[3]);
          *(u32x4*)(rowp + bj * HALF) = w;
        }
      }
  }
};

struct EpiRes {
  static constexpr bool PERM = false, AFTER_DRAIN = false;
  float* X; const float* gate; float* rowss; bf16_t* xa; const float* An;
  __device__ __forceinline__ void operator()(const f32x4 (&acc)[2][2][4][2], const Unit& u, int wr, int wc, int fr, int fq) const {
    const int row0 = u.pm * BM + wr * 64 + fr, col0 = u.pn * BM + wc * 32 + 4 * fq;
    const int seg = seg_of_row(u.pm * BM);
    f32x4 gv[2][2], av[2][2];
#pragma unroll
    for (int bj = 0; bj < 2; ++bj)
#pragma unroll
      for (int n = 0; n < 2; ++n) {
        gv[bj][n] = *(const f32x4*)(gate + seg * 6144 + col0 + bj * HALF + n * 16);
        av[bj][n] = xa ? *(const f32x4*)(An + seg * 1024 + col0 + bj * HALF + n * 16) : (f32x4){0.f, 0.f, 0.f, 0.f};
      }
#pragma unroll
    for (int ai = 0; ai < 2; ++ai)
#pragma unroll
      for (int m = 0; m < 4; ++m) {
        const int r = row0 + ai * HALF + m * 16;
        float* xrow = X + (size_t)r * 1024 + col0;
        float ss = 0.f;
#pragma unroll
        for (int bj = 0; bj < 2; ++bj)
#pragma unroll
          for (int n = 0; n < 2; ++n) {
            const f32x4 xo = *(const f32x4*)(xrow + bj * HALF + n * 16);
            const f32x4 xn = xo + gv[bj][n] * acc[ai][bj][m][n];
            *(f32x4*)(xrow + bj * HALF + n * 16) = xn;
            ss += (xn[0] * xn[0] + xn[1] * xn[1]) + (xn[2] * xn[2] + xn[3] * xn[3]);
            if (xa) {
              const f32x4 t = xn * av[bj][n];
              u32x2 w; w.x = pg8::cvt_pk_bf16(t[0], t[1]); w.y = pg8::cvt_pk_bf16(t[2], t[3]);
              *(u32x2*)(xa + (size_t)r * 1024 + col0 + bj * HALF + n * 16) = w;
            }
          }
        ss += __shfl_xor(ss, 16); ss += __shfl_xor(ss, 32);
        if (fq == 0) atomicAdd(rowss + r, ss);
      }
  }
};

struct EpiGu {
  static constexpr bool PERM = true, AFTER_DRAIN = false;
  bf16_t* act; const float* rowss; const float* bias;
  __device__ __forceinline__ void operator()(const f32x4 (&acc)[2][2][4][2], const Unit& u, int wr, int wc, int fr, int fq) const {
    const int row0 = u.pm * BM + wr * 64 + fr;
    const int seg = seg_of_row(u.pm * BM);
    const int hid0 = u.pn * HALF + wc * 32 + 8 * fq, bcol0 = seg * (2 * FFH) + u.pn * BM + wc * 32 + 8 * fq;
    f32x4 bv[2][2];
#pragma unroll
    for (int bj = 0; bj < 2; ++bj)
#pragma unroll
      for (int n = 0; n < 2; ++n) bv[bj][n] = *(const f32x4*)(bias + bcol0 + bj * HALF + 4 * n);
#pragma unroll
    for (int ai = 0; ai < 2; ++ai)
#pragma unroll
      for (int m = 0; m < 4; ++m) {
        const int r = row0 + ai * HALF + m * 16;
        const float rinv = rsqrtf(rowss[r] * (1.0f / 1024.0f) + 1e-6f);
        float o[8];
#pragma unroll
        for (int n = 0; n < 2; ++n) {
          const f32x4 g = acc[ai][0][m][n] * rinv + bv[0][n], up = acc[ai][1][m][n] * rinv + bv[1][n];
#pragma unroll
          for (int j = 0; j < 4; ++j) o[n * 4 + j] = g[j] * __builtin_amdgcn_rcpf(1.f + __expf(-g[j])) * up[j];
        }
        u32x4 w; w.x = pg8::cvt_pk_bf16(o[0], o[1]); w.y = pg8::cvt_pk_bf16(o[2], o[3]); w.z = pg8::cvt_pk_bf16(o[4], o[5]); w.w = pg8::cvt_pk_bf16(o[6], o[7]);
        *(u32x4*)(act + (size_t)r * FFH + hid0) = w;
      }
  }
};


struct EpiResFinal {
  static constexpr bool PERM = false, AFTER_DRAIN = true;
  const float* X; const float* gate; float* out; const float* normf; float* slots; unsigned* cnt;
  __device__ __forceinline__ void operator()(const f32x4 (&)[2][2][4][2], const Unit&, int, int, int, int) const {}
  __device__ __forceinline__ void fused(f32x4 (&acc)[2][2][4][2], const Unit& u, int wr, int wc, int fr, int fq, PG8_LAS unsigned char* lds, int wid, int lane) const {
    PG8_LAS float* P = (PG8_LAS float*)lds;
    PG8_LAS float* R = (PG8_LAS float*)(lds + 4096);
    const int row0 = u.pm * BM + wr * 64 + fr, col0 = u.pn * BM + wc * 32 + 4 * fq;
    const int seg = seg_of_row(u.pm * BM);
    f32x4 gv[2][2];
#pragma unroll
    for (int bj = 0; bj < 2; ++bj)
#pragma unroll
      for (int n = 0; n < 2; ++n) gv[bj][n] = *(const f32x4*)(gate + seg * 6144 + col0 + bj * HALF + n * 16);
#pragma unroll
    for (int ai = 0; ai < 2; ++ai)
#pragma unroll
      for (int m = 0; m < 4; ++m) {
        const int r = row0 + ai * HALF + m * 16;
        const float* xrow = X + (size_t)r * 1024 + col0;
        float ss = 0.f;
#pragma unroll
        for (int bj = 0; bj < 2; ++bj)
#pragma unroll
          for (int n = 0; n < 2; ++n) {
            const f32x4 xo = *(const f32x4*)(xrow + bj * HALF + n * 16);
            const f32x4 xn = xo + gv[bj][n] * acc[ai][bj][m][n];
            acc[ai][bj][m][n] = xn;
            ss += (xn[0] * xn[0] + xn[1] * xn[1]) + (xn[2] * xn[2] + xn[3] * xn[3]);
          }
        ss += __shfl_xor(ss, 16); ss += __shfl_xor(ss, 32);
        if (fq == 0) P[(ai * HALF + wr * 64 + m * 16 + fr) * 4 + wc] = ss;
      }
    __syncthreads();
    const int tid = wid * 64 + lane;
    if (tid < 256) {
      const float s = (P[tid * 4 + 0] + P[tid * 4 + 1]) + (P[tid * 4 + 2] + P[tid * 4 + 3]);
      __hip_atomic_store(slots + (size_t)(u.pm * 4 + u.pn) * 256 + tid, s, __ATOMIC_RELAXED, __HIP_MEMORY_SCOPE_AGENT);
    }
    asm volatile("s_waitcnt vmcnt(0)" ::: "memory");
    __syncthreads();
    if (tid == 0) {
      (void)__hip_atomic_fetch_add(cnt + u.pm, 1u, __ATOMIC_RELAXED, __HIP_MEMORY_SCOPE_AGENT);
      unsigned sp = 0u;
      while (__hip_atomic_load(cnt + u.pm, __ATOMIC_RELAXED, __HIP_MEMORY_SCOPE_AGENT) < 4u) { __builtin_amdgcn_s_sleep(1); if (++sp > (1u << 22)) break; }
      __builtin_amdgcn_fence(__ATOMIC_ACQUIRE, "agent");
      asm volatile("s_waitcnt vmcnt(0)" ::: "memory");
    }
    __syncthreads();
    if (tid < 256) {
      float tot = 0.f;
#pragma unroll
      for (int k = 0; k < 4; ++k) tot += __hip_atomic_load(slots + (size_t)(u.pm * 4 + k) * 256 + tid, __ATOMIC_RELAXED, __HIP_MEMORY_SCOPE_AGENT);
      R[tid] = rsqrtf(tot * (1.0f / 1024.0f) + 1e-6f);
    }
    __syncthreads();
    f32x4 nf[2][2];
#pragma unroll
    for (int bj = 0; bj < 2; ++bj)
#pragma unroll
      for (int n = 0; n < 2; ++n) nf[bj][n] = *(const f32x4*)(normf + col0 + bj * HALF + n * 16);
#pragma unroll
    for (int ai = 0; ai < 2; ++ai)
#pragma unroll
      for (int m = 0; m < 4; ++m) {
        const int lr = ai * HALF + wr * 64 + m * 16 + fr;
        const float rinv = R[lr];
        float* orow = out + (size_t)(u.pm * BM + lr) * 1024 + col0;
#pragma unroll
        for (int bj = 0; bj < 2; ++bj)
#pragma unroll
          for (int n = 0; n < 2; ++n) *(f32x4*)(orow + bj * HALF + n * 16) = acc[ai][bj][m][n] * rinv * nf[bj][n];
      }
  }
};

__device__ __forceinline__ int win_srccol(int j) { return j < 2048 ? j : j + 16; }
__device__ __forceinline__ int wgu_srccol(int j) { const int pn = j >> 8, w = j & 255; return w < 128 ? pn * 128 + w : FFH + pn * 128 + (w - 128); }

__device__ __forceinline__ void transpose_tile(const float* __restrict__ src, int ldsrc, int srccol0, bf16_t* __restrict__ dst, int K, int j0, int k0, float* tile, int t,
                                               const float* __restrict__ shv, float* __restrict__ bias, int bstride) {
  const int jl = t & 63, kg = t >> 6;
#pragma unroll
  for (int i = 0; i < 16; ++i) { const int k = kg * 16 + i; tile[jl * 65 + k] = src[(size_t)(k0 + k) * ldsrc + srccol0 + jl]; }
  __syncthreads();
  if (shv) {
    float a0 = 0.f, a1 = 0.f, a2 = 0.f;
#pragma unroll
    for (int i = 0; i < 16; ++i) { const int k = kg * 16 + i; const float wv = tile[jl * 65 + k]; a0 += shv[k0 + k] * wv; a1 += shv[6144 + k0 + k] * wv; a2 += shv[2 * 6144 + k0 + k] * wv; }
    atomicAdd(bias + j0 + jl, a0); atomicAdd(bias + bstride + j0 + jl, a1); atomicAdd(bias + 2 * bstride + j0 + jl, a2);
  }
  const int j = t >> 2, kc = (t & 3) * 16;
  const float* s = tile + j * 65 + kc;
  u32x4 o0, o1;
  o0.x = pack_bf16(s[0], s[1]); o0.y = pack_bf16(s[2], s[3]); o0.z = pack_bf16(s[4], s[5]); o0.w = pack_bf16(s[6], s[7]);
  o1.x = pack_bf16(s[8], s[9]); o1.y = pack_bf16(s[10], s[11]); o1.z = pack_bf16(s[12], s[13]); o1.w = pack_bf16(s[14], s[15]);
  bf16_t* d = dst + (size_t)(j0 + j) * K + k0 + kc;
  *(u32x4*)d = o0; *(u32x4*)(d + 8) = o1;
  __syncthreads();
}

#define WT_IN 0
#define WT_OUT (2816 * 1024)
#define WT_GU (WT_OUT + 1024 * 1024)
#define WT_DOWN (WT_GU + 5632 * 1024)
#define WT_LAYER (WT_DOWN + 1024 * 2816)


#define PRE_QP 0
#define PRE_KTP 16384
#define PRE_DIR0 32768
#define PRE_DIRSZ 41984
#define PRE_NW 0
#define PRE_UP 16384
#define PRE_QKP 32768
#define PRE_SC 40960
#define PRE_ITEM 116736
#define PRE_LDS 118784
#define SCAN_BUF 58368
#define SCAN_LDS (2 * SCAN_BUF)

using pg8::bf16x8;
__device__ __forceinline__ int perm_inv(int x) { return (x & ~31) | (((x >> 2) & 3) << 3) | (((x >> 4) & 1) << 2) | (x & 3); }
__device__ __forceinline__ bf16x8 pack8(const f32x4& x, const f32x4& y) {
  u32x4 w; w.x = pg8::cvt_pk_bf16(x[0], x[1]); w.y = pg8::cvt_pk_bf16(x[2], x[3]); w.z = pg8::cvt_pk_bf16(y[0], y[1]); w.w = pg8::cvt_pk_bf16(y[2], y[3]);
  return __builtin_bit_cast(bf16x8, w);
}

__device__ __forceinline__ void pre_item(int item, const bf16_t* __restrict__ QKV, const float* __restrict__ LOG, const float* __restrict__ cw,
                                         const float* __restrict__ a_log, const float* __restrict__ dt_bias, unsigned char* __restrict__ PRE,
                                         unsigned char* lds) {
  int t_ = threadIdx.x; asm volatile("" : "+v"(t_));
  const int t = t_, lane = t & 63, w = t >> 6;
  const int c = item >> 2, h = item & 3, r0 = c * 64;
  bf16_t* qb = (bf16_t*)lds; bf16_t* kb = (bf16_t*)(lds + 17408); float* vf = (float*)(lds + 34816);
  float* Lf = (float*)(lds + 67584); float* Lb = (float*)(lds + 83968); float* sc = (float*)(lds + 100352);
  unsigned char* pre = PRE + (size_t)item * PRE_ITEM;
  {
    const int i = t >> 3, cg = t & 7, r = r0 + i;
    int s0, len;
    if (r < NCTX) { s0 = r & ~255; len = 256; } else { s0 = NCTX + ((r - NCTX) & ~2047); len = 2048; }
    const int tt = r - s0; const bool hp = tt > 0, hn = tt < len - 1;
#pragma unroll
    for (int x = 0; x < 3; ++x) {
      const int cb = x * 512 + h * 128 + cg * 16;
      const bf16_t* p0 = QKV + (size_t)r * NQKV + cb;
      u32x4 m0 = (u32x4){0u, 0u, 0u, 0u}, m1 = m0, n0 = m0, n1 = m0;
      const u32x4 c0 = *(const u32x4*)p0, c1 = *(const u32x4*)(p0 + 8);
      if (hp) { m0 = *(const u32x4*)(p0 - NQKV); m1 = *(const u32x4*)(p0 - NQKV + 8); }
      if (hn) { n0 = *(const u32x4*)(p0 + NQKV); n1 = *(const u32x4*)(p0 + NQKV + 8); }
      float val[16]; float ss = 0.f;
#pragma unroll
      for (int e = 0; e < 16; ++e) {
        const unsigned wm = (e < 8 ? m0 : m1)[(e & 7) >> 1], wc = (e < 8 ? c0 : c1)[(e & 7) >> 1], wn = (e < 8 ? n0 : n1)[(e & 7) >> 1];
        const float xm = __uint_as_float((e & 1) ? (wm & 0xffff0000u) : (wm << 16));
        const float xc = __uint_as_float((e & 1) ? (wc & 0xffff0000u) : (wc << 16));
        const float xn = __uint_as_float((e & 1) ? (wn & 0xffff0000u) : (wn << 16));
        const float y = cw[cb + e] * xm + cw[NQKV + cb + e] * xc + cw[2 * NQKV + cb + e] * xn;
        val[e] = silu_fast(y); ss += val[e] * val[e];
      }
      if (x < 2) {
        ss += __shfl_xor(ss, 1); ss += __shfl_xor(ss, 2); ss += __shfl_xor(ss, 4);
        const float rn = rsqrtf(ss + 1e-6f) * (x == 0 ? 0.08838834764831845f : 1.0f);
        bf16_t* dst = (x == 0 ? qb : kb) + i * 136 + cg * 16;
        u32x4 o0, o1;
        o0.x = pack_bf16(val[0] * rn, val[1] * rn); o0.y = pack_bf16(val[2] * rn, val[3] * rn); o0.z = pack_bf16(val[4] * rn, val[5] * rn); o0.w = pack_bf16(val[6] * rn, val[7] * rn);
        o1.x = pack_bf16(val[8] * rn, val[9] * rn); o1.y = pack_bf16(val[10] * rn, val[11] * rn); o1.z = pack_bf16(val[12] * rn, val[13] * rn); o1.w = pack_bf16(val[14] * rn, val[15] * rn);
        *(u32x4*)dst = o0; *(u32x4*)(dst + 8) = o1;
      } else {
        float* dst = vf + i * 128 + cg * 16;
#pragma unroll
        for (int e = 0; e < 16; e += 4) *(f32x4*)(dst + e) = (f32x4){val[e], val[e + 1], val[e + 2], val[e + 3]};
      }
    }
  }
  if (w == 0) {
    const int i = lane, r = r0 + i;
#pragma unroll
    for (int d = 0; d < 2; ++d) {
      const float bl = LOG[(size_t)r * 16 + d * 4 + h], al = LOG[(size_t)r * 16 + 8 + d * 4 + h];
      const float beta = sigmoid_f(bl);
      const float g = -expf(a_log[d * 4 + h]) * softplus_f(al + dt_bias[d * 4 + h]);
      float s = g;
#pragma unroll
      for (int o = 1; o < 64; o <<= 1) {
        const float nb = d == 0 ? __shfl_up(s, o) : __shfl_down(s, o);
        const bool ok = d == 0 ? (lane >= o) : (lane + o < 64);
        if (ok) s += nb;
      }
      sc[d * 64 + i] = beta; sc[128 + d * 64 + i] = s; sc[256 + d * 64 + i] = beta * expf(s);
    }
  }
  __syncthreads();
  {
    const int p = w >> 2, it = w & 3, fr = lane & 15, g = lane >> 4;
    const bf16_t* Ab = p ? qb : kb;
    bf16x8 af[4];
#pragma unroll
    for (int ks = 0; ks < 4; ++ks) af[ks] = *(const bf16x8*)(Ab + (it * 16 + fr) * 136 + ks * 32 + 8 * g);
    bf16_t* qkf = (bf16_t*)(lds + 102400);
    bf16_t* qkb = (bf16_t*)(lds + 102400 + 8192);
#pragma unroll
    for (int jt = 0; jt < 4; ++jt) {
      f32x4 acc = (f32x4){0.f, 0.f, 0.f, 0.f};
#pragma unroll
      for (int ks = 0; ks < 4; ++ks) {
        const bf16x8 bfr = *(const bf16x8*)(kb + (jt * 16 + fr) * 136 + ks * 32 + 8 * g);
        acc = __builtin_amdgcn_mfma_f32_16x16x32_bf16(af[ks], bfr, acc, 0, 0, 0);
      }
      const int j = jt * 16 + fr;
      const float gfj = sc[128 + j], gbj = sc[192 + j];
#pragma unroll
      for (int r = 0; r < 4; ++r) {
        const int i = it * 16 + 4 * g + r;
        const float val = acc[r];
        const float ef = __expf(fminf(sc[128 + i] - gfj, 0.f)), eb = __expf(fminf(sc[192 + i] - gbj, 0.f));
        if (p == 0) {
          Lf[i * 64 + j] = (j < i) ? sc[i] * val * ef : 0.f;
          Lb[(63 - i) * 64 + (63 - j)] = (j > i) ? sc[64 + i] * val * eb : 0.f;
        } else {
          const int jp = perm_inv(j);
          qkf[i * 64 + jp] = f2bf((j <= i) ? val * ef : 0.f);
          qkb[i * 64 + jp] = f2bf((j >= i) ? val * eb : 0.f);
        }
      }
    }
  }
  __syncthreads();
#pragma unroll
  for (int it2 = 0; it2 < 2; ++it2) {
    const int q = t + 512 * it2;
    { const int i = q >> 4, s = (q >> 2) & 3, g = q & 3;
      const u32x2 lo = *(const u32x2*)(qb + i * 136 + 32 * s + 4 * g), hi = *(const u32x2*)(qb + i * 136 + 32 * s + 16 + 4 * g);
      *(u32x4*)(pre + PRE_QP + (size_t)(i * 128 + 32 * s + 8 * g) * 2) = (u32x4){lo.x, lo.y, hi.x, hi.y}; }
    { const int dk = q >> 3, s2 = (q >> 2) & 1, g = q & 3;
      unsigned short e[8];
#pragma unroll
      for (int jj = 0; jj < 8; ++jj) e[jj] = kb[(32 * s2 + 16 * (jj >> 2) + 4 * g + (jj & 3)) * 136 + dk];
      u32x4 o; o.x = (unsigned)e[0] | ((unsigned)e[1] << 16); o.y = (unsigned)e[2] | ((unsigned)e[3] << 16); o.z = (unsigned)e[4] | ((unsigned)e[5] << 16); o.w = (unsigned)e[6] | ((unsigned)e[7] << 16);
      *(u32x4*)(pre + PRE_KTP + (size_t)(dk * 64 + 32 * s2 + 8 * g) * 2) = o; }
  }
  if (t < 384) {
    const int d = t / 192, rem = t % 192, k3 = rem >> 6, i = rem & 63;
    const float glast = d ? sc[192] : sc[128 + 63], gci = sc[128 + d * 64 + i];
    const float v = k3 == 0 ? expf(gci) : (k3 == 1 ? expf(glast - gci) : expf(glast));
    ((float*)(pre + PRE_DIR0 + d * PRE_DIRSZ + PRE_SC))[k3 * 64 + i] = v;
  }
  {
    const int d = w >> 2, kind = (w >> 1) & 1, cc = t & 127;
    int rowsel = d ? 63 : 0, rstep = d ? -1 : 1; unsigned Loff = d ? 83968u : 67584u;
    asm volatile("" : "+v"(rowsel), "+v"(rstep), "+v"(Loff));
    const float* L = (const float*)(lds + Loff);
    float x[64];
    if (kind == 0) {
#pragma unroll
      for (int ip = 0; ip < 64; ++ip) { const int i = rowsel + rstep * ip; x[ip] = sc[d * 64 + i] * vf[i * 128 + cc]; }
    } else {
#pragma unroll
      for (int ip = 0; ip < 64; ++ip) { const int i = rowsel + rstep * ip; x[ip] = sc[256 + d * 64 + i] * bf2f(kb[i * 136 + cc]); }
    }
    const f32x4* L4 = (const f32x4*)__builtin_assume_aligned(L, 16);
#pragma unroll
    for (int ip = 1; ip < 64; ++ip) {
      float a0 = 0.f, a1 = 0.f, a2 = 0.f, a3 = 0.f;
#pragma unroll
      for (int q = 0; q < (ip + 3) / 4; ++q) {
        const f32x4 lv = L4[ip * 16 + q];
        a0 += lv[0] * x[4 * q]; a1 += lv[1] * x[4 * q + 1]; a2 += lv[2] * x[4 * q + 2]; a3 += lv[3] * x[4 * q + 3];
      }
      x[ip] -= (a0 + a1) + (a2 + a3);
    }
    __syncthreads();
    unsigned char* outd = lds + 34816 + d * 32768;
    if (kind == 0) {
      const int dv = cc, wv = dv >> 4;
      unsigned char* ub = outd + 16384 + ((wv * 4) * 64 + (dv & 15)) * 8;
#pragma unroll
      for (int qp = 0; qp < 16; ++qp) {
        const int q = (rowsel >> 2) + rstep * qp;
        const float v0 = d ? x[4 * qp + 3] : x[4 * qp], v1 = d ? x[4 * qp + 2] : x[4 * qp + 1], v2 = d ? x[4 * qp + 1] : x[4 * qp + 2], v3 = d ? x[4 * qp] : x[4 * qp + 3];
        u32x2 pk; pk.x = pack_bf16(v0, v1); pk.y = pack_bf16(v2, v3);
        *(u32x2*)(ub + q * 128) = pk;
      }
    } else {
      const int kp = perm_inv(cc);
      bf16_t* nw = (bf16_t*)outd + kp;
#pragma unroll
      for (int ip = 0; ip < 64; ++ip) { const int i = rowsel + rstep * ip; nw[i * 128] = f2bf(-x[ip]); }
    }
  }
  __syncthreads();
  for (int k = 0; k < 8; ++k) {
    const int q = t + 512 * k, d = q >> 11, wi = q & 2047;
    *(u32x4*)(pre + PRE_DIR0 + d * PRE_DIRSZ + wi * 16) = *(const u32x4*)(lds + 34816 + q * 16);
  }
  for (int k = 0; k < 2; ++k) {
    const int q = t + 512 * k, d = q >> 9, wi = q & 511;
    *(u32x4*)(pre + PRE_DIR0 + d * PRE_DIRSZ + PRE_QKP + wi * 16) = *(const u32x4*)(lds + 102400 + q * 16);
  }
  __syncthreads();
}

__global__ __launch_bounds__(512, 2) void k_pre(const bf16_t* __restrict__ QKV, const float* __restrict__ LOG, const float* __restrict__ cw,
                                                const float* __restrict__ a_log, const float* __restrict__ dt_bias, unsigned char* __restrict__ PRE) {
  extern __shared__ __attribute__((aligned(16))) unsigned char smem[];
  for (int item = blockIdx.x; item < 768; item += gridDim.x) pre_item(item, QKV, LOG, cw, a_log, dt_bias, PRE, smem);
}

#define SCAN_OT (2 * SCAN_BUF)
#undef SCAN_LDS
#define SCAN_LDS (2 * SCAN_BUF + 8 * 2048)
__device__ __forceinline__ void scan_item(int b, int h, int d, int chunk0, int nc, int half, bool write_state, const unsigned char* __restrict__ PRE, const float* __restrict__ s_in,
                                          bf16_t* __restrict__ OB, float* __restrict__ s_out, unsigned char* lds) {
  int t_ = threadIdx.x; asm volatile("" : "+v"(t_));
  const int t = t_, lane = t & 63, w = t >> 6, fr = lane & 15, g = lane >> 4;
  const bool active = half < 0 || w < 4;
  const int dvw = half < 0 ? w : half * 4 + (w & 3), dv = 16 * dvw + fr;
  f32x4 S[8];
  if (s_in == nullptr) {
#pragma unroll
    for (int m = 0; m < 8; ++m) S[m] = (f32x4){0.f, 0.f, 0.f, 0.f};
  } else {
#pragma unroll
    for (int m = 0; m < 8; ++m)
#pragma unroll
      for (int r = 0; r < 4; ++r) S[m][r] = s_in[(16 * m + 4 * g + r) * 128 + dv];
  }
  unsigned soff[7], doff[7];
#pragma unroll
  for (int k = 0; k < 7; ++k) {
    const int q = t + 512 * k;
    if (k < 2) { const int row = q >> 4, c = q & 15; soff[k] = PRE_DIR0 + PRE_NW + q * 16; doff[k] = row * 256 + ((c ^ (row & 15)) << 4); }
    else if (k < 4) { const int q2 = q - 1024, row = q2 >> 4, c = q2 & 15; soff[k] = PRE_QP + q2 * 16; doff[k] = 16384 + row * 256 + ((c ^ (row & 15)) << 4); }
    else if (k < 5) { const int q2 = q - 2048, row = q2 >> 3, c = q2 & 7; soff[k] = PRE_DIR0 + PRE_QKP + q2 * 16; doff[k] = 32768 + row * 128 + ((c ^ ((row >> 1) & 7)) << 4); }
    else { const int q2 = q - 2560, row = q2 >> 3, c = q2 & 7; soff[k] = PRE_KTP + q2 * 16; doff[k] = 40960 + row * 128 + ((c ^ ((row >> 1) & 7)) << 4); }
    if (k < 2 || k == 4) soff[k] += d * PRE_DIRSZ;
  }
  const unsigned soff7 = PRE_DIR0 + d * PRE_DIRSZ + PRE_SC + t * 16, doff7 = 57344 + t * 16;
  const unsigned upoff = PRE_DIR0 + d * PRE_DIRSZ + PRE_UP + ((dvw * 4) * 64 + lane) * 8;
  u32x4 st[7]; u32x4 st7 = (u32x4){0u, 0u, 0u, 0u}; u32x2 up[4];
  {
    const int cidx = chunk0 + (d ? nc - 1 : 0);
    const unsigned char* pre = PRE + (size_t)(cidx * 4 + h) * PRE_ITEM;
#pragma unroll
    for (int k = 0; k < 7; ++k) st[k] = *(const u32x4*)(pre + soff[k]);
    if (t < 48) st7 = *(const u32x4*)(pre + soff7);
#pragma unroll
    for (int m = 0; m < 4; ++m) up[m] = *(const u32x2*)(pre + upoff + m * 512);
#pragma unroll
    for (int k = 0; k < 7; ++k) *(u32x4*)(lds + doff[k]) = st[k];
    if (t < 48) *(u32x4*)(lds + doff7) = st7;
  }
  __syncthreads();
  bf16_t* ot = (bf16_t*)(lds + SCAN_OT + w * 2048);
  for (int step = 0; step < nc; ++step) {
    const int cidx = chunk0 + (d ? nc - 1 - step : step);
    const unsigned char* B = lds + (step & 1) * SCAN_BUF;
    const bool more = step + 1 < nc;
    f32x4 a1[4], a2[4];
#pragma unroll
    for (int m = 0; m < 4; ++m) {
      a1[m] = (f32x4){__uint_as_float(up[m].x << 16), __uint_as_float(up[m].x & 0xffff0000u), __uint_as_float(up[m].y << 16), __uint_as_float(up[m].y & 0xffff0000u)};
      a2[m] = (f32x4){0.f, 0.f, 0.f, 0.f};
    }
    if (more) {
      const int cn = chunk0 + (d ? nc - 2 - step : step + 1);
      const unsigned char* pre = PRE + (size_t)(cn * 4 + h) * PRE_ITEM;
#pragma unroll
      for (int k = 0; k < 7; ++k) st[k] = *(const u32x4*)(pre + soff[k]);
      if (t < 48) st7 = *(const u32x4*)(pre + soff7);
#pragma unroll
      for (int m = 0; m < 4; ++m) up[m] = *(const u32x2*)(pre + upoff + m * 512);
    }
    if (active) {
      const float* SC = (const float*)(B + 57344);
      const float gt = SC[128];
      bf16x8 Sb[4];
#pragma unroll
      for (int s = 0; s < 4; ++s) Sb[s] = pack8(S[2 * s], S[2 * s + 1]);
#pragma unroll
      for (int m = 0; m < 8; ++m) S[m] = S[m] * gt;
      {
        bf16x8 fa[2][4], fq[2][4];
#pragma unroll
        for (int m = 0; m < 4; ++m) {
          fa[0][m] = *(const bf16x8*)(B + (16 * m + fr) * 256 + (((0 + g) ^ fr) << 4));
          fq[0][m] = *(const bf16x8*)(B + 16384 + (16 * m + fr) * 256 + (((0 + g) ^ fr) << 4));
        }
#pragma unroll
        for (int s = 0; s < 4; ++s) {
          if (s < 3) {
#pragma unroll
            for (int m = 0; m < 4; ++m) {
              fa[(s + 1) & 1][m] = *(const bf16x8*)(B + (16 * m + fr) * 256 + (((4 * (s + 1) + g) ^ fr) << 4));
              fq[(s + 1) & 1][m] = *(const bf16x8*)(B + 16384 + (16 * m + fr) * 256 + (((4 * (s + 1) + g) ^ fr) << 4));
            }
          }
#pragma unroll
          for (int m = 0; m < 4; ++m) a1[m] = __builtin_amdgcn_mfma_f32_16x16x32_bf16(fa[s & 1][m], Sb[s], a1[m], 0, 0, 0);
#pragma unroll
          for (int m = 0; m < 4; ++m) a2[m] = __builtin_amdgcn_mfma_f32_16x16x32_bf16(fq[s & 1][m], Sb[s], a2[m], 0, 0, 0);
        }
      }
      bf16x8 Vb[2], Vs[2];
#pragma unroll
      for (int s = 0; s < 2; ++s) Vb[s] = pack8(a1[2 * s], a1[2 * s + 1]);
#pragma unroll
      for (int m = 0; m < 4; ++m) { const f32x4 e = *(const f32x4*)(SC + 64 + 16 * m + 4 * g); a1[m] = a1[m] * e; }
#pragma unroll
      for (int s = 0; s < 2; ++s) Vs[s] = pack8(a1[2 * s], a1[2 * s + 1]);
      {
        bf16x8 fk[2][8];
#pragma unroll
        for (int s = 0; s < 2; ++s)
#pragma unroll
          for (int m = 0; m < 8; ++m) fk[s][m] = *(const bf16x8*)(B + 40960 + (16 * m + fr) * 128 + (((4 * s + g) ^ (fr >> 1)) << 4));
#pragma unroll
        for (int s = 0; s < 2; ++s)
#pragma unroll
          for (int m = 0; m < 8; ++m) S[m] = __builtin_amdgcn_mfma_f32_16x16x32_bf16(fk[s][m], Vs[s], S[m], 0, 0, 0);
      }
#pragma unroll
      for (int m = 0; m < 4; ++m) { const f32x4 e = *(const f32x4*)(SC + 16 * m + 4 * g); a2[m] = a2[m] * e; }
#pragma unroll
      for (int s = 0; s < 2; ++s)
#pragma unroll
        for (int m = 0; m < 4; ++m) {
          const bf16x8 fa = *(const bf16x8*)(B + 32768 + (16 * m + fr) * 128 + (((4 * s + g) ^ (fr >> 1)) << 4));
          a2[m] = __builtin_amdgcn_mfma_f32_16x16x32_bf16(fa, Vb[s], a2[m], 0, 0, 0);
        }
#pragma unroll
      for (int m = 0; m < 4; ++m)
#pragma unroll
        for (int r = 0; r < 4; ++r) ot[(16 * m + 4 * g + r) * 16 + fr] = f2bf(a2[m][r]);
      {
        bf16_t* op = OB + ((size_t)d * NTOK + (size_t)cidx * 64) * 512 + h * 128 + 16 * dvw;
#pragma unroll
        for (int k = 0; k < 2; ++k) {
          const int q = lane + 64 * k, row = q >> 1, hf = q & 1;
          *(u32x4*)(op + (size_t)row * 512 + hf * 8) = *(const u32x4*)(ot + row * 16 + hf * 8);
        }
      }
    }
    if (more) {
      unsigned char* Bn = lds + ((step + 1) & 1) * SCAN_BUF;
#pragma unroll
      for (int k = 0; k < 7; ++k) *(u32x4*)(Bn + doff[k]) = st[k];
      if (t < 48) *(u32x4*)(Bn + doff7) = st7;
    }
    __syncthreads();
  }
  if (write_state && active) {
#pragma unroll
    for (int m = 0; m < 8; ++m)
#pragma unroll
      for (int r = 0; r < 4; ++r) s_out[(16 * m + 4 * g + r) * 128 + dv] = S[m][r];
  }
}

__device__ __forceinline__ void scan_dispatch(int i, const unsigned char* PRE, const float* state_in, bf16_t* OB, float* state_out, int layer, unsigned char* lds) {
#ifdef LAT_FULL
  if (i < 32) {
    if (i >= 16) return;
    const int q = i, half = -1, b = q >> 3, h = (q >> 1) & 3, d = q & 1;
#else
  if (i < 32) {
    const int q = i >> 1, half = i & 1, b = q >> 3, h = (q >> 1) & 3, d = q & 1;
#endif
    scan_item(b, h, d, 128 + b * 32, 32, half, false, PRE, state_in + ((((size_t)b * 2 + layer) * 2 + d) * 4 + h) * 16384, OB, nullptr, lds);
  } else {
    const int sid = i - 32, b = sid >> 3, h = (sid >> 1) & 3, d = sid & 1;
    scan_item(b, h, d, b * 4, 4, -1, true, PRE, nullptr, OB, state_out + ((((size_t)b * 2 + layer) * 2 + d) * 4 + h) * 16384, lds);
  }
}

__global__ __launch_bounds__(512, 2) void k_scan2(const unsigned char* __restrict__ PRE, const float* __restrict__ state_in, bf16_t* __restrict__ OB,
                                                  float* __restrict__ state_out, int layer) {
  extern __shared__ __attribute__((aligned(16))) unsigned char smem[];
  for (int i = blockIdx.x; i < 288; i += gridDim.x) scan_dispatch(i, PRE, state_in, OB, state_out, layer, smem);
}
#define XB_TMO      128
#define XB_XCNT(j)  (256  + 64 * (j))
#define XB_XSUB(j)  (1280 + 64 * (j))
#define XB_XGEN(j)  (2304 + 64 * (j))
#define XB_TOP      3328
#define XB_TOPGEN   3392
#define XCD_BAR_WORDS 3456
#define XB_SPIN_CAP (1u << 18)
#define LAS __attribute__((address_space(3)))

__device__ __forceinline__ unsigned xb_ld(unsigned* p)              { return __hip_atomic_load(p, __ATOMIC_RELAXED, __HIP_MEMORY_SCOPE_AGENT); }
__device__ __forceinline__ unsigned xb_add(unsigned* p, unsigned v) { return __hip_atomic_fetch_add(p, v, __ATOMIC_RELAXED, __HIP_MEMORY_SCOPE_AGENT); }
__device__ __forceinline__ unsigned xb_xcc_id() { return (unsigned)__builtin_amdgcn_s_getreg((3 << 11) | 20) & 0xFu; }
#define XB_SPIN(cond, bar) do { unsigned _sp = 0; while (cond) { __builtin_amdgcn_s_sleep(1); \
    if ((++_sp & 255u) == 0u) { if (xb_ld(&(bar)[XB_TMO])) break; if (_sp > XB_SPIN_CAP) { atomicAdd(&(bar)[XB_TMO], 1u); break; } } } } while (0)

struct XcdBarrier {
    unsigned* bar; unsigned x;
    volatile LAS unsigned* st;
};

__device__ __forceinline__ XcdBarrier xcd_barrier_post(unsigned* bar, volatile LAS unsigned* st) {
    XcdBarrier b; b.bar = bar; b.x = xb_xcc_id(); b.st = st;
    if (threadIdx.x == 0) (void)xb_add(&bar[XB_XCNT(b.x)], 1u);
    return b;
}
__device__ __forceinline__ void xcd_barrier_complete(unsigned* bar, unsigned x, unsigned& nloc, unsigned& nx) {
    const unsigned G = gridDim.x * gridDim.y * gridDim.z;
    unsigned sum, cnt, mine, sp = 0u;
    for (;;) {
        sum = 0u; cnt = 0u; mine = 0u;
#pragma unroll
        for (unsigned j = 0; j < 16; ++j) { const unsigned c = xb_ld(&bar[XB_XCNT(j)]); sum += c; cnt += (c > 0u) ? 1u : 0u; mine = (j == x) ? c : mine; }
        if (sum == G) break;
        __builtin_amdgcn_s_sleep(1);
        if ((++sp & 255u) == 0u) { if (xb_ld(&bar[XB_TMO])) break; if (sp > XB_SPIN_CAP) { atomicAdd(&bar[XB_TMO], 1u); break; } }
    }
    nloc = mine > 0u ? mine : 1u; nx = cnt > 0u ? cnt : 1u;
}

__device__ __forceinline__ void xcd_barrier(const XcdBarrier& b) {
    asm volatile("s_waitcnt vmcnt(0)" ::: "memory");
    __syncthreads();
    if (threadIdx.x == 0) {
        unsigned* bar = b.bar;
        __builtin_amdgcn_s_waitcnt(0);
        unsigned nloc = b.st[0], nx = b.st[1];
        if (nloc == 0u) { xcd_barrier_complete(bar, b.x, nloc, nx); b.st[0] = nloc; b.st[1] = nx; }
        const unsigned old = xb_add(&bar[XB_XSUB(b.x)], 1u);
        const unsigned gen = old / nloc;
        if (old + 1u == (gen + 1u) * nloc) {
            __builtin_amdgcn_fence(__ATOMIC_RELEASE, "agent");
            asm volatile("s_waitcnt vmcnt(0)" ::: "memory");
            const unsigned og = xb_add(&bar[XB_TOP], 1u);
            const unsigned tg = og / nx;
            if (og + 1u == (tg + 1u) * nx) xb_add(&bar[XB_TOPGEN], 1u);
            else XB_SPIN(xb_ld(&bar[XB_TOPGEN]) == tg, bar);
            __builtin_amdgcn_fence(__ATOMIC_ACQUIRE, "agent");
            xb_add(&bar[XB_XGEN(b.x)], 1u);
            asm volatile("s_waitcnt vmcnt(0)" ::: "memory");
        } else {
            XB_SPIN(xb_ld(&bar[XB_XGEN(b.x)]) == gen, bar);
            __builtin_amdgcn_fence(__ATOMIC_ACQUIRE, "agent");
            asm volatile("s_waitcnt vmcnt(0)" ::: "memory");
        }
    }
    __syncthreads();
}


#include <hip/hip_cooperative_groups.h>
namespace cg = cooperative_groups;

#define MEGA_LDS_MAIN 143360
#define MEGA_LDS (MEGA_LDS_MAIN + 16)
#define WS_X 0ull
#define WS_WTA (WS_X + (size_t)NTOK * 1024 * 4)
#define WS_WTB (WS_WTA + (size_t)WT_LAYER * 2)
#define WS_QKV (WS_WTB + (size_t)2816 * 1024 * 2)
#define WS_REST (WS_QKV + (size_t)NTOK * NQKV * 2)
#define WS_PRE (WS_REST + (size_t)NTOK * NREST * 2)
#define WS_MIXB (WS_PRE + (size_t)768 * PRE_ITEM)
#define WS_MODS (WS_MIXB + (size_t)NTOK * 1024 * 2)
#define WS_AV (WS_MODS + 2 * 3 * 6144 * 4)
#define WS_BIN (WS_AV + 2 * 2 * 3 * 1024 * 4)
#define WS_BGU (WS_BIN + 2 * 3 * NCOLS * 4)
#define WS_BLOG (WS_BGU + 2 * 3 * 2 * FFH * 4)
#define WS_ROWSS (WS_BLOG + 2 * 3 * 16 * 4 + 128)
#define WS_LOG (WS_ROWSS + 5 * NTOK * 4)
#define WS_BAR (WS_LOG + (size_t)NTOK * 16 * 4)
#define WS_WLT (WS_BAR + 16384)
#define WS_POS (WS_WLT + 2 * 16 * 1024 * 2)
#define WS_SLOT (WS_POS + 96 * 512 * 4)
#define WS_END (WS_SLOT + 48 * 4 * 256 * 4)
struct MP {
  const float *x_prompt, *x_sample, *state_delta, *c, *c_ctx, *w_in, *conv_w, *a_log, *dt_bias, *delta_norm_g, *sgu_norm_g, *w_spatial, *b_spatial,
      *w_pool, *pool_scale, *w_out, *norm1_g, *norm2_g, *w_mod, *b_mod, *w_gu, *w_down, *norm_f;
  float* out; unsigned char* ws;
  __device__ __forceinline__ float* X_() const { return (float*)(ws + WS_X); }
  __device__ __forceinline__ bf16_t* WTA_() const { return (bf16_t*)(ws + WS_WTA); }
  __device__ __forceinline__ bf16_t* WTB_() const { return (bf16_t*)(ws + WS_WTB); }
  __device__ __forceinline__ bf16_t* QKV_() const { return (bf16_t*)(ws + WS_QKV); }
  __device__ __forceinline__ bf16_t* REST_() const { return (bf16_t*)(ws + WS_REST); }
  __device__ __forceinline__ unsigned char* PRE_() const { return ws + WS_PRE; }
  __device__ __forceinline__ bf16_t* MIXB_() const { return (bf16_t*)(ws + WS_MIXB); }
  __device__ __forceinline__ float* mods_() const { return (float*)(ws + WS_MODS); }
  __device__ __forceinline__ float* AV_() const { return (float*)(ws + WS_AV); }
  __device__ __forceinline__ float* BIN_() const { return (float*)(ws + WS_BIN); }
  __device__ __forceinline__ float* BGU_() const { return (float*)(ws + WS_BGU); }
  __device__ __forceinline__ float* BLOG_() const { return (float*)(ws + WS_BLOG); }
  __device__ __forceinline__ float* rowss_() const { return (float*)(ws + WS_ROWSS); }
  __device__ __forceinline__ float* LOG_() const { return (float*)(ws + WS_LOG); }
  __device__ __forceinline__ unsigned* bar_() const { return (unsigned*)(ws + WS_BAR); }
  __device__ __forceinline__ bf16_t* WLT_() const { return (bf16_t*)(ws + WS_WLT); }
  __device__ __forceinline__ float* POS_() const { return (float*)(ws + WS_POS); }
  __device__ __forceinline__ float* SLOT_() const { return (float*)(ws + WS_SLOT); }
};

__device__ __forceinline__ void gemv3_item(const float* __restrict__ W, int ld, int ncols, const float* vec  , float* red  ,
                                           const float* __restrict__ bias, float* __restrict__ o0, float* __restrict__ o1, float* __restrict__ o2, int t) {
  const int col = t & 63, ds = t >> 6;
  float a0 = 0.f, a1 = 0.f, a2 = 0.f;
  if (col < ncols) {
    const float* w = W + (size_t)(ds * 128) * ld + col;
#pragma unroll 16
    for (int d = 0; d < 128; ++d) { const float wv = w[(size_t)d * ld]; const int dd = ds * 128 + d; a0 += vec[dd] * wv; a1 += vec[1024 + dd] * wv; a2 += vec[2048 + dd] * wv; }
  }
  red[(ds * 3 + 0) * 64 + col] = a0; red[(ds * 3 + 1) * 64 + col] = a1; red[(ds * 3 + 2) * 64 + col] = a2;
  __syncthreads();
  if (t < 192) {
    const int s = t >> 6, cc = t & 63;
    float v = 0.f;
#pragma unroll
    for (int k = 0; k < 8; ++k) v += red[(k * 3 + s) * 64 + cc];
    if (cc < ncols) { v += bias ? bias[cc] : 0.f; (s == 0 ? o0 : (s == 1 ? o1 : o2))[cc] = v; }
  }
  __syncthreads();
}

__device__ __forceinline__ void wtile(const MP& p, int l, int r  , bf16_t* wt_in, bf16_t* wt_rest, float* tile, int tt) {
  const float* ml = p.mods_() + l * 3 * 6144;
  if (r < 704) { const int kt = r / 44, jt = r % 44; transpose_tile(p.w_in + (size_t)l * 1024 * INC, INC, win_srccol(jt * 64), wt_in, 1024, jt * 64, kt * 64, tile, tt, ml, p.BIN_() + l * 3 * NCOLS, NCOLS); return; }
  r -= 704;
  if (r < 256) { const int kt = r / 16, jt = r % 16; transpose_tile(p.w_out + (size_t)l * 1024 * 1024, 1024, jt * 64, wt_rest + WT_OUT, 1024, jt * 64, kt * 64, tile, tt, nullptr, nullptr, 0); return; }
  r -= 256;
  if (r < 1408) { const int kt = r / 88, jt = r % 88; transpose_tile(p.w_gu + (size_t)l * 1024 * 2 * FFH, 2 * FFH, wgu_srccol(jt * 64), wt_rest + WT_GU, 1024, jt * 64, kt * 64, tile, tt, ml + 3072, p.BGU_() + l * 3 * 2 * FFH, 2 * FFH); return; }
  r -= 1408;
  { const int kt = r / 16, jt = r % 16; transpose_tile(p.w_down + (size_t)l * FFH * 1024, 1024, jt * 64, wt_rest + WT_DOWN, FFH, jt * 64, kt * 64, tile, tt, nullptr, nullptr, 0); }
}

__device__ __forceinline__ void phase_prep0(const MP& p, int bid, int nb, unsigned char* smem, bool tiles) {
  int t_ = threadIdx.x; asm volatile("" : "+v"(t_)); const int t = t_;
  if (!tiles) for (int i = bid * 512 + t; i < 4 * NTOK; i += nb * 512) p.rowss_()[NTOK + i] = 0.f;
  if (!tiles) for (int i = bid * 512 + t; i < 2 * 3 * NCOLS + 2 * 3 * 2 * FFH; i += nb * 512) p.BIN_()[i] = 0.f;
  if (!tiles) for (int i = bid * 512 + t; i < 96 * 512; i += nb * 512) {
    const int rc = i >> 9, dd = i & 511, jj = dd & 255;
    const float omega = 1.0f / powf(10000.0f, (float)jj / 256.0f);
    const float ang = (float)(rc < 32 ? rc : rc - 32) * omega;
    p.POS_()[i] = (dd & 256) ? cosf(ang) : sinf(ang);
  }
  if (!tiles) for (int i = bid * 512 + t; i < 2 * 16 * 1024; i += nb * 512) { const int l = i >> 14, j = (i >> 10) & 15, d = i & 1023; p.WLT_()[i] = f2bf(p.w_in[((size_t)l * 1024 + d) * INC + 2048 + j]); }
  float* vec = (float*)smem; float* red = vec + 3072; float* tile = (float*)(smem + 32768) + (t >> 8) * (64 * 65);
  const int NMOD = 192, NPAIR = (3072 + 704) / 2;
  for (int it = bid; it < (tiles ? NMOD + NPAIR : NMOD); it += nb) {
    if (it < NMOD) { if (tiles) continue;
      const int l = it / 96, cgp = it % 96;
      for (int i = t; i < 1024; i += 512) { vec[i] = silu_f(p.c_ctx[i]); vec[1024 + i] = silu_f(p.c[i]); vec[2048 + i] = silu_f(p.c[1024 + i]); }
      __syncthreads();
      float* m = p.mods_() + l * 3 * 6144 + cgp * 64;
      gemv3_item(p.w_mod + (size_t)l * 1024 * 6144 + cgp * 64, 6144, 64, vec, red, p.b_mod + l * 6144 + cgp * 64, m, m + 6144, m + 2 * 6144, t);
    } else {
      const int r = (it - NMOD) * 2 + (t >> 8);
      if (r < 3072) wtile(p, 0, r, p.WTA_() + WT_IN, p.WTA_(), tile, t & 255);
      else wtile(p, 1, r - 3072, p.WTB_(), p.WTA_(), tile, t & 255);
    }
  }
}

__device__ __forceinline__ void phase_vecs(const MP& p, int bid, int nb, unsigned char* smem) {
  int t_ = threadIdx.x; asm volatile("" : "+v"(t_)); const int t = t_;
  float* vec = (float*)smem; float* red = vec + 3072;
  for (int i = bid * 512 + t; i < 2 * 2 * 1024; i += nb * 512) {
    const int l = i >> 11, n = (i >> 10) & 1, d = i & 1023;
    const float g = n ? p.norm2_g[l * 1024 + d] : p.norm1_g[l * 1024 + d];
#pragma unroll
    for (int s = 0; s < 3; ++s) p.AV_()[((l * 2 + n) * 3 + s) * 1024 + d] = g * (1.f + p.mods_()[(l * 3 + s) * 6144 + (n ? 4096 : 1024) + d]);
  }
  const int N_IN = 44, N_GU = 88;
  for (int it = bid; it < 2; it += nb) {
    const int l = it, r = N_IN + N_GU;
    const int sh_off = (r >= N_IN && r < N_IN + N_GU) ? 3072 : 0;
    for (int i = t; i < 1024; i += 512) {
#pragma unroll
      for (int s = 0; s < 3; ++s) vec[s * 1024 + i] = p.mods_()[(l * 3 + s) * 6144 + sh_off + i];
    }
    __syncthreads();
    if (r < N_IN) { float* o = p.BIN_() + l * 3 * NCOLS + r * 64; gemv3_item(p.w_in + (size_t)l * 1024 * INC + win_srccol(r * 64), INC, 64, vec, red, nullptr, o, o + NCOLS, o + 2 * NCOLS, t); }
    else if (r < N_IN + N_GU) { const int j0 = (r - N_IN) * 64; float* o = p.BGU_() + l * 3 * 2 * FFH + j0; gemv3_item(p.w_gu + (size_t)l * 1024 * 2 * FFH + wgu_srccol(j0), 2 * FFH, 64, vec, red, nullptr, o, o + 2 * FFH, o + 4 * FFH, t); }
    else { float* o = p.BLOG_() + l * 3 * 16; gemv3_item(p.w_in + (size_t)l * 1024 * INC + 2048, INC, 16, vec, red, nullptr, o, o + 16, o + 32, t); }
  }
}

__device__ __forceinline__ void prepx_row(const MP& p, int r, int lane) {
  const int seg = seg_of_row(r);
  float ss = 0.f;
#pragma unroll
  for (int i = 0; i < 4; ++i) {
    const int d = i * 256 + lane * 4;
    f32x4 v;
    if (r < NCTX) v = *(const f32x4*)(p.x_prompt + (size_t)r * 1024 + d);
    else {
      const int rl = r - NCTX, pp = rl & 2047, row = pp >> 6, col = pp & 63;
      v = *(const f32x4*)(p.x_sample + (size_t)rl * 1024 + d);
      const f32x4 e = *(const f32x4*)(p.POS_() + (d < 512 ? row * 512 + d : (32 + col) * 512 + (d - 512)));
      v = v + e;
    }
    *(f32x4*)(p.X_() + (size_t)r * 1024 + d) = v;
    ss += (v[0] * v[0] + v[1] * v[1]) + (v[2] * v[2] + v[3] * v[3]);
    const f32x4 g1 = *(const f32x4*)(p.norm1_g + d), sc1 = *(const f32x4*)(p.mods_() + seg * 6144 + 1024 + d);
    const f32x4 a = g1 * (1.f + sc1);
    u32x2 w; w.x = pack_bf16(v[0] * a[0], v[1] * a[1]); w.y = pack_bf16(v[2] * a[2], v[3] * a[3]);
    *(u32x2*)((bf16_t*)p.PRE_() + (size_t)r * 1024 + d) = w;
  }
  ss = wave_sum(ss);
  if (lane == 0) p.rowss_()[r] = ss;
}

__device__ __forceinline__ void phase_logits(const MP& p, int l, int bid, int nb, unsigned char* smem) {
  int tl = threadIdx.x; asm volatile("" : "+v"(tl)); const int t = tl, lane = tl & 63, w = tl >> 6, fr = lane & 15, g = lane >> 4;
  bf16_t* wl = (bf16_t*)smem;
  const bf16_t* XA = (const bf16_t*)p.PRE_();
  for (int q = t; q < 2048; q += 512) { const int j = q >> 7, c = q & 127; *(u32x4*)(wl + j * 1032 + c * 8) = *(const u32x4*)(p.WLT_() + (size_t)l * 16 * 1024 + j * 1024 + c * 8); }
  __syncthreads();
  for (int rg = bid * 8 + w; rg < NTOK / 16; rg += nb * 8) {
    const int row0 = rg * 16;
    const bf16_t* arow = XA + (size_t)(row0 + fr) * 1024 + 8 * g;
    bf16x8 af[32];
#pragma unroll
    for (int ks = 0; ks < 32; ++ks) af[ks] = *(const bf16x8*)(arow + 32 * ks);
    f32x4 acc0 = (f32x4){0.f, 0.f, 0.f, 0.f}, acc1 = acc0;
#pragma unroll
    for (int ks = 0; ks < 32; ks += 2) {
      const bf16x8 b0 = *(const bf16x8*)(wl + fr * 1032 + 32 * ks + 8 * g), b1 = *(const bf16x8*)(wl + fr * 1032 + 32 * (ks + 1) + 8 * g);
      acc0 = __builtin_amdgcn_mfma_f32_16x16x32_bf16(af[ks], b0, acc0, 0, 0, 0);
      acc1 = __builtin_amdgcn_mfma_f32_16x16x32_bf16(af[ks + 1], b1, acc1, 0, 0, 0);
    }
    const int seg = seg_of_row(row0);
    const float bias = p.BLOG_()[l * 3 * 16 + seg * 16 + fr];
#pragma unroll
    for (int r = 0; r < 4; ++r) {
      const int row = row0 + 4 * g + r;
      const float rinv = rsqrtf(p.rowss_()[(2 * l) * NTOK + row] * (1.0f / 1024.0f) + 1e-6f);
      p.LOG_()[(size_t)row * 16 + fr] = (acc0[r] + acc1[r]) * rinv + bias;
    }
  }
  __syncthreads();
}

__device__ __forceinline__ void delta_post_row(const MP& p, int l, int r, int lane) {
  const bf16_t* OB = p.QKV_();
  const u32x4 of = *(const u32x4*)(OB + (size_t)r * 512 + lane * 8), ob = *(const u32x4*)(OB + ((size_t)NTOK + r) * 512 + lane * 8);
  const u32x4 zz = *(const u32x4*)(p.REST_() + (size_t)r * NREST + lane * 8);
  float o[8]; float ss = 0.f;
#pragma unroll
  for (int e = 0; e < 8; ++e) {
    const unsigned wf = of[e >> 1], wb = ob[e >> 1];
    o[e] = __uint_as_float((e & 1) ? (wf & 0xffff0000u) : (wf << 16)) + __uint_as_float((e & 1) ? (wb & 0xffff0000u) : (wb << 16));
    ss += o[e] * o[e];
  }
  ss += __shfl_xor(ss, 1); ss += __shfl_xor(ss, 2); ss += __shfl_xor(ss, 4); ss += __shfl_xor(ss, 8);
  const float rn = rsqrtf(ss * (1.0f / 128.0f) + 1e-6f);
  const float* ng = p.delta_norm_g + l * 128 + (lane & 15) * 8;
  float y[8];
#pragma unroll
  for (int e = 0; e < 8; ++e) {
    const unsigned wz = zz[e >> 1];
    const float z = __uint_as_float((e & 1) ? (wz & 0xffff0000u) : (wz << 16));
    y[e] = o[e] * rn * ng[e] * silu_fast(z);
  }
  u32x4 w; w.x = pack_bf16(y[0], y[1]); w.y = pack_bf16(y[2], y[3]); w.z = pack_bf16(y[4], y[5]); w.w = pack_bf16(y[6], y[7]);
  *(u32x4*)(p.MIXB_() + (size_t)r * 1024 + lane * 8) = w;
}

__device__ __forceinline__ void sgu_item(const MP& p, int l, int ch, int g, unsigned char* smem) {
  int tl = threadIdx.x; asm volatile("" : "+v"(tl)); const int t = tl, lane = tl & 63, w = __builtin_amdgcn_readfirstlane(tl >> 6), fr = lane & 15, g4 = lane >> 4;
  const bf16_t* REST = p.REST_(); const float* norm_g = p.sgu_norm_g + l * 256 + g * 64;
  const float* w_s = p.w_spatial + ((size_t)l * 4 + g) * 128 * 128; const float* b_s = p.b_spatial + (l * 4 + g) * 128;
  const int r0 = ch * 128;
  bf16_t* vnT = (bf16_t*)smem;
  bf16_t* ut = (bf16_t*)(smem + 17408);
  const int s_ = t >> 2, q4 = t & 3;
  const bf16_t* vrow = REST + (size_t)(r0 + s_) * NREST + 768 + g * 64 + q4 * 16;
  const u32x4 v0 = *(const u32x4*)vrow, v1 = *(const u32x4*)(vrow + 8);
  u32x4 uu[2];
#pragma unroll
  for (int k = 0; k < 2; ++k) { const int q = t + 512 * k, row = q >> 3, c8 = q & 7; uu[k] = *(const u32x4*)(REST + (size_t)(r0 + row) * NREST + 512 + g * 64 + c8 * 8); }
  f32x4 wa[4][2];
  { const float* wrow = w_s + (size_t)(w * 16 + fr) * 128 + 8 * g4;
#pragma unroll
    for (int ks = 0; ks < 4; ++ks) { wa[ks][0] = *(const f32x4*)(wrow + 32 * ks); wa[ks][1] = *(const f32x4*)(wrow + 32 * ks + 4); } }
  {
    float val[16]; float ss = 0.f;
#pragma unroll
    for (int e = 0; e < 16; ++e) {
      const unsigned wv = (e < 8 ? v0 : v1)[(e & 7) >> 1];
      val[e] = gelu_fast(__uint_as_float((e & 1) ? (wv & 0xffff0000u) : (wv << 16))); ss += val[e] * val[e];
    }
    ss += __shfl_xor(ss, 1); ss += __shfl_xor(ss, 2);
    const float rinv = rsqrtf(ss * (1.0f / 64.0f) + 1e-6f);
#pragma unroll
    for (int e = 0; e < 16; ++e) vnT[(q4 * 16 + e) * 136 + s_] = f2bf(val[e] * rinv * norm_g[q4 * 16 + e]);
#pragma unroll
    for (int k = 0; k < 2; ++k) { const int q = t + 512 * k, row = q >> 3, c8 = q & 7; *(u32x4*)(ut + row * 72 + c8 * 8) = uu[k]; }
  }
  __syncthreads();
  {
    bf16x8 af[4];
#pragma unroll
    for (int ks = 0; ks < 4; ++ks) af[ks] = pack8(wa[ks][0], wa[ks][1]);
    f32x4 acc[4];
#pragma unroll
    for (int nt = 0; nt < 4; ++nt) {
      acc[nt] = (f32x4){0.f, 0.f, 0.f, 0.f};
#pragma unroll
      for (int ks = 0; ks < 4; ++ks) {
        const bf16x8 bfr = *(const bf16x8*)(vnT + (nt * 16 + fr) * 136 + 32 * ks + 8 * g4);
        acc[nt] = __builtin_amdgcn_mfma_f32_16x16x32_bf16(af[ks], bfr, acc[nt], 0, 0, 0);
      }
    }
#pragma unroll
    for (int r = 0; r < 4; ++r) {
      const int tt = w * 16 + 4 * g4 + r;
      const float bb = b_s[tt];
#pragma unroll
      for (int nt = 0; nt < 4; ++nt) { bf16_t* e = ut + tt * 72 + nt * 16 + fr; *e = f2bf(gelu_fast(bf2f(*e)) * (acc[nt][r] + bb)); }
    }
  }
  __syncthreads();
#pragma unroll
  for (int k = 0; k < 2; ++k) { const int q = t + 512 * k, row = q >> 3, c8 = q & 7; *(u32x4*)(p.MIXB_() + (size_t)(r0 + row) * 1024 + 512 + g * 64 + c8 * 8) = *(const u32x4*)(ut + row * 72 + c8 * 8); }
  __syncthreads();
}

__device__ __forceinline__ void pool_item(const MP& p, int l, int blk, unsigned char* smem) {
  int tl = threadIdx.x; asm volatile("" : "+v"(tl)); const int t = tl, lane = tl & 63, w = __builtin_amdgcn_readfirstlane(tl >> 6), fr = lane & 15, g4 = lane >> 4;
  const bf16_t* REST = p.REST_(); const float* w_pool = p.w_pool + (size_t)l * 4 * 64 * 64; const float* scale = p.pool_scale + l * 256;
  const int r0 = blk * 64;
  int seg0, seglen;
  if (r0 < NCTX) { seg0 = r0 & ~255; seglen = 256; } else { seg0 = r0; seglen = 64; }
  bf16_t* xs = (bf16_t*)smem;
  bf16_t* dm = (bf16_t*)(smem + 42240);
  bf16_t* wT = (bf16_t*)(smem + 42240 + 36864);
  u32x4 xv[5];
#pragma unroll
  for (int k = 0; k < 5; ++k) {
    const int q = t + 512 * k, lr = q >> 5, c8 = q & 31, row = r0 - 8 + lr;
    xv[k] = (u32x4){0u, 0u, 0u, 0u};
    if (row >= seg0 && row < seg0 + seglen) xv[k] = *(const u32x4*)(REST + (size_t)row * NREST + 1024 + c8 * 8);
  }
  f32x4 wv[8];
#pragma unroll
  for (int k = 0; k < 8; ++k) wv[k] = *(const f32x4*)(w_pool + (size_t)(t + 512 * k) * 4);
#pragma unroll
  for (int k = 0; k < 5; ++k) { const int q = t + 512 * k, lr = q >> 5, c8 = q & 31; *(u32x4*)(xs + lr * 264 + c8 * 8) = xv[k]; }
#pragma unroll
  for (int k = 0; k < 8; ++k) {
    const int q = t + 512 * k, i = q >> 10, c = (q >> 4) & 63, d4 = (q & 15) * 4;
#pragma unroll
    for (int e = 0; e < 4; ++e) wT[(i * 64 + d4 + e) * 72 + c] = f2bf(wv[k][e]);
  }
  __syncthreads();
  {
    const int c = t & 255, i = c >> 6, win = 2 << i, ph = t >> 8;
    for (int pp = ph * 32; pp < ph * 32 + 32; ++pp) {
      const int pos = r0 + pp - seg0;
      const int lo = max(pos - win / 2, 0), hi = min(pos + win - win / 2, seglen);
      float s = 0.f;
      for (int q = lo; q < hi; ++q) s += bf2f(xs[(q + seg0 - r0 + 8) * 264 + c]);
      dm[(i * 64 + pp) * 72 + (c & 63)] = f2bf(s * __builtin_amdgcn_rcpf((float)(hi - lo)) - bf2f(xs[(pp + 8) * 264 + c]));
    }
  }
  __syncthreads();
  {
    const int i = w >> 1;
    bf16x8 bfr[4][2];
#pragma unroll
    for (int nt = 0; nt < 4; ++nt)
#pragma unroll
      for (int ks = 0; ks < 2; ++ks) bfr[nt][ks] = *(const bf16x8*)(wT + (i * 64 + nt * 16 + fr) * 72 + 32 * ks + 8 * g4);
#pragma unroll
    for (int pt2 = 0; pt2 < 2; ++pt2) {
      const int pt = (w & 1) * 2 + pt2;
      bf16x8 af[2];
#pragma unroll
      for (int ks = 0; ks < 2; ++ks) af[ks] = *(const bf16x8*)(dm + (i * 64 + pt * 16 + fr) * 72 + 32 * ks + 8 * g4);
#pragma unroll
      for (int nt = 0; nt < 4; ++nt) {
        f32x4 acc = (f32x4){0.f, 0.f, 0.f, 0.f};
#pragma unroll
        for (int ks = 0; ks < 2; ++ks) acc = __builtin_amdgcn_mfma_f32_16x16x32_bf16(af[ks], bfr[nt][ks], acc, 0, 0, 0);
        const float sc = scale[i * 64 + nt * 16 + fr];
#pragma unroll
        for (int r = 0; r < 4; ++r) xs[(pt * 16 + 4 * g4 + r) * 264 + i * 64 + nt * 16 + fr] = f2bf(acc[r] * sc);
      }
    }
  }
  __syncthreads();
#pragma unroll
  for (int k = 0; k < 4; ++k) { const int q = t + 512 * k, row = q >> 5, c8 = q & 31; *(u32x4*)(p.MIXB_() + (size_t)(r0 + row) * 1024 + 768 + c8 * 8) = *(const u32x4*)(xs + row * 264 + c8 * 8); }
  __syncthreads();
}

__device__ __forceinline__ void final_row(const MP& p, int r, int lane) {
  const float rinv = rsqrtf(p.rowss_()[4 * NTOK + r] * (1.0f / 1024.0f) + 1e-6f);
#pragma unroll
  for (int i = 0; i < 4; ++i) {
    const int d = i * 256 + lane * 4;
    const f32x4 v = *(const f32x4*)(p.X_() + (size_t)r * 1024 + d), gg = *(const f32x4*)(p.norm_f + d);
    *(f32x4*)(p.out + (size_t)r * 1024 + d) = v * rinv * gg;
  }
}

#ifndef REPEAT
#define REPEAT 0
#endif
#define REP_CAT2(a, b) a##b
#define REP_CAT(a, b) REP_CAT2(a, b)
#define REP(k) for (int REP_CAT(rep_, __LINE__) = 0; REP_CAT(rep_, __LINE__) < 1 + ((REPEAT >> (k)) & 1); ++REP_CAT(rep_, __LINE__))
#ifndef USE_CG_SYNC
#define USE_CG_SYNC 0
#endif
#if USE_CG_SYNC
#define GRID_SYNC() grid.sync()
#else
#define GRID_SYNC() do { REP(21) { XcdBarrier xb2; xb2.bar = p.bar_(); xb2.x = xb_xcc_id(); xb2.st = xst; xcd_barrier(xb2); } } while (0)
#endif

__global__ __launch_bounds__(512, 2) void mega(MP p) {
  extern __shared__ __attribute__((aligned(16))) unsigned char smem[];
#if USE_CG_SYNC
  cg::grid_group grid = cg::this_grid();
#else
  volatile LAS unsigned* xst = (volatile LAS unsigned*)((LAS unsigned char*)smem + MEGA_LDS_MAIN);
  if (threadIdx.x == 0) { xst[0] = 0u; xst[1] = 0u; }
  __syncthreads();
  (void)xcd_barrier_post(p.bar_(), xst);
#endif
  const int bid = blockIdx.x, nb = gridDim.x;
  bf16_t* XA = (bf16_t*)p.PRE_(); bf16_t* ACT = p.QKV_(); bf16_t* OB = p.QKV_();
  float* states_out = p.out + (size_t)NTOK * 1024;

  REP(0) phase_prep0(p, bid, nb, smem, false);
  GRID_SYNC();
  REP(1) { phase_prep0(p, bid, nb, smem, true); phase_vecs(p, bid, nb, smem); }
  REP(2) { int tl = threadIdx.x; asm volatile("" : "+v"(tl)); const int lane = tl & 63, w = tl >> 6;
    for (int r = bid * 8 + w; r < NTOK; r += nb * 8) prepx_row(p, r, lane); }
  GRID_SYNC();
  for (int l = 0; l < 2; ++l) {
#define TL_DECL int tl = threadIdx.x; asm volatile("" : "+v"(tl)); const int t = tl, lane = tl & 63, w = tl >> 6; (void)t; (void)lane; (void)w
    const float* ml = p.mods_() + l * 3 * 6144;
    float* rs1 = p.rowss_() + (2 * l) * NTOK; float* rs2 = p.rowss_() + (2 * l + 1) * NTOK; float* rs3 = p.rowss_() + (2 * l + 2) * NTOK;
    const float* A2 = p.AV_() + (l * 2 + 1) * 3 * 1024; const float* A1n = p.AV_() + (2 + 0) * 3 * 1024;
    REP(4) {
      pg8::Gemm g; g.A = XA; g.Bt = l ? p.WTB_() : p.WTA_() + WT_IN; g.M = NTOK; g.N = NCOLS; g.K = 1024;
      EpiIn E{p.QKV_(), p.REST_(), rs1, p.BIN_() + l * 3 * NCOLS};
      pg8::StaticOrder S; S.init(g.M, g.N, nb, bid);
      pg8::gemm_phase<EpiIn, pg8::StaticOrder, true, true>((PG8_LAS unsigned char*)smem, g, S, E);
    }
    REP(3) if (bid >= 16) phase_logits(p, l, bid - 16, nb - 16, smem);
    GRID_SYNC();
    REP(5) for (int item = bid; item < 768; item += nb) pre_item(item, p.QKV_(), p.LOG_(), p.conv_w + (size_t)l * 3 * NQKV, p.a_log + l * 8, p.dt_bias + l * 8, p.PRE_(), smem);
    if (l == 1) {
      TL_DECL;
      float* tile = (float*)smem + (t >> 8) * (64 * 65);
      for (int it = bid; it < (3072 - 704) / 2; it += nb) wtile(p, 1, 704 + it * 2 + (t >> 8), p.WTB_(), p.WTA_(), tile, t & 255);
    }
    GRID_SYNC();
    REP(6) { if (bid < 32) { REP(13) scan_dispatch(bid, p.PRE_(), p.state_delta, OB, states_out, l, smem); }
             else { REP(14) for (int i = bid - 32; i < 256; i += nb - 32) scan_dispatch(32 + i, p.PRE_(), p.state_delta, OB, states_out, l, smem); } }
    REP(12) if (bid >= 32) {
      for (int it = bid - 32; it < 384; it += nb - 32) sgu_item(p, l, it >> 2, it & 3, smem);
      for (int it = bid - 32; it < 192; it += nb - 32) pool_item(p, l, it, smem);
    }
    GRID_SYNC();
    REP(7) { TL_DECL; for (int r = bid * 8 + w; r < NTOK; r += nb * 8) delta_post_row(p, l, r, lane); }
    GRID_SYNC();
    {
      pg8::Gemm g; g.A = p.MIXB_(); g.Bt = p.WTA_() + WT_OUT; g.M = NTOK; g.N = 1024; g.K = 1024;
      EpiRes E{p.X_(), ml + 2048, rs2, XA, A2};
      pg8::StaticOrder S; S.init(g.M, g.N, nb, bid);
      pg8::gemm_phase<EpiRes, pg8::StaticOrder, true, true>((PG8_LAS unsigned char*)smem, g, S, E);
    }
    GRID_SYNC();
    REP(9) {
      pg8::Gemm g; g.A = XA; g.Bt = p.WTA_() + WT_GU; g.M = NTOK; g.N = 2 * FFH; g.K = 1024;
      EpiGu E{ACT, rs2, p.BGU_() + l * 3 * 2 * FFH};
      pg8::StaticOrder S; S.init(g.M, g.N, nb, bid);
      pg8::gemm_phase<EpiGu, pg8::StaticOrder, true, true>((PG8_LAS unsigned char*)smem, g, S, E);
    }
    GRID_SYNC();
    if (l == 0) {
      pg8::Gemm g; g.A = ACT; g.Bt = p.WTA_() + WT_DOWN; g.M = NTOK; g.N = 1024; g.K = FFH;
      EpiRes E{p.X_(), ml + 5120, rs3, XA, A1n};
      pg8::StaticOrder S; S.init(g.M, g.N, nb, bid);
      pg8::gemm_phase<EpiRes, pg8::StaticOrder, true, true>((PG8_LAS unsigned char*)smem, g, S, E);
      GRID_SYNC();
    } else {
      pg8::Gemm g; g.A = ACT; g.Bt = p.WTA_() + WT_DOWN; g.M = NTOK; g.N = 1024; g.K = FFH;
      EpiResFinal E{p.X_(), ml + 5120, p.out, p.norm_f, p.SLOT_(), p.bar_() + 3584};
      pg8::StaticOrder S; S.init(g.M, g.N, nb, bid);
      pg8::gemm_phase<EpiResFinal, pg8::StaticOrder, false, true>((PG8_LAS unsigned char*)smem, g, S, E);
    }
  }
}

extern "C" void kernel_launch(void* const* d_in, const int* in_sizes, int n_in, void* d_out, int out_size, void* d_ws, size_t ws_size,
                              hipStream_t stream) {
  static int grid_blocks = 0;
  if (!grid_blocks) {
    int dev = 0, cus = 0, per_cu = 0;
    (void)hipGetDevice(&dev);
    (void)hipDeviceGetAttribute(&cus, hipDeviceAttributeMultiprocessorCount, dev);
    (void)hipFuncSetAttribute((const void*)mega, hipFuncAttributeMaxDynamicSharedMemorySize, MEGA_LDS);
    (void)hipOccupancyMaxActiveBlocksPerMultiprocessor(&per_cu, (const void*)mega, 512, MEGA_LDS);
    if (per_cu < 1) { fprintf(stderr, "occupancy query says %d blocks per CU\n", per_cu); per_cu = 1; }
    if (per_cu > 1) per_cu = 1;
    grid_blocks = cus * per_cu;
    if (grid_blocks > 256) grid_blocks = 256;
  }
  MP p; memset(&p, 0, sizeof p);
  const float** ins = (const float**)&p;
  for (int i = 0; i < 23; ++i) ins[i] = (const float*)d_in[i];
  p.out = (float*)d_out;
  p.ws = (unsigned char*)d_ws;
  if (WS_END > ws_size) { fprintf(stderr, "workspace too small: need %zu have %zu\n", (size_t)WS_END, ws_size); return; }
  (void)hipMemsetAsync((char*)d_ws + WS_BAR, 0, 16384, stream);
  void* args[] = {&p};
  hipError_t e = hipLaunchCooperativeKernel((const void*)mega, dim3(grid_blocks), dim3(512), args, MEGA_LDS, stream);
  if (e != hipSuccess) fprintf(stderr, "cooperative launch failed: %s (grid %d)\n", hipGetErrorString(e), grid_blocks);
}
```

```cpp
#include <hip/hip_runtime.h>
#include <math.h>
#include <cstdio>
#include <cstring>

#define NTOK 12288
#define NCTX 8192
#define DM 1024
#define INC 2832
#define FFH 2816
#define NQKV 1536
#define NREST 1280
#define NCOLS 2816

typedef unsigned short bf16_t;
typedef float f32x2_cv __attribute__((ext_vector_type(2)));
typedef __bf16 bf16x2_cv __attribute__((ext_vector_type(2)));
__device__ __forceinline__ unsigned pack_bf16(float lo, float hi) { return __builtin_bit_cast(unsigned, __builtin_convertvector((f32x2_cv){lo, hi}, bf16x2_cv)); }
__device__ __forceinline__ bf16_t f2bf(float f) { return (bf16_t)(pack_bf16(f, 0.f) & 0xffffu); }
__device__ __forceinline__ float bf2f(bf16_t b) { return __uint_as_float(((unsigned)b) << 16); }
__device__ __forceinline__ float silu_f(float x) { return x / (1.f + expf(-x)); }
__device__ __forceinline__ float silu_fast(float x) { return x * __builtin_amdgcn_rcpf(1.f + __expf(-x)); }
__device__ __forceinline__ float gelu_fast(float x) { const float u = 1.5957691216057308f * (x + 0.044715f * x * x * x); return x * __builtin_amdgcn_rcpf(1.f + __expf(-u)); }
__device__ __forceinline__ float sigmoid_f(float x) { return 1.f / (1.f + expf(-x)); }
__device__ __forceinline__ float gelu_f(float x) { return 0.5f * x * (1.f + tanhf(0.7978845608028654f * (x + 0.044715f * x * x * x))); }
__device__ __forceinline__ float softplus_f(float x) { return x > 20.f ? x : log1pf(expf(x)); }
__device__ __forceinline__ int seg_of_row(int r) { return r < NCTX ? 0 : 1 + ((r - NCTX) >> 11); }
__device__ __forceinline__ float wave_sum(float v) {
#pragma unroll
  for (int o = 32; o > 0; o >>= 1) v += __shfl_xor(v, o);
  return v;
}
namespace pg8 {
#define PG8_LAS __attribute__((address_space(3)))
typedef unsigned short bf16_t;
typedef short bf16x8 __attribute__((ext_vector_type(8)));
typedef float f32x4 __attribute__((ext_vector_type(4)));
typedef unsigned u32x4 __attribute__((ext_vector_type(4)));
constexpr int BM = 256, BK = 64, HALF = 128, HTB = HALF * BK * 2  , STAGE_BYTES = 8 * HTB, NXCD = 8, WGM = 8;

__host__ __device__ __forceinline__ int lds_byte(int r, int c) { const int st = (r >> 4) * 2 + (c >> 5), rr = r & 15, cc = c & 31, ob = rr * 64 + cc * 2; return st * 1024 + (ob ^ (((ob >> 9) & 1) << 5)); }
__host__ __device__ __forceinline__ void stage_rc(int b, int& R, int& C) { const int st = b / 1024, sb = b % 1024, swz = sb ^ (((sb >> 9) & 1) << 5); R = (st >> 1) * 16 + swz / 64; C = (st & 1) * 32 + (swz % 64) / 2; }
__host__ __device__ __forceinline__ int perm32(int rho) { const int n = rho >> 4, i = rho & 15; return 8 * (i >> 2) + 4 * n + (i & 3); }

struct Unit { int pm, pn; };
struct Gemm { const bf16_t* A; const bf16_t* Bt; int M, N, K; };

struct StaticOrder {
    int nM, nN, nwg, G, c;
    __host__ __device__ void init(int M, int N, int G_, int c_) { nM = M / BM; nN = N / BM; nwg = nM * nN; G = G_; c = c_; }
    __host__ __device__ bool next(int i, Unit& u) const {
        const long L = (long)i * G + c; if (L >= nwg) return false;
        int wgid = (int)L; { const int q = nwg / NXCD, r = nwg % NXCD, xcd = wgid % NXCD, off = wgid / NXCD; wgid = (xcd < r ? xcd * (q + 1) : r * (q + 1) + (xcd - r) * q) + off; }
        const int nig = WGM * nN, gid = wgid / nig, fm = gid * WGM, gsz = (nM - fm) < WGM ? (nM - fm) : WGM;
        u.pm = fm + ((wgid % nig) % gsz); u.pn = (wgid % nig) / gsz; return true;
    }
    __device__ __forceinline__ void a_ready(const Unit&) const {}
    __device__ __forceinline__ void done(const Unit&) const {}
};

__device__ __forceinline__ unsigned cvt_pk_bf16(float lo, float hi) { return ::pack_bf16(lo, hi); }
template <class Epi, class Sched, bool ALIGN_EPI = false, bool SP2 = false>
__device__ __forceinline__ void gemm_phase(PG8_LAS unsigned char* lds, const Gemm g, const Sched& S, const Epi& E) {
    int tid_ = threadIdx.x; asm volatile("" : "+v"(tid_));
    const int tid = tid_, wid = __builtin_amdgcn_readfirstlane(tid >> 6), lane = tid & 63, wr = wid >> 2, wc = wid & 3, fr = lane & 15, fq = lane >> 4;
    const int K = g.K, nt = K / BK;
    unsigned voffA[2], voffB[2];
#pragma unroll
    for (int i = 0; i < 2; ++i) { int R, C; stage_rc(tid * 16 + i * 8192, R, C); const int Rb = Epi::PERM ? ((R & ~31) + perm32(R & 31)) : R;
        voffA[i] = (unsigned)(R * K + C) * 2u; voffB[i] = (unsigned)(Rb * K + C) * 2u; }
    const size_t kstep = (size_t)(BK * 2);
    const size_t hstep = (size_t)HALF * K * 2;
    const size_t tstep = 2 * hstep;
    const unsigned ldsw = (unsigned)wid * 1024u;
    const int aoff = lds_byte(wr * 64 + fr, fq * 8), boff = lds_byte(wc * 32 + fr, fq * 8);
#define PG8_SA(b, h) (((b) * 2 + (h)) * HTB)
#define PG8_SB(b, h) ((4 + (b) * 2 + (h)) * HTB)
#define PG8_STAGE(bufoff, gbase, voff) do { _Pragma("unroll") for (int _i = 0; _i < 2; ++_i) \
        __builtin_amdgcn_global_load_lds((const unsigned*)((const char*)(gbase) + (voff)[_i]), (PG8_LAS unsigned*)(lds + (bufoff) + ldsw + _i * 8192), 16, 0, 0); } while (0)
#define PG8_LDA(dst, b, h) do { _Pragma("unroll") for (int m = 0; m < 4; ++m) _Pragma("unroll") for (int k = 0; k < 2; ++k) dst[m][k] = *(const PG8_LAS bf16x8*)(lds + PG8_SA(b, h) + aoff + m * 2048 + k * 1024); } while (0)
#define PG8_LDB(dst, b, h) do { _Pragma("unroll") for (int n = 0; n < 2; ++n) _Pragma("unroll") for (int k = 0; k < 2; ++k) dst[n][k] = *(const PG8_LAS bf16x8*)(lds + PG8_SB(b, h) + boff + n * 2048 + k * 1024); } while (0)
#define PG8_MMA(ai, bj, At, Bt) do { __builtin_amdgcn_s_setprio(1); _Pragma("unroll") for (int m = 0; m < 4; ++m) _Pragma("unroll") for (int n = 0; n < 2; ++n) _Pragma("unroll") for (int k = 0; k < 2; ++k) \
        acc[ai][bj][m][n] = __builtin_amdgcn_mfma_f32_16x16x32_bf16(Bt[n][k], At[m][k], acc[ai][bj][m][n], 0, 0, 0); __builtin_amdgcn_s_setprio(0); } while (0)
#define PG8_WAIT_V(n) asm volatile("s_waitcnt vmcnt(" #n ")" ::: "memory")
#define PG8_WAIT_L(n) asm volatile("s_waitcnt lgkmcnt(" #n ")" ::: "memory")
#define PG8_BAR __builtin_amdgcn_s_barrier()
#define PG8_SCHED __builtin_amdgcn_sched_barrier(0)
    Unit cur, nxt; int ui = 0;
    if (!S.next(0, cur)) return;
    f32x4 acc[2][2][4][2];
#pragma unroll
    for (int a = 0; a < 2; ++a)
#pragma unroll
        for (int b = 0; b < 2; ++b)
#pragma unroll
            for (int m = 0; m < 4; ++m)
#pragma unroll
                for (int n = 0; n < 2; ++n) acc[a][b][m][n] = (f32x4){0.f, 0.f, 0.f, 0.f};
    bf16x8 At[4][2], B0[2][2], B1[2][2];
    const char* cA = (const char*)g.A + (size_t)cur.pm * tstep; const char* cB = (const char*)g.Bt + (size_t)cur.pn * tstep;
    S.a_ready(cur);
    if constexpr (SP2) {
        PG8_STAGE(PG8_SB(0, 0), cB, voffB); PG8_STAGE(PG8_SB(0, 1), cB + hstep, voffB); PG8_STAGE(PG8_SA(0, 0), cA, voffA); PG8_STAGE(PG8_SA(0, 1), cA + hstep, voffA);
        if (wr == 1) PG8_BAR;
        PG8_WAIT_V(2); PG8_BAR;
        PG8_STAGE(PG8_SB(1, 0), cB + kstep, voffB); PG8_STAGE(PG8_SA(1, 0), cA + kstep, voffA); PG8_STAGE(PG8_SB(1, 1), cB + hstep + kstep, voffB);
        PG8_WAIT_V(6); PG8_BAR;
    } else {
        PG8_STAGE(PG8_SB(0, 0), cB, voffB); PG8_STAGE(PG8_SA(0, 0), cA, voffA); PG8_STAGE(PG8_SB(0, 1), cB + hstep, voffB); PG8_STAGE(PG8_SA(0, 1), cA + hstep, voffA);
        if (wr == 1) PG8_BAR;
        PG8_WAIT_V(4); PG8_BAR;
        PG8_STAGE(PG8_SB(1, 0), cB + kstep, voffB); PG8_STAGE(PG8_SA(1, 0), cA + kstep, voffA); PG8_STAGE(PG8_SB(1, 1), cB + hstep + kstep, voffB);
        PG8_WAIT_V(6); PG8_BAR;
    }
    for (;;) {
        const bool has_next = S.next(ui + 1, nxt);
        const char* nA = has_next ? (const char*)g.A + (size_t)nxt.pm * tstep : cA; const char* nB = has_next ? (const char*)g.Bt + (size_t)nxt.pn * tstep : cB;
        for (int t = 0; t < nt; t += 2) {
            const bool last = (t == nt - 2);
            const char* a1 = cA + (size_t)(t + 1) * kstep;
            const char* a2 = last ? nA : cA + (size_t)(t + 2) * kstep; const char* b2 = last ? nB : cB + (size_t)(t + 2) * kstep;
            const char* a3 = a2 + kstep; const char* b3 = b2 + kstep;
            if (last && has_next) S.a_ready(nxt);
            if constexpr (SP2) {
            PG8_LDB(B0, 0, 0); PG8_LDB(B1, 0, 1); PG8_SCHED; PG8_LDA(At, 0, 0); PG8_STAGE(PG8_SA(1, 1), a1 + hstep, voffA);
            PG8_WAIT_V(8); PG8_WAIT_L(0); PG8_BAR; PG8_MMA(0, 0, At, B0); PG8_MMA(0, 1, At, B1); PG8_BAR; PG8_SCHED;
            PG8_LDA(At, 0, 1); PG8_STAGE(PG8_SB(0, 0), b2, voffB); PG8_STAGE(PG8_SB(0, 1), b2 + hstep, voffB); PG8_STAGE(PG8_SA(0, 0), a2, voffA);
            PG8_WAIT_V(8); PG8_WAIT_L(0); PG8_BAR; PG8_MMA(1, 0, At, B0); PG8_MMA(1, 1, At, B1); PG8_BAR; PG8_SCHED;
            PG8_LDB(B0, 1, 0); PG8_LDB(B1, 1, 1); PG8_SCHED; PG8_LDA(At, 1, 0); PG8_STAGE(PG8_SA(0, 1), a2 + hstep, voffA);
            PG8_WAIT_V(8); PG8_WAIT_L(0); PG8_BAR; PG8_MMA(0, 0, At, B0); PG8_MMA(0, 1, At, B1); PG8_BAR; PG8_SCHED;
            PG8_LDA(At, 1, 1); PG8_STAGE(PG8_SB(1, 0), b3, voffB); PG8_STAGE(PG8_SB(1, 1), b3 + hstep, voffB); PG8_STAGE(PG8_SA(1, 0), a3, voffA);
            PG8_WAIT_V(8); PG8_WAIT_L(0); PG8_BAR; PG8_MMA(1, 0, At, B0); PG8_MMA(1, 1, At, B1); PG8_BAR; PG8_SCHED;
            } else {
            PG8_LDB(B0, 0, 0); PG8_SCHED; PG8_LDA(At, 0, 0); PG8_STAGE(PG8_SA(1, 1), a1 + hstep, voffA);
            PG8_WAIT_L(8); PG8_BAR; PG8_WAIT_L(0); PG8_MMA(0, 0, At, B0); PG8_BAR; PG8_SCHED;
            PG8_LDB(B1, 0, 1); PG8_STAGE(PG8_SB(0, 0), b2, voffB);
            PG8_BAR; PG8_WAIT_L(0); PG8_MMA(0, 1, At, B1); PG8_BAR;
            PG8_LDA(At, 0, 1); PG8_STAGE(PG8_SA(0, 0), a2, voffA);
            PG8_BAR; PG8_WAIT_L(0); PG8_MMA(1, 0, At, B0); PG8_BAR; PG8_SCHED;
            PG8_STAGE(PG8_SB(0, 1), b2 + hstep, voffB);
            PG8_WAIT_V(6); PG8_BAR; PG8_MMA(1, 1, At, B1); PG8_BAR;
            PG8_LDB(B0, 1, 0); PG8_SCHED; PG8_LDA(At, 1, 0); PG8_STAGE(PG8_SA(0, 1), a2 + hstep, voffA);
            PG8_WAIT_L(8); PG8_BAR; PG8_WAIT_L(0); PG8_MMA(0, 0, At, B0); PG8_BAR; PG8_SCHED;
            PG8_LDB(B1, 1, 1); PG8_STAGE(PG8_SB(1, 0), b3, voffB);
            PG8_BAR; PG8_WAIT_L(0); PG8_MMA(0, 1, At, B1); PG8_BAR;
            PG8_LDA(At, 1, 1); PG8_STAGE(PG8_SA(1, 0), a3, voffA);
            PG8_BAR; PG8_WAIT_L(0); PG8_MMA(1, 0, At, B0); PG8_BAR; PG8_SCHED;
            PG8_STAGE(PG8_SB(1, 1), b3 + hstep, voffB);
            PG8_WAIT_V(6); PG8_BAR; PG8_MMA(1, 1, At, B1); PG8_BAR;
            }
        }
        if constexpr (ALIGN_EPI) { if (wr == 0) PG8_BAR; }
        if constexpr (!Epi::AFTER_DRAIN) { E(acc, cur, wr, wc, fr, fq); S.done(cur); }
        if (!has_next) break;
#pragma unroll
        for (int a = 0; a < 2; ++a)
#pragma unroll
            for (int b = 0; b < 2; ++b)
#pragma unroll
                for (int m = 0; m < 4; ++m)
#pragma unroll
                    for (int n = 0; n < 2; ++n) acc[a][b][m][n] = (f32x4){0.f, 0.f, 0.f, 0.f};
        cur = nxt; cA = nA; cB = nB; ++ui;
        if constexpr (ALIGN_EPI) { if (wr == 1) PG8_BAR; }
    }
    PG8_WAIT_V(0);
    if constexpr (!ALIGN_EPI) { if (wr == 0) PG8_BAR; }
    PG8_BAR;
    if constexpr (Epi::AFTER_DRAIN) { E.fused(acc, cur, wr, wc, fr, fq, lds, wid, lane); S.done(cur); }
#undef PG8_SA
#undef PG8_SB
#undef PG8_STAGE
#undef PG8_LDA
#undef PG8_LDB
#undef PG8_MMA
#undef PG8_WAIT_V
#undef PG8_WAIT_L
#undef PG8_BAR
#undef PG8_SCHED
}
}

using pg8::f32x4; using pg8::u32x4; using pg8::Unit; using pg8::HALF; using pg8::BM;
typedef unsigned u32x2 __attribute__((ext_vector_type(2)));

struct EpiIn {
  static constexpr bool PERM = true, AFTER_DRAIN = false;
  bf16_t* qkv; bf16_t* rest; const float* rowss; const float* bias;
  __device__ __forceinline__ void operator()(const f32x4 (&acc)[2][2][4][2], const Unit& u, int wr, int wc, int fr, int fq) const {
    const int row0 = u.pm * BM + wr * 64 + fr;
    const int seg = seg_of_row(u.pm * BM);
    int colt = u.pn * BM; bf16_t* base = qkv; int ldc = NQKV;
    if (colt >= NQKV) { base = rest; ldc = NREST; colt -= NQKV; }
    const int col0 = colt + wc * 32 + 8 * fq, bcol0 = seg * NCOLS + u.pn * BM + wc * 32 + 8 * fq;
    f32x4 bv[2][2];
#pragma unroll
    for (int bj = 0; bj < 2; ++bj)
#pragma unroll
      for (int n = 0; n < 2; ++n) bv[bj][n] = *(const f32x4*)(bias + bcol0 + bj * HALF + 4 * n);
#pragma unroll
    for (int ai = 0; ai < 2; ++ai)
#pragma unroll
      for (int m = 0; m < 4; ++m) {
        const int r = row0 + ai * HALF + m * 16;
        const float rinv = rsqrtf(rowss[r] * (1.0f / 1024.0f) + 1e-6f);
        bf16_t* rowp = base + (size_t)r * ldc + col0;
#pragma unroll
        for (int bj = 0; bj < 2; ++bj) {
          const f32x4 v0 = acc[ai][bj][m][0] * rinv + bv[bj][0], v1 = acc[ai][bj][m][1] * rinv + bv[bj][1];
          u32x4 w; w.x = pg8::cvt_pk_bf16(v0[0], v0[1]); w.y = pg8::cvt_pk_bf16(v0[2], v0[3]); w.z = pg8::cvt_pk_bf16(v1[0], v1[1]); w.w = pg8::cvt_pk_bf16(v1[2], v1[3]);
          *(u32x4*)(rowp + bj * HALF) = w;
        }
      }
  }
};

struct EpiRes {
  static constexpr bool PERM = false, AFTER_DRAIN = false;
  float* X; const float* gate; float* rowss; bf16_t* xa; const float* An;
  __device__ __forceinline__ void operator()(const f32x4 (&acc)[2][2][4][2], const Unit& u, int wr, int wc, int fr, int fq) const {
    const int row0 = u.pm * BM + wr * 64 + fr, col0 = u.pn * BM + wc * 32 + 4 * fq;
    const int seg = seg_of_row(u.pm * BM);
    f32x4 gv[2][2], av[2][2];
#pragma unroll
    for (int bj = 0; bj < 2; ++bj)
#pragma unroll
      for (int n = 0; n < 2; ++n) {
        gv[bj][n] = *(const f32x4*)(gate + seg * 6144 + col0 + bj * HALF + n * 16);
        av[bj][n] = xa ? *(const f32x4*)(An + seg * 1024 + col0 + bj * HALF + n * 16) : (f32x4){0.f, 0.f, 0.f, 0.f};
      }
#pragma unroll
    for (int ai = 0; ai < 2; ++ai)
#pragma unroll
      for (int m = 0; m < 4; ++m) {
        const int r = row0 + ai * HALF + m * 16;
        float* xrow = X + (size_t)r * 1024 + col0;
        float ss = 0.f;
#pragma unroll
        for (int bj = 0; bj < 2; ++bj)
#pragma unroll
          for (int n = 0; n < 2; ++n) {
            const f32x4 xo = *(const f32x4*)(xrow + bj * HALF + n * 16);
            const f32x4 xn = xo + gv[bj][n] * acc[ai][bj][m][n];
            *(f32x4*)(xrow + bj * HALF + n * 16) = xn;
            ss += (xn[0] * xn[0] + xn[1] * xn[1]) + (xn[2] * xn[2] + xn[3] * xn[3]);
            if (xa) {
              const f32x4 t = xn * av[bj][n];
              u32x2 w; w.x = pg8::cvt_pk_bf16(t[0], t[1]); w.y = pg8::cvt_pk_bf16(t[2], t[3]);
              *(u32x2*)(xa + (size_t)r * 1024 + col0 + bj * HALF + n * 16) = w;
            }
          }
        ss += __shfl_xor(ss, 16); ss += __shfl_xor(ss, 32);
        if (fq == 0) atomicAdd(rowss + r, ss);
      }
  }
};

struct EpiGu {
  static constexpr bool PERM = true, AFTER_DRAIN = false;
  bf16_t* act; const float* rowss; const float* bias;
  __device__ __forceinline__ void operator()(const f32x4 (&acc)[2][2][4][2], const Unit& u, int wr, int wc, int fr, int fq) const {
    const int row0 = u.pm * BM + wr * 64 + fr;
    const int seg = seg_of_row(u.pm * BM);
    const int hid0 = u.pn * HALF + wc * 32 + 8 * fq, bcol0 = seg * (2 * FFH) + u.pn * BM + wc * 32 + 8 * fq;
    f32x4 bv[2][2];
#pragma unroll
    for (int bj = 0; bj < 2; ++bj)
#pragma unroll
      for (int n = 0; n < 2; ++n) bv[bj][n] = *(const f32x4*)(bias + bcol0 + bj * HALF + 4 * n);
#pragma unroll
    for (int ai = 0; ai < 2; ++ai)
#pragma unroll
      for (int m = 0; m < 4; ++m) {
        const int r = row0 + ai * HALF + m * 16;
        const float rinv = rsqrtf(rowss[r] * (1.0f / 1024.0f) + 1e-6f);
        float o[8];
#pragma unroll
        for (int n = 0; n < 2; ++n) {
          const f32x4 g = acc[ai][0][m][n] * rinv + bv[0][n], up = acc[ai][1][m][n] * rinv + bv[1][n];
#pragma unroll
          for (int j = 0; j < 4; ++j) o[n * 4 + j] = g[j] * __builtin_amdgcn_rcpf(1.f + __expf(-g[j])) * up[j];
        }
        u32x4 w; w.x = pg8::cvt_pk_bf16(o[0], o[1]); w.y = pg8::cvt_pk_bf16(o[2], o[3]); w.z = pg8::cvt_pk_bf16(o[4], o[5]); w.w = pg8::cvt_pk_bf16(o[6], o[7]);
        *(u32x4*)(act + (size_t)r * FFH + hid0) = w;
      }
  }
};


struct EpiResFinal {
  static constexpr bool PERM = false, AFTER_DRAIN = true;
  const float* X; const float* gate; float* out; const float* normf; float* slots; unsigned* cnt;
  __device__ __forceinline__ void operator()(const f32x4 (&)[2][2][4][2], const Unit&, int, int, int, int) const {}
  __device__ __forceinline__ void fused(f32x4 (&acc)[2][2][4][2], const Unit& u, int wr, int wc, int fr, int fq, PG8_LAS unsigned char* lds, int wid, int lane) const {
    PG8_LAS float* P = (PG8_LAS float*)lds;
    PG8_LAS float* R = (PG8_LAS float*)(lds + 4096);
    const int row0 = u.pm * BM + wr * 64 + fr, col0 = u.pn * BM + wc * 32 + 4 * fq;
    const int seg = seg_of_row(u.pm * BM);
    f32x4 gv[2][2];
#pragma unroll
    for (int bj = 0; bj < 2; ++bj)
#pragma unroll
      for (int n = 0; n < 2; ++n) gv[bj][n] = *(const f32x4*)(gate + seg * 6144 + col0 + bj * HALF + n * 16);
#pragma unroll
    for (int ai = 0; ai < 2; ++ai)
#pragma unroll
      for (int m = 0; m < 4; ++m) {
        const int r = row0 + ai * HALF + m * 16;
        const float* xrow = X + (size_t)r * 1024 + col0;
        float ss = 0.f;
#pragma unroll
        for (int bj = 0; bj < 2; ++bj)
#pragma unroll
          for (int n = 0; n < 2; ++n) {
            const f32x4 xo = *(const f32x4*)(xrow + bj * HALF + n * 16);
            const f32x4 xn = xo + gv[bj][n] * acc[ai][bj][m][n];
            acc[ai][bj][m][n] = xn;
            ss += (xn[0] * xn[0] + xn[1] * xn[1]) + (xn[2] * xn[2] + xn[3] * xn[3]);
          }
        ss += __shfl_xor(ss, 16); ss += __shfl_xor(ss, 32);
        if (fq == 0) P[(ai * HALF + wr * 64 + m * 16 + fr) * 4 + wc] = ss;
      }
    __syncthreads();
    const int tid = wid * 64 + lane;
    if (tid < 256) {
      const float s = (P[tid * 4 + 0] + P[tid * 4 + 1]) + (P[tid * 4 + 2] + P[tid * 4 + 3]);
      __hip_atomic_store(slots + (size_t)(u.pm * 4 + u.pn) * 256 + tid, s, __ATOMIC_RELAXED, __HIP_MEMORY_SCOPE_AGENT);
    }
    asm volatile("s_waitcnt vmcnt(0)" ::: "memory");
    __syncthreads();
    if (tid == 0) {
      (void)__hip_atomic_fetch_add(cnt + u.pm, 1u, __ATOMIC_RELAXED, __HIP_MEMORY_SCOPE_AGENT);
      unsigned sp = 0u;
      while (__hip_atomic_load(cnt + u.pm, __ATOMIC_RELAXED, __HIP_MEMORY_SCOPE_AGENT) < 4u) { __builtin_amdgcn_s_sleep(1); if (++sp > (1u << 22)) break; }
      __builtin_amdgcn_fence(__ATOMIC_ACQUIRE, "agent");
      asm volatile("s_waitcnt vmcnt(0)" ::: "memory");
    }
    __syncthreads();
    if (tid < 256) {
      float tot = 0.f;
#pragma unroll
      for (int k = 0; k < 4; ++k) tot += __hip_atomic_load(slots + (size_t)(u.pm * 4 + k) * 256 + tid, __ATOMIC_RELAXED, __HIP_MEMORY_SCOPE_AGENT);
      R[tid] = rsqrtf(tot * (1.0f / 1024.0f) + 1e-6f);
    }
    __syncthreads();
    f32x4 nf[2][2];
#pragma unroll
    for (int bj = 0; bj < 2; ++bj)
#pragma unroll
      for (int n = 0; n < 2; ++n) nf[bj][n] = *(const f32x4*)(normf + col0 + bj * HALF + n * 16);
#pragma unroll
    for (int ai = 0; ai < 2; ++ai)
#pragma unroll
      for (int m = 0; m < 4; ++m) {
        const int lr = ai * HALF + wr * 64 + m * 16 + fr;
        const float rinv = R[lr];
        float* orow = out + (size_t)(u.pm * BM + lr) * 1024 + col0;
#pragma unroll
        for (int bj = 0; bj < 2; ++bj)
#pragma unroll
          for (int n = 0; n < 2; ++n) *(f32x4*)(orow + bj * HALF + n * 16) = acc[ai][bj][m][n] * rinv * nf[bj][n];
      }
  }
};

__device__ __forceinline__ int win_srccol(int j) { return j < 2048 ? j : j + 16; }
__device__ __forceinline__ int wgu_srccol(int j) { const int pn = j >> 8, w = j & 255; return w < 128 ? pn * 128 + w : FFH + pn * 128 + (w - 128); }

__device__ __forceinline__ void transpose_tile(const float* __restrict__ src, int ldsrc, int srccol0, bf16_t* __restrict__ dst, int K, int j0, int k0, float* tile, int t,
                                               const float* __restrict__ shv, float* __restrict__ bias, int bstride) {
  const int jl = t & 63, kg = t >> 6;
#pragma unroll
  for (int i = 0; i < 16; ++i) { const int k = kg * 16 + i; tile[jl * 65 + k] = src[(size_t)(k0 + k) * ldsrc + srccol0 + jl]; }
  __syncthreads();
  if (shv) {
    float a0 = 0.f, a1 = 0.f, a2 = 0.f;
#pragma unroll
    for (int i = 0; i < 16; ++i) { const int k = kg * 16 + i; const float wv = tile[jl * 65 + k]; a0 += shv[k0 + k] * wv; a1 += shv[6144 + k0 + k] * wv; a2 += shv[2 * 6144 + k0 + k] * wv; }
    atomicAdd(bias + j0 + jl, a0); atomicAdd(bias + bstride + j0 + jl, a1); atomicAdd(bias + 2 * bstride + j0 + jl, a2);
  }
  const int j = t >> 2, kc = (t & 3) * 16;
  const float* s = tile + j * 65 + kc;
  u32x4 o0, o1;
  o0.x = pack_bf16(s[0], s[1]); o0.y = pack_bf16(s[2], s[3]); o0.z = pack_bf16(s[4], s[5]); o0.w = pack_bf16(s[6], s[7]);
  o1.x = pack_bf16(s[8], s[9]); o1.y = pack_bf16(s[10], s[11]); o1.z = pack_bf16(s[12], s[13]); o1.w = pack_bf16(s[14], s[15]);
  bf16_t* d = dst + (size_t)(j0 + j) * K + k0 + kc;
  *(u32x4*)d = o0; *(u32x4*)(d + 8) = o1;
  __syncthreads();
}

#define WT_IN 0
#define WT_OUT (2816 * 1024)
#define WT_GU (WT_OUT + 1024 * 1024)
#define WT_DOWN (WT_GU + 5632 * 1024)
#define WT_LAYER (WT_DOWN + 1024 * 2816)


#define PRE_QP 0
#define PRE_KTP 16384
#define PRE_DIR0 32768
#define PRE_DIRSZ 41984
#define PRE_NW 0
#define PRE_UP 16384
#define PRE_QKP 32768
#define PRE_SC 40960
#define PRE_ITEM 116736
#define PRE_LDS 118784
#define SCAN_BUF 58368
#define SCAN_LDS (2 * SCAN_BUF)

using pg8::bf16x8;
__device__ __forceinline__ int perm_inv(int x) { return (x & ~31) | (((x >> 2) & 3) << 3) | (((x >> 4) & 1) << 2) | (x & 3); }
__device__ __forceinline__ bf16x8 pack8(const f32x4& x, const f32x4& y) {
  u32x4 w; w.x = pg8::cvt_pk_bf16(x[0], x[1]); w.y = pg8::cvt_pk_bf16(x[2], x[3]); w.z = pg8::cvt_pk_bf16(y[0], y[1]); w.w = pg8::cvt_pk_bf16(y[2], y[3]);
  return __builtin_bit_cast(bf16x8, w);
}

__device__ __forceinline__ void pre_item(int item, const bf16_t* __restrict__ QKV, const float* __restrict__ LOG, const float* __restrict__ cw,
                                         const float* __restrict__ a_log, const float* __restrict__ dt_bias, unsigned char* __restrict__ PRE,
                                         unsigned char* lds) {
  int t_ = threadIdx.x; asm volatile("" : "+v"(t_));
  const int t = t_, lane = t & 63, w = t >> 6;
  const int c = item >> 2, h = item & 3, r0 = c * 64;
  bf16_t* qb = (bf16_t*)lds; bf16_t* kb = (bf16_t*)(lds + 17408); float* vf = (float*)(lds + 34816);
  float* Lf = (float*)(lds + 67584); float* Lb = (float*)(lds + 83968); float* sc = (float*)(lds + 100352);
  unsigned char* pre = PRE + (size_t)item * PRE_ITEM;
  {
    const int i = t >> 3, cg = t & 7, r = r0 + i;
    int s0, len;
    if (r < NCTX) { s0 = r & ~255; len = 256; } else { s0 = NCTX + ((r - NCTX) & ~2047); len = 2048; }
    const int tt = r - s0; const bool hp = tt > 0, hn = tt < len - 1;
#pragma unroll
    for (int x = 0; x < 3; ++x) {
      const int cb = x * 512 + h * 128 + cg * 16;
      const bf16_t* p0 = QKV + (size_t)r * NQKV + cb;
      u32x4 m0 = (u32x4){0u, 0u, 0u, 0u}, m1 = m0, n0 = m0, n1 = m0;
      const u32x4 c0 = *(const u32x4*)p0, c1 = *(const u32x4*)(p0 + 8);
      if (hp) { m0 = *(const u32x4*)(p0 - NQKV); m1 = *(const u32x4*)(p0 - NQKV + 8); }
      if (hn) { n0 = *(const u32x4*)(p0 + NQKV); n1 = *(const u32x4*)(p0 + NQKV + 8); }
      float val[16]; float ss = 0.f;
#pragma unroll
      for (int e = 0; e < 16; ++e) {
        const unsigned wm = (e < 8 ? m0 : m1)[(e & 7) >> 1], wc = (e < 8 ? c0 : c1)[(e & 7) >> 1], wn = (e < 8 ? n0 : n1)[(e & 7) >> 1];
        const float xm = __uint_as_float((e & 1) ? (wm & 0xffff0000u) : (wm << 16));
        const float xc = __uint_as_float((e & 1) ? (wc & 0xffff0000u) : (wc << 16));
        const float xn = __uint_as_float((e & 1) ? (wn & 0xffff0000u) : (wn << 16));
        const float y = cw[cb + e] * xm + cw[NQKV + cb + e] * xc + cw[2 * NQKV + cb + e] * xn;
        val[e] = silu_fast(y); ss += val[e] * val[e];
      }
      if (x < 2) {
        ss += __shfl_xor(ss, 1); ss += __shfl_xor(ss, 2); ss += __shfl_xor(ss, 4);
        const float rn = rsqrtf(ss + 1e-6f) * (x == 0 ? 0.08838834764831845f : 1.0f);
        bf16_t* dst = (x == 0 ? qb : kb) + i * 136 + cg * 16;
        u32x4 o0, o1;
        o0.x = pack_bf16(val[0] * rn, val[1] * rn); o0.y = pack_bf16(val[2] * rn, val[3] * rn); o0.z = pack_bf16(val[4] * rn, val[5] * rn); o0.w = pack_bf16(val[6] * rn, val[7] * rn);
        o1.x = pack_bf16(val[8] * rn, val[9] * rn); o1.y = pack_bf16(val[10] * rn, val[11] * rn); o1.z = pack_bf16(val[12] * rn, val[13] * rn); o1.w = pack_bf16(val[14] * rn, val[15] * rn);
        *(u32x4*)dst = o0; *(u32x4*)(dst + 8) = o1;
      } else {
        float* dst = vf + i * 128 + cg * 16;
#pragma unroll
        for (int e = 0; e < 16; e += 4) *(f32x4*)(dst + e) = (f32x4){val[e], val[e + 1], val[e + 2], val[e + 3]};
      }
    }
  }
  if (w == 0) {
    const int i = lane, r = r0 + i;
#pragma unroll
    for (int d = 0; d < 2; ++d) {
      const float bl = LOG[(size_t)r * 16 + d * 4 + h], al = LOG[(size_t)r * 16 + 8 + d * 4 + h];
      const float beta = sigmoid_f(bl);
      const float g = -expf(a_log[d * 4 + h]) * softplus_f(al + dt_bias[d * 4 + h]);
      float s = g;
#pragma unroll
      for (int o = 1; o < 64; o <<= 1) {
        const float nb = d == 0 ? __shfl_up(s, o) : __shfl_down(s, o);
        const bool ok = d == 0 ? (lane >= o) : (lane + o < 64);
        if (ok) s += nb;
      }
      sc[d * 64 + i] = beta; sc[128 + d * 64 + i] = s; sc[256 + d * 64 + i] = beta * expf(s);
    }
  }
  __syncthreads();
  {
    const int p = w >> 2, it = w & 3, fr = lane & 15, g = lane >> 4;
    const bf16_t* Ab = p ? qb : kb;
    bf16x8 af[4];
#pragma unroll
    for (int ks = 0; ks < 4; ++ks) af[ks] = *(const bf16x8*)(Ab + (it * 16 + fr) * 136 + ks * 32 + 8 * g);
    bf16_t* qkf = (bf16_t*)(lds + 102400);
    bf16_t* qkb = (bf16_t*)(lds + 102400 + 8192);
#pragma unroll
    for (int jt = 0; jt < 4; ++jt) {
      f32x4 acc = (f32x4){0.f, 0.f, 0.f, 0.f};
#pragma unroll
      for (int ks = 0; ks < 4; ++ks) {
        const bf16x8 bfr = *(const bf16x8*)(kb + (jt * 16 + fr) * 136 + ks * 32 + 8 * g);
        acc = __builtin_amdgcn_mfma_f32_16x16x32_bf16(af[ks], bfr, acc, 0, 0, 0);
      }
      const int j = jt * 16 + fr;
      const float gfj = sc[128 + j], gbj = sc[192 + j];
#pragma unroll
      for (int r = 0; r < 4; ++r) {
        const int i = it * 16 + 4 * g + r;
        const float val = acc[r];
        const float ef = __expf(fminf(sc[128 + i] - gfj, 0.f)), eb = __expf(fminf(sc[192 + i] - gbj, 0.f));
        if (p == 0) {
          Lf[i * 64 + j] = (j < i) ? sc[i] * val * ef : 0.f;
          Lb[(63 - i) * 64 + (63 - j)] = (j > i) ? sc[64 + i] * val * eb : 0.f;
        } else {
          const int jp = perm_inv(j);
          qkf[i * 64 + jp] = f2bf((j <= i) ? val * ef : 0.f);
          qkb[i * 64 + jp] = f2bf((j >= i) ? val * eb : 0.f);
        }
      }
    }
  }
  __syncthreads();
#pragma unroll
  for (int it2 = 0; it2 < 2; ++it2) {
    const int q = t + 512 * it2;
    { const int i = q >> 4, s = (q >> 2) & 3, g = q & 3;
      const u32x2 lo = *(const u32x2*)(qb + i * 136 + 32 * s + 4 * g), hi = *(const u32x2*)(qb + i * 136 + 32 * s + 16 + 4 * g);
      *(u32x4*)(pre + PRE_QP + (size_t)(i * 128 + 32 * s + 8 * g) * 2) = (u32x4){lo.x, lo.y, hi.x, hi.y}; }
    { const int dk = q >> 3, s2 = (q >> 2) & 1, g = q & 3;
      unsigned short e[8];
#pragma unroll
      for (int jj = 0; jj < 8; ++jj) e[jj] = kb[(32 * s2 + 16 * (jj >> 2) + 4 * g + (jj & 3)) * 136 + dk];
      u32x4 o; o.x = (unsigned)e[0] | ((unsigned)e[1] << 16); o.y = (unsigned)e[2] | ((unsigned)e[3] << 16); o.z = (unsigned)e[4] | ((unsigned)e[5] << 16); o.w = (unsigned)e[6] | ((unsigned)e[7] << 16);
      *(u32x4*)(pre + PRE_KTP + (size_t)(dk * 64 + 32 * s2 + 8 * g) * 2) = o; }
  }
  if (t < 384) {
    const int d = t / 192, rem = t % 192, k3 = rem >> 6, i = rem & 63;
    const float glast = d ? sc[192] : sc[128 + 63], gci = sc[128 + d * 64 + i];
    const float v = k3 == 0 ? expf(gci) : (k3 == 1 ? expf(glast - gci) : expf(glast));
    ((float*)(pre + PRE_DIR0 + d * PRE_DIRSZ + PRE_SC))[k3 * 64 + i] = v;
  }
  {
    const int d = w >> 2, kind = (w >> 1) & 1, cc = t & 127;
    int rowsel = d ? 63 : 0, rstep = d ? -1 : 1; unsigned Loff = d ? 83968u : 67584u;
    asm volatile("" : "+v"(rowsel), "+v"(rstep), "+v"(Loff));
    const float* L = (const float*)(lds + Loff);
    float x[64];
    if (kind == 0) {
#pragma unroll
      for (int ip = 0; ip < 64; ++ip) { const int i = rowsel + rstep * ip; x[ip] = sc[d * 64 + i] * vf[i * 128 + cc]; }
    } else {
#pragma unroll
      for (int ip = 0; ip < 64; ++ip) { const int i = rowsel + rstep * ip; x[ip] = sc[256 + d * 64 + i] * bf2f(kb[i * 136 + cc]); }
    }
    const f32x4* L4 = (const f32x4*)__builtin_assume_aligned(L, 16);
#pragma unroll
    for (int ip = 1; ip < 64; ++ip) {
      float a0 = 0.f, a1 = 0.f, a2 = 0.f, a3 = 0.f;
#pragma unroll
      for (int q = 0; q < (ip + 3) / 4; ++q) {
        const f32x4 lv = L4[ip * 16 + q];
        a0 += lv[0] * x[4 * q]; a1 += lv[1] * x[4 * q + 1]; a2 += lv[2] * x[4 * q + 2]; a3 += lv[3] * x[4 * q + 3];
      }
      x[ip] -= (a0 + a1) + (a2 + a3);
    }
    __syncthreads();
    unsigned char* outd = lds + 34816 + d * 32768;
    if (kind == 0) {
      const int dv = cc, wv = dv >> 4;
      unsigned char* ub = outd + 16384 + ((wv * 4) * 64 + (dv & 15)) * 8;
#pragma unroll
      for (int qp = 0; qp < 16; ++qp) {
        const int q = (rowsel >> 2) + rstep * qp;
        const float v0 = d ? x[4 * qp + 3] : x[4 * qp], v1 = d ? x[4 * qp + 2] : x[4 * qp + 1], v2 = d ? x[4 * qp + 1] : x[4 * qp + 2], v3 = d ? x[4 * qp] : x[4 * qp + 3];
        u32x2 pk; pk.x = pack_bf16(v0, v1); pk.y = pack_bf16(v2, v3);
        *(u32x2*)(ub + q * 128) = pk;
      }
    } else {
      const int kp = perm_inv(cc);
      bf16_t* nw = (bf16_t*)outd + kp;
#pragma unroll
      for (int ip = 0; ip < 64; ++ip) { const int i = rowsel + rstep * ip; nw[i * 128] = f2bf(-x[ip]); }
    }
  }
  __syncthreads();
  for (int k = 0; k < 8; ++k) {
    const int q = t + 512 * k, d = q >> 11, wi = q & 2047;
    *(u32x4*)(pre + PRE_DIR0 + d * PRE_DIRSZ + wi * 16) = *(const u32x4*)(lds + 34816 + q * 16);
  }
  for (int k = 0; k < 2; ++k) {
    const int q = t + 512 * k, d = q >> 9, wi = q & 511;
    *(u32x4*)(pre + PRE_DIR0 + d * PRE_DIRSZ + PRE_QKP + wi * 16) = *(const u32x4*)(lds + 102400 + q * 16);
  }
  __syncthreads();
}

__global__ __launch_bounds__(512, 2) void k_pre(const bf16_t* __restrict__ QKV, const float* __restrict__ LOG, const float* __restrict__ cw,
                                                const float* __restrict__ a_log, const float* __restrict__ dt_bias, unsigned char* __restrict__ PRE) {
  extern __shared__ __attribute__((aligned(16))) unsigned char smem[];
  for (int item = blockIdx.x; item < 768; item += gridDim.x) pre_item(item, QKV, LOG, cw, a_log, dt_bias, PRE, smem);
}

#define SCAN_OT (2 * SCAN_BUF)
#undef SCAN_LDS
#define SCAN_LDS (2 * SCAN_BUF + 8 * 2048)
__device__ __forceinline__ void scan_item(int b, int h, int d, int chunk0, int nc, int half, bool write_state, const unsigned char* __restrict__ PRE, const float* __restrict__ s_in,
                                          bf16_t* __restrict__ OB, float* __restrict__ s_out, unsigned char* lds) {
  int t_ = threadIdx.x; asm volatile("" : "+v"(t_));
  const int t = t_, lane = t & 63, w = t >> 6, fr = lane & 15, g = lane >> 4;
  const bool active = half < 0 || w < 4;
  const int dvw = half < 0 ? w : half * 4 + (w & 3), dv = 16 * dvw + fr;
  f32x4 S[8];
  if (s_in == nullptr) {
#pragma unroll
    for (int m = 0; m < 8; ++m) S[m] = (f32x4){0.f, 0.f, 0.f, 0.f};
  } else {
#pragma unroll
    for (int m = 0; m < 8; ++m)
#pragma unroll
      for (int r = 0; r < 4; ++r) S[m][r] = s_in[(16 * m + 4 * g + r) * 128 + dv];
  }
  unsigned soff[7], doff[7];
#pragma unroll
  for (int k = 0; k < 7; ++k) {
    const int q = t + 512 * k;
    if (k < 2) { const int row = q >> 4, c = q & 15; soff[k] = PRE_DIR0 + PRE_NW + q * 16; doff[k] = row * 256 + ((c ^ (row & 15)) << 4); }
    else if (k < 4) { const int q2 = q - 1024, row = q2 >> 4, c = q2 & 15; soff[k] = PRE_QP + q2 * 16; doff[k] = 16384 + row * 256 + ((c ^ (row & 15)) << 4); }
    else if (k < 5) { const int q2 = q - 2048, row = q2 >> 3, c = q2 & 7; soff[k] = PRE_DIR0 + PRE_QKP + q2 * 16; doff[k] = 32768 + row * 128 + ((c ^ ((row >> 1) & 7)) << 4); }
    else { const int q2 = q - 2560, row = q2 >> 3, c = q2 & 7; soff[k] = PRE_KTP + q2 * 16; doff[k] = 40960 + row * 128 + ((c ^ ((row >> 1) & 7)) << 4); }
    if (k < 2 || k == 4) soff[k] += d * PRE_DIRSZ;
  }
  const unsigned soff7 = PRE_DIR0 + d * PRE_DIRSZ + PRE_SC + t * 16, doff7 = 57344 + t * 16;
  const unsigned upoff = PRE_DIR0 + d * PRE_DIRSZ + PRE_UP + ((dvw * 4) * 64 + lane) * 8;
  u32x4 st[7]; u32x4 st7 = (u32x4){0u, 0u, 0u, 0u}; u32x2 up[4];
  {
    const int cidx = chunk0 + (d ? nc - 1 : 0);
    const unsigned char* pre = PRE + (size_t)(cidx * 4 + h) * PRE_ITEM;
#pragma unroll
    for (int k = 0; k < 7; ++k) st[k] = *(const u32x4*)(pre + soff[k]);
    if (t < 48) st7 = *(const u32x4*)(pre + soff7);
#pragma unroll
    for (int m = 0; m < 4; ++m) up[m] = *(const u32x2*)(pre + upoff + m * 512);
#pragma unroll
    for (int k = 0; k < 7; ++k) *(u32x4*)(lds + doff[k]) = st[k];
    if (t < 48) *(u32x4*)(lds + doff7) = st7;
  }
  __syncthreads();
  bf16_t* ot = (bf16_t*)(lds + SCAN_OT + w * 2048);
  for (int step = 0; step < nc; ++step) {
    const int cidx = chunk0 + (d ? nc - 1 - step : step);
    const unsigned char* B = lds + (step & 1) * SCAN_BUF;
    const bool more = step + 1 < nc;
    f32x4 a1[4], a2[4];
#pragma unroll
    for (int m = 0; m < 4; ++m) {
      a1[m] = (f32x4){__uint_as_float(up[m].x << 16), __uint_as_float(up[m].x & 0xffff0000u), __uint_as_float(up[m].y << 16), __uint_as_float(up[m].y & 0xffff0000u)};
      a2[m] = (f32x4){0.f, 0.f, 0.f, 0.f};
    }
    if (more) {
      const int cn = chunk0 + (d ? nc - 2 - step : step + 1);
      const unsigned char* pre = PRE + (size_t)(cn * 4 + h) * PRE_ITEM;
#pragma unroll
      for (int k = 0; k < 7; ++k) st[k] = *(const u32x4*)(pre + soff[k]);
      if (t < 48) st7 = *(const u32x4*)(pre + soff7);
#pragma unroll
      for (int m = 0; m < 4; ++m) up[m] = *(const u32x2*)(pre + upoff + m * 512);
    }
    if (active) {
      const float* SC = (const float*)(B + 57344);
      const float gt = SC[128];
      bf16x8 Sb[4];
#pragma unroll
      for (int s = 0; s < 4; ++s) Sb[s] = pack8(S[2 * s], S[2 * s + 1]);
#pragma unroll
      for (int m = 0; m < 8; ++m) S[m] = S[m] * gt;
      {
        bf16x8 fa[2][4], fq[2][4];
#pragma unroll
        for (int m = 0; m < 4; ++m) {
          fa[0][m] = *(const bf16x8*)(B + (16 * m + fr) * 256 + (((0 + g) ^ fr) << 4));
          fq[0][m] = *(const bf16x8*)(B + 16384 + (16 * m + fr) * 256 + (((0 + g) ^ fr) << 4));
        }
#pragma unroll
        for (int s = 0; s < 4; ++s) {
          if (s < 3) {
#pragma unroll
            for (int m = 0; m < 4; ++m) {
              fa[(s + 1) & 1][m] = *(const bf16x8*)(B + (16 * m + fr) * 256 + (((4 * (s + 1) + g) ^ fr) << 4));
              fq[(s + 1) & 1][m] = *(const bf16x8*)(B + 16384 + (16 * m + fr) * 256 + (((4 * (s + 1) + g) ^ fr) << 4));
            }
          }
#pragma unroll
          for (int m = 0; m < 4; ++m) a1[m] = __builtin_amdgcn_mfma_f32_16x16x32_bf16(fa[s & 1][m], Sb[s], a1[m], 0, 0, 0);
#pragma unroll
          for (int m = 0; m < 4; ++m) a2[m] = __builtin_amdgcn_mfma_f32_16x16x32_bf16(fq[s & 1][m], Sb[s], a2[m], 0, 0, 0);
        }
      }
      bf16x8 Vb[2], Vs[2];
#pragma unroll
      for (int s = 0; s < 2; ++s) Vb[s] = pack8(a1[2 * s], a1[2 * s + 1]);
#pragma unroll
      for (int m = 0; m < 4; ++m) { const f32x4 e = *(const f32x4*)(SC + 64 + 16 * m + 4 * g); a1[m] = a1[m] * e; }
#pragma unroll
      for (int s = 0; s < 2; ++s) Vs[s] = pack8(a1[2 * s], a1[2 * s + 1]);
      {
        bf16x8 fk[2][8];
#pragma unroll
        for (int s = 0; s < 2; ++s)
#pragma unroll
          for (int m = 0; m < 8; ++m) fk[s][m] = *(const bf16x8*)(B + 40960 + (16 * m + fr) * 128 + (((4 * s + g) ^ (fr >> 1)) << 4));
#pragma unroll
        for (int s = 0; s < 2; ++s)
#pragma unroll
          for (int m = 0; m < 8; ++m) S[m] = __builtin_amdgcn_mfma_f32_16x16x32_bf16(fk[s][m], Vs[s], S[m], 0, 0, 0);
      }
#pragma unroll
      for (int m = 0; m < 4; ++m) { const f32x4 e = *(const f32x4*)(SC + 16 * m + 4 * g); a2[m] = a2[m] * e; }
#pragma unroll
      for (int s = 0; s < 2; ++s)
#pragma unroll
        for (int m = 0; m < 4; ++m) {
          const bf16x8 fa = *(const bf16x8*)(B + 32768 + (16 * m + fr) * 128 + (((4 * s + g) ^ (fr >> 1)) << 4));
          a2[m] = __builtin_amdgcn_mfma_f32_16x16x32_bf16(fa, Vb[s], a2[m], 0, 0, 0);
        }
#pragma unroll
      for (int m = 0; m < 4; ++m)
#pragma unroll
        for (int r = 0; r < 4; ++r) ot[(16 * m + 4 * g + r) * 16 + fr] = f2bf(a2[m][r]);
      {
        bf16_t* op = OB + ((size_t)d * NTOK + (size_t)cidx * 64) * 512 + h * 128 + 16 * dvw;
#pragma unroll
        for (int k = 0; k < 2; ++k) {
          const int q = lane + 64 * k, row = q >> 1, hf = q & 1;
          *(u32x4*)(op + (size_t)row * 512 + hf * 8) = *(const u32x4*)(ot + row * 16 + hf * 8);
        }
      }
    }
    if (more) {
      unsigned char* Bn = lds + ((step + 1) & 1) * SCAN_BUF;
#pragma unroll
      for (int k = 0; k < 7; ++k) *(u32x4*)(Bn + doff[k]) = st[k];
      if (t < 48) *(u32x4*)(Bn + doff7) = st7;
    }
    __syncthreads();
  }
  if (write_state && active) {
#pragma unroll
    for (int m = 0; m < 8; ++m)
#pragma unroll
      for (int r = 0; r < 4; ++r) s_out[(16 * m + 4 * g + r) * 128 + dv] = S[m][r];
  }
}

__device__ __forceinline__ void scan_dispatch(int i, const unsigned char* PRE, const float* state_in, bf16_t* OB, float* state_out, int layer, unsigned char* lds) {
#ifdef LAT_FULL
  if (i < 32) {
    if (i >= 16) return;
    const int q = i, half = -1, b = q >> 3, h = (q >> 1) & 3, d = q & 1;
#else
  if (i < 32) {
    const int q = i >> 1, half = i & 1, b = q >> 3, h = (q >> 1) & 3, d = q & 1;
#endif
    scan_item(b, h, d, 128 + b * 32, 32, half, false, PRE, state_in + ((((size_t)b * 2 + layer) * 2 + d) * 4 + h) * 16384, OB, nullptr, lds);
  } else {
    const int sid = i - 32, b = sid >> 3, h = (sid >> 1) & 3, d = sid & 1;
    scan_item(b, h, d, b * 4, 4, -1, true, PRE, nullptr, OB, state_out + ((((size_t)b * 2 + layer) * 2 + d) * 4 + h) * 16384, lds);
  }
}

__global__ __launch_bounds__(512, 2) void k_scan2(const unsigned char* __restrict__ PRE, const float* __restrict__ state_in, bf16_t* __restrict__ OB,
                                                  float* __restrict__ state_out, int layer) {
  extern __shared__ __attribute__((aligned(16))) unsigned char smem[];
  for (int i = blockIdx.x; i < 288; i += gridDim.x) scan_dispatch(i, PRE, state_in, OB, state_out, layer, smem);
}
#define XB_TMO      128
#define XB_XCNT(j)  (256  + 64 * (j))
#define XB_XSUB(j)  (1280 + 64 * (j))
#define XB_XGEN(j)  (2304 + 64 * (j))
#define XB_TOP      3328
#define XB_TOPGEN   3392
#define XCD_BAR_WORDS 3456
#define XB_SPIN_CAP (1u << 18)
#define LAS __attribute__((address_space(3)))

__device__ __forceinline__ unsigned xb_ld(unsigned* p)              { return __hip_atomic_load(p, __ATOMIC_RELAXED, __HIP_MEMORY_SCOPE_AGENT); }
__device__ __forceinline__ unsigned xb_add(unsigned* p, unsigned v) { return __hip_atomic_fetch_add(p, v, __ATOMIC_RELAXED, __HIP_MEMORY_SCOPE_AGENT); }
__device__ __forceinline__ unsigned xb_xcc_id() { return (unsigned)__builtin_amdgcn_s_getreg((3 << 11) | 20) & 0xFu; }
#define XB_SPIN(cond, bar) do { unsigned _sp = 0; while (cond) { __builtin_amdgcn_s_sleep(1); \
    if ((++_sp & 255u) == 0u) { if (xb_ld(&(bar)[XB_TMO])) break; if (_sp > XB_SPIN_CAP) { atomicAdd(&(bar)[XB_TMO], 1u); break; } } } } while (0)

struct XcdBarrier {
    unsigned* bar; unsigned x;
    volatile LAS unsigned* st;
};

__device__ __forceinline__ XcdBarrier xcd_barrier_post(unsigned* bar, volatile LAS unsigned* st) {
    XcdBarrier b; b.bar = bar; b.x = xb_xcc_id(); b.st = st;
    if (threadIdx.x == 0) (void)xb_add(&bar[XB_XCNT(b.x)], 1u);
    return b;
}
__device__ __forceinline__ void xcd_barrier_complete(unsigned* bar, unsigned x, unsigned& nloc, unsigned& nx) {
    const unsigned G = gridDim.x * gridDim.y * gridDim.z;
    unsigned sum, cnt, mine, sp = 0u;
    for (;;) {
        sum = 0u; cnt = 0u; mine = 0u;
#pragma unroll
        for (unsigned j = 0; j < 16; ++j) { const unsigned c = xb_ld(&bar[XB_XCNT(j)]); sum += c; cnt += (c > 0u) ? 1u : 0u; mine = (j == x) ? c : mine; }
        if (sum == G) break;
        __builtin_amdgcn_s_sleep(1);
        if ((++sp & 255u) == 0u) { if (xb_ld(&bar[XB_TMO])) break; if (sp > XB_SPIN_CAP) { atomicAdd(&bar[XB_TMO], 1u); break; } }
    }
    nloc = mine > 0u ? mine : 1u; nx = cnt > 0u ? cnt : 1u;
}

__device__ __forceinline__ void xcd_barrier(const XcdBarrier& b) {
    asm volatile("s_waitcnt vmcnt(0)" ::: "memory");
    __syncthreads();
    if (threadIdx.x == 0) {
        unsigned* bar = b.bar;
        __builtin_amdgcn_s_waitcnt(0);
        unsigned nloc = b.st[0], nx = b.st[1];
        if (nloc == 0u) { xcd_barrier_complete(bar, b.x, nloc, nx); b.st[0] = nloc; b.st[1] = nx; }
        const unsigned old = xb_add(&bar[XB_XSUB(b.x)], 1u);
        const unsigned gen = old / nloc;
        if (old + 1u == (gen + 1u) * nloc) {
            __builtin_amdgcn_fence(__ATOMIC_RELEASE, "agent");
            asm volatile("s_waitcnt vmcnt(0)" ::: "memory");
            const unsigned og = xb_add(&bar[XB_TOP], 1u);
            const unsigned tg = og / nx;
            if (og + 1u == (tg + 1u) * nx) xb_add(&bar[XB_TOPGEN], 1u);
            else XB_SPIN(xb_ld(&bar[XB_TOPGEN]) == tg, bar);
            __builtin_amdgcn_fence(__ATOMIC_ACQUIRE, "agent");
            xb_add(&bar[XB_XGEN(b.x)], 1u);
            asm volatile("s_waitcnt vmcnt(0)" ::: "memory");
        } else {
            XB_SPIN(xb_ld(&bar[XB_XGEN(b.x)]) == gen, bar);
            __builtin_amdgcn_fence(__ATOMIC_ACQUIRE, "agent");
            asm volatile("s_waitcnt vmcnt(0)" ::: "memory");
        }
    }
    __syncthreads();
}


#include <hip/hip_cooperative_groups.h>
namespace cg = cooperative_groups;

#define MEGA_LDS_MAIN 143360
#define MEGA_LDS (MEGA_LDS_MAIN + 16)
#define WS_X 0ull
#define WS_WTA (WS_X + (size_t)NTOK * 1024 * 4)
#define WS_WTB (WS_WTA + (size_t)WT_LAYER * 2)
#define WS_QKV (WS_WTB + (size_t)2816 * 1024 * 2)
#define WS_REST (WS_QKV + (size_t)NTOK * NQKV * 2)
#define WS_PRE (WS_REST + (size_t)NTOK * NREST * 2)
#define WS_MIXB (WS_PRE + (size_t)768 * PRE_ITEM)
#define WS_MODS (WS_MIXB + (size_t)NTOK * 1024 * 2)
#define WS_AV (WS_MODS + 2 * 3 * 6144 * 4)
#define WS_BIN (WS_AV + 2 * 2 * 3 * 1024 * 4)
#define WS_BGU (WS_BIN + 2 * 3 * NCOLS * 4)
#define WS_BLOG (WS_BGU + 2 * 3 * 2 * FFH * 4)
#define WS_ROWSS (WS_BLOG + 2 * 3 * 16 * 4 + 128)
#define WS_LOG (WS_ROWSS + 5 * NTOK * 4)
#define WS_BAR (WS_LOG + (size_t)NTOK * 16 * 4)
#define WS_WLT (WS_BAR + 16384)
#define WS_POS (WS_WLT + 2 * 16 * 1024 * 2)
#define WS_SLOT (WS_POS + 96 * 512 * 4)
#define WS_END (WS_SLOT + 48 * 4 * 256 * 4)
struct MP {
  const float *x_prompt, *x_sample, *state_delta, *c, *c_ctx, *w_in, *conv_w, *a_log, *dt_bias, *delta_norm_g, *sgu_norm_g, *w_spatial, *b_spatial,
      *w_pool, *pool_scale, *w_out, *norm1_g, *norm2_g, *w_mod, *b_mod, *w_gu, *w_down, *norm_f;
  float* out; unsigned char* ws;
  __device__ __forceinline__ float* X_() const { return (float*)(ws + WS_X); }
  __device__ __forceinline__ bf16_t* WTA_() const { return (bf16_t*)(ws + WS_WTA); }
  __device__ __forceinline__ bf16_t* WTB_() const { return (bf16_t*)(ws + WS_WTB); }
  __device__ __forceinline__ bf16_t* QKV_() const { return (bf16_t*)(ws + WS_QKV); }
  __device__ __forceinline__ bf16_t* REST_() const { return (bf16_t*)(ws + WS_REST); }
  __device__ __forceinline__ unsigned char* PRE_() const { return ws + WS_PRE; }
  __device__ __forceinline__ bf16_t* MIXB_() const { return (bf16_t*)(ws + WS_MIXB); }
  __device__ __forceinline__ float* mods_() const { return (float*)(ws + WS_MODS); }
  __device__ __forceinline__ float* AV_() const { return (float*)(ws + WS_AV); }
  __device__ __forceinline__ float* BIN_() const { return (float*)(ws + WS_BIN); }
  __device__ __forceinline__ float* BGU_() const { return (float*)(ws + WS_BGU); }
  __device__ __forceinline__ float* BLOG_() const { return (float*)(ws + WS_BLOG); }
  __device__ __forceinline__ float* rowss_() const { return (float*)(ws + WS_ROWSS); }
  __device__ __forceinline__ float* LOG_() const { return (float*)(ws + WS_LOG); }
  __device__ __forceinline__ unsigned* bar_() const { return (unsigned*)(ws + WS_BAR); }
  __device__ __forceinline__ bf16_t* WLT_() const { return (bf16_t*)(ws + WS_WLT); }
  __device__ __forceinline__ float* POS_() const { return (float*)(ws + WS_POS); }
  __device__ __forceinline__ float* SLOT_() const { return (float*)(ws + WS_SLOT); }
};

__device__ __forceinline__ void gemv3_item(const float* __restrict__ W, int ld, int ncols, const float* vec  , float* red  ,
                                           const float* __restrict__ bias, float* __restrict__ o0, float* __restrict__ o1, float* __restrict__ o2, int t) {
  const int col = t & 63, ds = t >> 6;
  float a0 = 0.f, a1 = 0.f, a2 = 0.f;
  if (col < ncols) {
    const float* w = W + (size_t)(ds * 128) * ld + col;
#pragma unroll 16
    for (int d = 0; d < 128; ++d) { const float wv = w[(size_t)d * ld]; const int dd = ds * 128 + d; a0 += vec[dd] * wv; a1 += vec[1024 + dd] * wv; a2 += vec[2048 + dd] * wv; }
  }
  red[(ds * 3 + 0) * 64 + col] = a0; red[(ds * 3 + 1) * 64 + col] = a1; red[(ds * 3 + 2) * 64 + col] = a2;
  __syncthreads();
  if (t < 192) {
    const int s = t >> 6, cc = t & 63;
    float v = 0.f;
#pragma unroll
    for (int k = 0; k < 8; ++k) v += red[(k * 3 + s) * 64 + cc];
    if (cc < ncols) { v += bias ? bias[cc] : 0.f; (s == 0 ? o0 : (s == 1 ? o1 : o2))[cc] = v; }
  }
  __syncthreads();
}

__device__ __forceinline__ void wtile(const MP& p, int l, int r  , bf16_t* wt_in, bf16_t* wt_rest, float* tile, int tt) {
  const float* ml = p.mods_() + l * 3 * 6144;
  if (r < 704) { const int kt = r / 44, jt = r % 44; transpose_tile(p.w_in + (size_t)l * 1024 * INC, INC, win_srccol(jt * 64), wt_in, 1024, jt * 64, kt * 64, tile, tt, ml, p.BIN_() + l * 3 * NCOLS, NCOLS); return; }
  r -= 704;
  if (r < 256) { const int kt = r / 16, jt = r % 16; transpose_tile(p.w_out + (size_t)l * 1024 * 1024, 1024, jt * 64, wt_rest + WT_OUT, 1024, jt * 64, kt * 64, tile, tt, nullptr, nullptr, 0); return; }
  r -= 256;
  if (r < 1408) { const int kt = r / 88, jt = r % 88; transpose_tile(p.w_gu + (size_t)l * 1024 * 2 * FFH, 2 * FFH, wgu_srccol(jt * 64), wt_rest + WT_GU, 1024, jt * 64, kt * 64, tile, tt, ml + 3072, p.BGU_() + l * 3 * 2 * FFH, 2 * FFH); return; }
  r -= 1408;
  { const int kt = r / 16, jt = r % 16; transpose_tile(p.w_down + (size_t)l * FFH * 1024, 1024, jt * 64, wt_rest + WT_DOWN, FFH, jt * 64, kt * 64, tile, tt, nullptr, nullptr, 0); }
}

__device__ __forceinline__ void phase_prep0(const MP& p, int bid, int nb, unsigned char* smem, bool tiles) {
  int t_ = threadIdx.x; asm volatile("" : "+v"(t_)); const int t = t_;
  if (!tiles) for (int i = bid * 512 + t; i < 4 * NTOK; i += nb * 512) p.rowss_()[NTOK + i] = 0.f;
  if (!tiles) for (int i = bid * 512 + t; i < 2 * 3 * NCOLS + 2 * 3 * 2 * FFH; i += nb * 512) p.BIN_()[i] = 0.f;
  if (!tiles) for (int i = bid * 512 + t; i < 96 * 512; i += nb * 512) {
    const int rc = i >> 9, dd = i & 511, jj = dd & 255;
    const float omega = 1.0f / powf(10000.0f, (float)jj / 256.0f);
    const float ang = (float)(rc < 32 ? rc : rc - 32) * omega;
    p.POS_()[i] = (dd & 256) ? cosf(ang) : sinf(ang);
  }
  if (!tiles) for (int i = bid * 512 + t; i < 2 * 16 * 1024; i += nb * 512) { const int l = i >> 14, j = (i >> 10) & 15, d = i & 1023; p.WLT_()[i] = f2bf(p.w_in[((size_t)l * 1024 + d) * INC + 2048 + j]); }
  float* vec = (float*)smem; float* red = vec + 3072; float* tile = (float*)(smem + 32768) + (t >> 8) * (64 * 65);
  const int NMOD = 192, NPAIR = (3072 + 704) / 2;
  for (int it = bid; it < (tiles ? NMOD + NPAIR : NMOD); it += nb) {
    if (it < NMOD) { if (tiles) continue;
      const int l = it / 96, cgp = it % 96;
      for (int i = t; i < 1024; i += 512) { vec[i] = silu_f(p.c_ctx[i]); vec[1024 + i] = silu_f(p.c[i]); vec[2048 + i] = silu_f(p.c[1024 + i]); }
      __syncthreads();
      float* m = p.mods_() + l * 3 * 6144 + cgp * 64;
      gemv3_item(p.w_mod + (size_t)l * 1024 * 6144 + cgp * 64, 6144, 64, vec, red, p.b_mod + l * 6144 + cgp * 64, m, m + 6144, m + 2 * 6144, t);
    } else {
      const int r = (it - NMOD) * 2 + (t >> 8);
      if (r < 3072) wtile(p, 0, r, p.WTA_() + WT_IN, p.WTA_(), tile, t & 255);
      else wtile(p, 1, r - 3072, p.WTB_(), p.WTA_(), tile, t & 255);
    }
  }
}

__device__ __forceinline__ void phase_vecs(const MP& p, int bid, int nb, unsigned char* smem) {
  int t_ = threadIdx.x; asm volatile("" : "+v"(t_)); const int t = t_;
  float* vec = (float*)smem; float* red = vec + 3072;
  for (int i = bid * 512 + t; i < 2 * 2 * 1024; i += nb * 512) {
    const int l = i >> 11, n = (i >> 10) & 1, d = i & 1023;
    const float g = n ? p.norm2_g[l * 1024 + d] : p.norm1_g[l * 1024 + d];
#pragma unroll
    for (int s = 0; s < 3; ++s) p.AV_()[((l * 2 + n) * 3 + s) * 1024 + d] = g * (1.f + p.mods_()[(l * 3 + s) * 6144 + (n ? 4096 : 1024) + d]);
  }
  const int N_IN = 44, N_GU = 88;
  for (int it = bid; it < 2; it += nb) {
    const int l = it, r = N_IN + N_GU;
    const int sh_off = (r >= N_IN && r < N_IN + N_GU) ? 3072 : 0;
    for (int i = t; i < 1024; i += 512) {
#pragma unroll
      for (int s = 0; s < 3; ++s) vec[s * 1024 + i] = p.mods_()[(l * 3 + s) * 6144 + sh_off + i];
    }
    __syncthreads();
    if (r < N_IN) { float* o = p.BIN_() + l * 3 * NCOLS + r * 64; gemv3_item(p.w_in + (size_t)l * 1024 * INC + win_srccol(r * 64), INC, 64, vec, red, nullptr, o, o + NCOLS, o + 2 * NCOLS, t); }
    else if (r < N_IN + N_GU) { const int j0 = (r - N_IN) * 64; float* o = p.BGU_() + l * 3 * 2 * FFH + j0; gemv3_item(p.w_gu + (size_t)l * 1024 * 2 * FFH + wgu_srccol(j0), 2 * FFH, 64, vec, red, nullptr, o, o + 2 * FFH, o + 4 * FFH, t); }
    else { float* o = p.BLOG_() + l * 3 * 16; gemv3_item(p.w_in + (size_t)l * 1024 * INC + 2048, INC, 16, vec, red, nullptr, o, o + 16, o + 32, t); }
  }
}

__device__ __forceinline__ void prepx_row(const MP& p, int r, int lane) {
  const int seg = seg_of_row(r);
  float ss = 0.f;
#pragma unroll
  for (int i = 0; i < 4; ++i) {
    const int d = i * 256 + lane * 4;
    f32x4 v;
    if (r < NCTX) v = *(const f32x4*)(p.x_prompt + (size_t)r * 1024 + d);
    else {
      const int rl = r - NCTX, pp = rl & 2047, row = pp >> 6, col = pp & 63;
      v = *(const f32x4*)(p.x_sample + (size_t)rl * 1024 + d);
      const f32x4 e = *(const f32x4*)(p.POS_() + (d < 512 ? row * 512 + d : (32 + col) * 512 + (d - 512)));
      v = v + e;
    }
    *(f32x4*)(p.X_() + (size_t)r * 1024 + d) = v;
    ss += (v[0] * v[0] + v[1] * v[1]) + (v[2] * v[2] + v[3] * v[3]);
    const f32x4 g1 = *(const f32x4*)(p.norm1_g + d), sc1 = *(const f32x4*)(p.mods_() + seg * 6144 + 1024 + d);
    const f32x4 a = g1 * (1.f + sc1);
    u32x2 w; w.x = pack_bf16(v[0] * a[0], v[1] * a[1]); w.y = pack_bf16(v[2] * a[2], v[3] * a[3]);
    *(u32x2*)((bf16_t*)p.PRE_() + (size_t)r * 1024 + d) = w;
  }
  ss = wave_sum(ss);
  if (lane == 0) p.rowss_()[r] = ss;
}

__device__ __forceinline__ void phase_logits(const MP& p, int l, int bid, int nb, unsigned char* smem) {
  int tl = threadIdx.x; asm volatile("" : "+v"(tl)); const int t = tl, lane = tl & 63, w = tl >> 6, fr = lane & 15, g = lane >> 4;
  bf16_t* wl = (bf16_t*)smem;
  const bf16_t* XA = (const bf16_t*)p.PRE_();
  for (int q = t; q < 2048; q += 512) { const int j = q >> 7, c = q & 127; *(u32x4*)(wl + j * 1032 + c * 8) = *(const u32x4*)(p.WLT_() + (size_t)l * 16 * 1024 + j * 1024 + c * 8); }
  __syncthreads();
  for (int rg = bid * 8 + w; rg < NTOK / 16; rg += nb * 8) {
    const int row0 = rg * 16;
    const bf16_t* arow = XA + (size_t)(row0 + fr) * 1024 + 8 * g;
    bf16x8 af[32];
#pragma unroll
    for (int ks = 0; ks < 32; ++ks) af[ks] = *(const bf16x8*)(arow + 32 * ks);
    f32x4 acc0 = (f32x4){0.f, 0.f, 0.f, 0.f}, acc1 = acc0;
#pragma unroll
    for (int ks = 0; ks < 32; ks += 2) {
      const bf16x8 b0 = *(const bf16x8*)(wl + fr * 1032 + 32 * ks + 8 * g), b1 = *(const bf16x8*)(wl + fr * 1032 + 32 * (ks + 1) + 8 * g);
      acc0 = __builtin_amdgcn_mfma_f32_16x16x32_bf16(af[ks], b0, acc0, 0, 0, 0);
      acc1 = __builtin_amdgcn_mfma_f32_16x16x32_bf16(af[ks + 1], b1, acc1, 0, 0, 0);
    }
    const int seg = seg_of_row(row0);
    const float bias = p.BLOG_()[l * 3 * 16 + seg * 16 + fr];
#pragma unroll
    for (int r = 0; r < 4; ++r) {
      const int row = row0 + 4 * g + r;
      const float rinv = rsqrtf(p.rowss_()[(2 * l) * NTOK + row] * (1.0f / 1024.0f) + 1e-6f);
      p.LOG_()[(size_t)row * 16 + fr] = (acc0[r] + acc1[r]) * rinv + bias;
    }
  }
  __syncthreads();
}

__device__ __forceinline__ void delta_post_row(const MP& p, int l, int r, int lane) {
  const bf16_t* OB = p.QKV_();
  const u32x4 of = *(const u32x4*)(OB + (size_t)r * 512 + lane * 8), ob = *(const u32x4*)(OB + ((size_t)NTOK + r) * 512 + lane * 8);
  const u32x4 zz = *(const u32x4*)(p.REST_() + (size_t)r * NREST + lane * 8);
  float o[8]; float ss = 0.f;
#pragma unroll
  for (int e = 0; e < 8; ++e) {
    const unsigned wf = of[e >> 1], wb = ob[e >> 1];
    o[e] = __uint_as_float((e & 1) ? (wf & 0xffff0000u) : (wf << 16)) + __uint_as_float((e & 1) ? (wb & 0xffff0000u) : (wb << 16));
    ss += o[e] * o[e];
  }
  ss += __shfl_xor(ss, 1); ss += __shfl_xor(ss, 2); ss += __shfl_xor(ss, 4); ss += __shfl_xor(ss, 8);
  const float rn = rsqrtf(ss * (1.0f / 128.0f) + 1e-6f);
  const float* ng = p.delta_norm_g + l * 128 + (lane & 15) * 8;
  float y[8];
#pragma unroll
  for (int e = 0; e < 8; ++e) {
    const unsigned wz = zz[e >> 1];
    const float z = __uint_as_float((e & 1) ? (wz & 0xffff0000u) : (wz << 16));
    y[e] = o[e] * rn * ng[e] * silu_fast(z);
  }
  u32x4 w; w.x = pack_bf16(y[0], y[1]); w.y = pack_bf16(y[2], y[3]); w.z = pack_bf16(y[4], y[5]); w.w = pack_bf16(y[6], y[7]);
  *(u32x4*)(p.MIXB_() + (size_t)r * 1024 + lane * 8) = w;
}

__device__ __forceinline__ void sgu_pair(const MP& p, int l, int item0, unsigned char* smem) {
  int tl = threadIdx.x; asm volatile("" : "+v"(tl)); const int t = tl & 255, lane = tl & 63, w = __builtin_amdgcn_readfirstlane(tl >> 6), hb = w >> 2, wl = w & 3, fr = lane & 15, g4 = lane >> 4;
  const int item = item0 + hb, ch = item >> 2, g = item & 3;
  const bf16_t* REST = p.REST_(); const float* norm_g = p.sgu_norm_g + l * 256 + g * 64;
  const float* w_s = p.w_spatial + ((size_t)l * 4 + g) * 128 * 128; const float* b_s = p.b_spatial + (l * 4 + g) * 128;
  const int r0 = ch * 128;
  bf16_t* vnT = (bf16_t*)(smem + hb * 35840);
  bf16_t* ut = (bf16_t*)(smem + hb * 35840 + 17408);
  const int s_ = t >> 1, q2 = t & 1;
  const bf16_t* vrow = REST + (size_t)(r0 + s_) * NREST + 768 + g * 64 + q2 * 32;
  u32x4 vv[4];
#pragma unroll
  for (int k = 0; k < 4; ++k) vv[k] = *(const u32x4*)(vrow + 8 * k);
  u32x4 uu[4];
#pragma unroll
  for (int k = 0; k < 4; ++k) { const int q = t + 256 * k, row = q >> 3, c8 = q & 7; uu[k] = *(const u32x4*)(REST + (size_t)(r0 + row) * NREST + 512 + g * 64 + c8 * 8); }
  f32x4 wa[2][4][2];
#pragma unroll
  for (int mt = 0; mt < 2; ++mt) {
    const float* wrow = w_s + (size_t)(wl * 32 + mt * 16 + fr) * 128 + 8 * g4;
#pragma unroll
    for (int ks = 0; ks < 4; ++ks) { wa[mt][ks][0] = *(const f32x4*)(wrow + 32 * ks); wa[mt][ks][1] = *(const f32x4*)(wrow + 32 * ks + 4); }
  }
  {
    float val[32]; float ss = 0.f;
#pragma unroll
    for (int e = 0; e < 32; ++e) {
      const unsigned wv = vv[e >> 3][(e & 7) >> 1];
      val[e] = gelu_fast(__uint_as_float((e & 1) ? (wv & 0xffff0000u) : (wv << 16))); ss += val[e] * val[e];
    }
    ss += __shfl_xor(ss, 1);
    const float rinv = rsqrtf(ss * (1.0f / 64.0f) + 1e-6f);
#pragma unroll
    for (int e = 0; e < 32; ++e) vnT[(q2 * 32 + e) * 136 + s_] = f2bf(val[e] * rinv * norm_g[q2 * 32 + e]);
#pragma unroll
    for (int k = 0; k < 4; ++k) { const int q = t + 256 * k, row = q >> 3, c8 = q & 7; *(u32x4*)(ut + row * 72 + c8 * 8) = uu[k]; }
  }
  __syncthreads();
#pragma unroll
  for (int mt = 0; mt < 2; ++mt) {
    bf16x8 af[4];
#pragma unroll
    for (int ks = 0; ks < 4; ++ks) af[ks] = pack8(wa[mt][ks][0], wa[mt][ks][1]);
    f32x4 acc[4];
#pragma unroll
    for (int nt = 0; nt < 4; ++nt) {
      acc[nt] = (f32x4){0.f, 0.f, 0.f, 0.f};
#pragma unroll
      for (int ks = 0; ks < 4; ++ks) {
        const bf16x8 bfr = *(const bf16x8*)(vnT + (nt * 16 + fr) * 136 + 32 * ks + 8 * g4);
        acc[nt] = __builtin_amdgcn_mfma_f32_16x16x32_bf16(af[ks], bfr, acc[nt], 0, 0, 0);
      }
    }
#pragma unroll
    for (int r = 0; r < 4; ++r) {
      const int tt = wl * 32 + mt * 16 + 4 * g4 + r;
      const float bb = b_s[tt];
#pragma unroll
      for (int nt = 0; nt < 4; ++nt) { bf16_t* e = ut + tt * 72 + nt * 16 + fr; *e = f2bf(gelu_fast(bf2f(*e)) * (acc[nt][r] + bb)); }
    }
  }
  __syncthreads();
#pragma unroll
  for (int k = 0; k < 4; ++k) { const int q = t + 256 * k, row = q >> 3, c8 = q & 7; *(u32x4*)(p.MIXB_() + (size_t)(r0 + row) * 1024 + 512 + g * 64 + c8 * 8) = *(const u32x4*)(ut + row * 72 + c8 * 8); }
  __syncthreads();
}

__device__ __forceinline__ void pool_item(const MP& p, int l, int blk, unsigned char* smem) {
  int tl = threadIdx.x; asm volatile("" : "+v"(tl)); const int t = tl, lane = tl & 63, w = __builtin_amdgcn_readfirstlane(tl >> 6), fr = lane & 15, g4 = lane >> 4;
  const bf16_t* REST = p.REST_(); const float* w_pool = p.w_pool + (size_t)l * 4 * 64 * 64; const float* scale = p.pool_scale + l * 256;
  const int r0 = blk * 64;
  int seg0, seglen;
  if (r0 < NCTX) { seg0 = r0 & ~255; seglen = 256; } else { seg0 = r0; seglen = 64; }
  bf16_t* xs = (bf16_t*)smem;
  bf16_t* dm = (bf16_t*)(smem + 42240);
  bf16_t* wT = (bf16_t*)(smem + 42240 + 36864);
  u32x4 xv[5];
#pragma unroll
  for (int k = 0; k < 5; ++k) {
    const int q = t + 512 * k, lr = q >> 5, c8 = q & 31, row = r0 - 8 + lr;
    xv[k] = (u32x4){0u, 0u, 0u, 0u};
    if (row >= seg0 && row < seg0 + seglen) xv[k] = *(const u32x4*)(REST + (size_t)row * NREST + 1024 + c8 * 8);
  }
  f32x4 wv[8];
#pragma unroll
  for (int k = 0; k < 8; ++k) wv[k] = *(const f32x4*)(w_pool + (size_t)(t + 512 * k) * 4);
#pragma unroll
  for (int k = 0; k < 5; ++k) { const int q = t + 512 * k, lr = q >> 5, c8 = q & 31; *(u32x4*)(xs + lr * 264 + c8 * 8) = xv[k]; }
#pragma unroll
  for (int k = 0; k < 8; ++k) {
    const int q = t + 512 * k, i = q >> 10, c = (q >> 4) & 63, d4 = (q & 15) * 4;
#pragma unroll
    for (int e = 0; e < 4; ++e) wT[(i * 64 + d4 + e) * 72 + c] = f2bf(wv[k][e]);
  }
  __syncthreads();
  {
    const int c = t & 255, i = c >> 6, win = 2 << i, ph = t >> 8, hw = win >> 1;
    const int xoff = seg0 - r0 + 8;
    int pos = r0 + ph * 32 - seg0;
    int lo = max(pos - hw, 0), hi = min(pos + hw, seglen);
    float s = 0.f;
    for (int q = lo; q < hi; ++q) s += bf2f(xs[(q + xoff) * 264 + c]);
#pragma unroll 4
    for (int pp = ph * 32; pp < ph * 32 + 32; ++pp) {
      dm[(i * 64 + pp) * 72 + (c & 63)] = f2bf(s * __builtin_amdgcn_rcpf((float)(hi - lo)) - bf2f(xs[(pp + 8) * 264 + c]));
      ++pos;
      const int lo2 = max(pos - hw, 0), hi2 = min(pos + hw, seglen);
      if (hi2 > hi) s += bf2f(xs[(hi + xoff) * 264 + c]);
      if (lo2 > lo) s -= bf2f(xs[(lo + xoff) * 264 + c]);
      lo = lo2; hi = hi2;
    }
  }
  __syncthreads();
  {
    const int i = w >> 1;
    bf16x8 bfr[4][2];
#pragma unroll
    for (int nt = 0; nt < 4; ++nt)
#pragma unroll
      for (int ks = 0; ks < 2; ++ks) bfr[nt][ks] = *(const bf16x8*)(wT + (i * 64 + nt * 16 + fr) * 72 + 32 * ks + 8 * g4);
#pragma unroll
    for (int pt2 = 0; pt2 < 2; ++pt2) {
      const int pt = (w & 1) * 2 + pt2;
      bf16x8 af[2];
#pragma unroll
      for (int ks = 0; ks < 2; ++ks) af[ks] = *(const bf16x8*)(dm + (i * 64 + pt * 16 + fr) * 72 + 32 * ks + 8 * g4);
#pragma unroll
      for (int nt = 0; nt < 4; ++nt) {
        f32x4 acc = (f32x4){0.f, 0.f, 0.f, 0.f};
#pragma unroll
        for (int ks = 0; ks < 2; ++ks) acc = __builtin_amdgcn_mfma_f32_16x16x32_bf16(af[ks], bfr[nt][ks], acc, 0, 0, 0);
        const float sc = scale[i * 64 + nt * 16 + fr];
#pragma unroll
        for (int r = 0; r < 4; ++r) xs[(pt * 16 + 4 * g4 + r) * 264 + i * 64 + nt * 16 + fr] = f2bf(acc[r] * sc);
      }
    }
  }
  __syncthreads();
#pragma unroll
  for (int k = 0; k < 4; ++k) { const int q = t + 512 * k, row = q >> 5, c8 = q & 31; *(u32x4*)(p.MIXB_() + (size_t)(r0 + row) * 1024 + 768 + c8 * 8) = *(const u32x4*)(xs + row * 264 + c8 * 8); }
  __syncthreads();
}

__device__ __forceinline__ void final_row(const MP& p, int r, int lane) {
  const float rinv = rsqrtf(p.rowss_()[4 * NTOK + r] * (1.0f / 1024.0f) + 1e-6f);
#pragma unroll
  for (int i = 0; i < 4; ++i) {
    const int d = i * 256 + lane * 4;
    const f32x4 v = *(const f32x4*)(p.X_() + (size_t)r * 1024 + d), gg = *(const f32x4*)(p.norm_f + d);
    *(f32x4*)(p.out + (size_t)r * 1024 + d) = v * rinv * gg;
  }
}

#ifndef REPEAT
#define REPEAT 0
#endif
#define REP_CAT2(a, b) a##b
#define REP_CAT(a, b) REP_CAT2(a, b)
#define REP(k) for (int REP_CAT(rep_, __LINE__) = 0; REP_CAT(rep_, __LINE__) < 1 + ((REPEAT >> (k)) & 1); ++REP_CAT(rep_, __LINE__))
#ifndef USE_CG_SYNC
#define USE_CG_SYNC 0
#endif
#if USE_CG_SYNC
#define GRID_SYNC() grid.sync()
#else
#define GRID_SYNC() do { REP(21) { XcdBarrier xb2; xb2.bar = p.bar_(); xb2.x = xb_xcc_id(); xb2.st = xst; xcd_barrier(xb2); } } while (0)
#endif

__global__ __launch_bounds__(512, 2) void mega(MP p) {
  extern __shared__ __attribute__((aligned(16))) unsigned char smem[];
#if USE_CG_SYNC
  cg::grid_group grid = cg::this_grid();
#else
  volatile LAS unsigned* xst = (volatile LAS unsigned*)((LAS unsigned char*)smem + MEGA_LDS_MAIN);
  if (threadIdx.x == 0) { xst[0] = 0u; xst[1] = 0u; }
  __syncthreads();
  (void)xcd_barrier_post(p.bar_(), xst);
#endif
  const int bid = blockIdx.x, nb = gridDim.x;
  bf16_t* XA = (bf16_t*)p.PRE_(); bf16_t* ACT = p.QKV_(); bf16_t* OB = p.QKV_();
  float* states_out = p.out + (size_t)NTOK * 1024;

  REP(0) phase_prep0(p, bid, nb, smem, false);
  GRID_SYNC();
  REP(1) { phase_prep0(p, bid, nb, smem, true); phase_vecs(p, bid, nb, smem); }
  REP(2) { int tl = threadIdx.x; asm volatile("" : "+v"(tl)); const int lane = tl & 63, w = tl >> 6;
    for (int r = bid * 8 + w; r < NTOK; r += nb * 8) prepx_row(p, r, lane); }
  GRID_SYNC();
  for (int l = 0; l < 2; ++l) {
#define TL_DECL int tl = threadIdx.x; asm volatile("" : "+v"(tl)); const int t = tl, lane = tl & 63, w = tl >> 6; (void)t; (void)lane; (void)w
    const float* ml = p.mods_() + l * 3 * 6144;
    float* rs1 = p.rowss_() + (2 * l) * NTOK; float* rs2 = p.rowss_() + (2 * l + 1) * NTOK; float* rs3 = p.rowss_() + (2 * l + 2) * NTOK;
    const float* A2 = p.AV_() + (l * 2 + 1) * 3 * 1024; const float* A1n = p.AV_() + (2 + 0) * 3 * 1024;
    REP(4) {
      pg8::Gemm g; g.A = XA; g.Bt = l ? p.WTB_() : p.WTA_() + WT_IN; g.M = NTOK; g.N = NCOLS; g.K = 1024;
      EpiIn E{p.QKV_(), p.REST_(), rs1, p.BIN_() + l * 3 * NCOLS};
      pg8::StaticOrder S; S.init(g.M, g.N, nb, bid);
      pg8::gemm_phase<EpiIn, pg8::StaticOrder, true, true>((PG8_LAS unsigned char*)smem, g, S, E);
    }
    REP(3) if (bid >= 16) phase_logits(p, l, bid - 16, nb - 16, smem);
    GRID_SYNC();
    REP(5) for (int item = bid; item < 768; item += nb) pre_item(item, p.QKV_(), p.LOG_(), p.conv_w + (size_t)l * 3 * NQKV, p.a_log + l * 8, p.dt_bias + l * 8, p.PRE_(), smem);
    if (l == 1) {
      TL_DECL;
      float* tile = (float*)smem + (t >> 8) * (64 * 65);
      for (int it = bid; it < (3072 - 704) / 2; it += nb) wtile(p, 1, 704 + it * 2 + (t >> 8), p.WTB_(), p.WTA_(), tile, t & 255);
    }
    GRID_SYNC();
    REP(6) { if (bid < 32) { REP(13) scan_dispatch(bid, p.PRE_(), p.state_delta, OB, states_out, l, smem); }
             else { REP(14) for (int i = bid - 32; i < 256; i += nb - 32) scan_dispatch(32 + i, p.PRE_(), p.state_delta, OB, states_out, l, smem); } }
    REP(12) if (bid >= 32) {
      for (int it = bid - 32; it < 192; it += nb - 32) sgu_pair(p, l, 2 * it, smem);
      for (int it = bid - 32; it < 192; it += nb - 32) pool_item(p, l, it, smem);
    }
    GRID_SYNC();
    REP(7) { TL_DECL; for (int r = bid * 8 + w; r < NTOK; r += nb * 8) delta_post_row(p, l, r, lane); }
    GRID_SYNC();
    {
      pg8::Gemm g; g.A = p.MIXB_(); g.Bt = p.WTA_() + WT_OUT; g.M = NTOK; g.N = 1024; g.K = 1024;
      EpiRes E{p.X_(), ml + 2048, rs2, XA, A2};
      pg8::StaticOrder S; S.init(g.M, g.N, nb, bid);
      pg8::gemm_phase<EpiRes, pg8::StaticOrder, true, true>((PG8_LAS unsigned char*)smem, g, S, E);
    }
    GRID_SYNC();
    REP(9) {
      pg8::Gemm g; g.A = XA; g.Bt = p.WTA_() + WT_GU; g.M = NTOK; g.N = 2 * FFH; g.K = 1024;
      EpiGu E{ACT, rs2, p.BGU_() + l * 3 * 2 * FFH};
      pg8::StaticOrder S; S.init(g.M, g.N, nb, bid);
      pg8::gemm_phase<EpiGu, pg8::StaticOrder, true, true>((PG8_LAS unsigned char*)smem, g, S, E);
    }
    GRID_SYNC();
    if (l == 0) {
      pg8::Gemm g; g.A = ACT; g.Bt = p.WTA_() + WT_DOWN; g.M = NTOK; g.N = 1024; g.K = FFH;
      EpiRes E{p.X_(), ml + 5120, rs3, XA, A1n};
      pg8::StaticOrder S; S.init(g.M, g.N, nb, bid);
      pg8::gemm_phase<EpiRes, pg8::StaticOrder, true, true>((PG8_LAS unsigned char*)smem, g, S, E);
      GRID_SYNC();
    } else {
      pg8::Gemm g; g.A = ACT; g.Bt = p.WTA_() + WT_DOWN; g.M = NTOK; g.N = 1024; g.K = FFH;
      EpiResFinal E{p.X_(), ml + 5120, p.out, p.norm_f, p.SLOT_(), p.bar_() + 3584};
      pg8::StaticOrder S; S.init(g.M, g.N, nb, bid);
      pg8::gemm_phase<EpiResFinal, pg8::StaticOrder, false, true>((PG8_LAS unsigned char*)smem, g, S, E);
    }
  }
}

extern "C" void kernel_launch(void* const* d_in, const int* in_sizes, int n_in, void* d_out, int out_size, void* d_ws, size_t ws_size,
                              hipStream_t stream) {
  static int grid_blocks = 0;
  if (!grid_blocks) {
    int dev = 0, cus = 0, per_cu = 0;
    (void)hipGetDevice(&dev);
    (void)hipDeviceGetAttribute(&cus, hipDeviceAttributeMultiprocessorCount, dev);
    (void)hipFuncSetAttribute((const void*)mega, hipFuncAttributeMaxDynamicSharedMemorySize, MEGA_LDS);
    (void)hipOccupancyMaxActiveBlocksPerMultiprocessor(&per_cu, (const void*)mega, 512, MEGA_LDS);
    if (per_cu < 1) { fprintf(stderr, "occupancy query says %d blocks per CU\n", per_cu); per_cu = 1; }
    if (per_cu > 1) per_cu = 1;
    grid_blocks = cus * per_cu;
    if (grid_blocks > 256) grid_blocks = 256;
  }
  MP p; memset(&p, 0, sizeof p);
  const float** ins = (const float**)&p;
  for (int i = 0; i < 23; ++i) ins[i] = (const float*)d_in[i];
  p.out = (float*)d_out;
  p.ws = (unsigned char*)d_ws;
  if (WS_END > ws_size) { fprintf(stderr, "workspace too small: need %zu have %zu\n", (size_t)WS_END, ws_size); return; }
  (void)hipMemsetAsync((char*)d_ws + WS_BAR, 0, 16384, stream);
  void* args[] = {&p};
  hipError_t e = hipLaunchCooperativeKernel((const void*)mega, dim3(grid_blocks), dim3(512), args, MEGA_LDS, stream);
  if (e != hipSuccess) fprintf(stderr, "cooperative launch failed: %s (grid %d)\n", hipGetErrorString(e), grid_blocks);
}
```

```cpp
#include <hip/hip_runtime.h>
#include <math.h>
#include <cstdio>
#include <cstring>

#define NTOK 12288
#define NCTX 8192
#define DM 1024
#define INC 2832
#define FFH 2816
#define NQKV 1536
#define NREST 1280
#define NCOLS 2816

typedef unsigned short bf16_t;
typedef float f32x2_cv __attribute__((ext_vector_type(2)));
typedef __bf16 bf16x2_cv __attribute__((ext_vector_type(2)));
__device__ __forceinline__ unsigned pack_bf16(float lo, float hi) { return __builtin_bit_cast(unsigned, __builtin_convertvector((f32x2_cv){lo, hi}, bf16x2_cv)); }
__device__ __forceinline__ bf16_t f2bf(float f) { return (bf16_t)(pack_bf16(f, 0.f) & 0xffffu); }
__device__ __forceinline__ float bf2f(bf16_t b) { return __uint_as_float(((unsigned)b) << 16); }
__device__ __forceinline__ float silu_f(float x) { return x / (1.f + expf(-x)); }
__device__ __forceinline__ float silu_fast(float x) { return x * __builtin_amdgcn_rcpf(1.f + __expf(-x)); }
__device__ __forceinline__ float gelu_fast(float x) { const float u = 1.5957691216057308f * (x + 0.044715f * x * x * x); return x * __builtin_amdgcn_rcpf(1.f + __expf(-u)); }
__device__ __forceinline__ float sigmoid_f(float x) { return 1.f / (1.f + expf(-x)); }
__device__ __forceinline__ float gelu_f(float x) { return 0.5f * x * (1.f + tanhf(0.7978845608028654f * (x + 0.044715f * x * x * x))); }
__device__ __forceinline__ float softplus_f(float x) { return x > 20.f ? x : log1pf(expf(x)); }
__device__ __forceinline__ int seg_of_row(int r) { return r < NCTX ? 0 : 1 + ((r - NCTX) >> 11); }
__device__ __forceinline__ float wave_sum(float v) {
#pragma unroll
  for (int o = 32; o > 0; o >>= 1) v += __shfl_xor(v, o);
  return v;
}
namespace pg8 {
#define PG8_LAS __attribute__((address_space(3)))
typedef unsigned short bf16_t;
typedef short bf16x8 __attribute__((ext_vector_type(8)));
typedef float f32x4 __attribute__((ext_vector_type(4)));
typedef unsigned u32x4 __attribute__((ext_vector_type(4)));
constexpr int BM = 256, BK = 64, HALF = 128, HTB = HALF * BK * 2  , STAGE_BYTES = 8 * HTB, NXCD = 8, WGM = 8;

__host__ __device__ __forceinline__ int lds_byte(int r, int c) { const int st = (r >> 4) * 2 + (c >> 5), rr = r & 15, cc = c & 31, ob = rr * 64 + cc * 2; return st * 1024 + (ob ^ (((ob >> 9) & 1) << 5)); }
__host__ __device__ __forceinline__ void stage_rc(int b, int& R, int& C) { const int st = b / 1024, sb = b % 1024, swz = sb ^ (((sb >> 9) & 1) << 5); R = (st >> 1) * 16 + swz / 64; C = (st & 1) * 32 + (swz % 64) / 2; }
__host__ __device__ __forceinline__ int perm32(int rho) { const int n = rho >> 4, i = rho & 15; return 8 * (i >> 2) + 4 * n + (i & 3); }

struct Unit { int pm, pn; };
struct Gemm { const bf16_t* A; const bf16_t* Bt; int M, N, K; };

struct StaticOrder {
    int nM, nN, nwg, G, c;
    __host__ __device__ void init(int M, int N, int G_, int c_) { nM = M / BM; nN = N / BM; nwg = nM * nN; G = G_; c = c_; }
    __host__ __device__ bool next(int i, Unit& u) const {
        const long L = (long)i * G + c; if (L >= nwg) return false;
        int wgid = (int)L; { const int q = nwg / NXCD, r = nwg % NXCD, xcd = wgid % NXCD, off = wgid / NXCD; wgid = (xcd < r ? xcd * (q + 1) : r * (q + 1) + (xcd - r) * q) + off; }
        const int nig = WGM * nN, gid = wgid / nig, fm = gid * WGM, gsz = (nM - fm) < WGM ? (nM - fm) : WGM;
        u.pm = fm + ((wgid % nig) % gsz); u.pn = (wgid % nig) / gsz; return true;
    }
    __device__ __forceinline__ void a_ready(const Unit&) const {}
    __device__ __forceinline__ void done(const Unit&) const {}
};

__device__ __forceinline__ unsigned cvt_pk_bf16(float lo, float hi) { return ::pack_bf16(lo, hi); }
template <class Epi, class Sched, bool ALIGN_EPI = false, bool SP2 = false>
__device__ __forceinline__ void gemm_phase(PG8_LAS unsigned char* lds, const Gemm g, const Sched& S, const Epi& E) {
    int tid_ = threadIdx.x; asm volatile("" : "+v"(tid_));
    const int tid = tid_, wid = __builtin_amdgcn_readfirstlane(tid >> 6), lane = tid & 63, wr = wid >> 2, wc = wid & 3, fr = lane & 15, fq = lane >> 4;
    const int K = g.K, nt = K / BK;
    unsigned voffA[2], voffB[2];
#pragma unroll
    for (int i = 0; i < 2; ++i) { int R, C; stage_rc(tid * 16 + i * 8192, R, C); const int Rb = Epi::PERM ? ((R & ~31) + perm32(R & 31)) : R;
        voffA[i] = (unsigned)(R * K + C) * 2u; voffB[i] = (unsigned)(Rb * K + C) * 2u; }
    const size_t kstep = (size_t)(BK * 2);
    const size_t hstep = (size_t)HALF * K * 2;
    const size_t tstep = 2 * hstep;
    const unsigned ldsw = (unsigned)wid * 1024u;
    const int aoff = lds_byte(wr * 64 + fr, fq * 8), boff = lds_byte(wc * 32 + fr, fq * 8);
#define PG8_SA(b, h) (((b) * 2 + (h)) * HTB)
#define PG8_SB(b, h) ((4 + (b) * 2 + (h)) * HTB)
#define PG8_STAGE(bufoff, gbase, voff) do { _Pragma("unroll") for (int _i = 0; _i < 2; ++_i) \
        __builtin_amdgcn_global_load_lds((const unsigned*)((const char*)(gbase) + (voff)[_i]), (PG8_LAS unsigned*)(lds + (bufoff) + ldsw + _i * 8192), 16, 0, 0); } while (0)
#define PG8_LDA(dst, b, h) do { _Pragma("unroll") for (int m = 0; m < 4; ++m) _Pragma("unroll") for (int k = 0; k < 2; ++k) dst[m][k] = *(const PG8_LAS bf16x8*)(lds + PG8_SA(b, h) + aoff + m * 2048 + k * 1024); } while (0)
#define PG8_LDB(dst, b, h) do { _Pragma("unroll") for (int n = 0; n < 2; ++n) _Pragma("unroll") for (int k = 0; k < 2; ++k) dst[n][k] = *(const PG8_LAS bf16x8*)(lds + PG8_SB(b, h) + boff + n * 2048 + k * 1024); } while (0)
#define PG8_MMA(ai, bj, At, Bt) do { __builtin_amdgcn_s_setprio(1); _Pragma("unroll") for (int m = 0; m < 4; ++m) _Pragma("unroll") for (int n = 0; n < 2; ++n) _Pragma("unroll") for (int k = 0; k < 2; ++k) \
        acc[ai][bj][m][n] = __builtin_amdgcn_mfma_f32_16x16x32_bf16(Bt[n][k], At[m][k], acc[ai][bj][m][n], 0, 0, 0); __builtin_amdgcn_s_setprio(0); } while (0)
#define PG8_WAIT_V(n) asm volatile("s_waitcnt vmcnt(" #n ")" ::: "memory")
#define PG8_WAIT_L(n) asm volatile("s_waitcnt lgkmcnt(" #n ")" ::: "memory")
#define PG8_BAR __builtin_amdgcn_s_barrier()
#define PG8_SCHED __builtin_amdgcn_sched_barrier(0)
    Unit cur, nxt; int ui = 0;
    if (!S.next(0, cur)) return;
    f32x4 acc[2][2][4][2];
#pragma unroll
    for (int a = 0; a < 2; ++a)
#pragma unroll
        for (int b = 0; b < 2; ++b)
#pragma unroll
            for (int m = 0; m < 4; ++m)
#pragma unroll
                for (int n = 0; n < 2; ++n) acc[a][b][m][n] = (f32x4){0.f, 0.f, 0.f, 0.f};
    bf16x8 At[4][2], B0[2][2], B1[2][2];
    const char* cA = (const char*)g.A + (size_t)cur.pm * tstep; const char* cB = (const char*)g.Bt + (size_t)cur.pn * tstep;
    S.a_ready(cur);
    if constexpr (SP2) {
        PG8_STAGE(PG8_SB(0, 0), cB, voffB); PG8_STAGE(PG8_SB(0, 1), cB + hstep, voffB); PG8_STAGE(PG8_SA(0, 0), cA, voffA); PG8_STAGE(PG8_SA(0, 1), cA + hstep, voffA);
        if (wr == 1) PG8_BAR;
        PG8_WAIT_V(2); PG8_BAR;
        PG8_STAGE(PG8_SB(1, 0), cB + kstep, voffB); PG8_STAGE(PG8_SA(1, 0), cA + kstep, voffA); PG8_STAGE(PG8_SB(1, 1), cB + hstep + kstep, voffB);
        PG8_WAIT_V(6); PG8_BAR;
    } else {
        PG8_STAGE(PG8_SB(0, 0), cB, voffB); PG8_STAGE(PG8_SA(0, 0), cA, voffA); PG8_STAGE(PG8_SB(0, 1), cB + hstep, voffB); PG8_STAGE(PG8_SA(0, 1), cA + hstep, voffA);
        if (wr == 1) PG8_BAR;
        PG8_WAIT_V(4); PG8_BAR;
        PG8_STAGE(PG8_SB(1, 0), cB + kstep, voffB); PG8_STAGE(PG8_SA(1, 0), cA + kstep, voffA); PG8_STAGE(PG8_SB(1, 1), cB + hstep + kstep, voffB);
        PG8_WAIT_V(6); PG8_BAR;
    }
    for (;;) {
        const bool has_next = S.next(ui + 1, nxt);
        const char* nA = has_next ? (const char*)g.A + (size_t)nxt.pm * tstep : cA; const char* nB = has_next ? (const char*)g.Bt + (size_t)nxt.pn * tstep : cB;
        for (int t = 0; t < nt; t += 2) {
            const bool last = (t == nt - 2);
            const char* a1 = cA + (size_t)(t + 1) * kstep;
            const char* a2 = last ? nA : cA + (size_t)(t + 2) * kstep; const char* b2 = last ? nB : cB + (size_t)(t + 2) * kstep;
            const char* a3 = a2 + kstep; const char* b3 = b2 + kstep;
            if (last && has_next) S.a_ready(nxt);
            if constexpr (SP2) {
            PG8_LDB(B0, 0, 0); PG8_LDB(B1, 0, 1); PG8_SCHED; PG8_LDA(At, 0, 0); PG8_STAGE(PG8_SA(1, 1), a1 + hstep, voffA);
            PG8_WAIT_V(8); PG8_WAIT_L(0); PG8_BAR; PG8_MMA(0, 0, At, B0); PG8_MMA(0, 1, At, B1); PG8_BAR; PG8_SCHED;
            PG8_LDA(At, 0, 1); PG8_STAGE(PG8_SB(0, 0), b2, voffB); PG8_STAGE(PG8_SB(0, 1), b2 + hstep, voffB); PG8_STAGE(PG8_SA(0, 0), a2, voffA);
            PG8_WAIT_V(8); PG8_WAIT_L(0); PG8_BAR; PG8_MMA(1, 0, At, B0); PG8_MMA(1, 1, At, B1); PG8_BAR; PG8_SCHED;
            PG8_LDB(B0, 1, 0); PG8_LDB(B1, 1, 1); PG8_SCHED; PG8_LDA(At, 1, 0); PG8_STAGE(PG8_SA(0, 1), a2 + hstep, voffA);
            PG8_WAIT_V(8); PG8_WAIT_L(0); PG8_BAR; PG8_MMA(0, 0, At, B0); PG8_MMA(0, 1, At, B1); PG8_BAR; PG8_SCHED;
            PG8_LDA(At, 1, 1); PG8_STAGE(PG8_SB(1, 0), b3, voffB); PG8_STAGE(PG8_SB(1, 1), b3 + hstep, voffB); PG8_STAGE(PG8_SA(1, 0), a3, voffA);
            PG8_WAIT_V(8); PG8_WAIT_L(0); PG8_BAR; PG8_MMA(1, 0, At, B0); PG8_MMA(1, 1, At, B1); PG8_BAR; PG8_SCHED;
            } else {
            PG8_LDB(B0, 0, 0); PG8_SCHED; PG8_LDA(At, 0, 0); PG8_STAGE(PG8_SA(1, 1), a1 + hstep, voffA);
            PG8_WAIT_L(8); PG8_BAR; PG8_WAIT_L(0); PG8_MMA(0, 0, At, B0); PG8_BAR; PG8_SCHED;
            PG8_LDB(B1, 0, 1); PG8_STAGE(PG8_SB(0, 0), b2, voffB);
            PG8_BAR; PG8_WAIT_L(0); PG8_MMA(0, 1, At, B1); PG8_BAR;
            PG8_LDA(At, 0, 1); PG8_STAGE(PG8_SA(0, 0), a2, voffA);
            PG8_BAR; PG8_WAIT_L(0); PG8_MMA(1, 0, At, B0); PG8_BAR; PG8_SCHED;
            PG8_STAGE(PG8_SB(0, 1), b2 + hstep, voffB);
            PG8_WAIT_V(6); PG8_BAR; PG8_MMA(1, 1, At, B1); PG8_BAR;
            PG8_LDB(B0, 1, 0); PG8_SCHED; PG8_LDA(At, 1, 0); PG8_STAGE(PG8_SA(0, 1), a2 + hstep, voffA);
            PG8_WAIT_L(8); PG8_BAR; PG8_WAIT_L(0); PG8_MMA(0, 0, At, B0); PG8_BAR; PG8_SCHED;
            PG8_LDB(B1, 1, 1); PG8_STAGE(PG8_SB(1, 0), b3, voffB);
            PG8_BAR; PG8_WAIT_L(0); PG8_MMA(0, 1, At, B1); PG8_BAR;
            PG8_LDA(At, 1, 1); PG8_STAGE(PG8_SA(1, 0), a3, voffA);
            PG8_BAR; PG8_WAIT_L(0); PG8_MMA(1, 0, At, B0); PG8_BAR; PG8_SCHED;
            PG8_STAGE(PG8_SB(1, 1), b3 + hstep, voffB);
            PG8_WAIT_V(6); PG8_BAR; PG8_MMA(1, 1, At, B1); PG8_BAR;
            }
        }
        if constexpr (ALIGN_EPI) { if (wr == 0) PG8_BAR; }
        if constexpr (!Epi::AFTER_DRAIN) { E(acc, cur, wr, wc, fr, fq); S.done(cur); }
        if (!has_next) break;
#pragma unroll
        for (int a = 0; a < 2; ++a)
#pragma unroll
            for (int b = 0; b < 2; ++b)
#pragma unroll
                for (int m = 0; m < 4; ++m)
#pragma unroll
                    for (int n = 0; n < 2; ++n) acc[a][b][m][n] = (f32x4){0.f, 0.f, 0.f, 0.f};
        cur = nxt; cA = nA; cB = nB; ++ui;
        if constexpr (ALIGN_EPI) { if (wr == 1) PG8_BAR; }
    }
    PG8_WAIT_V(0);
    if constexpr (!ALIGN_EPI) { if (wr == 0) PG8_BAR; }
    PG8_BAR;
    if constexpr (Epi::AFTER_DRAIN) { E.fused(acc, cur, wr, wc, fr, fq, lds, wid, lane); S.done(cur); }
#undef PG8_SA
#undef PG8_SB
#undef PG8_STAGE
#undef PG8_LDA
#undef PG8_LDB
#undef PG8_MMA
#undef PG8_WAIT_V
#undef PG8_WAIT_L
#undef PG8_BAR
#undef PG8_SCHED
}
}

using pg8::f32x4; using pg8::u32x4; using pg8::Unit; using pg8::HALF; using pg8::BM;
typedef unsigned u32x2 __attribute__((ext_vector_type(2)));

struct EpiIn {
  static constexpr bool PERM = true, AFTER_DRAIN = false;
  bf16_t* qkv; bf16_t* rest; const float* rowss; const float* bias;
  __device__ __forceinline__ void operator()(const f32x4 (&acc)[2][2][4][2], const Unit& u, int wr, int wc, int fr, int fq) const {
    const int row0 = u.pm * BM + wr * 64 + fr;
    const int seg = seg_of_row(u.pm * BM);
    int colt = u.pn * BM; bf16_t* base = qkv; int ldc = NQKV;
    if (colt >= NQKV) { base = rest; ldc = NREST; colt -= NQKV; }
    const int col0 = colt + wc * 32 + 8 * fq, bcol0 = seg * NCOLS + u.pn * BM + wc * 32 + 8 * fq;
    f32x4 bv[2][2];
#pragma unroll
    for (int bj = 0; bj < 2; ++bj)
#pragma unroll
      for (int n = 0; n < 2; ++n) bv[bj][n] = *(const f32x4*)(bias + bcol0 + bj * HALF + 4 * n);
#pragma unroll
    for (int ai = 0; ai < 2; ++ai)
#pragma unroll
      for (int m = 0; m < 4; ++m) {
        const int r = row0 + ai * HALF + m * 16;
        const float rinv = rsqrtf(rowss[r] * (1.0f / 1024.0f) + 1e-6f);
        bf16_t* rowp = base + (size_t)r * ldc + col0;
#pragma unroll
        for (int bj = 0; bj < 2; ++bj) {
          const f32x4 v0 = acc[ai][bj][m][0] * rinv + bv[bj][0], v1 = acc[ai][bj][m][1] * rinv + bv[bj][1];
          u32x4 w; w.x = pg8::cvt_pk_bf16(v0[0], v0[1]); w.y = pg8::cvt_pk_bf16(v0[2], v0[3]); w.z = pg8::cvt_pk_bf16(v1[0], v1[1]); w.w = pg8::cvt_pk_bf16(v1[2], v1[3]);
          *(u32x4*)(rowp + bj * HALF) = w;
        }
      }
  }
};

struct EpiRes {
  static constexpr bool PERM = false, AFTER_DRAIN = false;
  float* X; const float* gate; float* rowss; bf16_t* xa; const float* An;
  __device__ __forceinline__ void operator()(const f32x4 (&acc)[2][2][4][2], const Unit& u, int wr, int wc, int fr, int fq) const {
    const int row0 = u.pm * BM + wr * 64 + fr, col0 = u.pn * BM + wc * 32 + 4 * fq;
    const int seg = seg_of_row(u.pm * BM);
    f32x4 gv[2][2], av[2][2];
#pragma unroll
    for (int bj = 0; bj < 2; ++bj)
#pragma unroll
      for (int n = 0; n < 2; ++n) {
        gv[bj][n] = *(const f32x4*)(gate + seg * 6144 + col0 + bj * HALF + n * 16);
        av[bj][n] = xa ? *(const f32x4*)(An + seg * 1024 + col0 + bj * HALF + n * 16) : (f32x4){0.f, 0.f, 0.f, 0.f};
      }
#pragma unroll
    for (int ai = 0; ai < 2; ++ai)
#pragma unroll
      for (int m = 0; m < 4; ++m) {
        const int r = row0 + ai * HALF + m * 16;
        float* xrow = X + (size_t)r * 1024 + col0;
        float ss = 0.f;
#pragma unroll
        for (int bj = 0; bj < 2; ++bj)
#pragma unroll
          for (int n = 0; n < 2; ++n) {
            const f32x4 xo = *(const f32x4*)(xrow + bj * HALF + n * 16);
            const f32x4 xn = xo + gv[bj][n] * acc[ai][bj][m][n];
            *(f32x4*)(xrow + bj * HALF + n * 16) = xn;
            ss += (xn[0] * xn[0] + xn[1] * xn[1]) + (xn[2] * xn[2] + xn[3] * xn[3]);
            if (xa) {
              const f32x4 t = xn * av[bj][n];
              u32x2 w; w.x = pg8::cvt_pk_bf16(t[0], t[1]); w.y = pg8::cvt_pk_bf16(t[2], t[3]);
              *(u32x2*)(xa + (size_t)r * 1024 + col0 + bj * HALF + n * 16) = w;
            }
          }
        ss += __shfl_xor(ss, 16); ss += __shfl_xor(ss, 32);
        if (fq == 0) atomicAdd(rowss + r, ss);
      }
  }
};

struct EpiGu {
  static constexpr bool PERM = true, AFTER_DRAIN = false;
  bf16_t* act; const float* rowss; const float* bias;
  __device__ __forceinline__ void operator()(const f32x4 (&acc)[2][2][4][2], const Unit& u, int wr, int wc, int fr, int fq) const {
    const int row0 = u.pm * BM + wr * 64 + fr;
    const int seg = seg_of_row(u.pm * BM);
    const int hid0 = u.pn * HALF + wc * 32 + 8 * fq, bcol0 = seg * (2 * FFH) + u.pn * BM + wc * 32 + 8 * fq;
    f32x4 bv[2][2];
#pragma unroll
    for (int bj = 0; bj < 2; ++bj)
#pragma unroll
      for (int n = 0; n < 2; ++n) bv[bj][n] = *(const f32x4*)(bias + bcol0 + bj * HALF + 4 * n);
#pragma unroll
    for (int ai = 0; ai < 2; ++ai)
#pragma unroll
      for (int m = 0; m < 4; ++m) {
        const int r = row0 + ai * HALF + m * 16;
        const float rinv = rsqrtf(rowss[r] * (1.0f / 1024.0f) + 1e-6f);
        float o[8];
#pragma unroll
        for (int n = 0; n < 2; ++n) {
          const f32x4 g = acc[ai][0][m][n] * rinv + bv[0][n], up = acc[ai][1][m][n] * rinv + bv[1][n];
#pragma unroll
          for (int j = 0; j < 4; ++j) o[n * 4 + j] = g[j] * __builtin_amdgcn_rcpf(1.f + __expf(-g[j])) * up[j];
        }
        u32x4 w; w.x = pg8::cvt_pk_bf16(o[0], o[1]); w.y = pg8::cvt_pk_bf16(o[2], o[3]); w.z = pg8::cvt_pk_bf16(o[4], o[5]); w.w = pg8::cvt_pk_bf16(o[6], o[7]);
        *(u32x4*)(act + (size_t)r * FFH + hid0) = w;
      }
  }
};


struct EpiResFinal {
  static constexpr bool PERM = false, AFTER_DRAIN = true;
  const float* X; const float* gate; float* out; const float* normf; float* slots; unsigned* cnt;
  __device__ __forceinline__ void operator()(const f32x4 (&)[2][2][4][2], const Unit&, int, int, int, int) const {}
  __device__ __forceinline__ void fused(f32x4 (&acc)[2][2][4][2], const Unit& u, int wr, int wc, int fr, int fq, PG8_LAS unsigned char* lds, int wid, int lane) const {
    PG8_LAS float* P = (PG8_LAS float*)lds;
    PG8_LAS float* R = (PG8_LAS float*)(lds + 4096);
    const int row0 = u.pm * BM + wr * 64 + fr, col0 = u.pn * BM + wc * 32 + 4 * fq;
    const int seg = seg_of_row(u.pm * BM);
    f32x4 gv[2][2];
#pragma unroll
    for (int bj = 0; bj < 2; ++bj)
#pragma unroll
      for (int n = 0; n < 2; ++n) gv[bj][n] = *(const f32x4*)(gate + seg * 6144 + col0 + bj * HALF + n * 16);
#pragma unroll
    for (int ai = 0; ai < 2; ++ai)
#pragma unroll
      for (int m = 0; m < 4; ++m) {
        const int r = row0 + ai * HALF + m * 16;
        const float* xrow = X + (size_t)r * 1024 + col0;
        float ss = 0.f;
#pragma unroll
        for (int bj = 0; bj < 2; ++bj)
#pragma unroll
          for (int n = 0; n < 2; ++n) {
            const f32x4 xo = *(const f32x4*)(xrow + bj * HALF + n * 16);
            const f32x4 xn = xo + gv[bj][n] * acc[ai][bj][m][n];
            acc[ai][bj][m][n] = xn;
            ss += (xn[0] * xn[0] + xn[1] * xn[1]) + (xn[2] * xn[2] + xn[3] * xn[3]);
          }
        ss += __shfl_xor(ss, 16); ss += __shfl_xor(ss, 32);
        if (fq == 0) P[(ai * HALF + wr * 64 + m * 16 + fr) * 4 + wc] = ss;
      }
    __syncthreads();
    const int tid = wid * 64 + lane;
    if (tid < 256) {
      const float s = (P[tid * 4 + 0] + P[tid * 4 + 1]) + (P[tid * 4 + 2] + P[tid * 4 + 3]);
      __hip_atomic_store(slots + (size_t)(u.pm * 4 + u.pn) * 256 + tid, s, __ATOMIC_RELAXED, __HIP_MEMORY_SCOPE_AGENT);
    }
    asm volatile("s_waitcnt vmcnt(0)" ::: "memory");
    __syncthreads();
    if (tid == 0) {
      (void)__hip_atomic_fetch_add(cnt + u.pm, 1u, __ATOMIC_RELAXED, __HIP_MEMORY_SCOPE_AGENT);
      unsigned sp = 0u;
      while (__hip_atomic_load(cnt + u.pm, __ATOMIC_RELAXED, __HIP_MEMORY_SCOPE_AGENT) < 4u) { __builtin_amdgcn_s_sleep(1); if (++sp > (1u << 22)) break; }
      __builtin_amdgcn_fence(__ATOMIC_ACQUIRE, "agent");
      asm volatile("s_waitcnt vmcnt(0)" ::: "memory");
    }
    __syncthreads();
    if (tid < 256) {
      float tot = 0.f;
#pragma unroll
      for (int k = 0; k < 4; ++k) tot += __hip_atomic_load(slots + (size_t)(u.pm * 4 + k) * 256 + tid, __ATOMIC_RELAXED, __HIP_MEMORY_SCOPE_AGENT);
      R[tid] = rsqrtf(tot * (1.0f / 1024.0f) + 1e-6f);
    }
    __syncthreads();
    f32x4 nf[2][2];
#pragma unroll
    for (int bj = 0; bj < 2; ++bj)
#pragma unroll
      for (int n = 0; n < 2; ++n) nf[bj][n] = *(const f32x4*)(normf + col0 + bj * HALF + n * 16);
#pragma unroll
    for (int ai = 0; ai < 2; ++ai)
#pragma unroll
      for (int m = 0; m < 4; ++m) {
        const int lr = ai * HALF + wr * 64 + m * 16 + fr;
        const float rinv = R[lr];
        float* orow = out + (size_t)(u.pm * BM + lr) * 1024 + col0;
#pragma unroll
        for (int bj = 0; bj < 2; ++bj)
#pragma unroll
          for (int n = 0; n < 2; ++n) *(f32x4*)(orow + bj * HALF + n * 16) = acc[ai][bj][m][n] * rinv * nf[bj][n];
      }
  }
};

__device__ __forceinline__ int win_srccol(int j) { return j < 2048 ? j : j + 16; }
__device__ __forceinline__ int wgu_srccol(int j) { const int pn = j >> 8, w = j & 255; return w < 128 ? pn * 128 + w : FFH + pn * 128 + (w - 128); }

__device__ __forceinline__ void transpose_tile(const float* __restrict__ src, int ldsrc, int srccol0, bf16_t* __restrict__ dst, int K, int j0, int k0, float* tile, int t,
                                               const float* __restrict__ shv, float* __restrict__ bias, int bstride) {
  const int jl = t & 63, kg = t >> 6;
#pragma unroll
  for (int i = 0; i < 16; ++i) { const int k = kg * 16 + i; tile[jl * 65 + k] = src[(size_t)(k0 + k) * ldsrc + srccol0 + jl]; }
  __syncthreads();
  if (shv) {
    float a0 = 0.f, a1 = 0.f, a2 = 0.f;
#pragma unroll
    for (int i = 0; i < 16; ++i) { const int k = kg * 16 + i; const float wv = tile[jl * 65 + k]; a0 += shv[k0 + k] * wv; a1 += shv[6144 + k0 + k] * wv; a2 += shv[2 * 6144 + k0 + k] * wv; }
    atomicAdd(bias + j0 + jl, a0); atomicAdd(bias + bstride + j0 + jl, a1); atomicAdd(bias + 2 * bstride + j0 + jl, a2);
  }
  const int j = t >> 2, kc = (t & 3) * 16;
  const float* s = tile + j * 65 + kc;
  u32x4 o0, o1;
  o0.x = pack_bf16(s[0], s[1]); o0.y = pack_bf16(s[2], s[3]); o0.z = pack_bf16(s[4], s[5]); o0.w = pack_bf16(s[6], s[7]);
  o1.x = pack_bf16(s[8], s[9]); o1.y = pack_bf16(s[10], s[11]); o1.z = pack_bf16(s[12], s[13]); o1.w = pack_bf16(s[14], s[15]);
  bf16_t* d = dst + (size_t)(j0 + j) * K + k0 + kc;
  *(u32x4*)d = o0; *(u32x4*)(d + 8) = o1;
  __syncthreads();
}

#define WT_IN 0
#define WT_OUT (2816 * 1024)
#define WT_GU (WT_OUT + 1024 * 1024)
#define WT_DOWN (WT_GU + 5632 * 1024)
#define WT_LAYER (WT_DOWN + 1024 * 2816)


#define PRE_QP 0
#define PRE_KTP 16384
#define PRE_DIR0 32768
#define PRE_DIRSZ 41984
#define PRE_NW 0
#define PRE_UP 16384
#define PRE_QKP 32768
#define PRE_SC 40960
#define PRE_ITEM 116736
#define PRE_LDS 118784
#define SCAN_BUF 58368
#define SCAN_LDS (2 * SCAN_BUF)

using pg8::bf16x8;
__device__ __forceinline__ int perm_inv(int x) { return (x & ~31) | (((x >> 2) & 3) << 3) | (((x >> 4) & 1) << 2) | (x & 3); }
__device__ __forceinline__ bf16x8 pack8(const f32x4& x, const f32x4& y) {
  u32x4 w; w.x = pg8::cvt_pk_bf16(x[0], x[1]); w.y = pg8::cvt_pk_bf16(x[2], x[3]); w.z = pg8::cvt_pk_bf16(y[0], y[1]); w.w = pg8::cvt_pk_bf16(y[2], y[3]);
  return __builtin_bit_cast(bf16x8, w);
}

__device__ __forceinline__ void pre_item(int item, const bf16_t* __restrict__ QKV, const float* __restrict__ LOG, const float* __restrict__ cw,
                                         const float* __restrict__ a_log, const float* __restrict__ dt_bias, unsigned char* __restrict__ PRE,
                                         unsigned char* lds) {
  int t_ = threadIdx.x; asm volatile("" : "+v"(t_));
  const int t = t_, lane = t & 63, w = t >> 6;
  const int c = item >> 2, h = item & 3, r0 = c * 64;
  bf16_t* qb = (bf16_t*)lds; bf16_t* kb = (bf16_t*)(lds + 17408); float* vf = (float*)(lds + 34816);
  float* Lf = (float*)(lds + 67584); float* Lb = (float*)(lds + 83968); float* sc = (float*)(lds + 100352);
  unsigned char* pre = PRE + (size_t)item * PRE_ITEM;
  {
    const int i = t >> 3, cg = t & 7, r = r0 + i;
    int s0, len;
    if (r < NCTX) { s0 = r & ~255; len = 256; } else { s0 = NCTX + ((r - NCTX) & ~2047); len = 2048; }
    const int tt = r - s0; const bool hp = tt > 0, hn = tt < len - 1;
#pragma unroll
    for (int x = 0; x < 3; ++x) {
      const int cb = x * 512 + h * 128 + cg * 16;
      const bf16_t* p0 = QKV + (size_t)r * NQKV + cb;
      u32x4 m0 = (u32x4){0u, 0u, 0u, 0u}, m1 = m0, n0 = m0, n1 = m0;
      const u32x4 c0 = *(const u32x4*)p0, c1 = *(const u32x4*)(p0 + 8);
      if (hp) { m0 = *(const u32x4*)(p0 - NQKV); m1 = *(const u32x4*)(p0 - NQKV + 8); }
      if (hn) { n0 = *(const u32x4*)(p0 + NQKV); n1 = *(const u32x4*)(p0 + NQKV + 8); }
      float val[16]; float ss = 0.f;
#pragma unroll
      for (int e = 0; e < 16; ++e) {
        const unsigned wm = (e < 8 ? m0 : m1)[(e & 7) >> 1], wc = (e < 8 ? c0 : c1)[(e & 7) >> 1], wn = (e < 8 ? n0 : n1)[(e & 7) >> 1];
        const float xm = __uint_as_float((e & 1) ? (wm & 0xffff0000u) : (wm << 16));
        const float xc = __uint_as_float((e & 1) ? (wc & 0xffff0000u) : (wc << 16));
        const float xn = __uint_as_float((e & 1) ? (wn & 0xffff0000u) : (wn << 16));
        const float y = cw[cb + e] * xm + cw[NQKV + cb + e] * xc + cw[2 * NQKV + cb + e] * xn;
        val[e] = silu_fast(y); ss += val[e] * val[e];
      }
      if (x < 2) {
        ss += __shfl_xor(ss, 1); ss += __shfl_xor(ss, 2); ss += __shfl_xor(ss, 4);
        const float rn = rsqrtf(ss + 1e-6f) * (x == 0 ? 0.08838834764831845f : 1.0f);
        bf16_t* dst = (x == 0 ? qb : kb) + i * 136 + cg * 16;
        u32x4 o0, o1;
        o0.x = pack_bf16(val[0] * rn, val[1] * rn); o0.y = pack_bf16(val[2] * rn, val[3] * rn); o0.z = pack_bf16(val[4] * rn, val[5] * rn); o0.w = pack_bf16(val[6] * rn, val[7] * rn);
        o1.x = pack_bf16(val[8] * rn, val[9] * rn); o1.y = pack_bf16(val[10] * rn, val[11] * rn); o1.z = pack_bf16(val[12] * rn, val[13] * rn); o1.w = pack_bf16(val[14] * rn, val[15] * rn);
        *(u32x4*)dst = o0; *(u32x4*)(dst + 8) = o1;
      } else {
        float* dst = vf + i * 128 + cg * 16;
#pragma unroll
        for (int e = 0; e < 16; e += 4) *(f32x4*)(dst + e) = (f32x4){val[e], val[e + 1], val[e + 2], val[e + 3]};
      }
    }
  }
  if (w == 0) {
    const int i = lane, r = r0 + i;
#pragma unroll
    for (int d = 0; d < 2; ++d) {
      const float bl = LOG[(size_t)r * 16 + d * 4 + h], al = LOG[(size_t)r * 16 + 8 + d * 4 + h];
      const float beta = sigmoid_f(bl);
      const float g = -expf(a_log[d * 4 + h]) * softplus_f(al + dt_bias[d * 4 + h]);
      float s = g;
#pragma unroll
      for (int o = 1; o < 64; o <<= 1) {
        const float nb = d == 0 ? __shfl_up(s, o) : __shfl_down(s, o);
        const bool ok = d == 0 ? (lane >= o) : (lane + o < 64);
        if (ok) s += nb;
      }
      sc[d * 64 + i] = beta; sc[128 + d * 64 + i] = s; sc[256 + d * 64 + i] = beta * expf(s);
    }
  }
  __syncthreads();
  {
    const int p = w >> 2, it = w & 3, fr = lane & 15, g = lane >> 4;
    const bf16_t* Ab = p ? qb : kb;
    bf16x8 af[4];
#pragma unroll
    for (int ks = 0; ks < 4; ++ks) af[ks] = *(const bf16x8*)(Ab + (it * 16 + fr) * 136 + ks * 32 + 8 * g);
    bf16_t* qkf = (bf16_t*)(lds + 102400);
    bf16_t* qkb = (bf16_t*)(lds + 102400 + 8192);
#pragma unroll
    for (int jt = 0; jt < 4; ++jt) {
      f32x4 acc = (f32x4){0.f, 0.f, 0.f, 0.f};
#pragma unroll
      for (int ks = 0; ks < 4; ++ks) {
        const bf16x8 bfr = *(const bf16x8*)(kb + (jt * 16 + fr) * 136 + ks * 32 + 8 * g);
        acc = __builtin_amdgcn_mfma_f32_16x16x32_bf16(af[ks], bfr, acc, 0, 0, 0);
      }
      const int j = jt * 16 + fr;
      const float gfj = sc[128 + j], gbj = sc[192 + j];
#pragma unroll
      for (int r = 0; r < 4; ++r) {
        const int i = it * 16 + 4 * g + r;
        const float val = acc[r];
        const float ef = __expf(fminf(sc[128 + i] - gfj, 0.f)), eb = __expf(fminf(sc[192 + i] - gbj, 0.f));
        if (p == 0) {
          Lf[i * 64 + j] = (j < i) ? sc[i] * val * ef : 0.f;
          Lb[(63 - i) * 64 + (63 - j)] = (j > i) ? sc[64 + i] * val * eb : 0.f;
        } else {
          const int jp = perm_inv(j);
          qkf[i * 64 + jp] = f2bf((j <= i) ? val * ef : 0.f);
          qkb[i * 64 + jp] = f2bf((j >= i) ? val * eb : 0.f);
        }
      }
    }
  }
  __syncthreads();
#pragma unroll
  for (int it2 = 0; it2 < 2; ++it2) {
    const int q = t + 512 * it2;
    { const int i = q >> 4, s = (q >> 2) & 3, g = q & 3;
      const u32x2 lo = *(const u32x2*)(qb + i * 136 + 32 * s + 4 * g), hi = *(const u32x2*)(qb + i * 136 + 32 * s + 16 + 4 * g);
      *(u32x4*)(pre + PRE_QP + (size_t)(i * 128 + 32 * s + 8 * g) * 2) = (u32x4){lo.x, lo.y, hi.x, hi.y}; }
    { const int dk = q >> 3, s2 = (q >> 2) & 1, g = q & 3;
      unsigned short e[8];
#pragma unroll
      for (int jj = 0; jj < 8; ++jj) e[jj] = kb[(32 * s2 + 16 * (jj >> 2) + 4 * g + (jj & 3)) * 136 + dk];
      u32x4 o; o.x = (unsigned)e[0] | ((unsigned)e[1] << 16); o.y = (unsigned)e[2] | ((unsigned)e[3] << 16); o.z = (unsigned)e[4] | ((unsigned)e[5] << 16); o.w = (unsigned)e[6] | ((unsigned)e[7] << 16);
      *(u32x4*)(pre + PRE_KTP + (size_t)(dk * 64 + 32 * s2 + 8 * g) * 2) = o; }
  }
  if (t < 384) {
    const int d = t / 192, rem = t % 192, k3 = rem >> 6, i = rem & 63;
    const float glast = d ? sc[192] : sc[128 + 63], gci = sc[128 + d * 64 + i];
    const float v = k3 == 0 ? expf(gci) : (k3 == 1 ? expf(glast - gci) : expf(glast));
    ((float*)(pre + PRE_DIR0 + d * PRE_DIRSZ + PRE_SC))[k3 * 64 + i] = v;
  }
  {
    const int d = w >> 2, kind = (w >> 1) & 1, cc = t & 127;
    int rowsel = d ? 63 : 0, rstep = d ? -1 : 1; unsigned Loff = d ? 83968u : 67584u;
    asm volatile("" : "+v"(rowsel), "+v"(rstep), "+v"(Loff));
    const float* L = (const float*)(lds + Loff);
    float x[64];
    if (kind == 0) {
#pragma unroll
      for (int ip = 0; ip < 64; ++ip) { const int i = rowsel + rstep * ip; x[ip] = sc[d * 64 + i] * vf[i * 128 + cc]; }
    } else {
#pragma unroll
      for (int ip = 0; ip < 64; ++ip) { const int i = rowsel + rstep * ip; x[ip] = sc[256 + d * 64 + i] * bf2f(kb[i * 136 + cc]); }
    }
    const f32x4* L4 = (const f32x4*)__builtin_assume_aligned(L, 16);
#pragma unroll
    for (int ip = 1; ip < 64; ++ip) {
      float a0 = 0.f, a1 = 0.f, a2 = 0.f, a3 = 0.f;
#pragma unroll
      for (int q = 0; q < (ip + 3) / 4; ++q) {
        const f32x4 lv = L4[ip * 16 + q];
        a0 += lv[0] * x[4 * q]; a1 += lv[1] * x[4 * q + 1]; a2 += lv[2] * x[4 * q + 2]; a3 += lv[3] * x[4 * q + 3];
      }
      x[ip] -= (a0 + a1) + (a2 + a3);
    }
    __syncthreads();
    unsigned char* outd = lds + 34816 + d * 32768;
    if (kind == 0) {
      const int dv = cc, wv = dv >> 4;
      unsigned char* ub = outd + 16384 + ((wv * 4) * 64 + (dv & 15)) * 8;
#pragma unroll
      for (int qp = 0; qp < 16; ++qp) {
        const int q = (rowsel >> 2) + rstep * qp;
        const float v0 = d ? x[4 * qp + 3] : x[4 * qp], v1 = d ? x[4 * qp + 2] : x[4 * qp + 1], v2 = d ? x[4 * qp + 1] : x[4 * qp + 2], v3 = d ? x[4 * qp] : x[4 * qp + 3];
        u32x2 pk; pk.x = pack_bf16(v0, v1); pk.y = pack_bf16(v2, v3);
        *(u32x2*)(ub + q * 128) = pk;
      }
    } else {
      const int kp = perm_inv(cc);
      bf16_t* nw = (bf16_t*)outd + kp;
#pragma unroll
      for (int ip = 0; ip < 64; ++ip) { const int i = rowsel + rstep * ip; nw[i * 128] = f2bf(-x[ip]); }
    }
  }
  __syncthreads();
  for (int k = 0; k < 8; ++k) {
    const int q = t + 512 * k, d = q >> 11, wi = q & 2047;
    *(u32x4*)(pre + PRE_DIR0 + d * PRE_DIRSZ + wi * 16) = *(const u32x4*)(lds + 34816 + q * 16);
  }
  for (int k = 0; k < 2; ++k) {
    const int q = t + 512 * k, d = q >> 9, wi = q & 511;
    *(u32x4*)(pre + PRE_DIR0 + d * PRE_DIRSZ + PRE_QKP + wi * 16) = *(const u32x4*)(lds + 102400 + q * 16);
  }
  __syncthreads();
}

__global__ __launch_bounds__(512, 2) void k_pre(const bf16_t* __restrict__ QKV, const float* __restrict__ LOG, const float* __restrict__ cw,
                                                const float* __restrict__ a_log, const float* __restrict__ dt_bias, unsigned char* __restrict__ PRE) {
  extern __shared__ __attribute__((aligned(16))) unsigned char smem[];
  for (int item = blockIdx.x; item < 768; item += gridDim.x) pre_item(item, QKV, LOG, cw, a_log, dt_bias, PRE, smem);
}

#define SCAN_OT (2 * SCAN_BUF)
#undef SCAN_LDS
#define SCAN_LDS (2 * SCAN_BUF + 8 * 2048)
__device__ __forceinline__ void scan_item(int b, int h, int d, int chunk0, int nc, int half, bool write_state, const unsigned char* __restrict__ PRE, const float* __restrict__ s_in,
                                          bf16_t* __restrict__ OB, float* __restrict__ s_out, unsigned char* lds) {
  int t_ = threadIdx.x; asm volatile("" : "+v"(t_));
  const int t = t_, lane = t & 63, w = t >> 6, fr = lane & 15, g = lane >> 4;
  const bool active = half < 0 || w < 4;
  const int dvw = half < 0 ? w : half * 4 + (w & 3), dv = 16 * dvw + fr;
  f32x4 S[8];
  if (s_in == nullptr) {
#pragma unroll
    for (int m = 0; m < 8; ++m) S[m] = (f32x4){0.f, 0.f, 0.f, 0.f};
  } else {
#pragma unroll
    for (int m = 0; m < 8; ++m)
#pragma unroll
      for (int r = 0; r < 4; ++r) S[m][r] = s_in[(16 * m + 4 * g + r) * 128 + dv];
  }
  unsigned soff[7], doff[7];
#pragma unroll
  for (int k = 0; k < 7; ++k) {
    const int q = t + 512 * k;
    if (k < 2) { const int row = q >> 4, c = q & 15; soff[k] = PRE_DIR0 + PRE_NW + q * 16; doff[k] = row * 256 + ((c ^ (row & 15)) << 4); }
    else if (k < 4) { const int q2 = q - 1024, row = q2 >> 4, c = q2 & 15; soff[k] = PRE_QP + q2 * 16; doff[k] = 16384 + row * 256 + ((c ^ (row & 15)) << 4); }
    else if (k < 5) { const int q2 = q - 2048, row = q2 >> 3, c = q2 & 7; soff[k] = PRE_DIR0 + PRE_QKP + q2 * 16; doff[k] = 32768 + row * 128 + ((c ^ ((row >> 1) & 7)) << 4); }
    else { const int q2 = q - 2560, row = q2 >> 3, c = q2 & 7; soff[k] = PRE_KTP + q2 * 16; doff[k] = 40960 + row * 128 + ((c ^ ((row >> 1) & 7)) << 4); }
    if (k < 2 || k == 4) soff[k] += d * PRE_DIRSZ;
  }
  const unsigned soff7 = PRE_DIR0 + d * PRE_DIRSZ + PRE_SC + t * 16, doff7 = 57344 + t * 16;
  const unsigned upoff = PRE_DIR0 + d * PRE_DIRSZ + PRE_UP + ((dvw * 4) * 64 + lane) * 8;
  u32x4 st[7]; u32x4 st7 = (u32x4){0u, 0u, 0u, 0u}; u32x2 up[4];
  {
    const int cidx = chunk0 + (d ? nc - 1 : 0);
    const unsigned char* pre = PRE + (size_t)(cidx * 4 + h) * PRE_ITEM;
#pragma unroll
    for (int k = 0; k < 7; ++k) st[k] = *(const u32x4*)(pre + soff[k]);
    if (t < 48) st7 = *(const u32x4*)(pre + soff7);
#pragma unroll
    for (int m = 0; m < 4; ++m) up[m] = *(const u32x2*)(pre + upoff + m * 512);
#pragma unroll
    for (int k = 0; k < 7; ++k) *(u32x4*)(lds + doff[k]) = st[k];
    if (t < 48) *(u32x4*)(lds + doff7) = st7;
  }
  __syncthreads();
  bf16_t* ot = (bf16_t*)(lds + SCAN_OT + w * 2048);
  for (int step = 0; step < nc; ++step) {
    const int cidx = chunk0 + (d ? nc - 1 - step : step);
    const unsigned char* B = lds + (step & 1) * SCAN_BUF;
    const bool more = step + 1 < nc;
    f32x4 a1[4], a2[4];
#pragma unroll
    for (int m = 0; m < 4; ++m) {
      a1[m] = (f32x4){__uint_as_float(up[m].x << 16), __uint_as_float(up[m].x & 0xffff0000u), __uint_as_float(up[m].y << 16), __uint_as_float(up[m].y & 0xffff0000u)};
      a2[m] = (f32x4){0.f, 0.f, 0.f, 0.f};
    }
    if (more) {
      const int cn = chunk0 + (d ? nc - 2 - step : step + 1);
      const unsigned char* pre = PRE + (size_t)(cn * 4 + h) * PRE_ITEM;
#pragma unroll
      for (int k = 0; k < 7; ++k) st[k] = *(const u32x4*)(pre + soff[k]);
      if (t < 48) st7 = *(const u32x4*)(pre + soff7);
#pragma unroll
      for (int m = 0; m < 4; ++m) up[m] = *(const u32x2*)(pre + upoff + m * 512);
    }
    if (active) {
      const float* SC = (const float*)(B + 57344);
      const float gt = SC[128];
      bf16x8 Sb[4];
#pragma unroll
      for (int s = 0; s < 4; ++s) Sb[s] = pack8(S[2 * s], S[2 * s + 1]);
#pragma unroll
      for (int m = 0; m < 8; ++m) S[m] = S[m] * gt;
      {
        bf16x8 fa[2][4], fq[2][4];
#pragma unroll
        for (int m = 0; m < 4; ++m) {
          fa[0][m] = *(const bf16x8*)(B + (16 * m + fr) * 256 + (((0 + g) ^ fr) << 4));
          fq[0][m] = *(const bf16x8*)(B + 16384 + (16 * m + fr) * 256 + (((0 + g) ^ fr) << 4));
        }
#pragma unroll
        for (int s = 0; s < 4; ++s) {
          if (s < 3) {
#pragma unroll
            for (int m = 0; m < 4; ++m) {
              fa[(s + 1) & 1][m] = *(const bf16x8*)(B + (16 * m + fr) * 256 + (((4 * (s + 1) + g) ^ fr) << 4));
              fq[(s + 1) & 1][m] = *(const bf16x8*)(B + 16384 + (16 * m + fr) * 256 + (((4 * (s + 1) + g) ^ fr) << 4));
            }
          }
#pragma unroll
          for (int m = 0; m < 4; ++m) a1[m] = __builtin_amdgcn_mfma_f32_16x16x32_bf16(fa[s & 1][m], Sb[s], a1[m], 0, 0, 0);
#pragma unroll
          for (int m = 0; m < 4; ++m) a2[m] = __builtin_amdgcn_mfma_f32_16x16x32_bf16(fq[s & 1][m], Sb[s], a2[m], 0, 0, 0);
        }
      }
      bf16x8 Vb[2], Vs[2];
#pragma unroll
      for (int s = 0; s < 2; ++s) Vb[s] = pack8(a1[2 * s], a1[2 * s + 1]);
#pragma unroll
      for (int m = 0; m < 4; ++m) { const f32x4 e = *(const f32x4*)(SC + 64 + 16 * m + 4 * g); a1[m] = a1[m] * e; }
#pragma unroll
      for (int s = 0; s < 2; ++s) Vs[s] = pack8(a1[2 * s], a1[2 * s + 1]);
      {
        bf16x8 fk[2][8];
#pragma unroll
        for (int s = 0; s < 2; ++s)
#pragma unroll
          for (int m = 0; m < 8; ++m) fk[s][m] = *(const bf16x8*)(B + 40960 + (16 * m + fr) * 128 + (((4 * s + g) ^ (fr >> 1)) << 4));
#pragma unroll
        for (int s = 0; s < 2; ++s)
#pragma unroll
          for (int m = 0; m < 8; ++m) S[m] = __builtin_amdgcn_mfma_f32_16x16x32_bf16(fk[s][m], Vs[s], S[m], 0, 0, 0);
      }
#pragma unroll
      for (int m = 0; m < 4; ++m) { const f32x4 e = *(const f32x4*)(SC + 16 * m + 4 * g); a2[m] = a2[m] * e; }
#pragma unroll
      for (int s = 0; s < 2; ++s)
#pragma unroll
        for (int m = 0; m < 4; ++m) {
          const bf16x8 fa = *(const bf16x8*)(B + 32768 + (16 * m + fr) * 128 + (((4 * s + g) ^ (fr >> 1)) << 4));
          a2[m] = __builtin_amdgcn_mfma_f32_16x16x32_bf16(fa, Vb[s], a2[m], 0, 0, 0);
        }
#pragma unroll
      for (int m = 0; m < 4; ++m)
#pragma unroll
        for (int r = 0; r < 4; ++r) ot[(16 * m + 4 * g + r) * 16 + fr] = f2bf(a2[m][r]);
      {
        bf16_t* op = OB + ((size_t)d * NTOK + (size_t)cidx * 64) * 512 + h * 128 + 16 * dvw;
#pragma unroll
        for (int k = 0; k < 2; ++k) {
          const int q = lane + 64 * k, row = q >> 1, hf = q & 1;
          *(u32x4*)(op + (size_t)row * 512 + hf * 8) = *(const u32x4*)(ot + row * 16 + hf * 8);
        }
      }
    }
    if (more) {
      unsigned char* Bn = lds + ((step + 1) & 1) * SCAN_BUF;
#pragma unroll
      for (int k = 0; k < 7; ++k) *(u32x4*)(Bn + doff[k]) = st[k];
      if (t < 48) *(u32x4*)(Bn + doff7) = st7;
    }
    __syncthreads();
  }
  if (write_state && active) {
#pragma unroll
    for (int m = 0; m < 8; ++m)
#pragma unroll
      for (int r = 0; r < 4; ++r) s_out[(16 * m + 4 * g + r) * 128 + dv] = S[m][r];
  }
}

__device__ __forceinline__ void scan_dispatch(int i, const unsigned char* PRE, const float* state_in, bf16_t* OB, float* state_out, int layer, unsigned char* lds) {
#ifdef LAT_FULL
  if (i < 32) {
    if (i >= 16) return;
    const int q = i, half = -1, b = q >> 3, h = (q >> 1) & 3, d = q & 1;
#else
  if (i < 32) {
    const int q = i >> 1, half = i & 1, b = q >> 3, h = (q >> 1) & 3, d = q & 1;
#endif
    scan_item(b, h, d, 128 + b * 32, 32, half, false, PRE, state_in + ((((size_t)b * 2 + layer) * 2 + d) * 4 + h) * 16384, OB, nullptr, lds);
  } else {
    const int sid = i - 32, b = sid >> 3, h = (sid >> 1) & 3, d = sid & 1;
    scan_item(b, h, d, b * 4, 4, -1, true, PRE, nullptr, OB, state_out + ((((size_t)b * 2 + layer) * 2 + d) * 4 + h) * 16384, lds);
  }
}

__global__ __launch_bounds__(512, 2) void k_scan2(const unsigned char* __restrict__ PRE, const float* __restrict__ state_in, bf16_t* __restrict__ OB,
                                                  float* __restrict__ state_out, int layer) {
  extern __shared__ __attribute__((aligned(16))) unsigned char smem[];
  for (int i = blockIdx.x; i < 288; i += gridDim.x) scan_dispatch(i, PRE, state_in, OB, state_out, layer, smem);
}
#define XB_TMO      128
#define XB_XCNT(j)  (256  + 64 * (j))
#define XB_XSUB(j)  (1280 + 64 * (j))
#define XB_XGEN(j)  (2304 + 64 * (j))
#define XB_TOP      3328
#define XB_TOPGEN   3392
#define XCD_BAR_WORDS 3456
#define XB_SPIN_CAP (1u << 18)
#define LAS __attribute__((address_space(3)))

__device__ __forceinline__ unsigned xb_ld(unsigned* p)              { return __hip_atomic_load(p, __ATOMIC_RELAXED, __HIP_MEMORY_SCOPE_AGENT); }
__device__ __forceinline__ unsigned xb_add(unsigned* p, unsigned v) { return __hip_atomic_fetch_add(p, v, __ATOMIC_RELAXED, __HIP_MEMORY_SCOPE_AGENT); }
__device__ __forceinline__ unsigned xb_xcc_id() { return (unsigned)__builtin_amdgcn_s_getreg((3 << 11) | 20) & 0xFu; }
#define XB_SPIN(cond, bar) do { unsigned _sp = 0; while (cond) { __builtin_amdgcn_s_sleep(1); \
    if ((++_sp & 255u) == 0u) { if (xb_ld(&(bar)[XB_TMO])) break; if (_sp > XB_SPIN_CAP) { atomicAdd(&(bar)[XB_TMO], 1u); break; } } } } while (0)

struct XcdBarrier {
    unsigned* bar; unsigned x;
    volatile LAS unsigned* st;
};

__device__ __forceinline__ XcdBarrier xcd_barrier_post(unsigned* bar, volatile LAS unsigned* st) {
    XcdBarrier b; b.bar = bar; b.x = xb_xcc_id(); b.st = st;
    if (threadIdx.x == 0) (void)xb_add(&bar[XB_XCNT(b.x)], 1u);
    return b;
}
__device__ __forceinline__ void xcd_barrier_complete(unsigned* bar, unsigned x, unsigned& nloc, unsigned& nx) {
    const unsigned G = gridDim.x * gridDim.y * gridDim.z;
    unsigned sum, cnt, mine, sp = 0u;
    for (;;) {
        sum = 0u; cnt = 0u; mine = 0u;
#pragma unroll
        for (unsigned j = 0; j < 16; ++j) { const unsigned c = xb_ld(&bar[XB_XCNT(j)]); sum += c; cnt += (c > 0u) ? 1u : 0u; mine = (j == x) ? c : mine; }
        if (sum == G) break;
        __builtin_amdgcn_s_sleep(1);
        if ((++sp & 255u) == 0u) { if (xb_ld(&bar[XB_TMO])) break; if (sp > XB_SPIN_CAP) { atomicAdd(&bar[XB_TMO], 1u); break; } }
    }
    nloc = mine > 0u ? mine : 1u; nx = cnt > 0u ? cnt : 1u;
}

__device__ __forceinline__ void xcd_barrier(const XcdBarrier& b) {
    asm volatile("s_waitcnt vmcnt(0)" ::: "memory");
    __syncthreads();
    if (threadIdx.x == 0) {
        unsigned* bar = b.bar;
        __builtin_amdgcn_s_waitcnt(0);
        unsigned nloc = b.st[0], nx = b.st[1];
        if (nloc == 0u) { xcd_barrier_complete(bar, b.x, nloc, nx); b.st[0] = nloc; b.st[1] = nx; }
        const unsigned old = xb_add(&bar[XB_XSUB(b.x)], 1u);
        const unsigned gen = old / nloc;
        if (old + 1u == (gen + 1u) * nloc) {
            __builtin_amdgcn_fence(__ATOMIC_RELEASE, "agent");
            asm volatile("s_waitcnt vmcnt(0)" ::: "memory");
            const unsigned og = xb_add(&bar[XB_TOP], 1u);
            const unsigned tg = og / nx;
            if (og + 1u == (tg + 1u) * nx) xb_add(&bar[XB_TOPGEN], 1u);
            else XB_SPIN(xb_ld(&bar[XB_TOPGEN]) == tg, bar);
            __builtin_amdgcn_fence(__ATOMIC_ACQUIRE, "agent");
            xb_add(&bar[XB_XGEN(b.x)], 1u);
            asm volatile("s_waitcnt vmcnt(0)" ::: "memory");
        } else {
            XB_SPIN(xb_ld(&bar[XB_XGEN(b.x)]) == gen, bar);
            __builtin_amdgcn_fence(__ATOMIC_ACQUIRE, "agent");
            asm volatile("s_waitcnt vmcnt(0)" ::: "memory");
        }
    }
    __syncthreads();
}


#include <hip/hip_cooperative_groups.h>
namespace cg = cooperative_groups;

#define MEGA_LDS_MAIN 143360
#define MEGA_LDS (MEGA_LDS_MAIN + 16)
#define WS_X 0ull
#define WS_WTA (WS_X + (size_t)NTOK * 1024 * 4)
#define WS_WTB (WS_WTA + (size_t)WT_LAYER * 2)
#define WS_QKV (WS_WTB + (size_t)2816 * 1024 * 2)
#define WS_REST (WS_QKV + (size_t)NTOK * NQKV * 2)
#define WS_PRE (WS_REST + (size_t)NTOK * NREST * 2)
#define WS_MIXB (WS_PRE + (size_t)768 * PRE_ITEM)
#define WS_MODS (WS_MIXB + (size_t)NTOK * 1024 * 2)
#define WS_AV (WS_MODS + 2 * 3 * 6144 * 4)
#define WS_BIN (WS_AV + 2 * 2 * 3 * 1024 * 4)
#define WS_BGU (WS_BIN + 2 * 3 * NCOLS * 4)
#define WS_BLOG (WS_BGU + 2 * 3 * 2 * FFH * 4)
#define WS_ROWSS (WS_BLOG + 2 * 3 * 16 * 4 + 128)
#define WS_LOG (WS_ROWSS + 5 * NTOK * 4)
#define WS_BAR (WS_LOG + (size_t)NTOK * 16 * 4)
#define WS_WLT (WS_BAR + 16384)
#define WS_POS (WS_WLT + 2 * 16 * 1024 * 2)
#define WS_SLOT (WS_POS + 96 * 512 * 4)
#define WS_END (WS_SLOT + 48 * 4 * 256 * 4)
struct MP {
  const float *x_prompt, *x_sample, *state_delta, *c, *c_ctx, *w_in, *conv_w, *a_log, *dt_bias, *delta_norm_g, *sgu_norm_g, *w_spatial, *b_spatial,
      *w_pool, *pool_scale, *w_out, *norm1_g, *norm2_g, *w_mod, *b_mod, *w_gu, *w_down, *norm_f;
  float* out; unsigned char* ws;
  __device__ __forceinline__ float* X_() const { return (float*)(ws + WS_X); }
  __device__ __forceinline__ bf16_t* WTA_() const { return (bf16_t*)(ws + WS_WTA); }
  __device__ __forceinline__ bf16_t* WTB_() const { return (bf16_t*)(ws + WS_WTB); }
  __device__ __forceinline__ bf16_t* QKV_() const { return (bf16_t*)(ws + WS_QKV); }
  __device__ __forceinline__ bf16_t* REST_() const { return (bf16_t*)(ws + WS_REST); }
  __device__ __forceinline__ unsigned char* PRE_() const { return ws + WS_PRE; }
  __device__ __forceinline__ bf16_t* MIXB_() const { return (bf16_t*)(ws + WS_MIXB); }
  __device__ __forceinline__ float* mods_() const { return (float*)(ws + WS_MODS); }
  __device__ __forceinline__ float* AV_() const { return (float*)(ws + WS_AV); }
  __device__ __forceinline__ float* BIN_() const { return (float*)(ws + WS_BIN); }
  __device__ __forceinline__ float* BGU_() const { return (float*)(ws + WS_BGU); }
  __device__ __forceinline__ float* BLOG_() const { return (float*)(ws + WS_BLOG); }
  __device__ __forceinline__ float* rowss_() const { return (float*)(ws + WS_ROWSS); }
  __device__ __forceinline__ float* LOG_() const { return (float*)(ws + WS_LOG); }
  __device__ __forceinline__ unsigned* bar_() const { return (unsigned*)(ws + WS_BAR); }
  __device__ __forceinline__ bf16_t* WLT_() const { return (bf16_t*)(ws + WS_WLT); }
  __device__ __forceinline__ float* POS_() const { return (float*)(ws + WS_POS); }
  __device__ __forceinline__ float* SLOT_() const { return (float*)(ws + WS_SLOT); }
};

__device__ __forceinline__ void gemv3_item(const float* __restrict__ W, int ld, int ncols, const float* vec  , float* red  ,
                                           const float* __restrict__ bias, float* __restrict__ o0, float* __restrict__ o1, float* __restrict__ o2, int t) {
  const int col = t & 63, ds = t >> 6;
  float a0 = 0.f, a1 = 0.f, a2 = 0.f;
  if (col < ncols) {
    const float* w = W + (size_t)(ds * 128) * ld + col;
#pragma unroll 16
    for (int d = 0; d < 128; ++d) { const float wv = w[(size_t)d * ld]; const int dd = ds * 128 + d; a0 += vec[dd] * wv; a1 += vec[1024 + dd] * wv; a2 += vec[2048 + dd] * wv; }
  }
  red[(ds * 3 + 0) * 64 + col] = a0; red[(ds * 3 + 1) * 64 + col] = a1; red[(ds * 3 + 2) * 64 + col] = a2;
  __syncthreads();
  if (t < 192) {
    const int s = t >> 6, cc = t & 63;
    float v = 0.f;
#pragma unroll
    for (int k = 0; k < 8; ++k) v += red[(k * 3 + s) * 64 + cc];
    if (cc < ncols) { v += bias ? bias[cc] : 0.f; (s == 0 ? o0 : (s == 1 ? o1 : o2))[cc] = v; }
  }
  __syncthreads();
}

__device__ __forceinline__ void wtile(const MP& p, int l, int r  , bf16_t* wt_in, bf16_t* wt_rest, float* tile, int tt) {
  const float* ml = p.mods_() + l * 3 * 6144;
  if (r < 704) { const int kt = r / 44, jt = r % 44; transpose_tile(p.w_in + (size_t)l * 1024 * INC, INC, win_srccol(jt * 64), wt_in, 1024, jt * 64, kt * 64, tile, tt, ml, p.BIN_() + l * 3 * NCOLS, NCOLS); return; }
  r -= 704;
  if (r < 256) { const int kt = r / 16, jt = r % 16; transpose_tile(p.w_out + (size_t)l * 1024 * 1024, 1024, jt * 64, wt_rest + WT_OUT, 1024, jt * 64, kt * 64, tile, tt, nullptr, nullptr, 0); return; }
  r -= 256;
  if (r < 1408) { const int kt = r / 88, jt = r % 88; transpose_tile(p.w_gu + (size_t)l * 1024 * 2 * FFH, 2 * FFH, wgu_srccol(jt * 64), wt_rest + WT_GU, 1024, jt * 64, kt * 64, tile, tt, ml + 3072, p.BGU_() + l * 3 * 2 * FFH, 2 * FFH); return; }
  r -= 1408;
  { const int kt = r / 16, jt = r % 16; transpose_tile(p.w_down + (size_t)l * FFH * 1024, 1024, jt * 64, wt_rest + WT_DOWN, FFH, jt * 64, kt * 64, tile, tt, nullptr, nullptr, 0); }
}

__device__ __forceinline__ void wtiles(const MP& p, int l, int r_lo, int r_hi, int jb, int njb, unsigned char* smem) {
  int t_ = threadIdx.x; asm volatile("" : "+v"(t_)); const int t = t_;
  float* tile = (float*)smem + (t >> 8) * (64 * 65);
  for (int it = jb; it < (r_hi - r_lo) / 2; it += njb) wtile(p, l, r_lo + it * 2 + (t >> 8), p.WTA_() + WT_IN, p.WTA_(), tile, t & 255);
}

__device__ __forceinline__ void phase_prep0(const MP& p, int bid, int nb, unsigned char* smem, bool tiles) {
  int t_ = threadIdx.x; asm volatile("" : "+v"(t_)); const int t = t_;
  if (!tiles) for (int i = bid * 512 + t; i < 4 * NTOK; i += nb * 512) p.rowss_()[NTOK + i] = 0.f;
  if (!tiles) for (int i = bid * 512 + t; i < 2 * 3 * NCOLS + 2 * 3 * 2 * FFH; i += nb * 512) p.BIN_()[i] = 0.f;
  if (!tiles) for (int i = bid * 512 + t; i < 96 * 512; i += nb * 512) {
    const int rc = i >> 9, dd = i & 511, jj = dd & 255;
    const float omega = 1.0f / powf(10000.0f, (float)jj / 256.0f);
    const float ang = (float)(rc < 32 ? rc : rc - 32) * omega;
    p.POS_()[i] = (dd & 256) ? cosf(ang) : sinf(ang);
  }
  if (!tiles) for (int i = bid * 512 + t; i < 2 * 16 * 1024; i += nb * 512) { const int l = i >> 14, j = (i >> 10) & 15, d = i & 1023; p.WLT_()[i] = f2bf(p.w_in[((size_t)l * 1024 + d) * INC + 2048 + j]); }
  float* vec = (float*)smem; float* red = vec + 3072; float* tile = (float*)(smem + 32768) + (t >> 8) * (64 * 65);
  const int NMOD = 192, NPAIR = 704 / 2;
  for (int it = bid; it < (tiles ? NMOD + NPAIR : NMOD); it += nb) {
    if (it < NMOD) { if (tiles) continue;
      const int l = it / 96, cgp = it % 96;
      for (int i = t; i < 1024; i += 512) { vec[i] = silu_f(p.c_ctx[i]); vec[1024 + i] = silu_f(p.c[i]); vec[2048 + i] = silu_f(p.c[1024 + i]); }
      __syncthreads();
      float* m = p.mods_() + l * 3 * 6144 + cgp * 64;
      gemv3_item(p.w_mod + (size_t)l * 1024 * 6144 + cgp * 64, 6144, 64, vec, red, p.b_mod + l * 6144 + cgp * 64, m, m + 6144, m + 2 * 6144, t);
    } else {
      const int r = (it - NMOD) * 2 + (t >> 8);
      wtile(p, 0, r, p.WTA_() + WT_IN, p.WTA_(), tile, t & 255);
    }
  }
}

__device__ __forceinline__ void phase_vecs(const MP& p, int bid, int nb, unsigned char* smem) {
  int t_ = threadIdx.x; asm volatile("" : "+v"(t_)); const int t = t_;
  float* vec = (float*)smem; float* red = vec + 3072;
  for (int i = bid * 512 + t; i < 2 * 2 * 1024; i += nb * 512) {
    const int l = i >> 11, n = (i >> 10) & 1, d = i & 1023;
    const float g = n ? p.norm2_g[l * 1024 + d] : p.norm1_g[l * 1024 + d];
#pragma unroll
    for (int s = 0; s < 3; ++s) p.AV_()[((l * 2 + n) * 3 + s) * 1024 + d] = g * (1.f + p.mods_()[(l * 3 + s) * 6144 + (n ? 4096 : 1024) + d]);
  }
  const int N_IN = 44, N_GU = 88;
  for (int it = bid; it < 2; it += nb) {
    const int l = it, r = N_IN + N_GU;
    const int sh_off = (r >= N_IN && r < N_IN + N_GU) ? 3072 : 0;
    for (int i = t; i < 1024; i += 512) {
#pragma unroll
      for (int s = 0; s < 3; ++s) vec[s * 1024 + i] = p.mods_()[(l * 3 + s) * 6144 + sh_off + i];
    }
    __syncthreads();
    if (r < N_IN) { float* o = p.BIN_() + l * 3 * NCOLS + r * 64; gemv3_item(p.w_in + (size_t)l * 1024 * INC + win_srccol(r * 64), INC, 64, vec, red, nullptr, o, o + NCOLS, o + 2 * NCOLS, t); }
    else if (r < N_IN + N_GU) { const int j0 = (r - N_IN) * 64; float* o = p.BGU_() + l * 3 * 2 * FFH + j0; gemv3_item(p.w_gu + (size_t)l * 1024 * 2 * FFH + wgu_srccol(j0), 2 * FFH, 64, vec, red, nullptr, o, o + 2 * FFH, o + 4 * FFH, t); }
    else { float* o = p.BLOG_() + l * 3 * 16; gemv3_item(p.w_in + (size_t)l * 1024 * INC + 2048, INC, 16, vec, red, nullptr, o, o + 16, o + 32, t); }
  }
}

__device__ __forceinline__ void prepx_row(const MP& p, int r, int lane) {
  const int seg = seg_of_row(r);
  float ss = 0.f;
#pragma unroll
  for (int i = 0; i < 4; ++i) {
    const int d = i * 256 + lane * 4;
    f32x4 v;
    if (r < NCTX) v = *(const f32x4*)(p.x_prompt + (size_t)r * 1024 + d);
    else {
      const int rl = r - NCTX, pp = rl & 2047, row = pp >> 6, col = pp & 63;
      v = *(const f32x4*)(p.x_sample + (size_t)rl * 1024 + d);
      const f32x4 e = *(const f32x4*)(p.POS_() + (d < 512 ? row * 512 + d : (32 + col) * 512 + (d - 512)));
      v = v + e;
    }
    *(f32x4*)(p.X_() + (size_t)r * 1024 + d) = v;
    ss += (v[0] * v[0] + v[1] * v[1]) + (v[2] * v[2] + v[3] * v[3]);
    const f32x4 g1 = *(const f32x4*)(p.norm1_g + d), sc1 = *(const f32x4*)(p.mods_() + seg * 6144 + 1024 + d);
    const f32x4 a = g1 * (1.f + sc1);
    u32x2 w; w.x = pack_bf16(v[0] * a[0], v[1] * a[1]); w.y = pack_bf16(v[2] * a[2], v[3] * a[3]);
    *(u32x2*)((bf16_t*)p.PRE_() + (size_t)r * 1024 + d) = w;
  }
  ss = wave_sum(ss);
  if (lane == 0) p.rowss_()[r] = ss;
}

__device__ __forceinline__ void phase_logits(const MP& p, int l, int bid, int nb, unsigned char* smem) {
  int tl = threadIdx.x; asm volatile("" : "+v"(tl)); const int t = tl, lane = tl & 63, w = tl >> 6, fr = lane & 15, g = lane >> 4;
  bf16_t* wl = (bf16_t*)smem;
  const bf16_t* XA = (const bf16_t*)p.PRE_();
  for (int q = t; q < 2048; q += 512) { const int j = q >> 7, c = q & 127; *(u32x4*)(wl + j * 1032 + c * 8) = *(const u32x4*)(p.WLT_() + (size_t)l * 16 * 1024 + j * 1024 + c * 8); }
  __syncthreads();
  for (int rg = bid * 8 + w; rg < NTOK / 16; rg += nb * 8) {
    const int row0 = rg * 16;
    const bf16_t* arow = XA + (size_t)(row0 + fr) * 1024 + 8 * g;
    bf16x8 af[32];
#pragma unroll
    for (int ks = 0; ks < 32; ++ks) af[ks] = *(const bf16x8*)(arow + 32 * ks);
    f32x4 acc0 = (f32x4){0.f, 0.f, 0.f, 0.f}, acc1 = acc0;
#pragma unroll
    for (int ks = 0; ks < 32; ks += 2) {
      const bf16x8 b0 = *(const bf16x8*)(wl + fr * 1032 + 32 * ks + 8 * g), b1 = *(const bf16x8*)(wl + fr * 1032 + 32 * (ks + 1) + 8 * g);
      acc0 = __builtin_amdgcn_mfma_f32_16x16x32_bf16(af[ks], b0, acc0, 0, 0, 0);
      acc1 = __builtin_amdgcn_mfma_f32_16x16x32_bf16(af[ks + 1], b1, acc1, 0, 0, 0);
    }
    const int seg = seg_of_row(row0);
    const float bias = p.BLOG_()[l * 3 * 16 + seg * 16 + fr];
#pragma unroll
    for (int r = 0; r < 4; ++r) {
      const int row = row0 + 4 * g + r;
      const float rinv = rsqrtf(p.rowss_()[(2 * l) * NTOK + row] * (1.0f / 1024.0f) + 1e-6f);
      p.LOG_()[(size_t)row * 16 + fr] = (acc0[r] + acc1[r]) * rinv + bias;
    }
  }
  __syncthreads();
}

__device__ __forceinline__ void delta_post_row(const MP& p, int l, int r, int lane) {
  const bf16_t* OB = p.QKV_();
  const u32x4 of = *(const u32x4*)(OB + (size_t)r * 512 + lane * 8), ob = *(const u32x4*)(OB + ((size_t)NTOK + r) * 512 + lane * 8);
  const u32x4 zz = *(const u32x4*)(p.REST_() + (size_t)r * NREST + lane * 8);
  float o[8]; float ss = 0.f;
#pragma unroll
  for (int e = 0; e < 8; ++e) {
    const unsigned wf = of[e >> 1], wb = ob[e >> 1];
    o[e] = __uint_as_float((e & 1) ? (wf & 0xffff0000u) : (wf << 16)) + __uint_as_float((e & 1) ? (wb & 0xffff0000u) : (wb << 16));
    ss += o[e] * o[e];
  }
  ss += __shfl_xor(ss, 1); ss += __shfl_xor(ss, 2); ss += __shfl_xor(ss, 4); ss += __shfl_xor(ss, 8);
  const float rn = rsqrtf(ss * (1.0f / 128.0f) + 1e-6f);
  const float* ng = p.delta_norm_g + l * 128 + (lane & 15) * 8;
  float y[8];
#pragma unroll
  for (int e = 0; e < 8; ++e) {
    const unsigned wz = zz[e >> 1];
    const float z = __uint_as_float((e & 1) ? (wz & 0xffff0000u) : (wz << 16));
    y[e] = o[e] * rn * ng[e] * silu_fast(z);
  }
  u32x4 w; w.x = pack_bf16(y[0], y[1]); w.y = pack_bf16(y[2], y[3]); w.z = pack_bf16(y[4], y[5]); w.w = pack_bf16(y[6], y[7]);
  *(u32x4*)(p.MIXB_() + (size_t)r * 1024 + lane * 8) = w;
}

__device__ __forceinline__ void sgu_pair(const MP& p, int l, int item0, unsigned char* smem) {
  int tl = threadIdx.x; asm volatile("" : "+v"(tl)); const int t = tl & 255, lane = tl & 63, w = __builtin_amdgcn_readfirstlane(tl >> 6), hb = w >> 2, wl = w & 3, fr = lane & 15, g4 = lane >> 4;
  const int item = item0 + hb, ch = item >> 2, g = item & 3;
  const bf16_t* REST = p.REST_(); const float* norm_g = p.sgu_norm_g + l * 256 + g * 64;
  const float* w_s = p.w_spatial + ((size_t)l * 4 + g) * 128 * 128; const float* b_s = p.b_spatial + (l * 4 + g) * 128;
  const int r0 = ch * 128;
  bf16_t* vnT = (bf16_t*)(smem + hb * 35840);
  bf16_t* ut = (bf16_t*)(smem + hb * 35840 + 17408);
  const int s_ = t >> 1, q2 = t & 1;
  const bf16_t* vrow = REST + (size_t)(r0 + s_) * NREST + 768 + g * 64 + q2 * 32;
  u32x4 vv[4];
#pragma unroll
  for (int k = 0; k < 4; ++k) vv[k] = *(const u32x4*)(vrow + 8 * k);
  u32x4 uu[4];
#pragma unroll
  for (int k = 0; k < 4; ++k) { const int q = t + 256 * k, row = q >> 3, c8 = q & 7; uu[k] = *(const u32x4*)(REST + (size_t)(r0 + row) * NREST + 512 + g * 64 + c8 * 8); }
  f32x4 wa[2][4][2];
#pragma unroll
  for (int mt = 0; mt < 2; ++mt) {
    const float* wrow = w_s + (size_t)(wl * 32 + mt * 16 + fr) * 128 + 8 * g4;
#pragma unroll
    for (int ks = 0; ks < 4; ++ks) { wa[mt][ks][0] = *(const f32x4*)(wrow + 32 * ks); wa[mt][ks][1] = *(const f32x4*)(wrow + 32 * ks + 4); }
  }
  {
    float val[32]; float ss = 0.f;
#pragma unroll
    for (int e = 0; e < 32; ++e) {
      const unsigned wv = vv[e >> 3][(e & 7) >> 1];
      val[e] = gelu_fast(__uint_as_float((e & 1) ? (wv & 0xffff0000u) : (wv << 16))); ss += val[e] * val[e];
    }
    ss += __shfl_xor(ss, 1);
    const float rinv = rsqrtf(ss * (1.0f / 64.0f) + 1e-6f);
#pragma unroll
    for (int e = 0; e < 32; ++e) vnT[(q2 * 32 + e) * 136 + s_] = f2bf(val[e] * rinv * norm_g[q2 * 32 + e]);
#pragma unroll
    for (int k = 0; k < 4; ++k) { const int q = t + 256 * k, row = q >> 3, c8 = q & 7; *(u32x4*)(ut + row * 72 + c8 * 8) = uu[k]; }
  }
  __syncthreads();
#pragma unroll
  for (int mt = 0; mt < 2; ++mt) {
    bf16x8 af[4];
#pragma unroll
    for (int ks = 0; ks < 4; ++ks) af[ks] = pack8(wa[mt][ks][0], wa[mt][ks][1]);
    f32x4 acc[4];
#pragma unroll
    for (int nt = 0; nt < 4; ++nt) {
      acc[nt] = (f32x4){0.f, 0.f, 0.f, 0.f};
#pragma unroll
      for (int ks = 0; ks < 4; ++ks) {
        const bf16x8 bfr = *(const bf16x8*)(vnT + (nt * 16 + fr) * 136 + 32 * ks + 8 * g4);
        acc[nt] = __builtin_amdgcn_mfma_f32_16x16x32_bf16(af[ks], bfr, acc[nt], 0, 0, 0);
      }
    }
#pragma unroll
    for (int r = 0; r < 4; ++r) {
      const int tt = wl * 32 + mt * 16 + 4 * g4 + r;
      const float bb = b_s[tt];
#pragma unroll
      for (int nt = 0; nt < 4; ++nt) { bf16_t* e = ut + tt * 72 + nt * 16 + fr; *e = f2bf(gelu_fast(bf2f(*e)) * (acc[nt][r] + bb)); }
    }
  }
  __syncthreads();
#pragma unroll
  for (int k = 0; k < 4; ++k) { const int q = t + 256 * k, row = q >> 3, c8 = q & 7; *(u32x4*)(p.MIXB_() + (size_t)(r0 + row) * 1024 + 512 + g * 64 + c8 * 8) = *(const u32x4*)(ut + row * 72 + c8 * 8); }
  __syncthreads();
}

__device__ __forceinline__ void pool_item(const MP& p, int l, int blk, unsigned char* smem) {
  int tl = threadIdx.x; asm volatile("" : "+v"(tl)); const int t = tl, lane = tl & 63, w = __builtin_amdgcn_readfirstlane(tl >> 6), fr = lane & 15, g4 = lane >> 4;
  const bf16_t* REST = p.REST_(); const float* w_pool = p.w_pool + (size_t)l * 4 * 64 * 64; const float* scale = p.pool_scale + l * 256;
  const int r0 = blk * 64;
  int seg0, seglen;
  if (r0 < NCTX) { seg0 = r0 & ~255; seglen = 256; } else { seg0 = r0; seglen = 64; }
  bf16_t* xs = (bf16_t*)smem;
  bf16_t* dm = (bf16_t*)(smem + 42240);
  bf16_t* wT = (bf16_t*)(smem + 42240 + 36864);
  u32x4 xv[5];
#pragma unroll
  for (int k = 0; k < 5; ++k) {
    const int q = t + 512 * k, lr = q >> 5, c8 = q & 31, row = r0 - 8 + lr;
    xv[k] = (u32x4){0u, 0u, 0u, 0u};
    if (row >= seg0 && row < seg0 + seglen) xv[k] = *(const u32x4*)(REST + (size_t)row * NREST + 1024 + c8 * 8);
  }
  f32x4 wv[8];
#pragma unroll
  for (int k = 0; k < 8; ++k) wv[k] = *(const f32x4*)(w_pool + (size_t)(t + 512 * k) * 4);
#pragma unroll
  for (int k = 0; k < 5; ++k) { const int q = t + 512 * k, lr = q >> 5, c8 = q & 31; *(u32x4*)(xs + lr * 264 + c8 * 8) = xv[k]; }
#pragma unroll
  for (int k = 0; k < 8; ++k) {
    const int q = t + 512 * k, i = q >> 10, c = (q >> 4) & 63, d4 = (q & 15) * 4;
#pragma unroll
    for (int e = 0; e < 4; ++e) wT[(i * 64 + d4 + e) * 72 + c] = f2bf(wv[k][e]);
  }
  __syncthreads();
  {
    const int c = t & 255, i = c >> 6, win = 2 << i, ph = t >> 8, hw = win >> 1;
    const int xoff = seg0 - r0 + 8;
    int pos = r0 + ph * 32 - seg0;
    int lo = max(pos - hw, 0), hi = min(pos + hw, seglen);
    float s = 0.f;
    for (int q = lo; q < hi; ++q) s += bf2f(xs[(q + xoff) * 264 + c]);
#pragma unroll 4
    for (int pp = ph * 32; pp < ph * 32 + 32; ++pp) {
      dm[(i * 64 + pp) * 72 + (c & 63)] = f2bf(s * __builtin_amdgcn_rcpf((float)(hi - lo)) - bf2f(xs[(pp + 8) * 264 + c]));
      ++pos;
      const int lo2 = max(pos - hw, 0), hi2 = min(pos + hw, seglen);
      if (hi2 > hi) s += bf2f(xs[(hi + xoff) * 264 + c]);
      if (lo2 > lo) s -= bf2f(xs[(lo + xoff) * 264 + c]);
      lo = lo2; hi = hi2;
    }
  }
  __syncthreads();
  {
    const int i = w >> 1;
    bf16x8 bfr[4][2];
#pragma unroll
    for (int nt = 0; nt < 4; ++nt)
#pragma unroll
      for (int ks = 0; ks < 2; ++ks) bfr[nt][ks] = *(const bf16x8*)(wT + (i * 64 + nt * 16 + fr) * 72 + 32 * ks + 8 * g4);
#pragma unroll
    for (int pt2 = 0; pt2 < 2; ++pt2) {
      const int pt = (w & 1) * 2 + pt2;
      bf16x8 af[2];
#pragma unroll
      for (int ks = 0; ks < 2; ++ks) af[ks] = *(const bf16x8*)(dm + (i * 64 + pt * 16 + fr) * 72 + 32 * ks + 8 * g4);
#pragma unroll
      for (int nt = 0; nt < 4; ++nt) {
        f32x4 acc = (f32x4){0.f, 0.f, 0.f, 0.f};
#pragma unroll
        for (int ks = 0; ks < 2; ++ks) acc = __builtin_amdgcn_mfma_f32_16x16x32_bf16(af[ks], bfr[nt][ks], acc, 0, 0, 0);
        const float sc = scale[i * 64 + nt * 16 + fr];
#pragma unroll
        for (int r = 0; r < 4; ++r) xs[(pt * 16 + 4 * g4 + r) * 264 + i * 64 + nt * 16 + fr] = f2bf(acc[r] * sc);
      }
    }
  }
  __syncthreads();
#pragma unroll
  for (int k = 0; k < 4; ++k) { const int q = t + 512 * k, row = q >> 5, c8 = q & 31; *(u32x4*)(p.MIXB_() + (size_t)(r0 + row) * 1024 + 768 + c8 * 8) = *(const u32x4*)(xs + row * 264 + c8 * 8); }
  __syncthreads();
}

__device__ __forceinline__ void final_row(const MP& p, int r, int lane) {
  const float rinv = rsqrtf(p.rowss_()[4 * NTOK + r] * (1.0f / 1024.0f) + 1e-6f);
#pragma unroll
  for (int i = 0; i < 4; ++i) {
    const int d = i * 256 + lane * 4;
    const f32x4 v = *(const f32x4*)(p.X_() + (size_t)r * 1024 + d), gg = *(const f32x4*)(p.norm_f + d);
    *(f32x4*)(p.out + (size_t)r * 1024 + d) = v * rinv * gg;
  }
}

#ifndef REPEAT
#define REPEAT 0
#endif
#define REP_CAT2(a, b) a##b
#define REP_CAT(a, b) REP_CAT2(a, b)
#define REP(k) for (int REP_CAT(rep_, __LINE__) = 0; REP_CAT(rep_, __LINE__) < 1 + ((REPEAT >> (k)) & 1); ++REP_CAT(rep_, __LINE__))
#ifndef USE_CG_SYNC
#define USE_CG_SYNC 0
#endif
#if USE_CG_SYNC
#define GRID_SYNC() grid.sync()
#else
#define GRID_SYNC() do { REP(21) { XcdBarrier xb2; xb2.bar = p.bar_(); xb2.x = xb_xcc_id(); xb2.st = xst; xcd_barrier(xb2); } } while (0)
#endif

__global__ __launch_bounds__(512, 2) void mega(MP p) {
  extern __shared__ __attribute__((aligned(16))) unsigned char smem[];
#if USE_CG_SYNC
  cg::grid_group grid = cg::this_grid();
#else
  volatile LAS unsigned* xst = (volatile LAS unsigned*)((LAS unsigned char*)smem + MEGA_LDS_MAIN);
  if (threadIdx.x == 0) { xst[0] = 0u; xst[1] = 0u; }
  __syncthreads();
  (void)xcd_barrier_post(p.bar_(), xst);
#endif
  const int bid = blockIdx.x, nb = gridDim.x;
  bf16_t* XA = (bf16_t*)p.PRE_(); bf16_t* ACT = p.QKV_(); bf16_t* OB = p.QKV_();
  float* states_out = p.out + (size_t)NTOK * 1024;

  REP(0) phase_prep0(p, bid, nb, smem, false);
  GRID_SYNC();
  REP(1) { phase_prep0(p, bid, nb, smem, true); phase_vecs(p, bid, nb, smem); }
  REP(2) { int tl = threadIdx.x; asm volatile("" : "+v"(tl)); const int lane = tl & 63, w = tl >> 6;
    for (int r = bid * 8 + w; r < NTOK; r += nb * 8) prepx_row(p, r, lane); }
  GRID_SYNC();
  for (int l = 0; l < 2; ++l) {
#define TL_DECL int tl = threadIdx.x; asm volatile("" : "+v"(tl)); const int t = tl, lane = tl & 63, w = tl >> 6; (void)t; (void)lane; (void)w
    const float* ml = p.mods_() + l * 3 * 6144;
    float* rs1 = p.rowss_() + (2 * l) * NTOK; float* rs2 = p.rowss_() + (2 * l + 1) * NTOK; float* rs3 = p.rowss_() + (2 * l + 2) * NTOK;
    const float* A2 = p.AV_() + (l * 2 + 1) * 3 * 1024; const float* A1n = p.AV_() + (2 + 0) * 3 * 1024;
    REP(4) {
      pg8::Gemm g; g.A = XA; g.Bt = p.WTA_() + WT_IN; g.M = NTOK; g.N = NCOLS; g.K = 1024;
      EpiIn E{p.QKV_(), p.REST_(), rs1, p.BIN_() + l * 3 * NCOLS};
      pg8::StaticOrder S; S.init(g.M, g.N, nb, bid);
      pg8::gemm_phase<EpiIn, pg8::StaticOrder, true, true>((PG8_LAS unsigned char*)smem, g, S, E);
    }
    REP(3) if (bid >= 16) {
      phase_logits(p, l, bid - 16, nb - 16, smem);
      wtiles(p, l, 704, 2368, bid - 16, nb - 16, smem);
    }
    GRID_SYNC();
    REP(5) for (int item = bid; item < 768; item += nb) pre_item(item, p.QKV_(), p.LOG_(), p.conv_w + (size_t)l * 3 * NQKV, p.a_log + l * 8, p.dt_bias + l * 8, p.PRE_(), smem);
    GRID_SYNC();
    REP(6) { if (bid < 32) { REP(13) scan_dispatch(bid, p.PRE_(), p.state_delta, OB, states_out, l, smem); }
             else { REP(14) for (int i = bid - 32; i < 256; i += nb - 32) scan_dispatch(32 + i, p.PRE_(), p.state_delta, OB, states_out, l, smem); } }
    REP(12) if (bid >= 32) {
      for (int it = bid - 32; it < 192; it += nb - 32) sgu_pair(p, l, 2 * it, smem);
      for (int it = bid - 32; it < 192; it += nb - 32) pool_item(p, l, it, smem);
    }
    GRID_SYNC();
    REP(7) { TL_DECL; for (int r = bid * 8 + w; r < NTOK; r += nb * 8) delta_post_row(p, l, r, lane); }
    GRID_SYNC();
    {
      pg8::Gemm g; g.A = p.MIXB_(); g.Bt = p.WTA_() + WT_OUT; g.M = NTOK; g.N = 1024; g.K = 1024;
      EpiRes E{p.X_(), ml + 2048, rs2, XA, A2};
      pg8::StaticOrder S; S.init(g.M, g.N, nb, bid);
      pg8::gemm_phase<EpiRes, pg8::StaticOrder, true, true>((PG8_LAS unsigned char*)smem, g, S, E);
    }
    if (bid >= 192) wtiles(p, l, 2368, 3072, bid - 192, nb - 192, smem);
    GRID_SYNC();
    REP(9) {
      pg8::Gemm g; g.A = XA; g.Bt = p.WTA_() + WT_GU; g.M = NTOK; g.N = 2 * FFH; g.K = 1024;
      EpiGu E{ACT, rs2, p.BGU_() + l * 3 * 2 * FFH};
      pg8::StaticOrder S; S.init(g.M, g.N, nb, bid);
      pg8::gemm_phase<EpiGu, pg8::StaticOrder, true, true>((PG8_LAS unsigned char*)smem, g, S, E);
    }
    GRID_SYNC();
    if (l == 0) {
      pg8::Gemm g; g.A = ACT; g.Bt = p.WTA_() + WT_DOWN; g.M = NTOK; g.N = 1024; g.K = FFH;
      EpiRes E{p.X_(), ml + 5120, rs3, XA, A1n};
      pg8::StaticOrder S; S.init(g.M, g.N, nb, bid);
      pg8::gemm_phase<EpiRes, pg8::StaticOrder, true, true>((PG8_LAS unsigned char*)smem, g, S, E);
      if (bid >= 192) wtiles(p, 1, 0, 704, bid - 192, nb - 192, smem);
      GRID_SYNC();
    } else {
      pg8::Gemm g; g.A = ACT; g.Bt = p.WTA_() + WT_DOWN; g.M = NTOK; g.N = 1024; g.K = FFH;
      EpiResFinal E{p.X_(), ml + 5120, p.out, p.norm_f, p.SLOT_(), p.bar_() + 3584};
      pg8::StaticOrder S; S.init(g.M, g.N, nb, bid);
      pg8::gemm_phase<EpiResFinal, pg8::StaticOrder, false, true>((PG8_LAS unsigned char*)smem, g, S, E);
    }
  }
}

extern "C" void kernel_launch(void* const* d_in, const int* in_sizes, int n_in, void* d_out, int out_size, void* d_ws, size_t ws_size,
                              hipStream_t stream) {
  static int grid_blocks = 0;
  if (!grid_blocks) {
    int dev = 0, cus = 0, per_cu = 0;
    (void)hipGetDevice(&dev);
    (void)hipDeviceGetAttribute(&cus, hipDeviceAttributeMultiprocessorCount, dev);
    (void)hipFuncSetAttribute((const void*)mega, hipFuncAttributeMaxDynamicSharedMemorySize, MEGA_LDS);
    (void)hipOccupancyMaxActiveBlocksPerMultiprocessor(&per_cu, (const void*)mega, 512, MEGA_LDS);
    if (per_cu < 1) { fprintf(stderr, "occupancy query says %d blocks per CU\n", per_cu); per_cu = 1; }
    if (per_cu > 1) per_cu = 1;
    grid_blocks = cus * per_cu;
    if (grid_blocks > 256) grid_blocks = 256;
  }
  MP p; memset(&p, 0, sizeof p);
  const float** ins = (const float**)&p;
  for (int i = 0; i < 23; ++i) ins[i] = (const float*)d_in[i];
  p.out = (float*)d_out;
  p.ws = (unsigned char*)d_ws;
  if (WS_END > ws_size) { fprintf(stderr, "workspace too small: need %zu have %zu\n", (size_t)WS_END, ws_size); return; }
  (void)hipMemsetAsync((char*)d_ws + WS_BAR, 0, 16384, stream);
  void* args[] = {&p};
  hipError_t e = hipLaunchCooperativeKernel((const void*)mega, dim3(grid_blocks), dim3(512), args, MEGA_LDS, stream);
  if (e != hipSuccess) fprintf(stderr, "cooperative launch failed: %s (grid %d)\n", hipGetErrorString(e), grid_blocks);
}
```

```cpp
#include <hip/hip_runtime.h>
#include <math.h>
#include <cstdio>
#include <cstring>

#define NTOK 12288
#define NCTX 8192
#define DM 1024
#define INC 2832
#define FFH 2816
#define NQKV 1536
#define NREST 1280
#define NCOLS 2816

typedef unsigned short bf16_t;
typedef float f32x2_cv __attribute__((ext_vector_type(2)));
typedef __bf16 bf16x2_cv __attribute__((ext_vector_type(2)));
__device__ __forceinline__ unsigned pack_bf16(float lo, float hi) { return __builtin_bit_cast(unsigned, __builtin_convertvector((f32x2_cv){lo, hi}, bf16x2_cv)); }
__device__ __forceinline__ bf16_t f2bf(float f) { return (bf16_t)(pack_bf16(f, 0.f) & 0xffffu); }
__device__ __forceinline__ float bf2f(bf16_t b) { return __uint_as_float(((unsigned)b) << 16); }
__device__ __forceinline__ float silu_f(float x) { return x / (1.f + expf(-x)); }
__device__ __forceinline__ float silu_fast(float x) { return x * __builtin_amdgcn_rcpf(1.f + __expf(-x)); }
__device__ __forceinline__ float gelu_fast(float x) { const float u = 1.5957691216057308f * (x + 0.044715f * x * x * x); return x * __builtin_amdgcn_rcpf(1.f + __expf(-u)); }
__device__ __forceinline__ float sigmoid_f(float x) { return 1.f / (1.f + expf(-x)); }
__device__ __forceinline__ float gelu_f(float x) { return 0.5f * x * (1.f + tanhf(0.7978845608028654f * (x + 0.044715f * x * x * x))); }
__device__ __forceinline__ float softplus_f(float x) { return x > 20.f ? x : log1pf(expf(x)); }
__device__ __forceinline__ int seg_of_row(int r) { return r < NCTX ? 0 : 1 + ((r - NCTX) >> 11); }
__device__ __forceinline__ float wave_sum(float v) {
#pragma unroll
  for (int o = 32; o > 0; o >>= 1) v += __shfl_xor(v, o);
  return v;
}
namespace pg8 {
#define PG8_LAS __attribute__((address_space(3)))
typedef unsigned short bf16_t;
typedef short bf16x8 __attribute__((ext_vector_type(8)));
typedef float f32x4 __attribute__((ext_vector_type(4)));
typedef unsigned u32x4 __attribute__((ext_vector_type(4)));
constexpr int BM = 256, BK = 64, HALF = 128, HTB = HALF * BK * 2  , STAGE_BYTES = 8 * HTB, NXCD = 8, WGM = 8;

__host__ __device__ __forceinline__ int lds_byte(int r, int c) { const int st = (r >> 4) * 2 + (c >> 5), rr = r & 15, cc = c & 31, ob = rr * 64 + cc * 2; return st * 1024 + (ob ^ (((ob >> 9) & 1) << 5)); }
__host__ __device__ __forceinline__ void stage_rc(int b, int& R, int& C) { const int st = b / 1024, sb = b % 1024, swz = sb ^ (((sb >> 9) & 1) << 5); R = (st >> 1) * 16 + swz / 64; C = (st & 1) * 32 + (swz % 64) / 2; }
__host__ __device__ __forceinline__ int perm32(int rho) { const int n = rho >> 4, i = rho & 15; return 8 * (i >> 2) + 4 * n + (i & 3); }

struct Unit { int pm, pn; };
struct Gemm { const bf16_t* A; const bf16_t* Bt; int M, N, K; };

struct StaticOrder {
    int nM, nN, nwg, G, c;
    __host__ __device__ void init(int M, int N, int G_, int c_) { nM = M / BM; nN = N / BM; nwg = nM * nN; G = G_; c = c_; }
    __host__ __device__ bool next(int i, Unit& u) const {
        const long L = (long)i * G + c; if (L >= nwg) return false;
        int wgid = (int)L; { const int q = nwg / NXCD, r = nwg % NXCD, xcd = wgid % NXCD, off = wgid / NXCD; wgid = (xcd < r ? xcd * (q + 1) : r * (q + 1) + (xcd - r) * q) + off; }
        const int nig = WGM * nN, gid = wgid / nig, fm = gid * WGM, gsz = (nM - fm) < WGM ? (nM - fm) : WGM;
        u.pm = fm + ((wgid % nig) % gsz); u.pn = (wgid % nig) / gsz; return true;
    }
    __device__ __forceinline__ void a_ready(const Unit&) const {}
    __device__ __forceinline__ void done(const Unit&) const {}
    static constexpr bool KWAIT = false;
    __device__ __forceinline__ bool k_wait(const Unit&) const { return false; }
};

__device__ __forceinline__ unsigned cvt_pk_bf16(float lo, float hi) { return ::pack_bf16(lo, hi); }
template <class Epi, class Sched, bool ALIGN_EPI = false, bool SP2 = false>
__device__ __forceinline__ void gemm_phase(PG8_LAS unsigned char* lds, const Gemm g, const Sched& S, const Epi& E) {
    int tid_ = threadIdx.x; asm volatile("" : "+v"(tid_));
    const int tid = tid_, wid = __builtin_amdgcn_readfirstlane(tid >> 6), lane = tid & 63, wr = wid >> 2, wc = wid & 3, fr = lane & 15, fq = lane >> 4;
    const int K = g.K, nt = K / BK;
    unsigned voffA[2], voffB[2];
#pragma unroll
    for (int i = 0; i < 2; ++i) { int R, C; stage_rc(tid * 16 + i * 8192, R, C); const int Rb = Epi::PERM ? ((R & ~31) + perm32(R & 31)) : R;
        voffA[i] = (unsigned)(R * K + C) * 2u; voffB[i] = (unsigned)(Rb * K + C) * 2u; }
    const size_t kstep = (size_t)(BK * 2);
    const size_t hstep = (size_t)HALF * K * 2;
    const size_t tstep = 2 * hstep;
    const unsigned ldsw = (unsigned)wid * 1024u;
    const int aoff = lds_byte(wr * 64 + fr, fq * 8), boff = lds_byte(wc * 32 + fr, fq * 8);
#define PG8_SA(b, h) (((b) * 2 + (h)) * HTB)
#define PG8_SB(b, h) ((4 + (b) * 2 + (h)) * HTB)
#define PG8_STAGE(bufoff, gbase, voff) do { _Pragma("unroll") for (int _i = 0; _i < 2; ++_i) \
        __builtin_amdgcn_global_load_lds((const unsigned*)((const char*)(gbase) + (voff)[_i]), (PG8_LAS unsigned*)(lds + (bufoff) + ldsw + _i * 8192), 16, 0, 0); } while (0)
#define PG8_STAGE_SC1(bufoff, gbase, voff) do { _Pragma("unroll") for (int _i = 0; _i < 2; ++_i) \
        __builtin_amdgcn_global_load_lds((const unsigned*)((const char*)(gbase) + (voff)[_i]), (PG8_LAS unsigned*)(lds + (bufoff) + ldsw + _i * 8192), 16, 0, 16); } while (0)
#define PG8_STAGE_A(dep, bufoff, gbase) do { if constexpr (Sched::KWAIT) { if (dep) PG8_STAGE_SC1(bufoff, gbase, voffA); else PG8_STAGE(bufoff, gbase, voffA); } else PG8_STAGE(bufoff, gbase, voffA); } while (0)
#define PG8_LDA(dst, b, h) do { _Pragma("unroll") for (int m = 0; m < 4; ++m) _Pragma("unroll") for (int k = 0; k < 2; ++k) dst[m][k] = *(const PG8_LAS bf16x8*)(lds + PG8_SA(b, h) + aoff + m * 2048 + k * 1024); } while (0)
#define PG8_LDB(dst, b, h) do { _Pragma("unroll") for (int n = 0; n < 2; ++n) _Pragma("unroll") for (int k = 0; k < 2; ++k) dst[n][k] = *(const PG8_LAS bf16x8*)(lds + PG8_SB(b, h) + boff + n * 2048 + k * 1024); } while (0)
#define PG8_MMA(ai, bj, At, Bt) do { __builtin_amdgcn_s_setprio(1); _Pragma("unroll") for (int m = 0; m < 4; ++m) _Pragma("unroll") for (int n = 0; n < 2; ++n) _Pragma("unroll") for (int k = 0; k < 2; ++k) \
        acc[ai][bj][m][n] = __builtin_amdgcn_mfma_f32_16x16x32_bf16(Bt[n][k], At[m][k], acc[ai][bj][m][n], 0, 0, 0); __builtin_amdgcn_s_setprio(0); } while (0)
#define PG8_WAIT_V(n) asm volatile("s_waitcnt vmcnt(" #n ")" ::: "memory")
#define PG8_WAIT_L(n) asm volatile("s_waitcnt lgkmcnt(" #n ")" ::: "memory")
#define PG8_BAR __builtin_amdgcn_s_barrier()
#define PG8_SCHED __builtin_amdgcn_sched_barrier(0)
    Unit cur, nxt; int ui = 0;
    if (!S.next(0, cur)) return;
    f32x4 acc[2][2][4][2];
#pragma unroll
    for (int a = 0; a < 2; ++a)
#pragma unroll
        for (int b = 0; b < 2; ++b)
#pragma unroll
            for (int m = 0; m < 4; ++m)
#pragma unroll
                for (int n = 0; n < 2; ++n) acc[a][b][m][n] = (f32x4){0.f, 0.f, 0.f, 0.f};
    bf16x8 At[4][2], B0[2][2], B1[2][2];
    const char* cA = (const char*)g.A + (size_t)cur.pm * tstep; const char* cB = (const char*)g.Bt + (size_t)cur.pn * tstep;
    S.a_ready(cur);
    if constexpr (SP2) {
        PG8_STAGE(PG8_SB(0, 0), cB, voffB); PG8_STAGE(PG8_SB(0, 1), cB + hstep, voffB); PG8_STAGE(PG8_SA(0, 0), cA, voffA); PG8_STAGE(PG8_SA(0, 1), cA + hstep, voffA);
        if (wr == 1) PG8_BAR;
        PG8_WAIT_V(2); PG8_BAR;
        PG8_STAGE(PG8_SB(1, 0), cB + kstep, voffB); PG8_STAGE(PG8_SA(1, 0), cA + kstep, voffA); PG8_STAGE(PG8_SB(1, 1), cB + hstep + kstep, voffB);
        PG8_WAIT_V(6); PG8_BAR;
    } else {
        PG8_STAGE(PG8_SB(0, 0), cB, voffB); PG8_STAGE(PG8_SA(0, 0), cA, voffA); PG8_STAGE(PG8_SB(0, 1), cB + hstep, voffB); PG8_STAGE(PG8_SA(0, 1), cA + hstep, voffA);
        if (wr == 1) PG8_BAR;
        PG8_WAIT_V(4); PG8_BAR;
        PG8_STAGE(PG8_SB(1, 0), cB + kstep, voffB); PG8_STAGE(PG8_SA(1, 0), cA + kstep, voffA); PG8_STAGE(PG8_SB(1, 1), cB + hstep + kstep, voffB);
        PG8_WAIT_V(6); PG8_BAR;
    }
    static_assert(!Sched::KWAIT || SP2, "KWAIT schedulers: SP2 loop only");
    bool dep_unit = false;
    for (;;) {
        const bool has_next = S.next(ui + 1, nxt);
        const char* nA = has_next ? (const char*)g.A + (size_t)nxt.pm * tstep : cA; const char* nB = has_next ? (const char*)g.Bt + (size_t)nxt.pn * tstep : cB;
        for (int t = 0; t < nt; t += 2) {
            bool dep23 = false, dep1 = false;
            if constexpr (Sched::KWAIT) { if (t == nt - 4) dep_unit = S.k_wait(cur); dep23 = dep_unit && (t == nt - 4); dep1 = dep_unit && (t == nt - 2); }
            const bool last = (t == nt - 2);
            const char* a1 = cA + (size_t)(t + 1) * kstep;
            const char* a2 = last ? nA : cA + (size_t)(t + 2) * kstep; const char* b2 = last ? nB : cB + (size_t)(t + 2) * kstep;
            const char* a3 = a2 + kstep; const char* b3 = b2 + kstep;
            if (last && has_next) S.a_ready(nxt);
            if constexpr (SP2) {
            PG8_LDB(B0, 0, 0); PG8_LDB(B1, 0, 1); PG8_SCHED; PG8_LDA(At, 0, 0); PG8_STAGE_A(dep1, PG8_SA(1, 1), a1 + hstep);
            PG8_WAIT_V(8); PG8_WAIT_L(0); PG8_BAR; PG8_MMA(0, 0, At, B0); PG8_MMA(0, 1, At, B1); PG8_BAR; PG8_SCHED;
            PG8_LDA(At, 0, 1); PG8_STAGE(PG8_SB(0, 0), b2, voffB); PG8_STAGE(PG8_SB(0, 1), b2 + hstep, voffB); PG8_STAGE_A(dep23, PG8_SA(0, 0), a2);
            PG8_WAIT_V(8); PG8_WAIT_L(0); PG8_BAR; PG8_MMA(1, 0, At, B0); PG8_MMA(1, 1, At, B1); PG8_BAR; PG8_SCHED;
            PG8_LDB(B0, 1, 0); PG8_LDB(B1, 1, 1); PG8_SCHED; PG8_LDA(At, 1, 0); PG8_STAGE_A(dep23, PG8_SA(0, 1), a2 + hstep);
            PG8_WAIT_V(8); PG8_WAIT_L(0); PG8_BAR; PG8_MMA(0, 0, At, B0); PG8_MMA(0, 1, At, B1); PG8_BAR; PG8_SCHED;
            PG8_LDA(At, 1, 1); PG8_STAGE(PG8_SB(1, 0), b3, voffB); PG8_STAGE(PG8_SB(1, 1), b3 + hstep, voffB); PG8_STAGE_A(dep23, PG8_SA(1, 0), a3);
            PG8_WAIT_V(8); PG8_WAIT_L(0); PG8_BAR; PG8_MMA(1, 0, At, B0); PG8_MMA(1, 1, At, B1); PG8_BAR; PG8_SCHED;
            } else {
            PG8_LDB(B0, 0, 0); PG8_SCHED; PG8_LDA(At, 0, 0); PG8_STAGE(PG8_SA(1, 1), a1 + hstep, voffA);
            PG8_WAIT_L(8); PG8_BAR; PG8_WAIT_L(0); PG8_MMA(0, 0, At, B0); PG8_BAR; PG8_SCHED;
            PG8_LDB(B1, 0, 1); PG8_STAGE(PG8_SB(0, 0), b2, voffB);
            PG8_BAR; PG8_WAIT_L(0); PG8_MMA(0, 1, At, B1); PG8_BAR;
            PG8_LDA(At, 0, 1); PG8_STAGE(PG8_SA(0, 0), a2, voffA);
            PG8_BAR; PG8_WAIT_L(0); PG8_MMA(1, 0, At, B0); PG8_BAR; PG8_SCHED;
            PG8_STAGE(PG8_SB(0, 1), b2 + hstep, voffB);
            PG8_WAIT_V(6); PG8_BAR; PG8_MMA(1, 1, At, B1); PG8_BAR;
            PG8_LDB(B0, 1, 0); PG8_SCHED; PG8_LDA(At, 1, 0); PG8_STAGE(PG8_SA(0, 1), a2 + hstep, voffA);
            PG8_WAIT_L(8); PG8_BAR; PG8_WAIT_L(0); PG8_MMA(0, 0, At, B0); PG8_BAR; PG8_SCHED;
            PG8_LDB(B1, 1, 1); PG8_STAGE(PG8_SB(1, 0), b3, voffB);
            PG8_BAR; PG8_WAIT_L(0); PG8_MMA(0, 1, At, B1); PG8_BAR;
            PG8_LDA(At, 1, 1); PG8_STAGE(PG8_SA(1, 0), a3, voffA);
            PG8_BAR; PG8_WAIT_L(0); PG8_MMA(1, 0, At, B0); PG8_BAR; PG8_SCHED;
            PG8_STAGE(PG8_SB(1, 1), b3 + hstep, voffB);
            PG8_WAIT_V(6); PG8_BAR; PG8_MMA(1, 1, At, B1); PG8_BAR;
            }
        }
        if constexpr (ALIGN_EPI) { if (wr == 0) PG8_BAR; }
        if constexpr (!Epi::AFTER_DRAIN) { E(acc, cur, wr, wc, fr, fq); S.done(cur); }
        if (!has_next) break;
#pragma unroll
        for (int a = 0; a < 2; ++a)
#pragma unroll
            for (int b = 0; b < 2; ++b)
#pragma unroll
                for (int m = 0; m < 4; ++m)
#pragma unroll
                    for (int n = 0; n < 2; ++n) acc[a][b][m][n] = (f32x4){0.f, 0.f, 0.f, 0.f};
        cur = nxt; cA = nA; cB = nB; ++ui;
        if constexpr (ALIGN_EPI) { if (wr == 1) PG8_BAR; }
    }
    PG8_WAIT_V(0);
    if constexpr (!ALIGN_EPI) { if (wr == 0) PG8_BAR; }
    PG8_BAR;
    if constexpr (Epi::AFTER_DRAIN) { E.fused(acc, cur, wr, wc, fr, fq, lds, wid, lane); S.done(cur); }
#undef PG8_SA
#undef PG8_SB
#undef PG8_STAGE
#undef PG8_STAGE_SC1
#undef PG8_STAGE_A
#undef PG8_LDA
#undef PG8_LDB
#undef PG8_MMA
#undef PG8_WAIT_V
#undef PG8_WAIT_L
#undef PG8_BAR
#undef PG8_SCHED
}
}

using pg8::f32x4; using pg8::u32x4; using pg8::Unit; using pg8::HALF; using pg8::BM;
typedef unsigned u32x2 __attribute__((ext_vector_type(2)));

struct EpiIn {
  static constexpr bool PERM = true, AFTER_DRAIN = false;
  bf16_t* qkv; bf16_t* rest; const float* rowss; const float* bias;
  __device__ __forceinline__ void operator()(const f32x4 (&acc)[2][2][4][2], const Unit& u, int wr, int wc, int fr, int fq) const {
    const int row0 = u.pm * BM + wr * 64 + fr;
    const int seg = seg_of_row(u.pm * BM);
    int colt = u.pn * BM; bf16_t* base = qkv; int ldc = NQKV;
    if (colt >= NQKV) { base = rest; ldc = NREST; colt -= NQKV; }
    const int col0 = colt + wc * 32 + 8 * fq, bcol0 = seg * NCOLS + u.pn * BM + wc * 32 + 8 * fq;
    f32x4 bv[2][2];
#pragma unroll
    for (int bj = 0; bj < 2; ++bj)
#pragma unroll
      for (int n = 0; n < 2; ++n) bv[bj][n] = *(const f32x4*)(bias + bcol0 + bj * HALF + 4 * n);
#pragma unroll
    for (int ai = 0; ai < 2; ++ai)
#pragma unroll
      for (int m = 0; m < 4; ++m) {
        const int r = row0 + ai * HALF + m * 16;
        const float rinv = rsqrtf(rowss[r] * (1.0f / 1024.0f) + 1e-6f);
        bf16_t* rowp = base + (size_t)r * ldc + col0;
#pragma unroll
        for (int bj = 0; bj < 2; ++bj) {
          const f32x4 v0 = acc[ai][bj][m][0] * rinv + bv[bj][0], v1 = acc[ai][bj][m][1] * rinv + bv[bj][1];
          u32x4 w; w.x = pg8::cvt_pk_bf16(v0[0], v0[1]); w.y = pg8::cvt_pk_bf16(v0[2], v0[3]); w.z = pg8::cvt_pk_bf16(v1[0], v1[1]); w.w = pg8::cvt_pk_bf16(v1[2], v1[3]);
          *(u32x4*)(rowp + bj * HALF) = w;
        }
      }
  }
};

struct EpiRes {
  static constexpr bool PERM = false, AFTER_DRAIN = false;
  float* X; const float* gate; float* rowss; bf16_t* xa; const float* An;
  __device__ __forceinline__ void operator()(const f32x4 (&acc)[2][2][4][2], const Unit& u, int wr, int wc, int fr, int fq) const {
    const int row0 = u.pm * BM + wr * 64 + fr, col0 = u.pn * BM + wc * 32 + 4 * fq;
    const int seg = seg_of_row(u.pm * BM);
    f32x4 gv[2][2], av[2][2];
#pragma unroll
    for (int bj = 0; bj < 2; ++bj)
#pragma unroll
      for (int n = 0; n < 2; ++n) {
        gv[bj][n] = *(const f32x4*)(gate + seg * 6144 + col0 + bj * HALF + n * 16);
        av[bj][n] = xa ? *(const f32x4*)(An + seg * 1024 + col0 + bj * HALF + n * 16) : (f32x4){0.f, 0.f, 0.f, 0.f};
      }
#pragma unroll
    for (int ai = 0; ai < 2; ++ai)
#pragma unroll
      for (int m = 0; m < 4; ++m) {
        const int r = row0 + ai * HALF + m * 16;
        float* xrow = X + (size_t)r * 1024 + col0;
        float ss = 0.f;
#pragma unroll
        for (int bj = 0; bj < 2; ++bj)
#pragma unroll
          for (int n = 0; n < 2; ++n) {
            const f32x4 xo = *(const f32x4*)(xrow + bj * HALF + n * 16);
            const f32x4 xn = xo + gv[bj][n] * acc[ai][bj][m][n];
            *(f32x4*)(xrow + bj * HALF + n * 16) = xn;
            ss += (xn[0] * xn[0] + xn[1] * xn[1]) + (xn[2] * xn[2] + xn[3] * xn[3]);
            if (xa) {
              const f32x4 t = xn * av[bj][n];
              u32x2 w; w.x = pg8::cvt_pk_bf16(t[0], t[1]); w.y = pg8::cvt_pk_bf16(t[2], t[3]);
              *(u32x2*)(xa + (size_t)r * 1024 + col0 + bj * HALF + n * 16) = w;
            }
          }
        ss += __shfl_xor(ss, 16); ss += __shfl_xor(ss, 32);
        if (fq == 0) atomicAdd(rowss + r, ss);
      }
  }
};

struct EpiGu {
  static constexpr bool PERM = true, AFTER_DRAIN = false;
  bf16_t* act; const float* rowss; const float* bias;
  __device__ __forceinline__ void operator()(const f32x4 (&acc)[2][2][4][2], const Unit& u, int wr, int wc, int fr, int fq) const {
    const int row0 = u.pm * BM + wr * 64 + fr;
    const int seg = seg_of_row(u.pm * BM);
    const int hid0 = u.pn * HALF + wc * 32 + 8 * fq, bcol0 = seg * (2 * FFH) + u.pn * BM + wc * 32 + 8 * fq;
    f32x4 bv[2][2];
#pragma unroll
    for (int bj = 0; bj < 2; ++bj)
#pragma unroll
      for (int n = 0; n < 2; ++n) bv[bj][n] = *(const f32x4*)(bias + bcol0 + bj * HALF + 4 * n);
#pragma unroll
    for (int ai = 0; ai < 2; ++ai)
#pragma unroll
      for (int m = 0; m < 4; ++m) {
        const int r = row0 + ai * HALF + m * 16;
        const float rinv = rsqrtf(rowss[r] * (1.0f / 1024.0f) + 1e-6f);
        float o[8];
#pragma unroll
        for (int n = 0; n < 2; ++n) {
          const f32x4 g = acc[ai][0][m][n] * rinv + bv[0][n], up = acc[ai][1][m][n] * rinv + bv[1][n];
#pragma unroll
          for (int j = 0; j < 4; ++j) o[n * 4 + j] = g[j] * __builtin_amdgcn_rcpf(1.f + __expf(-g[j])) * up[j];
        }
        u32x4 w; w.x = pg8::cvt_pk_bf16(o[0], o[1]); w.y = pg8::cvt_pk_bf16(o[2], o[3]); w.z = pg8::cvt_pk_bf16(o[4], o[5]); w.w = pg8::cvt_pk_bf16(o[6], o[7]);
        *(u32x4*)(act + (size_t)r * FFH + hid0) = w;
      }
  }
};


struct EpiResFinal {
  static constexpr bool PERM = false, AFTER_DRAIN = true;
  const float* X; const float* gate; float* out; const float* normf; float* slots; unsigned* cnt;
  __device__ __forceinline__ void operator()(const f32x4 (&)[2][2][4][2], const Unit&, int, int, int, int) const {}
  __device__ __forceinline__ void fused(f32x4 (&acc)[2][2][4][2], const Unit& u, int wr, int wc, int fr, int fq, PG8_LAS unsigned char* lds, int wid, int lane) const {
    PG8_LAS float* P = (PG8_LAS float*)lds;
    PG8_LAS float* R = (PG8_LAS float*)(lds + 4096);
    const int row0 = u.pm * BM + wr * 64 + fr, col0 = u.pn * BM + wc * 32 + 4 * fq;
    const int seg = seg_of_row(u.pm * BM);
    f32x4 gv[2][2];
#pragma unroll
    for (int bj = 0; bj < 2; ++bj)
#pragma unroll
      for (int n = 0; n < 2; ++n) gv[bj][n] = *(const f32x4*)(gate + seg * 6144 + col0 + bj * HALF + n * 16);
#pragma unroll
    for (int ai = 0; ai < 2; ++ai)
#pragma unroll
      for (int m = 0; m < 4; ++m) {
        const int r = row0 + ai * HALF + m * 16;
        const float* xrow = X + (size_t)r * 1024 + col0;
        float ss = 0.f;
#pragma unroll
        for (int bj = 0; bj < 2; ++bj)
#pragma unroll
          for (int n = 0; n < 2; ++n) {
            const f32x4 xo = *(const f32x4*)(xrow + bj * HALF + n * 16);
            const f32x4 xn = xo + gv[bj][n] * acc[ai][bj][m][n];
            acc[ai][bj][m][n] = xn;
            ss += (xn[0] * xn[0] + xn[1] * xn[1]) + (xn[2] * xn[2] + xn[3] * xn[3]);
          }
        ss += __shfl_xor(ss, 16); ss += __shfl_xor(ss, 32);
        if (fq == 0) P[(ai * HALF + wr * 64 + m * 16 + fr) * 4 + wc] = ss;
      }
    __syncthreads();
    const int tid = wid * 64 + lane;
    if (tid < 256) {
      const float s = (P[tid * 4 + 0] + P[tid * 4 + 1]) + (P[tid * 4 + 2] + P[tid * 4 + 3]);
      __hip_atomic_store(slots + (size_t)(u.pm * 4 + u.pn) * 256 + tid, s, __ATOMIC_RELAXED, __HIP_MEMORY_SCOPE_AGENT);
    }
    asm volatile("s_waitcnt vmcnt(0)" ::: "memory");
    __syncthreads();
    if (tid == 0) {
      (void)__hip_atomic_fetch_add(cnt + u.pm, 1u, __ATOMIC_RELAXED, __HIP_MEMORY_SCOPE_AGENT);
      unsigned sp = 0u;
      while (__hip_atomic_load(cnt + u.pm, __ATOMIC_RELAXED, __HIP_MEMORY_SCOPE_AGENT) < 4u) { __builtin_amdgcn_s_sleep(1); if (++sp > (1u << 22)) break; }
      __builtin_amdgcn_fence(__ATOMIC_ACQUIRE, "agent");
      asm volatile("s_waitcnt vmcnt(0)" ::: "memory");
    }
    __syncthreads();
    if (tid < 256) {
      float tot = 0.f;
#pragma unroll
      for (int k = 0; k < 4; ++k) tot += __hip_atomic_load(slots + (size_t)(u.pm * 4 + k) * 256 + tid, __ATOMIC_RELAXED, __HIP_MEMORY_SCOPE_AGENT);
      R[tid] = rsqrtf(tot * (1.0f / 1024.0f) + 1e-6f);
    }
    __syncthreads();
    f32x4 nf[2][2];
#pragma unroll
    for (int bj = 0; bj < 2; ++bj)
#pragma unroll
      for (int n = 0; n < 2; ++n) nf[bj][n] = *(const f32x4*)(normf + col0 + bj * HALF + n * 16);
#pragma unroll
    for (int ai = 0; ai < 2; ++ai)
#pragma unroll
      for (int m = 0; m < 4; ++m) {
        const int lr = ai * HALF + wr * 64 + m * 16 + fr;
        const float rinv = R[lr];
        float* orow = out + (size_t)(u.pm * BM + lr) * 1024 + col0;
#pragma unroll
        for (int bj = 0; bj < 2; ++bj)
#pragma unroll
          for (int n = 0; n < 2; ++n) *(f32x4*)(orow + bj * HALF + n * 16) = acc[ai][bj][m][n] * rinv * nf[bj][n];
      }
  }
};

#define GU_DEFER_PM0 16
struct GuOrder {
  static constexpr bool KWAIT = false;
  pg8::StaticOrder S; int solo;
  __device__ __forceinline__ void init(int G, int c, int solo_) { S.nM = NTOK / pg8::BM; S.nN = 21; S.nwg = S.nM * 21; S.G = G; S.c = c; solo = solo_; }
  __device__ __forceinline__ bool next(int i, pg8::Unit& u) const {
    if (solo >= 0) { if (i) return false; u.pm = solo; u.pn = 21; return true; }
    if (S.next(i, u)) return true;
    const long L = (long)i * S.G + S.c - S.nwg;
    if (L < GU_DEFER_PM0) { u.pm = (int)L; u.pn = 21; return true; }
    return false;
  }
  __device__ __forceinline__ void a_ready(const pg8::Unit&) const {}
  __device__ __forceinline__ void done(const pg8::Unit&) const {}
  __device__ __forceinline__ bool k_wait(const pg8::Unit&) const { return false; }
};
#ifndef DOWN_KWAIT
#define DOWN_KWAIT true
#endif
struct DownOrder {
  static constexpr bool KWAIT = DOWN_KWAIT;
  pg8::StaticOrder S; unsigned* flag;
  __device__ __forceinline__ bool next(int i, pg8::Unit& u) const { return S.next(i, u); }
  __device__ __forceinline__ void a_ready(const pg8::Unit&) const {}
  __device__ __forceinline__ void done(const pg8::Unit&) const {}
  __device__ __forceinline__ bool k_wait(const pg8::Unit& u) const {
    if (u.pm < GU_DEFER_PM0) return false;
    unsigned sp = 0u;
    while (__builtin_amdgcn_readfirstlane(__hip_atomic_load(flag + u.pm, __ATOMIC_RELAXED, __HIP_MEMORY_SCOPE_AGENT)) == 0u) { __builtin_amdgcn_s_sleep(1); if (++sp > (1u << 22)) break; }
    asm volatile("" ::: "memory");
    return true;
  }
};

__device__ __forceinline__ int win_srccol(int j) { return j < 2048 ? j : j + 16; }
__device__ __forceinline__ int wgu_srccol(int j) { const int pn = j >> 8, w = j & 255; return w < 128 ? pn * 128 + w : FFH + pn * 128 + (w - 128); }

__device__ __forceinline__ void transpose_tile(const float* __restrict__ src, int ldsrc, int srccol0, bf16_t* __restrict__ dst, int K, int j0, int k0, float* tile, int t,
                                               const float* __restrict__ shv, float* __restrict__ bias, int bstride) {
  const int jl = t & 63, kg = t >> 6;
#pragma unroll
  for (int i = 0; i < 16; ++i) { const int k = kg * 16 + i; tile[jl * 65 + k] = src[(size_t)(k0 + k) * ldsrc + srccol0 + jl]; }
  __syncthreads();
  if (shv) {
    float a0 = 0.f, a1 = 0.f, a2 = 0.f;
#pragma unroll
    for (int i = 0; i < 16; ++i) { const int k = kg * 16 + i; const float wv = tile[jl * 65 + k]; a0 += shv[k0 + k] * wv; a1 += shv[6144 + k0 + k] * wv; a2 += shv[2 * 6144 + k0 + k] * wv; }
    atomicAdd(bias + j0 + jl, a0); atomicAdd(bias + bstride + j0 + jl, a1); atomicAdd(bias + 2 * bstride + j0 + jl, a2);
  }
  const int j = t >> 2, kc = (t & 3) * 16;
  const float* s = tile + j * 65 + kc;
  u32x4 o0, o1;
  o0.x = pack_bf16(s[0], s[1]); o0.y = pack_bf16(s[2], s[3]); o0.z = pack_bf16(s[4], s[5]); o0.w = pack_bf16(s[6], s[7]);
  o1.x = pack_bf16(s[8], s[9]); o1.y = pack_bf16(s[10], s[11]); o1.z = pack_bf16(s[12], s[13]); o1.w = pack_bf16(s[14], s[15]);
  bf16_t* d = dst + (size_t)(j0 + j) * K + k0 + kc;
  *(u32x4*)d = o0; *(u32x4*)(d + 8) = o1;
  __syncthreads();
}

#define WT_IN 0
#define WT_OUT (2816 * 1024)
#define WT_GU (WT_OUT + 1024 * 1024)
#define WT_DOWN (WT_GU + 5632 * 1024)
#define WT_LAYER (WT_DOWN + 1024 * 2816)


#define PRE_QP 0
#define PRE_KTP 16384
#define PRE_DIR0 32768
#define PRE_DIRSZ 41984
#define PRE_NW 0
#define PRE_UP 16384
#define PRE_QKP 32768
#define PRE_SC 40960
#define PRE_ITEM 116736
#define PRE_LDS 118784
#define SCAN_BUF 58368
#define SCAN_LDS (2 * SCAN_BUF)

using pg8::bf16x8;
__device__ __forceinline__ int perm_inv(int x) { return (x & ~31) | (((x >> 2) & 3) << 3) | (((x >> 4) & 1) << 2) | (x & 3); }
__device__ __forceinline__ bf16x8 pack8(const f32x4& x, const f32x4& y) {
  u32x4 w; w.x = pg8::cvt_pk_bf16(x[0], x[1]); w.y = pg8::cvt_pk_bf16(x[2], x[3]); w.z = pg8::cvt_pk_bf16(y[0], y[1]); w.w = pg8::cvt_pk_bf16(y[2], y[3]);
  return __builtin_bit_cast(bf16x8, w);
}

__device__ __forceinline__ void pre_item(int item, const bf16_t* __restrict__ QKV, const float* __restrict__ LOG, const float* __restrict__ cw,
                                         const float* __restrict__ a_log, const float* __restrict__ dt_bias, unsigned char* __restrict__ PRE,
                                         unsigned char* lds) {
  int t_ = threadIdx.x; asm volatile("" : "+v"(t_));
  const int t = t_, lane = t & 63, w = t >> 6;
  const int c = item >> 2, h = item & 3, r0 = c * 64;
  bf16_t* qb = (bf16_t*)lds; bf16_t* kb = (bf16_t*)(lds + 17408); float* vf = (float*)(lds + 34816);
  float* Lf = (float*)(lds + 67584); float* Lb = (float*)(lds + 83968); float* sc = (float*)(lds + 100352);
  unsigned char* pre = PRE + (size_t)item * PRE_ITEM;
  {
    const int i = t >> 3, cg = t & 7, r = r0 + i;
    int s0, len;
    if (r < NCTX) { s0 = r & ~255; len = 256; } else { s0 = NCTX + ((r - NCTX) & ~2047); len = 2048; }
    const int tt = r - s0; const bool hp = tt > 0, hn = tt < len - 1;
#pragma unroll
    for (int x = 0; x < 3; ++x) {
      const int cb = x * 512 + h * 128 + cg * 16;
      const bf16_t* p0 = QKV + (size_t)r * NQKV + cb;
      u32x4 m0 = (u32x4){0u, 0u, 0u, 0u}, m1 = m0, n0 = m0, n1 = m0;
      const u32x4 c0 = *(const u32x4*)p0, c1 = *(const u32x4*)(p0 + 8);
      if (hp) { m0 = *(const u32x4*)(p0 - NQKV); m1 = *(const u32x4*)(p0 - NQKV + 8); }
      if (hn) { n0 = *(const u32x4*)(p0 + NQKV); n1 = *(const u32x4*)(p0 + NQKV + 8); }
      float val[16]; float ss = 0.f;
#pragma unroll
      for (int e = 0; e < 16; ++e) {
        const unsigned wm = (e < 8 ? m0 : m1)[(e & 7) >> 1], wc = (e < 8 ? c0 : c1)[(e & 7) >> 1], wn = (e < 8 ? n0 : n1)[(e & 7) >> 1];
        const float xm = __uint_as_float((e & 1) ? (wm & 0xffff0000u) : (wm << 16));
        const float xc = __uint_as_float((e & 1) ? (wc & 0xffff0000u) : (wc << 16));
        const float xn = __uint_as_float((e & 1) ? (wn & 0xffff0000u) : (wn << 16));
        const float y = cw[cb + e] * xm + cw[NQKV + cb + e] * xc + cw[2 * NQKV + cb + e] * xn;
        val[e] = silu_fast(y); ss += val[e] * val[e];
      }
      if (x < 2) {
        ss += __shfl_xor(ss, 1); ss += __shfl_xor(ss, 2); ss += __shfl_xor(ss, 4);
        const float rn = rsqrtf(ss + 1e-6f) * (x == 0 ? 0.08838834764831845f : 1.0f);
        bf16_t* dst = (x == 0 ? qb : kb) + i * 136 + cg * 16;
        u32x4 o0, o1;
        o0.x = pack_bf16(val[0] * rn, val[1] * rn); o0.y = pack_bf16(val[2] * rn, val[3] * rn); o0.z = pack_bf16(val[4] * rn, val[5] * rn); o0.w = pack_bf16(val[6] * rn, val[7] * rn);
        o1.x = pack_bf16(val[8] * rn, val[9] * rn); o1.y = pack_bf16(val[10] * rn, val[11] * rn); o1.z = pack_bf16(val[12] * rn, val[13] * rn); o1.w = pack_bf16(val[14] * rn, val[15] * rn);
        *(u32x4*)dst = o0; *(u32x4*)(dst + 8) = o1;
      } else {
        float* dst = vf + i * 128 + cg * 16;
#pragma unroll
        for (int e = 0; e < 16; e += 4) *(f32x4*)(dst + e) = (f32x4){val[e], val[e + 1], val[e + 2], val[e + 3]};
      }
    }
  }
  if (w == 0) {
    const int i = lane, r = r0 + i;
#pragma unroll
    for (int d = 0; d < 2; ++d) {
      const float bl = LOG[(size_t)r * 16 + d * 4 + h], al = LOG[(size_t)r * 16 + 8 + d * 4 + h];
      const float beta = sigmoid_f(bl);
      const float g = -expf(a_log[d * 4 + h]) * softplus_f(al + dt_bias[d * 4 + h]);
      float s = g;
#pragma unroll
      for (int o = 1; o < 64; o <<= 1) {
        const float nb = d == 0 ? __shfl_up(s, o) : __shfl_down(s, o);
        const bool ok = d == 0 ? (lane >= o) : (lane + o < 64);
        if (ok) s += nb;
      }
      sc[d * 64 + i] = beta; sc[128 + d * 64 + i] = s; sc[256 + d * 64 + i] = beta * expf(s);
    }
  }
  __syncthreads();
  {
    const int p = w >> 2, it = w & 3, fr = lane & 15, g = lane >> 4;
    const bf16_t* Ab = p ? qb : kb;
    bf16x8 af[4];
#pragma unroll
    for (int ks = 0; ks < 4; ++ks) af[ks] = *(const bf16x8*)(Ab + (it * 16 + fr) * 136 + ks * 32 + 8 * g);
    bf16_t* qkf = (bf16_t*)(lds + 102400);
    bf16_t* qkb = (bf16_t*)(lds + 102400 + 8192);
#pragma unroll
    for (int jt = 0; jt < 4; ++jt) {
      f32x4 acc = (f32x4){0.f, 0.f, 0.f, 0.f};
#pragma unroll
      for (int ks = 0; ks < 4; ++ks) {
        const bf16x8 bfr = *(const bf16x8*)(kb + (jt * 16 + fr) * 136 + ks * 32 + 8 * g);
        acc = __builtin_amdgcn_mfma_f32_16x16x32_bf16(af[ks], bfr, acc, 0, 0, 0);
      }
      const int j = jt * 16 + fr;
      const float gfj = sc[128 + j], gbj = sc[192 + j];
#pragma unroll
      for (int r = 0; r < 4; ++r) {
        const int i = it * 16 + 4 * g + r;
        const float val = acc[r];
        const float ef = __expf(fminf(sc[128 + i] - gfj, 0.f)), eb = __expf(fminf(sc[192 + i] - gbj, 0.f));
        if (p == 0) {
          Lf[i * 64 + j] = (j < i) ? sc[i] * val * ef : 0.f;
          Lb[(63 - i) * 64 + (63 - j)] = (j > i) ? sc[64 + i] * val * eb : 0.f;
        } else {
          const int jp = perm_inv(j);
          qkf[i * 64 + jp] = f2bf((j <= i) ? val * ef : 0.f);
          qkb[i * 64 + jp] = f2bf((j >= i) ? val * eb : 0.f);
        }
      }
    }
  }
  __syncthreads();
#pragma unroll
  for (int it2 = 0; it2 < 2; ++it2) {
    const int q = t + 512 * it2;
    { const int i = q >> 4, s = (q >> 2) & 3, g = q & 3;
      const u32x2 lo = *(const u32x2*)(qb + i * 136 + 32 * s + 4 * g), hi = *(const u32x2*)(qb + i * 136 + 32 * s + 16 + 4 * g);
      *(u32x4*)(pre + PRE_QP + (size_t)(i * 128 + 32 * s + 8 * g) * 2) = (u32x4){lo.x, lo.y, hi.x, hi.y}; }
    { const int dk = q >> 3, s2 = (q >> 2) & 1, g = q & 3;
      unsigned short e[8];
#pragma unroll
      for (int jj = 0; jj < 8; ++jj) e[jj] = kb[(32 * s2 + 16 * (jj >> 2) + 4 * g + (jj & 3)) * 136 + dk];
      u32x4 o; o.x = (unsigned)e[0] | ((unsigned)e[1] << 16); o.y = (unsigned)e[2] | ((unsigned)e[3] << 16); o.z = (unsigned)e[4] | ((unsigned)e[5] << 16); o.w = (unsigned)e[6] | ((unsigned)e[7] << 16);
      *(u32x4*)(pre + PRE_KTP + (size_t)(dk * 64 + 32 * s2 + 8 * g) * 2) = o; }
  }
  if (t < 384) {
    const int d = t / 192, rem = t % 192, k3 = rem >> 6, i = rem & 63;
    const float glast = d ? sc[192] : sc[128 + 63], gci = sc[128 + d * 64 + i];
    const float v = k3 == 0 ? expf(gci) : (k3 == 1 ? expf(glast - gci) : expf(glast));
    ((float*)(pre + PRE_DIR0 + d * PRE_DIRSZ + PRE_SC))[k3 * 64 + i] = v;
  }
  {
    const int d = w >> 2, kind = (w >> 1) & 1, cc = t & 127;
    int rowsel = d ? 63 : 0, rstep = d ? -1 : 1; unsigned Loff = d ? 83968u : 67584u;
    asm volatile("" : "+v"(rowsel), "+v"(rstep), "+v"(Loff));
    const float* L = (const float*)(lds + Loff);
    float x[64];
    if (kind == 0) {
#pragma unroll
      for (int ip = 0; ip < 64; ++ip) { const int i = rowsel + rstep * ip; x[ip] = sc[d * 64 + i] * vf[i * 128 + cc]; }
    } else {
#pragma unroll
      for (int ip = 0; ip < 64; ++ip) { const int i = rowsel + rstep * ip; x[ip] = sc[256 + d * 64 + i] * bf2f(kb[i * 136 + cc]); }
    }
    const f32x4* L4 = (const f32x4*)__builtin_assume_aligned(L, 16);
#pragma unroll
    for (int ip = 1; ip < 64; ++ip) {
      float a0 = 0.f, a1 = 0.f, a2 = 0.f, a3 = 0.f;
#pragma unroll
      for (int q = 0; q < (ip + 3) / 4; ++q) {
        const f32x4 lv = L4[ip * 16 + q];
        a0 += lv[0] * x[4 * q]; a1 += lv[1] * x[4 * q + 1]; a2 += lv[2] * x[4 * q + 2]; a3 += lv[3] * x[4 * q + 3];
      }
      x[ip] -= (a0 + a1) + (a2 + a3);
    }
    __syncthreads();
    unsigned char* outd = lds + 34816 + d * 32768;
    if (kind == 0) {
      const int dv = cc, wv = dv >> 4;
      unsigned char* ub = outd + 16384 + ((wv * 4) * 64 + (dv & 15)) * 8;
#pragma unroll
      for (int qp = 0; qp < 16; ++qp) {
        const int q = (rowsel >> 2) + rstep * qp;
        const float v0 = d ? x[4 * qp + 3] : x[4 * qp], v1 = d ? x[4 * qp + 2] : x[4 * qp + 1], v2 = d ? x[4 * qp + 1] : x[4 * qp + 2], v3 = d ? x[4 * qp] : x[4 * qp + 3];
        u32x2 pk; pk.x = pack_bf16(v0, v1); pk.y = pack_bf16(v2, v3);
        *(u32x2*)(ub + q * 128) = pk;
      }
    } else {
      const int kp = perm_inv(cc);
      bf16_t* nw = (bf16_t*)outd + kp;
#pragma unroll
      for (int ip = 0; ip < 64; ++ip) { const int i = rowsel + rstep * ip; nw[i * 128] = f2bf(-x[ip]); }
    }
  }
  __syncthreads();
  for (int k = 0; k < 8; ++k) {
    const int q = t + 512 * k, d = q >> 11, wi = q & 2047;
    *(u32x4*)(pre + PRE_DIR0 + d * PRE_DIRSZ + wi * 16) = *(const u32x4*)(lds + 34816 + q * 16);
  }
  for (int k = 0; k < 2; ++k) {
    const int q = t + 512 * k, d = q >> 9, wi = q & 511;
    *(u32x4*)(pre + PRE_DIR0 + d * PRE_DIRSZ + PRE_QKP + wi * 16) = *(const u32x4*)(lds + 102400 + q * 16);
  }
  __syncthreads();
}

__global__ __launch_bounds__(512, 2) void k_pre(const bf16_t* __restrict__ QKV, const float* __restrict__ LOG, const float* __restrict__ cw,
                                                const float* __restrict__ a_log, const float* __restrict__ dt_bias, unsigned char* __restrict__ PRE) {
  extern __shared__ __attribute__((aligned(16))) unsigned char smem[];
  for (int item = blockIdx.x; item < 768; item += gridDim.x) pre_item(item, QKV, LOG, cw, a_log, dt_bias, PRE, smem);
}

#define SCAN_OT (2 * SCAN_BUF)
#undef SCAN_LDS
#define SCAN_LDS (2 * SCAN_BUF + 8 * 2048)
__device__ __forceinline__ void scan_item(int b, int h, int d, int chunk0, int nc, int half, bool write_state, const unsigned char* __restrict__ PRE, const float* __restrict__ s_in,
                                          bf16_t* __restrict__ OB, float* __restrict__ s_out, unsigned char* lds) {
  int t_ = threadIdx.x; asm volatile("" : "+v"(t_));
  const int t = t_, lane = t & 63, w = t >> 6, fr = lane & 15, g = lane >> 4;
  const bool active = half < 0 || w < 4;
  const int dvw = half < 0 ? w : half * 4 + (w & 3), dv = 16 * dvw + fr;
  f32x4 S[8];
  if (s_in == nullptr) {
#pragma unroll
    for (int m = 0; m < 8; ++m) S[m] = (f32x4){0.f, 0.f, 0.f, 0.f};
  } else {
#pragma unroll
    for (int m = 0; m < 8; ++m)
#pragma unroll
      for (int r = 0; r < 4; ++r) S[m][r] = s_in[(16 * m + 4 * g + r) * 128 + dv];
  }
  unsigned soff[7], doff[7];
#pragma unroll
  for (int k = 0; k < 7; ++k) {
    const int q = t + 512 * k;
    if (k < 2) { const int row = q >> 4, c = q & 15; soff[k] = PRE_DIR0 + PRE_NW + q * 16; doff[k] = row * 256 + ((c ^ (row & 15)) << 4); }
    else if (k < 4) { const int q2 = q - 1024, row = q2 >> 4, c = q2 & 15; soff[k] = PRE_QP + q2 * 16; doff[k] = 16384 + row * 256 + ((c ^ (row & 15)) << 4); }
    else if (k < 5) { const int q2 = q - 2048, row = q2 >> 3, c = q2 & 7; soff[k] = PRE_DIR0 + PRE_QKP + q2 * 16; doff[k] = 32768 + row * 128 + ((c ^ ((row >> 1) & 7)) << 4); }
    else { const int q2 = q - 2560, row = q2 >> 3, c = q2 & 7; soff[k] = PRE_KTP + q2 * 16; doff[k] = 40960 + row * 128 + ((c ^ ((row >> 1) & 7)) << 4); }
    if (k < 2 || k == 4) soff[k] += d * PRE_DIRSZ;
  }
  const unsigned soff7 = PRE_DIR0 + d * PRE_DIRSZ + PRE_SC + t * 16, doff7 = 57344 + t * 16;
  const unsigned upoff = PRE_DIR0 + d * PRE_DIRSZ + PRE_UP + ((dvw * 4) * 64 + lane) * 8;
  u32x4 st[7]; u32x4 st7 = (u32x4){0u, 0u, 0u, 0u}; u32x2 up[4];
  {
    const int cidx = chunk0 + (d ? nc - 1 : 0);
    const unsigned char* pre = PRE + (size_t)(cidx * 4 + h) * PRE_ITEM;
#pragma unroll
    for (int k = 0; k < 7; ++k) st[k] = *(const u32x4*)(pre + soff[k]);
    if (t < 48) st7 = *(const u32x4*)(pre + soff7);
#pragma unroll
    for (int m = 0; m < 4; ++m) up[m] = *(const u32x2*)(pre + upoff + m * 512);
#pragma unroll
    for (int k = 0; k < 7; ++k) *(u32x4*)(lds + doff[k]) = st[k];
    if (t < 48) *(u32x4*)(lds + doff7) = st7;
  }
  __syncthreads();
  bf16_t* ot = (bf16_t*)(lds + SCAN_OT + w * 2048);
  for (int step = 0; step < nc; ++step) {
    const int cidx = chunk0 + (d ? nc - 1 - step : step);
    const unsigned char* B = lds + (step & 1) * SCAN_BUF;
    const bool more = step + 1 < nc;
    f32x4 a1[4], a2[4];
#pragma unroll
    for (int m = 0; m < 4; ++m) {
      a1[m] = (f32x4){__uint_as_float(up[m].x << 16), __uint_as_float(up[m].x & 0xffff0000u), __uint_as_float(up[m].y << 16), __uint_as_float(up[m].y & 0xffff0000u)};
      a2[m] = (f32x4){0.f, 0.f, 0.f, 0.f};
    }
    if (more) {
      const int cn = chunk0 + (d ? nc - 2 - step : step + 1);
      const unsigned char* pre = PRE + (size_t)(cn * 4 + h) * PRE_ITEM;
#pragma unroll
      for (int k = 0; k < 7; ++k) st[k] = *(const u32x4*)(pre + soff[k]);
      if (t < 48) st7 = *(const u32x4*)(pre + soff7);
#pragma unroll
      for (int m = 0; m < 4; ++m) up[m] = *(const u32x2*)(pre + upoff + m * 512);
    }
    if (active) {
      const float* SC = (const float*)(B + 57344);
      const float gt = SC[128];
      bf16x8 Sb[4];
#pragma unroll
      for (int s = 0; s < 4; ++s) Sb[s] = pack8(S[2 * s], S[2 * s + 1]);
#pragma unroll
      for (int m = 0; m < 8; ++m) S[m] = S[m] * gt;
      {
        bf16x8 fa[2][4], fq[2][4];
#pragma unroll
        for (int m = 0; m < 4; ++m) {
          fa[0][m] = *(const bf16x8*)(B + (16 * m + fr) * 256 + (((0 + g) ^ fr) << 4));
          fq[0][m] = *(const bf16x8*)(B + 16384 + (16 * m + fr) * 256 + (((0 + g) ^ fr) << 4));
        }
#pragma unroll
        for (int s = 0; s < 4; ++s) {
          if (s < 3) {
#pragma unroll
            for (int m = 0; m < 4; ++m) {
              fa[(s + 1) & 1][m] = *(const bf16x8*)(B + (16 * m + fr) * 256 + (((4 * (s + 1) + g) ^ fr) << 4));
              fq[(s + 1) & 1][m] = *(const bf16x8*)(B + 16384 + (16 * m + fr) * 256 + (((4 * (s + 1) + g) ^ fr) << 4));
            }
          }
#pragma unroll
          for (int m = 0; m < 4; ++m) a1[m] = __builtin_amdgcn_mfma_f32_16x16x32_bf16(fa[s & 1][m], Sb[s], a1[m], 0, 0, 0);
#pragma unroll
          for (int m = 0; m < 4; ++m) a2[m] = __builtin_amdgcn_mfma_f32_16x16x32_bf16(fq[s & 1][m], Sb[s], a2[m], 0, 0, 0);
        }
      }
      bf16x8 Vb[2], Vs[2];
#pragma unroll
      for (int s = 0; s < 2; ++s) Vb[s] = pack8(a1[2 * s], a1[2 * s + 1]);
#pragma unroll
      for (int m = 0; m < 4; ++m) { const f32x4 e = *(const f32x4*)(SC + 64 + 16 * m + 4 * g); a1[m] = a1[m] * e; }
#pragma unroll
      for (int s = 0; s < 2; ++s) Vs[s] = pack8(a1[2 * s], a1[2 * s + 1]);
      {
        bf16x8 fk[2][8];
#pragma unroll
        for (int s = 0; s < 2; ++s)
#pragma unroll
          for (int m = 0; m < 8; ++m) fk[s][m] = *(const bf16x8*)(B + 40960 + (16 * m + fr) * 128 + (((4 * s + g) ^ (fr >> 1)) << 4));
#pragma unroll
        for (int s = 0; s < 2; ++s)
#pragma unroll
          for (int m = 0; m < 8; ++m) S[m] = __builtin_amdgcn_mfma_f32_16x16x32_bf16(fk[s][m], Vs[s], S[m], 0, 0, 0);
      }
#pragma unroll
      for (int m = 0; m < 4; ++m) { const f32x4 e = *(const f32x4*)(SC + 16 * m + 4 * g); a2[m] = a2[m] * e; }
#pragma unroll
      for (int s = 0; s < 2; ++s)
#pragma unroll
        for (int m = 0; m < 4; ++m) {
          const bf16x8 fa = *(const bf16x8*)(B + 32768 + (16 * m + fr) * 128 + (((4 * s + g) ^ (fr >> 1)) << 4));
          a2[m] = __builtin_amdgcn_mfma_f32_16x16x32_bf16(fa, Vb[s], a2[m], 0, 0, 0);
        }
#pragma unroll
      for (int m = 0; m < 4; ++m)
#pragma unroll
        for (int r = 0; r < 4; ++r) ot[(16 * m + 4 * g + r) * 16 + fr] = f2bf(a2[m][r]);
      {
        bf16_t* op = OB + ((size_t)d * NTOK + (size_t)cidx * 64) * 512 + h * 128 + 16 * dvw;
#pragma unroll
        for (int k = 0; k < 2; ++k) {
          const int q = lane + 64 * k, row = q >> 1, hf = q & 1;
          *(u32x4*)(op + (size_t)row * 512 + hf * 8) = *(const u32x4*)(ot + row * 16 + hf * 8);
        }
      }
    }
    if (more) {
      unsigned char* Bn = lds + ((step + 1) & 1) * SCAN_BUF;
#pragma unroll
      for (int k = 0; k < 7; ++k) *(u32x4*)(Bn + doff[k]) = st[k];
      if (t < 48) *(u32x4*)(Bn + doff7) = st7;
    }
    __syncthreads();
  }
  if (write_state && active) {
#pragma unroll
    for (int m = 0; m < 8; ++m)
#pragma unroll
      for (int r = 0; r < 4; ++r) s_out[(16 * m + 4 * g + r) * 128 + dv] = S[m][r];
  }
}

__device__ __forceinline__ void scan_dispatch(int i, const unsigned char* PRE, const float* state_in, bf16_t* OB, float* state_out, int layer, unsigned char* lds) {
#ifdef LAT_FULL
  if (i < 32) {
    if (i >= 16) return;
    const int q = i, half = -1, b = q >> 3, h = (q >> 1) & 3, d = q & 1;
#else
  if (i < 32) {
    const int q = i >> 1, half = i & 1, b = q >> 3, h = (q >> 1) & 3, d = q & 1;
#endif
    scan_item(b, h, d, 128 + b * 32, 32, half, false, PRE, state_in + ((((size_t)b * 2 + layer) * 2 + d) * 4 + h) * 16384, OB, nullptr, lds);
  } else {
    const int sid = i - 32, b = sid >> 3, h = (sid >> 1) & 3, d = sid & 1;
    scan_item(b, h, d, b * 4, 4, -1, true, PRE, nullptr, OB, state_out + ((((size_t)b * 2 + layer) * 2 + d) * 4 + h) * 16384, lds);
  }
}

__global__ __launch_bounds__(512, 2) void k_scan2(const unsigned char* __restrict__ PRE, const float* __restrict__ state_in, bf16_t* __restrict__ OB,
                                                  float* __restrict__ state_out, int layer) {
  extern __shared__ __attribute__((aligned(16))) unsigned char smem[];
  for (int i = blockIdx.x; i < 288; i += gridDim.x) scan_dispatch(i, PRE, state_in, OB, state_out, layer, smem);
}
#define XB_TMO      128
#define XB_XCNT(j)  (256  + 64 * (j))
#define XB_XSUB(j)  (1280 + 64 * (j))
#define XB_XGEN(j)  (2304 + 64 * (j))
#define XB_TOP      3328
#define XB_TOPGEN   3392
#define XCD_BAR_WORDS 3456
#define XB_SPIN_CAP (1u << 18)
#define LAS __attribute__((address_space(3)))

__device__ __forceinline__ unsigned xb_ld(unsigned* p)              { return __hip_atomic_load(p, __ATOMIC_RELAXED, __HIP_MEMORY_SCOPE_AGENT); }
__device__ __forceinline__ unsigned xb_add(unsigned* p, unsigned v) { return __hip_atomic_fetch_add(p, v, __ATOMIC_RELAXED, __HIP_MEMORY_SCOPE_AGENT); }
__device__ __forceinline__ unsigned xb_xcc_id() { return (unsigned)__builtin_amdgcn_s_getreg((3 << 11) | 20) & 0xFu; }
#define XB_SPIN(cond, bar) do { unsigned _sp = 0; while (cond) { __builtin_amdgcn_s_sleep(1); \
    if ((++_sp & 255u) == 0u) { if (xb_ld(&(bar)[XB_TMO])) break; if (_sp > XB_SPIN_CAP) { atomicAdd(&(bar)[XB_TMO], 1u); break; } } } } while (0)

struct XcdBarrier {
    unsigned* bar; unsigned x;
    volatile LAS unsigned* st;
};

__device__ __forceinline__ XcdBarrier xcd_barrier_post(unsigned* bar, volatile LAS unsigned* st) {
    XcdBarrier b; b.bar = bar; b.x = xb_xcc_id(); b.st = st;
    if (threadIdx.x == 0) (void)xb_add(&bar[XB_XCNT(b.x)], 1u);
    return b;
}
__device__ __forceinline__ void xcd_barrier_complete(unsigned* bar, unsigned x, unsigned& nloc, unsigned& nx) {
    const unsigned G = gridDim.x * gridDim.y * gridDim.z;
    unsigned sum, cnt, mine, sp = 0u;
    for (;;) {
        sum = 0u; cnt = 0u; mine = 0u;
#pragma unroll
        for (unsigned j = 0; j < 16; ++j) { const unsigned c = xb_ld(&bar[XB_XCNT(j)]); sum += c; cnt += (c > 0u) ? 1u : 0u; mine = (j == x) ? c : mine; }
        if (sum == G) break;
        __builtin_amdgcn_s_sleep(1);
        if ((++sp & 255u) == 0u) { if (xb_ld(&bar[XB_TMO])) break; if (sp > XB_SPIN_CAP) { atomicAdd(&bar[XB_TMO], 1u); break; } }
    }
    nloc = mine > 0u ? mine : 1u; nx = cnt > 0u ? cnt : 1u;
}

__device__ __forceinline__ void xcd_barrier(const XcdBarrier& b) {
    asm volatile("s_waitcnt vmcnt(0)" ::: "memory");
    __syncthreads();
    if (threadIdx.x == 0) {
        unsigned* bar = b.bar;
        __builtin_amdgcn_s_waitcnt(0);
        unsigned nloc = b.st[0], nx = b.st[1];
        if (nloc == 0u) { xcd_barrier_complete(bar, b.x, nloc, nx); b.st[0] = nloc; b.st[1] = nx; }
        const unsigned old = xb_add(&bar[XB_XSUB(b.x)], 1u);
        const unsigned gen = old / nloc;
        if (old + 1u == (gen + 1u) * nloc) {
            __builtin_amdgcn_fence(__ATOMIC_RELEASE, "agent");
            asm volatile("s_waitcnt vmcnt(0)" ::: "memory");
            const unsigned og = xb_add(&bar[XB_TOP], 1u);
            const unsigned tg = og / nx;
            if (og + 1u == (tg + 1u) * nx) xb_add(&bar[XB_TOPGEN], 1u);
            else XB_SPIN(xb_ld(&bar[XB_TOPGEN]) == tg, bar);
            __builtin_amdgcn_fence(__ATOMIC_ACQUIRE, "agent");
            xb_add(&bar[XB_XGEN(b.x)], 1u);
            asm volatile("s_waitcnt vmcnt(0)" ::: "memory");
        } else {
            XB_SPIN(xb_ld(&bar[XB_XGEN(b.x)]) == gen, bar);
            __builtin_amdgcn_fence(__ATOMIC_ACQUIRE, "agent");
            asm volatile("s_waitcnt vmcnt(0)" ::: "memory");
        }
    }
    __syncthreads();
}


#include <hip/hip_cooperative_groups.h>
namespace cg = cooperative_groups;

#define MEGA_LDS_MAIN 143360
#define MEGA_LDS (MEGA_LDS_MAIN + 16)
#define WS_X 0ull
#define WS_WTA (WS_X + (size_t)NTOK * 1024 * 4)
#define WS_WTB (WS_WTA + (size_t)WT_LAYER * 2)
#define WS_QKV (WS_WTB + (size_t)2816 * 1024 * 2)
#define WS_REST (WS_QKV + (size_t)NTOK * NQKV * 2)
#define WS_PRE (WS_REST + (size_t)NTOK * NREST * 2)
#define WS_MIXB (WS_PRE + (size_t)768 * PRE_ITEM)
#define WS_MODS (WS_MIXB + (size_t)NTOK * 1024 * 2)
#define WS_AV (WS_MODS + 2 * 3 * 6144 * 4)
#define WS_BIN (WS_AV + 2 * 2 * 3 * 1024 * 4)
#define WS_BGU (WS_BIN + 2 * 3 * NCOLS * 4)
#define WS_BLOG (WS_BGU + 2 * 3 * 2 * FFH * 4)
#define WS_ROWSS (WS_BLOG + 2 * 3 * 16 * 4 + 128)
#define WS_LOG (WS_ROWSS + 5 * NTOK * 4)
#define WS_BAR (WS_LOG + (size_t)NTOK * 16 * 4)
#define WS_WLT (WS_BAR + 16384)
#define WS_POS (WS_WLT + 2 * 16 * 1024 * 2)
#define WS_SLOT (WS_POS + 96 * 512 * 4)
#define WS_END (WS_SLOT + 48 * 4 * 256 * 4)
struct MP {
  const float *x_prompt, *x_sample, *state_delta, *c, *c_ctx, *w_in, *conv_w, *a_log, *dt_bias, *delta_norm_g, *sgu_norm_g, *w_spatial, *b_spatial,
      *w_pool, *pool_scale, *w_out, *norm1_g, *norm2_g, *w_mod, *b_mod, *w_gu, *w_down, *norm_f;
  float* out; unsigned char* ws;
  __device__ __forceinline__ float* X_() const { return (float*)(ws + WS_X); }
  __device__ __forceinline__ bf16_t* WTA_() const { return (bf16_t*)(ws + WS_WTA); }
  __device__ __forceinline__ bf16_t* WTB_() const { return (bf16_t*)(ws + WS_WTB); }
  __device__ __forceinline__ bf16_t* QKV_() const { return (bf16_t*)(ws + WS_QKV); }
  __device__ __forceinline__ bf16_t* REST_() const { return (bf16_t*)(ws + WS_REST); }
  __device__ __forceinline__ unsigned char* PRE_() const { return ws + WS_PRE; }
  __device__ __forceinline__ bf16_t* MIXB_() const { return (bf16_t*)(ws + WS_MIXB); }
  __device__ __forceinline__ float* mods_() const { return (float*)(ws + WS_MODS); }
  __device__ __forceinline__ float* AV_() const { return (float*)(ws + WS_AV); }
  __device__ __forceinline__ float* BIN_() const { return (float*)(ws + WS_BIN); }
  __device__ __forceinline__ float* BGU_() const { return (float*)(ws + WS_BGU); }
  __device__ __forceinline__ float* BLOG_() const { return (float*)(ws + WS_BLOG); }
  __device__ __forceinline__ float* rowss_() const { return (float*)(ws + WS_ROWSS); }
  __device__ __forceinline__ float* LOG_() const { return (float*)(ws + WS_LOG); }
  __device__ __forceinline__ unsigned* bar_() const { return (unsigned*)(ws + WS_BAR); }
  __device__ __forceinline__ bf16_t* WLT_() const { return (bf16_t*)(ws + WS_WLT); }
  __device__ __forceinline__ float* POS_() const { return (float*)(ws + WS_POS); }
  __device__ __forceinline__ float* SLOT_() const { return (float*)(ws + WS_SLOT); }
};

__device__ __forceinline__ void gemv3_item(const float* __restrict__ W, int ld, int ncols, const float* vec  , float* red  ,
                                           const float* __restrict__ bias, float* __restrict__ o0, float* __restrict__ o1, float* __restrict__ o2, int t) {
  const int col = t & 63, ds = t >> 6;
  float a0 = 0.f, a1 = 0.f, a2 = 0.f;
  if (col < ncols) {
    const float* w = W + (size_t)(ds * 128) * ld + col;
#pragma unroll 16
    for (int d = 0; d < 128; ++d) { const float wv = w[(size_t)d * ld]; const int dd = ds * 128 + d; a0 += vec[dd] * wv; a1 += vec[1024 + dd] * wv; a2 += vec[2048 + dd] * wv; }
  }
  red[(ds * 3 + 0) * 64 + col] = a0; red[(ds * 3 + 1) * 64 + col] = a1; red[(ds * 3 + 2) * 64 + col] = a2;
  __syncthreads();
  if (t < 192) {
    const int s = t >> 6, cc = t & 63;
    float v = 0.f;
#pragma unroll
    for (int k = 0; k < 8; ++k) v += red[(k * 3 + s) * 64 + cc];
    if (cc < ncols) { v += bias ? bias[cc] : 0.f; (s == 0 ? o0 : (s == 1 ? o1 : o2))[cc] = v; }
  }
  __syncthreads();
}

__device__ __forceinline__ void wtile(const MP& p, int l, int r  , bf16_t* wt_in, bf16_t* wt_rest, float* tile, int tt) {
  const float* ml = p.mods_() + l * 3 * 6144;
  if (r < 704) { const int kt = r / 44, jt = r % 44; transpose_tile(p.w_in + (size_t)l * 1024 * INC, INC, win_srccol(jt * 64), wt_in, 1024, jt * 64, kt * 64, tile, tt, ml, p.BIN_() + l * 3 * NCOLS, NCOLS); return; }
  r -= 704;
  if (r < 256) { const int kt = r / 16, jt = r % 16; transpose_tile(p.w_out + (size_t)l * 1024 * 1024, 1024, jt * 64, wt_rest + WT_OUT, 1024, jt * 64, kt * 64, tile, tt, nullptr, nullptr, 0); return; }
  r -= 256;
  if (r < 1408) { const int kt = r / 88, jt = r % 88; transpose_tile(p.w_gu + (size_t)l * 1024 * 2 * FFH, 2 * FFH, wgu_srccol(jt * 64), wt_rest + WT_GU, 1024, jt * 64, kt * 64, tile, tt, ml + 3072, p.BGU_() + l * 3 * 2 * FFH, 2 * FFH); return; }
  r -= 1408;
  { const int kt = r / 16, jt = r % 16; transpose_tile(p.w_down + (size_t)l * FFH * 1024, 1024, jt * 64, wt_rest + WT_DOWN, FFH, jt * 64, kt * 64, tile, tt, nullptr, nullptr, 0); }
}

__device__ __forceinline__ void wtiles(const MP& p, int l, int r_lo, int r_hi, int jb, int njb, unsigned char* smem) {
  int t_ = threadIdx.x; asm volatile("" : "+v"(t_)); const int t = t_;
  float* tile = (float*)smem + (t >> 8) * (64 * 65);
  for (int it = jb; it < (r_hi - r_lo) / 2; it += njb) wtile(p, l, r_lo + it * 2 + (t >> 8), p.WTA_() + WT_IN, p.WTA_(), tile, t & 255);
}

__device__ __forceinline__ void phase_prep0(const MP& p, int bid, int nb, unsigned char* smem, bool tiles) {
  int t_ = threadIdx.x; asm volatile("" : "+v"(t_)); const int t = t_;
  if (!tiles) for (int i = bid * 512 + t; i < 4 * NTOK; i += nb * 512) p.rowss_()[NTOK + i] = 0.f;
  if (!tiles) for (int i = bid * 512 + t; i < 2 * 3 * NCOLS + 2 * 3 * 2 * FFH; i += nb * 512) p.BIN_()[i] = 0.f;
  if (!tiles) for (int i = bid * 512 + t; i < 96 * 512; i += nb * 512) {
    const int rc = i >> 9, dd = i & 511, jj = dd & 255;
    const float omega = 1.0f / powf(10000.0f, (float)jj / 256.0f);
    const float ang = (float)(rc < 32 ? rc : rc - 32) * omega;
    p.POS_()[i] = (dd & 256) ? cosf(ang) : sinf(ang);
  }
  if (!tiles) for (int i = bid * 512 + t; i < 2 * 16 * 1024; i += nb * 512) { const int l = i >> 14, j = (i >> 10) & 15, d = i & 1023; p.WLT_()[i] = f2bf(p.w_in[((size_t)l * 1024 + d) * INC + 2048 + j]); }
  float* vec = (float*)smem; float* red = vec + 3072; float* tile = (float*)(smem + 32768) + (t >> 8) * (64 * 65);
  const int NMOD = 192, NPAIR = 704 / 2;
  for (int it = bid; it < (tiles ? NMOD + NPAIR : NMOD); it += nb) {
    if (it < NMOD) { if (tiles) continue;
      const int l = it / 96, cgp = it % 96;
      for (int i = t; i < 1024; i += 512) { vec[i] = silu_f(p.c_ctx[i]); vec[1024 + i] = silu_f(p.c[i]); vec[2048 + i] = silu_f(p.c[1024 + i]); }
      __syncthreads();
      float* m = p.mods_() + l * 3 * 6144 + cgp * 64;
      gemv3_item(p.w_mod + (size_t)l * 1024 * 6144 + cgp * 64, 6144, 64, vec, red, p.b_mod + l * 6144 + cgp * 64, m, m + 6144, m + 2 * 6144, t);
    } else {
      const int r = (it - NMOD) * 2 + (t >> 8);
      wtile(p, 0, r, p.WTA_() + WT_IN, p.WTA_(), tile, t & 255);
    }
  }
}

__device__ __forceinline__ void phase_vecs(const MP& p, int bid, int nb, unsigned char* smem) {
  int t_ = threadIdx.x; asm volatile("" : "+v"(t_)); const int t = t_;
  float* vec = (float*)smem; float* red = vec + 3072;
  for (int i = bid * 512 + t; i < 2 * 2 * 1024; i += nb * 512) {
    const int l = i >> 11, n = (i >> 10) & 1, d = i & 1023;
    const float g = n ? p.norm2_g[l * 1024 + d] : p.norm1_g[l * 1024 + d];
#pragma unroll
    for (int s = 0; s < 3; ++s) p.AV_()[((l * 2 + n) * 3 + s) * 1024 + d] = g * (1.f + p.mods_()[(l * 3 + s) * 6144 + (n ? 4096 : 1024) + d]);
  }
  const int N_IN = 44, N_GU = 88;
  for (int it = bid; it < 2; it += nb) {
    const int l = it, r = N_IN + N_GU;
    const int sh_off = (r >= N_IN && r < N_IN + N_GU) ? 3072 : 0;
    for (int i = t; i < 1024; i += 512) {
#pragma unroll
      for (int s = 0; s < 3; ++s) vec[s * 1024 + i] = p.mods_()[(l * 3 + s) * 6144 + sh_off + i];
    }
    __syncthreads();
    if (r < N_IN) { float* o = p.BIN_() + l * 3 * NCOLS + r * 64; gemv3_item(p.w_in + (size_t)l * 1024 * INC + win_srccol(r * 64), INC, 64, vec, red, nullptr, o, o + NCOLS, o + 2 * NCOLS, t); }
    else if (r < N_IN + N_GU) { const int j0 = (r - N_IN) * 64; float* o = p.BGU_() + l * 3 * 2 * FFH + j0; gemv3_item(p.w_gu + (size_t)l * 1024 * 2 * FFH + wgu_srccol(j0), 2 * FFH, 64, vec, red, nullptr, o, o + 2 * FFH, o + 4 * FFH, t); }
    else { float* o = p.BLOG_() + l * 3 * 16; gemv3_item(p.w_in + (size_t)l * 1024 * INC + 2048, INC, 16, vec, red, nullptr, o, o + 16, o + 32, t); }
  }
}

__device__ __forceinline__ void prepx_row(const MP& p, int r, int lane) {
  const int seg = seg_of_row(r);
  float ss = 0.f;
#pragma unroll
  for (int i = 0; i < 4; ++i) {
    const int d = i * 256 + lane * 4;
    f32x4 v;
    if (r < NCTX) v = *(const f32x4*)(p.x_prompt + (size_t)r * 1024 + d);
    else {
      const int rl = r - NCTX, pp = rl & 2047, row = pp >> 6, col = pp & 63;
      v = *(const f32x4*)(p.x_sample + (size_t)rl * 1024 + d);
      const f32x4 e = *(const f32x4*)(p.POS_() + (d < 512 ? row * 512 + d : (32 + col) * 512 + (d - 512)));
      v = v + e;
    }
    *(f32x4*)(p.X_() + (size_t)r * 1024 + d) = v;
    ss += (v[0] * v[0] + v[1] * v[1]) + (v[2] * v[2] + v[3] * v[3]);
    const f32x4 g1 = *(const f32x4*)(p.norm1_g + d), sc1 = *(const f32x4*)(p.mods_() + seg * 6144 + 1024 + d);
    const f32x4 a = g1 * (1.f + sc1);
    u32x2 w; w.x = pack_bf16(v[0] * a[0], v[1] * a[1]); w.y = pack_bf16(v[2] * a[2], v[3] * a[3]);
    *(u32x2*)((bf16_t*)p.PRE_() + (size_t)r * 1024 + d) = w;
  }
  ss = wave_sum(ss);
  if (lane == 0) p.rowss_()[r] = ss;
}

__device__ __forceinline__ void phase_logits(const MP& p, int l, int bid, int nb, unsigned char* smem) {
  int tl = threadIdx.x; asm volatile("" : "+v"(tl)); const int t = tl, lane = tl & 63, w = tl >> 6, fr = lane & 15, g = lane >> 4;
  bf16_t* wl = (bf16_t*)smem;
  const bf16_t* XA = (const bf16_t*)p.PRE_();
  for (int q = t; q < 2048; q += 512) { const int j = q >> 7, c = q & 127; *(u32x4*)(wl + j * 1032 + c * 8) = *(const u32x4*)(p.WLT_() + (size_t)l * 16 * 1024 + j * 1024 + c * 8); }
  __syncthreads();
  for (int rg = bid * 8 + w; rg < NTOK / 16; rg += nb * 8) {
    const int row0 = rg * 16;
    const bf16_t* arow = XA + (size_t)(row0 + fr) * 1024 + 8 * g;
    bf16x8 af[32];
#pragma unroll
    for (int ks = 0; ks < 32; ++ks) af[ks] = *(const bf16x8*)(arow + 32 * ks);
    f32x4 acc0 = (f32x4){0.f, 0.f, 0.f, 0.f}, acc1 = acc0;
#pragma unroll
    for (int ks = 0; ks < 32; ks += 2) {
      const bf16x8 b0 = *(const bf16x8*)(wl + fr * 1032 + 32 * ks + 8 * g), b1 = *(const bf16x8*)(wl + fr * 1032 + 32 * (ks + 1) + 8 * g);
      acc0 = __builtin_amdgcn_mfma_f32_16x16x32_bf16(af[ks], b0, acc0, 0, 0, 0);
      acc1 = __builtin_amdgcn_mfma_f32_16x16x32_bf16(af[ks + 1], b1, acc1, 0, 0, 0);
    }
    const int seg = seg_of_row(row0);
    const float bias = p.BLOG_()[l * 3 * 16 + seg * 16 + fr];
#pragma unroll
    for (int r = 0; r < 4; ++r) {
      const int row = row0 + 4 * g + r;
      const float rinv = rsqrtf(p.rowss_()[(2 * l) * NTOK + row] * (1.0f / 1024.0f) + 1e-6f);
      p.LOG_()[(size_t)row * 16 + fr] = (acc0[r] + acc1[r]) * rinv + bias;
    }
  }
  __syncthreads();
}

__device__ __forceinline__ void delta_post_row(const MP& p, int l, int r, int lane) {
  const bf16_t* OB = p.QKV_();
  const u32x4 of = *(const u32x4*)(OB + (size_t)r * 512 + lane * 8), ob = *(const u32x4*)(OB + ((size_t)NTOK + r) * 512 + lane * 8);
  const u32x4 zz = *(const u32x4*)(p.REST_() + (size_t)r * NREST + lane * 8);
  float o[8]; float ss = 0.f;
#pragma unroll
  for (int e = 0; e < 8; ++e) {
    const unsigned wf = of[e >> 1], wb = ob[e >> 1];
    o[e] = __uint_as_float((e & 1) ? (wf & 0xffff0000u) : (wf << 16)) + __uint_as_float((e & 1) ? (wb & 0xffff0000u) : (wb << 16));
    ss += o[e] * o[e];
  }
  ss += __shfl_xor(ss, 1); ss += __shfl_xor(ss, 2); ss += __shfl_xor(ss, 4); ss += __shfl_xor(ss, 8);
  const float rn = rsqrtf(ss * (1.0f / 128.0f) + 1e-6f);
  const float* ng = p.delta_norm_g + l * 128 + (lane & 15) * 8;
  float y[8];
#pragma unroll
  for (int e = 0; e < 8; ++e) {
    const unsigned wz = zz[e >> 1];
    const float z = __uint_as_float((e & 1) ? (wz & 0xffff0000u) : (wz << 16));
    y[e] = o[e] * rn * ng[e] * silu_fast(z);
  }
  u32x4 w; w.x = pack_bf16(y[0], y[1]); w.y = pack_bf16(y[2], y[3]); w.z = pack_bf16(y[4], y[5]); w.w = pack_bf16(y[6], y[7]);
  *(u32x4*)(p.MIXB_() + (size_t)r * 1024 + lane * 8) = w;
}

__device__ __forceinline__ void sgu_pair(const MP& p, int l, int item0, unsigned char* smem) {
  int tl = threadIdx.x; asm volatile("" : "+v"(tl)); const int t = tl & 255, lane = tl & 63, w = __builtin_amdgcn_readfirstlane(tl >> 6), hb = w >> 2, wl = w & 3, fr = lane & 15, g4 = lane >> 4;
  const int item = item0 + hb, ch = item >> 2, g = item & 3;
  const bf16_t* REST = p.REST_(); const float* norm_g = p.sgu_norm_g + l * 256 + g * 64;
  const float* w_s = p.w_spatial + ((size_t)l * 4 + g) * 128 * 128; const float* b_s = p.b_spatial + (l * 4 + g) * 128;
  const int r0 = ch * 128;
  bf16_t* vnT = (bf16_t*)(smem + hb * 35840);
  bf16_t* ut = (bf16_t*)(smem + hb * 35840 + 17408);
  const int s_ = t >> 1, q2 = t & 1;
  const bf16_t* vrow = REST + (size_t)(r0 + s_) * NREST + 768 + g * 64 + q2 * 32;
  u32x4 vv[4];
#pragma unroll
  for (int k = 0; k < 4; ++k) vv[k] = *(const u32x4*)(vrow + 8 * k);
  u32x4 uu[4];
#pragma unroll
  for (int k = 0; k < 4; ++k) { const int q = t + 256 * k, row = q >> 3, c8 = q & 7; uu[k] = *(const u32x4*)(REST + (size_t)(r0 + row) * NREST + 512 + g * 64 + c8 * 8); }
  f32x4 wa[2][4][2];
#pragma unroll
  for (int mt = 0; mt < 2; ++mt) {
    const float* wrow = w_s + (size_t)(wl * 32 + mt * 16 + fr) * 128 + 8 * g4;
#pragma unroll
    for (int ks = 0; ks < 4; ++ks) { wa[mt][ks][0] = *(const f32x4*)(wrow + 32 * ks); wa[mt][ks][1] = *(const f32x4*)(wrow + 32 * ks + 4); }
  }
  {
    float val[32]; float ss = 0.f;
#pragma unroll
    for (int e = 0; e < 32; ++e) {
      const unsigned wv = vv[e >> 3][(e & 7) >> 1];
      val[e] = gelu_fast(__uint_as_float((e & 1) ? (wv & 0xffff0000u) : (wv << 16))); ss += val[e] * val[e];
    }
    ss += __shfl_xor(ss, 1);
    const float rinv = rsqrtf(ss * (1.0f / 64.0f) + 1e-6f);
#pragma unroll
    for (int e = 0; e < 32; ++e) vnT[(q2 * 32 + e) * 136 + s_] = f2bf(val[e] * rinv * norm_g[q2 * 32 + e]);
#pragma unroll
    for (int k = 0; k < 4; ++k) { const int q = t + 256 * k, row = q >> 3, c8 = q & 7; *(u32x4*)(ut + row * 72 + c8 * 8) = uu[k]; }
  }
  __syncthreads();
#pragma unroll
  for (int mt = 0; mt < 2; ++mt) {
    bf16x8 af[4];
#pragma unroll
    for (int ks = 0; ks < 4; ++ks) af[ks] = pack8(wa[mt][ks][0], wa[mt][ks][1]);
    f32x4 acc[4];
#pragma unroll
    for (int nt = 0; nt < 4; ++nt) {
      acc[nt] = (f32x4){0.f, 0.f, 0.f, 0.f};
#pragma unroll
      for (int ks = 0; ks < 4; ++ks) {
        const bf16x8 bfr = *(const bf16x8*)(vnT + (nt * 16 + fr) * 136 + 32 * ks + 8 * g4);
        acc[nt] = __builtin_amdgcn_mfma_f32_16x16x32_bf16(af[ks], bfr, acc[nt], 0, 0, 0);
      }
    }
#pragma unroll
    for (int r = 0; r < 4; ++r) {
      const int tt = wl * 32 + mt * 16 + 4 * g4 + r;
      const float bb = b_s[tt];
#pragma unroll
      for (int nt = 0; nt < 4; ++nt) { bf16_t* e = ut + tt * 72 + nt * 16 + fr; *e = f2bf(gelu_fast(bf2f(*e)) * (acc[nt][r] + bb)); }
    }
  }
  __syncthreads();
#pragma unroll
  for (int k = 0; k < 4; ++k) { const int q = t + 256 * k, row = q >> 3, c8 = q & 7; *(u32x4*)(p.MIXB_() + (size_t)(r0 + row) * 1024 + 512 + g * 64 + c8 * 8) = *(const u32x4*)(ut + row * 72 + c8 * 8); }
  __syncthreads();
}

__device__ __forceinline__ void pool_item(const MP& p, int l, int blk, unsigned char* smem) {
  int tl = threadIdx.x; asm volatile("" : "+v"(tl)); const int t = tl, lane = tl & 63, w = __builtin_amdgcn_readfirstlane(tl >> 6), fr = lane & 15, g4 = lane >> 4;
  const bf16_t* REST = p.REST_(); const float* w_pool = p.w_pool + (size_t)l * 4 * 64 * 64; const float* scale = p.pool_scale + l * 256;
  const int r0 = blk * 64;
  int seg0, seglen;
  if (r0 < NCTX) { seg0 = r0 & ~255; seglen = 256; } else { seg0 = r0; seglen = 64; }
  bf16_t* xs = (bf16_t*)smem;
  bf16_t* dm = (bf16_t*)(smem + 42240);
  bf16_t* wT = (bf16_t*)(smem + 42240 + 36864);
  u32x4 xv[5];
#pragma unroll
  for (int k = 0; k < 5; ++k) {
    const int q = t + 512 * k, lr = q >> 5, c8 = q & 31, row = r0 - 8 + lr;
    xv[k] = (u32x4){0u, 0u, 0u, 0u};
    if (row >= seg0 && row < seg0 + seglen) xv[k] = *(const u32x4*)(REST + (size_t)row * NREST + 1024 + c8 * 8);
  }
  f32x4 wv[8];
#pragma unroll
  for (int k = 0; k < 8; ++k) wv[k] = *(const f32x4*)(w_pool + (size_t)(t + 512 * k) * 4);
#pragma unroll
  for (int k = 0; k < 5; ++k) { const int q = t + 512 * k, lr = q >> 5, c8 = q & 31; *(u32x4*)(xs + lr * 264 + c8 * 8) = xv[k]; }
#pragma unroll
  for (int k = 0; k < 8; ++k) {
    const int q = t + 512 * k, i = q >> 10, c = (q >> 4) & 63, d4 = (q & 15) * 4;
#pragma unroll
    for (int e = 0; e < 4; ++e) wT[(i * 64 + d4 + e) * 72 + c] = f2bf(wv[k][e]);
  }
  __syncthreads();
  {
    const int c = t & 255, i = c >> 6, win = 2 << i, ph = t >> 8, hw = win >> 1;
    const int xoff = seg0 - r0 + 8;
    int pos = r0 + ph * 32 - seg0;
    int lo = max(pos - hw, 0), hi = min(pos + hw, seglen);
    float s = 0.f;
    for (int q = lo; q < hi; ++q) s += bf2f(xs[(q + xoff) * 264 + c]);
#pragma unroll 4
    for (int pp = ph * 32; pp < ph * 32 + 32; ++pp) {
      dm[(i * 64 + pp) * 72 + (c & 63)] = f2bf(s * __builtin_amdgcn_rcpf((float)(hi - lo)) - bf2f(xs[(pp + 8) * 264 + c]));
      ++pos;
      const int lo2 = max(pos - hw, 0), hi2 = min(pos + hw, seglen);
      if (hi2 > hi) s += bf2f(xs[(hi + xoff) * 264 + c]);
      if (lo2 > lo) s -= bf2f(xs[(lo + xoff) * 264 + c]);
      lo = lo2; hi = hi2;
    }
  }
  __syncthreads();
  {
    const int i = w >> 1;
    bf16x8 bfr[4][2];
#pragma unroll
    for (int nt = 0; nt < 4; ++nt)
#pragma unroll
      for (int ks = 0; ks < 2; ++ks) bfr[nt][ks] = *(const bf16x8*)(wT + (i * 64 + nt * 16 + fr) * 72 + 32 * ks + 8 * g4);
#pragma unroll
    for (int pt2 = 0; pt2 < 2; ++pt2) {
      const int pt = (w & 1) * 2 + pt2;
      bf16x8 af[2];
#pragma unroll
      for (int ks = 0; ks < 2; ++ks) af[ks] = *(const bf16x8*)(dm + (i * 64 + pt * 16 + fr) * 72 + 32 * ks + 8 * g4);
#pragma unroll
      for (int nt = 0; nt < 4; ++nt) {
        f32x4 acc = (f32x4){0.f, 0.f, 0.f, 0.f};
#pragma unroll
        for (int ks = 0; ks < 2; ++ks) acc = __builtin_amdgcn_mfma_f32_16x16x32_bf16(af[ks], bfr[nt][ks], acc, 0, 0, 0);
        const float sc = scale[i * 64 + nt * 16 + fr];
#pragma unroll
        for (int r = 0; r < 4; ++r) xs[(pt * 16 + 4 * g4 + r) * 264 + i * 64 + nt * 16 + fr] = f2bf(acc[r] * sc);
      }
    }
  }
  __syncthreads();
#pragma unroll
  for (int k = 0; k < 4; ++k) { const int q = t + 512 * k, row = q >> 5, c8 = q & 31; *(u32x4*)(p.MIXB_() + (size_t)(r0 + row) * 1024 + 768 + c8 * 8) = *(const u32x4*)(xs + row * 264 + c8 * 8); }
  __syncthreads();
}

__device__ __forceinline__ void final_row(const MP& p, int r, int lane) {
  const float rinv = rsqrtf(p.rowss_()[4 * NTOK + r] * (1.0f / 1024.0f) + 1e-6f);
#pragma unroll
  for (int i = 0; i < 4; ++i) {
    const int d = i * 256 + lane * 4;
    const f32x4 v = *(const f32x4*)(p.X_() + (size_t)r * 1024 + d), gg = *(const f32x4*)(p.norm_f + d);
    *(f32x4*)(p.out + (size_t)r * 1024 + d) = v * rinv * gg;
  }
}

#ifndef REPEAT
#define REPEAT 0
#endif
#define REP_CAT2(a, b) a##b
#define REP_CAT(a, b) REP_CAT2(a, b)
#define REP(k) for (int REP_CAT(rep_, __LINE__) = 0; REP_CAT(rep_, __LINE__) < 1 + ((REPEAT >> (k)) & 1); ++REP_CAT(rep_, __LINE__))
#ifndef USE_CG_SYNC
#define USE_CG_SYNC 0
#endif
#if USE_CG_SYNC
#define GRID_SYNC() grid.sync()
#else
#define GRID_SYNC() do { REP(21) { XcdBarrier xb2; xb2.bar = p.bar_(); xb2.x = xb_xcc_id(); xb2.st = xst; xcd_barrier(xb2); } } while (0)
#endif

__global__ __launch_bounds__(512, 2) void mega(MP p) {
  extern __shared__ __attribute__((aligned(16))) unsigned char smem[];
#if USE_CG_SYNC
  cg::grid_group grid = cg::this_grid();
#else
  volatile LAS unsigned* xst = (volatile LAS unsigned*)((LAS unsigned char*)smem + MEGA_LDS_MAIN);
  if (threadIdx.x == 0) { xst[0] = 0u; xst[1] = 0u; }
  __syncthreads();
  (void)xcd_barrier_post(p.bar_(), xst);
#endif
  const int bid = blockIdx.x, nb = gridDim.x;
  bf16_t* XA = (bf16_t*)p.PRE_(); bf16_t* ACT = p.QKV_(); bf16_t* OB = p.QKV_();
  float* states_out = p.out + (size_t)NTOK * 1024;

  REP(0) phase_prep0(p, bid, nb, smem, false);
  GRID_SYNC();
  REP(1) { phase_prep0(p, bid, nb, smem, true); phase_vecs(p, bid, nb, smem); }
  REP(2) { int tl = threadIdx.x; asm volatile("" : "+v"(tl)); const int lane = tl & 63, w = tl >> 6;
    for (int r = bid * 8 + w; r < NTOK; r += nb * 8) prepx_row(p, r, lane); }
  GRID_SYNC();
  for (int l = 0; l < 2; ++l) {
#define TL_DECL int tl = threadIdx.x; asm volatile("" : "+v"(tl)); const int t = tl, lane = tl & 63, w = tl >> 6; (void)t; (void)lane; (void)w
    const float* ml = p.mods_() + l * 3 * 6144;
    float* rs1 = p.rowss_() + (2 * l) * NTOK; float* rs2 = p.rowss_() + (2 * l + 1) * NTOK; float* rs3 = p.rowss_() + (2 * l + 2) * NTOK;
    const float* A2 = p.AV_() + (l * 2 + 1) * 3 * 1024; const float* A1n = p.AV_() + (2 + 0) * 3 * 1024;
    REP(4) {
      pg8::Gemm g; g.A = XA; g.Bt = p.WTA_() + WT_IN; g.M = NTOK; g.N = NCOLS; g.K = 1024;
      EpiIn E{p.QKV_(), p.REST_(), rs1, p.BIN_() + l * 3 * NCOLS};
      pg8::StaticOrder S; S.init(g.M, g.N, nb, bid);
      pg8::gemm_phase<EpiIn, pg8::StaticOrder, true, true>((PG8_LAS unsigned char*)smem, g, S, E);
    }
    REP(3) if (bid >= 16) {
      phase_logits(p, l, bid - 16, nb - 16, smem);
      wtiles(p, l, 704, 2368, bid - 16, nb - 16, smem);
    }
    GRID_SYNC();
    REP(5) for (int item = bid; item < 768; item += nb) pre_item(item, p.QKV_(), p.LOG_(), p.conv_w + (size_t)l * 3 * NQKV, p.a_log + l * 8, p.dt_bias + l * 8, p.PRE_(), smem);
    GRID_SYNC();
    REP(6) { if (bid < 32) { REP(13) scan_dispatch(bid, p.PRE_(), p.state_delta, OB, states_out, l, smem); }
             else { REP(14) for (int i = bid - 32; i < 256; i += nb - 32) scan_dispatch(32 + i, p.PRE_(), p.state_delta, OB, states_out, l, smem); } }
    REP(12) if (bid >= 32) {
      for (int it = bid - 32; it < 192; it += nb - 32) sgu_pair(p, l, 2 * it, smem);
      for (int it = bid - 32; it < 192; it += nb - 32) pool_item(p, l, it, smem);
    }
    GRID_SYNC();
    REP(7) { TL_DECL; for (int r = bid * 8 + w; r < NTOK; r += nb * 8) delta_post_row(p, l, r, lane); }
    GRID_SYNC();
    {
      pg8::Gemm g; g.A = p.MIXB_(); g.Bt = p.WTA_() + WT_OUT; g.M = NTOK; g.N = 1024; g.K = 1024;
      EpiRes E{p.X_(), ml + 2048, rs2, XA, A2};
      pg8::StaticOrder S; S.init(g.M, g.N, nb, bid);
      pg8::gemm_phase<EpiRes, pg8::StaticOrder, true, true>((PG8_LAS unsigned char*)smem, g, S, E);
    }
    if (bid >= 192) wtiles(p, l, 2368, 3072, bid - 192, nb - 192, smem);
    GRID_SYNC();
    REP(9) {
      pg8::Gemm g; g.A = XA; g.Bt = p.WTA_() + WT_GU; g.M = NTOK; g.N = 2 * FFH; g.K = 1024;
      EpiGu E{ACT, rs2, p.BGU_() + l * 3 * 2 * FFH};
      GuOrder S; S.init(nb, bid, -1);
      pg8::gemm_phase<EpiGu, GuOrder, true, true>((PG8_LAS unsigned char*)smem, g, S, E);
    }
    GRID_SYNC();
    unsigned* gu_flag = p.bar_() + 3712 + l * 64;
#define GU_DEFERRED() do { for (int e = bid - 192; e < 48 - GU_DEFER_PM0; e += nb - 192) { \
      pg8::Gemm g; g.A = XA; g.Bt = p.WTA_() + WT_GU; g.M = NTOK; g.N = 2 * FFH; g.K = 1024; \
      EpiGu E{ACT, rs2, p.BGU_() + l * 3 * 2 * FFH}; \
      GuOrder S; S.init(nb, bid, GU_DEFER_PM0 + e); \
      pg8::gemm_phase<EpiGu, GuOrder, true, true>((PG8_LAS unsigned char*)smem, g, S, E); \
      asm volatile("s_waitcnt vmcnt(0)" ::: "memory"); \
      __syncthreads();                                                           \
      if (threadIdx.x == 0) { \
        __builtin_amdgcn_fence(__ATOMIC_RELEASE, "agent");                       \
        asm volatile("s_waitcnt vmcnt(0)" ::: "memory"); \
        __hip_atomic_store(gu_flag + GU_DEFER_PM0 + e, 1u, __ATOMIC_RELAXED, __HIP_MEMORY_SCOPE_AGENT); \
      } \
      __syncthreads(); } } while (0)
    if (l == 0) {
      pg8::Gemm g; g.A = ACT; g.Bt = p.WTA_() + WT_DOWN; g.M = NTOK; g.N = 1024; g.K = FFH;
      EpiRes E{p.X_(), ml + 5120, rs3, XA, A1n};
      DownOrder S; S.S.init(g.M, g.N, nb, bid); S.flag = gu_flag;
      pg8::gemm_phase<EpiRes, DownOrder, true, true>((PG8_LAS unsigned char*)smem, g, S, E);
      if (bid >= 192) { GU_DEFERRED(); wtiles(p, 1, 0, 704, bid - 192, nb - 192, smem); }
      GRID_SYNC();
    } else {
      pg8::Gemm g; g.A = ACT; g.Bt = p.WTA_() + WT_DOWN; g.M = NTOK; g.N = 1024; g.K = FFH;
      EpiResFinal E{p.X_(), ml + 5120, p.out, p.norm_f, p.SLOT_(), p.bar_() + 3584};
      DownOrder S; S.S.init(g.M, g.N, nb, bid); S.flag = gu_flag;
      pg8::gemm_phase<EpiResFinal, DownOrder, false, true>((PG8_LAS unsigned char*)smem, g, S, E);
      if (bid >= 192) GU_DEFERRED();
    }
  }
}

extern "C" void kernel_launch(void* const* d_in, const int* in_sizes, int n_in, void* d_out, int out_size, void* d_ws, size_t ws_size,
                              hipStream_t stream) {
  static int grid_blocks = 0;
  if (!grid_blocks) {
    int dev = 0, cus = 0, per_cu = 0;
    (void)hipGetDevice(&dev);
    (void)hipDeviceGetAttribute(&cus, hipDeviceAttributeMultiprocessorCount, dev);
    (void)hipFuncSetAttribute((const void*)mega, hipFuncAttributeMaxDynamicSharedMemorySize, MEGA_LDS);
    (void)hipOccupancyMaxActiveBlocksPerMultiprocessor(&per_cu, (const void*)mega, 512, MEGA_LDS);
    if (per_cu < 1) { fprintf(stderr, "occupancy query says %d blocks per CU\n", per_cu); per_cu = 1; }
    if (per_cu > 1) per_cu = 1;
    grid_blocks = cus * per_cu;
    if (grid_blocks > 256) grid_blocks = 256;
  }
  MP p; memset(&p, 0, sizeof p);
  const float** ins = (const float**)&p;
  for (int i = 0; i < 23; ++i) ins[i] = (const float*)d_in[i];
  p.out = (float*)d_out;
  p.ws = (unsigned char*)d_ws;
  if (WS_END > ws_size) { fprintf(stderr, "workspace too small: need %zu have %zu\n", (size_t)WS_END, ws_size); return; }
  (void)hipMemsetAsync((char*)d_ws + WS_BAR, 0, 16384, stream);
  void* args[] = {&p};
  hipError_t e = hipLaunchCooperativeKernel((const void*)mega, dim3(grid_blocks), dim3(512), args, MEGA_LDS, stream);
  if (e != hipSuccess) fprintf(stderr, "cooperative launch failed: %s (grid %d)\n", hipGetErrorString(e), grid_blocks);
}
```

```cpp
#include <hip/hip_runtime.h>
#include <math.h>
#include <cstdio>
#include <cstring>

#define NTOK 12288
#define NCTX 8192
#define DM 1024
#define INC 2832
#define FFH 2816
#define NQKV 1536
#define NREST 1280
#define NCOLS 2816

typedef unsigned short bf16_t;
typedef float f32x2_cv __attribute__((ext_vector_type(2)));
typedef __bf16 bf16x2_cv __attribute__((ext_vector_type(2)));
__device__ __forceinline__ unsigned pack_bf16(float lo, float hi) { return __builtin_bit_cast(unsigned, __builtin_convertvector((f32x2_cv){lo, hi}, bf16x2_cv)); }
__device__ __forceinline__ bf16_t f2bf(float f) { return (bf16_t)(pack_bf16(f, 0.f) & 0xffffu); }
__device__ __forceinline__ float bf2f(bf16_t b) { return __uint_as_float(((unsigned)b) << 16); }
__device__ __forceinline__ float silu_f(float x) { return x / (1.f + expf(-x)); }
__device__ __forceinline__ float silu_fast(float x) { return x * __builtin_amdgcn_rcpf(1.f + __expf(-x)); }
__device__ __forceinline__ float gelu_fast(float x) { const float u = 1.5957691216057308f * (x + 0.044715f * x * x * x); return x * __builtin_amdgcn_rcpf(1.f + __expf(-u)); }
__device__ __forceinline__ float sigmoid_f(float x) { return 1.f / (1.f + expf(-x)); }
__device__ __forceinline__ float gelu_f(float x) { return 0.5f * x * (1.f + tanhf(0.7978845608028654f * (x + 0.044715f * x * x * x))); }
__device__ __forceinline__ float softplus_f(float x) { return x > 20.f ? x : log1pf(expf(x)); }
__device__ __forceinline__ int seg_of_row(int r) { return r < NCTX ? 0 : 1 + ((r - NCTX) >> 11); }
__device__ __forceinline__ float wave_sum(float v) {
#pragma unroll
  for (int o = 32; o > 0; o >>= 1) v += __shfl_xor(v, o);
  return v;
}
namespace pg8 {
#define PG8_LAS __attribute__((address_space(3)))
typedef unsigned short bf16_t;
typedef short bf16x8 __attribute__((ext_vector_type(8)));
typedef float f32x4 __attribute__((ext_vector_type(4)));
typedef unsigned u32x4 __attribute__((ext_vector_type(4)));
constexpr int BM = 256, BK = 64, HALF = 128, HTB = HALF * BK * 2  , STAGE_BYTES = 8 * HTB, NXCD = 8, WGM = 8;

__host__ __device__ __forceinline__ int lds_byte(int r, int c) { const int st = (r >> 4) * 2 + (c >> 5), rr = r & 15, cc = c & 31, ob = rr * 64 + cc * 2; return st * 1024 + (ob ^ (((ob >> 9) & 1) << 5)); }
__host__ __device__ __forceinline__ void stage_rc(int b, int& R, int& C) { const int st = b / 1024, sb = b % 1024, swz = sb ^ (((sb >> 9) & 1) << 5); R = (st >> 1) * 16 + swz / 64; C = (st & 1) * 32 + (swz % 64) / 2; }
__host__ __device__ __forceinline__ int perm32(int rho) { const int n = rho >> 4, i = rho & 15; return 8 * (i >> 2) + 4 * n + (i & 3); }

struct Unit { int pm, pn; };
struct Gemm { const bf16_t* A; const bf16_t* Bt; int M, N, K; };

struct StaticOrder {
    int nM, nN, nwg, G, c;
    __host__ __device__ void init(int M, int N, int G_, int c_) { nM = M / BM; nN = N / BM; nwg = nM * nN; G = G_; c = c_; }
    __host__ __device__ bool next(int i, Unit& u) const {
        const long L = (long)i * G + c; if (L >= nwg) return false;
        int wgid = (int)L; { const int q = nwg / NXCD, r = nwg % NXCD, xcd = wgid % NXCD, off = wgid / NXCD; wgid = (xcd < r ? xcd * (q + 1) : r * (q + 1) + (xcd - r) * q) + off; }
        const int nig = WGM * nN, gid = wgid / nig, fm = gid * WGM, gsz = (nM - fm) < WGM ? (nM - fm) : WGM;
        u.pm = fm + ((wgid % nig) % gsz); u.pn = (wgid % nig) / gsz; return true;
    }
    __device__ __forceinline__ void a_ready(const Unit&) const {}
    __device__ __forceinline__ void done(const Unit&) const {}
    static constexpr bool KWAIT = false;
    __device__ __forceinline__ bool k_wait(const Unit&) const { return false; }
};

__device__ __forceinline__ unsigned cvt_pk_bf16(float lo, float hi) { return ::pack_bf16(lo, hi); }
template <class Epi, class Sched, bool ALIGN_EPI = false, bool SP2 = false>
__device__ __forceinline__ void gemm_phase(PG8_LAS unsigned char* lds, const Gemm g, const Sched& S, const Epi& E) {
    int tid_ = threadIdx.x; asm volatile("" : "+v"(tid_));
    const int tid = tid_, wid = __builtin_amdgcn_readfirstlane(tid >> 6), lane = tid & 63, wr = wid >> 2, wc = wid & 3, fr = lane & 15, fq = lane >> 4;
    const int K = g.K, nt = K / BK;
    unsigned voffA[2], voffB[2];
#pragma unroll
    for (int i = 0; i < 2; ++i) { int R, C; stage_rc(tid * 16 + i * 8192, R, C); const int Rb = Epi::PERM ? ((R & ~31) + perm32(R & 31)) : R;
        voffA[i] = (unsigned)(R * K + C) * 2u; voffB[i] = (unsigned)(Rb * K + C) * 2u; }
    const size_t kstep = (size_t)(BK * 2);
    const size_t hstep = (size_t)HALF * K * 2;
    const size_t tstep = 2 * hstep;
    const unsigned ldsw = (unsigned)wid * 1024u;
    const int aoff = lds_byte(wr * 64 + fr, fq * 8), boff = lds_byte(wc * 32 + fr, fq * 8);
#define PG8_SA(b, h) (((b) * 2 + (h)) * HTB)
#define PG8_SB(b, h) ((4 + (b) * 2 + (h)) * HTB)
#define PG8_STAGE(bufoff, gbase, voff) do { _Pragma("unroll") for (int _i = 0; _i < 2; ++_i) \
        __builtin_amdgcn_global_load_lds((const unsigned*)((const char*)(gbase) + (voff)[_i]), (PG8_LAS unsigned*)(lds + (bufoff) + ldsw + _i * 8192), 16, 0, 0); } while (0)
#define PG8_STAGE_SC1(bufoff, gbase, voff) do { _Pragma("unroll") for (int _i = 0; _i < 2; ++_i) \
        __builtin_amdgcn_global_load_lds((const unsigned*)((const char*)(gbase) + (voff)[_i]), (PG8_LAS unsigned*)(lds + (bufoff) + ldsw + _i * 8192), 16, 0, 16); } while (0)
#define PG8_STAGE_A(dep, bufoff, gbase) do { if constexpr (Sched::KWAIT) { if (dep) PG8_STAGE_SC1(bufoff, gbase, voffA); else PG8_STAGE(bufoff, gbase, voffA); } else PG8_STAGE(bufoff, gbase, voffA); } while (0)
#define PG8_LDA(dst, b, h) do { _Pragma("unroll") for (int m = 0; m < 4; ++m) _Pragma("unroll") for (int k = 0; k < 2; ++k) dst[m][k] = *(const PG8_LAS bf16x8*)(lds + PG8_SA(b, h) + aoff + m * 2048 + k * 1024); } while (0)
#define PG8_LDB(dst, b, h) do { _Pragma("unroll") for (int n = 0; n < 2; ++n) _Pragma("unroll") for (int k = 0; k < 2; ++k) dst[n][k] = *(const PG8_LAS bf16x8*)(lds + PG8_SB(b, h) + boff + n * 2048 + k * 1024); } while (0)
#define PG8_MMA(ai, bj, At, Bt) do { __builtin_amdgcn_s_setprio(1); _Pragma("unroll") for (int m = 0; m < 4; ++m) _Pragma("unroll") for (int n = 0; n < 2; ++n) _Pragma("unroll") for (int k = 0; k < 2; ++k) \
        acc[ai][bj][m][n] = __builtin_amdgcn_mfma_f32_16x16x32_bf16(Bt[n][k], At[m][k], acc[ai][bj][m][n], 0, 0, 0); PG8_XMMA(ai, bj, At); __builtin_amdgcn_s_setprio(0); } while (0)
#ifdef XMMA
#define PG8_XMMA(ai, bj, At) do { _Pragma("unroll") for (int m = 0; m < 4; ++m) _Pragma("unroll") for (int n = 0; n < 2; ++n) acc[ai][bj][m][n] = __builtin_amdgcn_mfma_f32_16x16x32_bf16(zerov, At[m][0], acc[ai][bj][m][n], 0, 0, 0); } while (0)
#else
#define PG8_XMMA(ai, bj, At) do { } while (0)
#endif
#define PG8_WAIT_V(n) asm volatile("s_waitcnt vmcnt(" #n ")" ::: "memory")
#define PG8_WAIT_L(n) asm volatile("s_waitcnt lgkmcnt(" #n ")" ::: "memory")
#define PG8_BAR __builtin_amdgcn_s_barrier()
#define PG8_SCHED __builtin_amdgcn_sched_barrier(0)
    Unit cur, nxt; int ui = 0;
    if (!S.next(0, cur)) return;
    f32x4 acc[2][2][4][2];
#pragma unroll
    for (int a = 0; a < 2; ++a)
#pragma unroll
        for (int b = 0; b < 2; ++b)
#pragma unroll
            for (int m = 0; m < 4; ++m)
#pragma unroll
                for (int n = 0; n < 2; ++n) acc[a][b][m][n] = (f32x4){0.f, 0.f, 0.f, 0.f};
    bf16x8 At[4][2], B0[2][2], B1[2][2];
#ifdef XMMA
    bf16x8 zerov = (bf16x8){0, 0, 0, 0, 0, 0, 0, 0}; asm volatile("" : "+v"(zerov));
#endif
    const char* cA = (const char*)g.A + (size_t)cur.pm * tstep; const char* cB = (const char*)g.Bt + (size_t)cur.pn * tstep;
    S.a_ready(cur);
    if constexpr (SP2) {
        PG8_STAGE(PG8_SB(0, 0), cB, voffB); PG8_STAGE(PG8_SB(0, 1), cB + hstep, voffB); PG8_STAGE(PG8_SA(0, 0), cA, voffA); PG8_STAGE(PG8_SA(0, 1), cA + hstep, voffA);
        if (wr == 1) PG8_BAR;
        PG8_WAIT_V(2); PG8_BAR;
        PG8_STAGE(PG8_SB(1, 0), cB + kstep, voffB); PG8_STAGE(PG8_SA(1, 0), cA + kstep, voffA); PG8_STAGE(PG8_SB(1, 1), cB + hstep + kstep, voffB);
        PG8_WAIT_V(6); PG8_BAR;
    } else {
        PG8_STAGE(PG8_SB(0, 0), cB, voffB); PG8_STAGE(PG8_SA(0, 0), cA, voffA); PG8_STAGE(PG8_SB(0, 1), cB + hstep, voffB); PG8_STAGE(PG8_SA(0, 1), cA + hstep, voffA);
        if (wr == 1) PG8_BAR;
        PG8_WAIT_V(4); PG8_BAR;
        PG8_STAGE(PG8_SB(1, 0), cB + kstep, voffB); PG8_STAGE(PG8_SA(1, 0), cA + kstep, voffA); PG8_STAGE(PG8_SB(1, 1), cB + hstep + kstep, voffB);
        PG8_WAIT_V(6); PG8_BAR;
    }
    static_assert(!Sched::KWAIT || SP2, "KWAIT schedulers: SP2 loop only");
    bool dep_unit = false;
    for (;;) {
        const bool has_next = S.next(ui + 1, nxt);
        const char* nA = has_next ? (const char*)g.A + (size_t)nxt.pm * tstep : cA; const char* nB = has_next ? (const char*)g.Bt + (size_t)nxt.pn * tstep : cB;
        for (int t = 0; t < nt; t += 2) {
            bool dep23 = false, dep1 = false;
            if constexpr (Sched::KWAIT) { if (t == nt - 4) dep_unit = S.k_wait(cur); dep23 = dep_unit && (t == nt - 4); dep1 = dep_unit && (t == nt - 2); }
            const bool last = (t == nt - 2);
            const char* a1 = cA + (size_t)(t + 1) * kstep;
            const char* a2 = last ? nA : cA + (size_t)(t + 2) * kstep; const char* b2 = last ? nB : cB + (size_t)(t + 2) * kstep;
            const char* a3 = a2 + kstep; const char* b3 = b2 + kstep;
            if (last && has_next) S.a_ready(nxt);
            if constexpr (SP2) {
            PG8_LDB(B0, 0, 0); PG8_LDB(B1, 0, 1); PG8_SCHED; PG8_LDA(At, 0, 0); PG8_STAGE_A(dep1, PG8_SA(1, 1), a1 + hstep);
            PG8_WAIT_V(8); PG8_WAIT_L(0); PG8_BAR; PG8_MMA(0, 0, At, B0); PG8_MMA(0, 1, At, B1); PG8_BAR; PG8_SCHED;
            PG8_LDA(At, 0, 1); PG8_STAGE(PG8_SB(0, 0), b2, voffB); PG8_STAGE(PG8_SB(0, 1), b2 + hstep, voffB); PG8_STAGE_A(dep23, PG8_SA(0, 0), a2);
            PG8_WAIT_V(8); PG8_WAIT_L(0); PG8_BAR; PG8_MMA(1, 0, At, B0); PG8_MMA(1, 1, At, B1); PG8_BAR; PG8_SCHED;
            PG8_LDB(B0, 1, 0); PG8_LDB(B1, 1, 1); PG8_SCHED; PG8_LDA(At, 1, 0); PG8_STAGE_A(dep23, PG8_SA(0, 1), a2 + hstep);
            PG8_WAIT_V(8); PG8_WAIT_L(0); PG8_BAR; PG8_MMA(0, 0, At, B0); PG8_MMA(0, 1, At, B1); PG8_BAR; PG8_SCHED;
            PG8_LDA(At, 1, 1); PG8_STAGE(PG8_SB(1, 0), b3, voffB); PG8_STAGE(PG8_SB(1, 1), b3 + hstep, voffB); PG8_STAGE_A(dep23, PG8_SA(1, 0), a3);
            PG8_WAIT_V(8); PG8_WAIT_L(0); PG8_BAR; PG8_MMA(1, 0, At, B0); PG8_MMA(1, 1, At, B1); PG8_BAR; PG8_SCHED;
            } else {
            PG8_LDB(B0, 0, 0); PG8_SCHED; PG8_LDA(At, 0, 0); PG8_STAGE(PG8_SA(1, 1), a1 + hstep, voffA);
            PG8_WAIT_L(8); PG8_BAR; PG8_WAIT_L(0); PG8_MMA(0, 0, At, B0); PG8_BAR; PG8_SCHED;
            PG8_LDB(B1, 0, 1); PG8_STAGE(PG8_SB(0, 0), b2, voffB);
            PG8_BAR; PG8_WAIT_L(0); PG8_MMA(0, 1, At, B1); PG8_BAR;
            PG8_LDA(At, 0, 1); PG8_STAGE(PG8_SA(0, 0), a2, voffA);
            PG8_BAR; PG8_WAIT_L(0); PG8_MMA(1, 0, At, B0); PG8_BAR; PG8_SCHED;
            PG8_STAGE(PG8_SB(0, 1), b2 + hstep, voffB);
            PG8_WAIT_V(6); PG8_BAR; PG8_MMA(1, 1, At, B1); PG8_BAR;
            PG8_LDB(B0, 1, 0); PG8_SCHED; PG8_LDA(At, 1, 0); PG8_STAGE(PG8_SA(0, 1), a2 + hstep, voffA);
            PG8_WAIT_L(8); PG8_BAR; PG8_WAIT_L(0); PG8_MMA(0, 0, At, B0); PG8_BAR; PG8_SCHED;
            PG8_LDB(B1, 1, 1); PG8_STAGE(PG8_SB(1, 0), b3, voffB);
            PG8_BAR; PG8_WAIT_L(0); PG8_MMA(0, 1, At, B1); PG8_BAR;
            PG8_LDA(At, 1, 1); PG8_STAGE(PG8_SA(1, 0), a3, voffA);
            PG8_BAR; PG8_WAIT_L(0); PG8_MMA(1, 0, At, B0); PG8_BAR; PG8_SCHED;
            PG8_STAGE(PG8_SB(1, 1), b3 + hstep, voffB);
            PG8_WAIT_V(6); PG8_BAR; PG8_MMA(1, 1, At, B1); PG8_BAR;
            }
        }
        if constexpr (ALIGN_EPI) { if (wr == 0) PG8_BAR; }
        if constexpr (!Epi::AFTER_DRAIN) { E(acc, cur, wr, wc, fr, fq); S.done(cur); }
        if (!has_next) break;
#pragma unroll
        for (int a = 0; a < 2; ++a)
#pragma unroll
            for (int b = 0; b < 2; ++b)
#pragma unroll
                for (int m = 0; m < 4; ++m)
#pragma unroll
                    for (int n = 0; n < 2; ++n) acc[a][b][m][n] = (f32x4){0.f, 0.f, 0.f, 0.f};
        cur = nxt; cA = nA; cB = nB; ++ui;
        if constexpr (ALIGN_EPI) { if (wr == 1) PG8_BAR; }
    }
    PG8_WAIT_V(0);
    if constexpr (!ALIGN_EPI) { if (wr == 0) PG8_BAR; }
    PG8_BAR;
    if constexpr (Epi::AFTER_DRAIN) { E.fused(acc, cur, wr, wc, fr, fq, lds, wid, lane); S.done(cur); }
#undef PG8_SA
#undef PG8_SB
#undef PG8_STAGE
#undef PG8_STAGE_SC1
#undef PG8_STAGE_A
#undef PG8_LDA
#undef PG8_LDB
#undef PG8_MMA
#undef PG8_XMMA
#undef PG8_WAIT_V
#undef PG8_WAIT_L
#undef PG8_BAR
#undef PG8_SCHED
}
}

using pg8::f32x4; using pg8::u32x4; using pg8::Unit; using pg8::HALF; using pg8::BM;
typedef unsigned u32x2 __attribute__((ext_vector_type(2)));

struct EpiIn {
  static constexpr bool PERM = true, AFTER_DRAIN = false;
  bf16_t* qkv; bf16_t* rest; const float* rowss; const float* bias;
  __device__ __forceinline__ void operator()(const f32x4 (&acc)[2][2][4][2], const Unit& u, int wr, int wc, int fr, int fq) const {
    const int row0 = u.pm * BM + wr * 64 + fr;
    const int seg = seg_of_row(u.pm * BM);
    int colt = u.pn * BM; bf16_t* base = qkv; int ldc = NQKV;
    if (colt >= NQKV) { base = rest; ldc = NREST; colt -= NQKV; }
    const int col0 = colt + wc * 32 + 8 * fq, bcol0 = seg * NCOLS + u.pn * BM + wc * 32 + 8 * fq;
    f32x4 bv[2][2];
#pragma unroll
    for (int bj = 0; bj < 2; ++bj)
#pragma unroll
      for (int n = 0; n < 2; ++n) bv[bj][n] = *(const f32x4*)(bias + bcol0 + bj * HALF + 4 * n);
#pragma unroll
    for (int ai = 0; ai < 2; ++ai)
#pragma unroll
      for (int m = 0; m < 4; ++m) {
        const int r = row0 + ai * HALF + m * 16;
        const float rinv = rsqrtf(rowss[r] * (1.0f / 1024.0f) + 1e-6f);
        bf16_t* rowp = base + (size_t)r * ldc + col0;
#pragma unroll
        for (int bj = 0; bj < 2; ++bj) {
          const f32x4 v0 = acc[ai][bj][m][0] * rinv + bv[bj][0], v1 = acc[ai][bj][m][1] * rinv + bv[bj][1];
          u32x4 w; w.x = pg8::cvt_pk_bf16(v0[0], v0[1]); w.y = pg8::cvt_pk_bf16(v0[2], v0[3]); w.z = pg8::cvt_pk_bf16(v1[0], v1[1]); w.w = pg8::cvt_pk_bf16(v1[2], v1[3]);
          *(u32x4*)(rowp + bj * HALF) = w;
        }
      }
  }
};

struct EpiRes {
  static constexpr bool PERM = false, AFTER_DRAIN = false;
  float* X; const float* gate; float* rowss; bf16_t* xa; const float* An;
  __device__ __forceinline__ void operator()(const f32x4 (&acc)[2][2][4][2], const Unit& u, int wr, int wc, int fr, int fq) const {
    const int row0 = u.pm * BM + wr * 64 + fr, col0 = u.pn * BM + wc * 32 + 4 * fq;
    const int seg = seg_of_row(u.pm * BM);
    f32x4 gv[2][2], av[2][2];
#pragma unroll
    for (int bj = 0; bj < 2; ++bj)
#pragma unroll
      for (int n = 0; n < 2; ++n) {
        gv[bj][n] = *(const f32x4*)(gate + seg * 6144 + col0 + bj * HALF + n * 16);
        av[bj][n] = xa ? *(const f32x4*)(An + seg * 1024 + col0 + bj * HALF + n * 16) : (f32x4){0.f, 0.f, 0.f, 0.f};
      }
#pragma unroll
    for (int ai = 0; ai < 2; ++ai)
#pragma unroll
      for (int m = 0; m < 4; ++m) {
        const int r = row0 + ai * HALF + m * 16;
        float* xrow = X + (size_t)r * 1024 + col0;
        float ss = 0.f;
#pragma unroll
        for (int bj = 0; bj < 2; ++bj)
#pragma unroll
          for (int n = 0; n < 2; ++n) {
            const f32x4 xo = *(const f32x4*)(xrow + bj * HALF + n * 16);
            const f32x4 xn = xo + gv[bj][n] * acc[ai][bj][m][n];
            *(f32x4*)(xrow + bj * HALF + n * 16) = xn;
            ss += (xn[0] * xn[0] + xn[1] * xn[1]) + (xn[2] * xn[2] + xn[3] * xn[3]);
            if (xa) {
              const f32x4 t = xn * av[bj][n];
              u32x2 w; w.x = pg8::cvt_pk_bf16(t[0], t[1]); w.y = pg8::cvt_pk_bf16(t[2], t[3]);
              *(u32x2*)(xa + (size_t)r * 1024 + col0 + bj * HALF + n * 16) = w;
            }
          }
        ss += __shfl_xor(ss, 16); ss += __shfl_xor(ss, 32);
        if (fq == 0) atomicAdd(rowss + r, ss);
      }
  }
};

struct EpiGu {
  static constexpr bool PERM = true, AFTER_DRAIN = false;
  bf16_t* act; const float* rowss; const float* bias;
  __device__ __forceinline__ void operator()(const f32x4 (&acc)[2][2][4][2], const Unit& u, int wr, int wc, int fr, int fq) const {
    const int row0 = u.pm * BM + wr * 64 + fr;
    const int seg = seg_of_row(u.pm * BM);
    const int hid0 = u.pn * HALF + wc * 32 + 8 * fq, bcol0 = seg * (2 * FFH) + u.pn * BM + wc * 32 + 8 * fq;
    f32x4 bv[2][2];
#pragma unroll
    for (int bj = 0; bj < 2; ++bj)
#pragma unroll
      for (int n = 0; n < 2; ++n) bv[bj][n] = *(const f32x4*)(bias + bcol0 + bj * HALF + 4 * n);
#pragma unroll
    for (int ai = 0; ai < 2; ++ai)
#pragma unroll
      for (int m = 0; m < 4; ++m) {
        const int r = row0 + ai * HALF + m * 16;
        const float rinv = rsqrtf(rowss[r] * (1.0f / 1024.0f) + 1e-6f);
        float o[8];
#pragma unroll
        for (int n = 0; n < 2; ++n) {
          const f32x4 g = acc[ai][0][m][n] * rinv + bv[0][n], up = acc[ai][1][m][n] * rinv + bv[1][n];
#pragma unroll
          for (int j = 0; j < 4; ++j) o[n * 4 + j] = g[j] * __builtin_amdgcn_rcpf(1.f + __expf(-g[j])) * up[j];
        }
        u32x4 w; w.x = pg8::cvt_pk_bf16(o[0], o[1]); w.y = pg8::cvt_pk_bf16(o[2], o[3]); w.z = pg8::cvt_pk_bf16(o[4], o[5]); w.w = pg8::cvt_pk_bf16(o[6], o[7]);
        *(u32x4*)(act + (size_t)r * FFH + hid0) = w;
      }
  }
};


struct EpiResFinal {
  static constexpr bool PERM = false, AFTER_DRAIN = true;
  const float* X; const float* gate; float* out; const float* normf; float* slots; unsigned* cnt;
  __device__ __forceinline__ void operator()(const f32x4 (&)[2][2][4][2], const Unit&, int, int, int, int) const {}
  __device__ __forceinline__ void fused(f32x4 (&acc)[2][2][4][2], const Unit& u, int wr, int wc, int fr, int fq, PG8_LAS unsigned char* lds, int wid, int lane) const {
    PG8_LAS float* P = (PG8_LAS float*)lds;
    PG8_LAS float* R = (PG8_LAS float*)(lds + 4096);
    const int row0 = u.pm * BM + wr * 64 + fr, col0 = u.pn * BM + wc * 32 + 4 * fq;
    const int seg = seg_of_row(u.pm * BM);
    f32x4 gv[2][2];
#pragma unroll
    for (int bj = 0; bj < 2; ++bj)
#pragma unroll
      for (int n = 0; n < 2; ++n) gv[bj][n] = *(const f32x4*)(gate + seg * 6144 + col0 + bj * HALF + n * 16);
#pragma unroll
    for (int ai = 0; ai < 2; ++ai)
#pragma unroll
      for (int m = 0; m < 4; ++m) {
        const int r = row0 + ai * HALF + m * 16;
        const float* xrow = X + (size_t)r * 1024 + col0;
        float ss = 0.f;
#pragma unroll
        for (int bj = 0; bj < 2; ++bj)
#pragma unroll
          for (int n = 0; n < 2; ++n) {
            const f32x4 xo = *(const f32x4*)(xrow + bj * HALF + n * 16);
            const f32x4 xn = xo + gv[bj][n] * acc[ai][bj][m][n];
            acc[ai][bj][m][n] = xn;
            ss += (xn[0] * xn[0] + xn[1] * xn[1]) + (xn[2] * xn[2] + xn[3] * xn[3]);
          }
        ss += __shfl_xor(ss, 16); ss += __shfl_xor(ss, 32);
        if (fq == 0) P[(ai * HALF + wr * 64 + m * 16 + fr) * 4 + wc] = ss;
      }
    __syncthreads();
    const int tid = wid * 64 + lane;
    if (tid < 256) {
      const float s = (P[tid * 4 + 0] + P[tid * 4 + 1]) + (P[tid * 4 + 2] + P[tid * 4 + 3]);
      __hip_atomic_store(slots + (size_t)(u.pm * 4 + u.pn) * 256 + tid, s, __ATOMIC_RELAXED, __HIP_MEMORY_SCOPE_AGENT);
    }
    asm volatile("s_waitcnt vmcnt(0)" ::: "memory");
    __syncthreads();
    if (tid == 0) {
      (void)__hip_atomic_fetch_add(cnt + u.pm, 1u, __ATOMIC_RELAXED, __HIP_MEMORY_SCOPE_AGENT);
      unsigned sp = 0u;
      while (__hip_atomic_load(cnt + u.pm, __ATOMIC_RELAXED, __HIP_MEMORY_SCOPE_AGENT) < 4u) { __builtin_amdgcn_s_sleep(1); if (++sp > (1u << 22)) break; }
      __builtin_amdgcn_fence(__ATOMIC_ACQUIRE, "agent");
      asm volatile("s_waitcnt vmcnt(0)" ::: "memory");
    }
    __syncthreads();
    if (tid < 256) {
      float tot = 0.f;
#pragma unroll
      for (int k = 0; k < 4; ++k) tot += __hip_atomic_load(slots + (size_t)(u.pm * 4 + k) * 256 + tid, __ATOMIC_RELAXED, __HIP_MEMORY_SCOPE_AGENT);
      R[tid] = rsqrtf(tot * (1.0f / 1024.0f) + 1e-6f);
    }
    __syncthreads();
    f32x4 nf[2][2];
#pragma unroll
    for (int bj = 0; bj < 2; ++bj)
#pragma unroll
      for (int n = 0; n < 2; ++n) nf[bj][n] = *(const f32x4*)(normf + col0 + bj * HALF + n * 16);
#pragma unroll
    for (int ai = 0; ai < 2; ++ai)
#pragma unroll
      for (int m = 0; m < 4; ++m) {
        const int lr = ai * HALF + wr * 64 + m * 16 + fr;
        const float rinv = R[lr];
        float* orow = out + (size_t)(u.pm * BM + lr) * 1024 + col0;
#pragma unroll
        for (int bj = 0; bj < 2; ++bj)
#pragma unroll
          for (int n = 0; n < 2; ++n) *(f32x4*)(orow + bj * HALF + n * 16) = acc[ai][bj][m][n] * rinv * nf[bj][n];
      }
  }
};

#define GU_DEFER_PM0 16
struct GuOrder {
  static constexpr bool KWAIT = false;
  pg8::StaticOrder S; int solo;
  __device__ __forceinline__ void init(int G, int c, int solo_) { S.nM = NTOK / pg8::BM; S.nN = 21; S.nwg = S.nM * 21; S.G = G; S.c = c; solo = solo_; }
  __device__ __forceinline__ bool next(int i, pg8::Unit& u) const {
    if (solo >= 0) { if (i) return false; u.pm = solo; u.pn = 21; return true; }
    if (S.next(i, u)) return true;
    const long L = (long)i * S.G + S.c - S.nwg;
    if (L < GU_DEFER_PM0) { u.pm = (int)L; u.pn = 21; return true; }
    return false;
  }
  __device__ __forceinline__ void a_ready(const pg8::Unit&) const {}
  __device__ __forceinline__ void done(const pg8::Unit&) const {}
  __device__ __forceinline__ bool k_wait(const pg8::Unit&) const { return false; }
};
#ifndef DOWN_KWAIT
#define DOWN_KWAIT true
#endif
struct DownOrder {
  static constexpr bool KWAIT = DOWN_KWAIT;
  pg8::StaticOrder S; unsigned* flag;
  __device__ __forceinline__ bool next(int i, pg8::Unit& u) const { return S.next(i, u); }
  __device__ __forceinline__ void a_ready(const pg8::Unit&) const {}
  __device__ __forceinline__ void done(const pg8::Unit&) const {}
  __device__ __forceinline__ bool k_wait(const pg8::Unit& u) const {
    if (u.pm < GU_DEFER_PM0) return false;
    unsigned sp = 0u;
    while (__builtin_amdgcn_readfirstlane(__hip_atomic_load(flag + u.pm, __ATOMIC_RELAXED, __HIP_MEMORY_SCOPE_AGENT)) == 0u) { __builtin_amdgcn_s_sleep(1); if (++sp > (1u << 22)) break; }
    asm volatile("" ::: "memory");
    return true;
  }
};

__device__ __forceinline__ int win_srccol(int j) { return j < 2048 ? j : j + 16; }
__device__ __forceinline__ int wgu_srccol(int j) { const int pn = j >> 8, w = j & 255; return w < 128 ? pn * 128 + w : FFH + pn * 128 + (w - 128); }

__device__ __forceinline__ void transpose_tile(const float* __restrict__ src, int ldsrc, int srccol0, bf16_t* __restrict__ dst, int K, int j0, int k0, float* tile, int t,
                                               const float* __restrict__ shv, float* __restrict__ bias, int bstride) {
  const int jl = t & 63, kg = t >> 6;
#pragma unroll
  for (int i = 0; i < 16; ++i) { const int k = kg * 16 + i; tile[jl * 65 + k] = src[(size_t)(k0 + k) * ldsrc + srccol0 + jl]; }
  __syncthreads();
  if (shv) {
    float a0 = 0.f, a1 = 0.f, a2 = 0.f;
#pragma unroll
    for (int i = 0; i < 16; ++i) { const int k = kg * 16 + i; const float wv = tile[jl * 65 + k]; a0 += shv[k0 + k] * wv; a1 += shv[6144 + k0 + k] * wv; a2 += shv[2 * 6144 + k0 + k] * wv; }
    atomicAdd(bias + j0 + jl, a0); atomicAdd(bias + bstride + j0 + jl, a1); atomicAdd(bias + 2 * bstride + j0 + jl, a2);
  }
  const int j = t >> 2, kc = (t & 3) * 16;
  const float* s = tile + j * 65 + kc;
  u32x4 o0, o1;
  o0.x = pack_bf16(s[0], s[1]); o0.y = pack_bf16(s[2], s[3]); o0.z = pack_bf16(s[4], s[5]); o0.w = pack_bf16(s[6], s[7]);
  o1.x = pack_bf16(s[8], s[9]); o1.y = pack_bf16(s[10], s[11]); o1.z = pack_bf16(s[12], s[13]); o1.w = pack_bf16(s[14], s[15]);
  bf16_t* d = dst + (size_t)(j0 + j) * K + k0 + kc;
  *(u32x4*)d = o0; *(u32x4*)(d + 8) = o1;
  __syncthreads();
}

#define WT_IN 0
#define WT_OUT (2816 * 1024)
#define WT_GU (WT_OUT + 1024 * 1024)
#define WT_DOWN (WT_GU + 5632 * 1024)
#define WT_LAYER (WT_DOWN + 1024 * 2816)


#define PRE_QP 0
#define PRE_KTP 16384
#define PRE_DIR0 32768
#define PRE_DIRSZ 41984
#define PRE_NW 0
#define PRE_UP 16384
#define PRE_QKP 32768
#define PRE_SC 40960
#define PRE_ITEM 116736
#define PRE_LDS 118784
#define SCAN_BUF 58368
#define SCAN_LDS (2 * SCAN_BUF)

using pg8::bf16x8;
__device__ __forceinline__ int perm_inv(int x) { return (x & ~31) | (((x >> 2) & 3) << 3) | (((x >> 4) & 1) << 2) | (x & 3); }
__device__ __forceinline__ bf16x8 pack8(const f32x4& x, const f32x4& y) {
  u32x4 w; w.x = pg8::cvt_pk_bf16(x[0], x[1]); w.y = pg8::cvt_pk_bf16(x[2], x[3]); w.z = pg8::cvt_pk_bf16(y[0], y[1]); w.w = pg8::cvt_pk_bf16(y[2], y[3]);
  return __builtin_bit_cast(bf16x8, w);
}

__device__ __forceinline__ void pre_item(int item, const bf16_t* __restrict__ QKV, const float* __restrict__ LOG, const float* __restrict__ cw,
                                         const float* __restrict__ a_log, const float* __restrict__ dt_bias, unsigned char* __restrict__ PRE,
                                         unsigned char* lds) {
  int t_ = threadIdx.x; asm volatile("" : "+v"(t_));
  const int t = t_, lane = t & 63, w = t >> 6;
  const int c = item >> 2, h = item & 3, r0 = c * 64;
  bf16_t* qb = (bf16_t*)lds; bf16_t* kb = (bf16_t*)(lds + 17408); float* vf = (float*)(lds + 34816);
  typedef _Float16 f16x4 __attribute__((ext_vector_type(4)));
  constexpr int MS = 72, TS = 20;
  _Float16* Mf = (_Float16*)(lds + 67584); _Float16* Mb = (_Float16*)(lds + 67584 + 64 * MS * 2); _Float16* Tm = (_Float16*)(lds + 67584 + 2 * 64 * MS * 2); float* sc = (float*)(lds + 100352);
  unsigned char* pre = PRE + (size_t)item * PRE_ITEM;
  {
    const int i = t >> 3, cg = t & 7, r = r0 + i;
    int s0, len;
    if (r < NCTX) { s0 = r & ~255; len = 256; } else { s0 = NCTX + ((r - NCTX) & ~2047); len = 2048; }
    const int tt = r - s0; const bool hp = tt > 0, hn = tt < len - 1;
#pragma unroll
    for (int x = 0; x < 3; ++x) {
      const int cb = x * 512 + h * 128 + cg * 16;
      const bf16_t* p0 = QKV + (size_t)r * NQKV + cb;
      u32x4 m0 = (u32x4){0u, 0u, 0u, 0u}, m1 = m0, n0 = m0, n1 = m0;
      const u32x4 c0 = *(const u32x4*)p0, c1 = *(const u32x4*)(p0 + 8);
      if (hp) { m0 = *(const u32x4*)(p0 - NQKV); m1 = *(const u32x4*)(p0 - NQKV + 8); }
      if (hn) { n0 = *(const u32x4*)(p0 + NQKV); n1 = *(const u32x4*)(p0 + NQKV + 8); }
      float val[16]; float ss = 0.f;
#pragma unroll
      for (int e = 0; e < 16; ++e) {
        const unsigned wm = (e < 8 ? m0 : m1)[(e & 7) >> 1], wc = (e < 8 ? c0 : c1)[(e & 7) >> 1], wn = (e < 8 ? n0 : n1)[(e & 7) >> 1];
        const float xm = __uint_as_float((e & 1) ? (wm & 0xffff0000u) : (wm << 16));
        const float xc = __uint_as_float((e & 1) ? (wc & 0xffff0000u) : (wc << 16));
        const float xn = __uint_as_float((e & 1) ? (wn & 0xffff0000u) : (wn << 16));
        const float y = cw[cb + e] * xm + cw[NQKV + cb + e] * xc + cw[2 * NQKV + cb + e] * xn;
        val[e] = silu_fast(y); ss += val[e] * val[e];
      }
      if (x < 2) {
        ss += __shfl_xor(ss, 1); ss += __shfl_xor(ss, 2); ss += __shfl_xor(ss, 4);
        const float rn = rsqrtf(ss + 1e-6f) * (x == 0 ? 0.08838834764831845f : 1.0f);
        bf16_t* dst = (x == 0 ? qb : kb) + i * 136 + cg * 16;
        u32x4 o0, o1;
        o0.x = pack_bf16(val[0] * rn, val[1] * rn); o0.y = pack_bf16(val[2] * rn, val[3] * rn); o0.z = pack_bf16(val[4] * rn, val[5] * rn); o0.w = pack_bf16(val[6] * rn, val[7] * rn);
        o1.x = pack_bf16(val[8] * rn, val[9] * rn); o1.y = pack_bf16(val[10] * rn, val[11] * rn); o1.z = pack_bf16(val[12] * rn, val[13] * rn); o1.w = pack_bf16(val[14] * rn, val[15] * rn);
        *(u32x4*)dst = o0; *(u32x4*)(dst + 8) = o1;
      } else {
        float* dst = vf + i * 128 + cg * 16;
#pragma unroll
        for (int e = 0; e < 16; e += 4) *(f32x4*)(dst + e) = (f32x4){val[e], val[e + 1], val[e + 2], val[e + 3]};
      }
    }
  }
  if (w == 0) {
    const int i = lane, r = r0 + i;
#pragma unroll
    for (int d = 0; d < 2; ++d) {
      const float bl = LOG[(size_t)r * 16 + d * 4 + h], al = LOG[(size_t)r * 16 + 8 + d * 4 + h];
      const float beta = sigmoid_f(bl);
      const float g = -expf(a_log[d * 4 + h]) * softplus_f(al + dt_bias[d * 4 + h]);
      float s = g;
#pragma unroll
      for (int o = 1; o < 64; o <<= 1) {
        const float nb = d == 0 ? __shfl_up(s, o) : __shfl_down(s, o);
        const bool ok = d == 0 ? (lane >= o) : (lane + o < 64);
        if (ok) s += nb;
      }
      sc[d * 64 + i] = beta; sc[128 + d * 64 + i] = s; sc[256 + d * 64 + i] = beta * expf(s);
    }
  }
  __syncthreads();
  {
    const int p = w >> 2, it = w & 3, fr = lane & 15, g = lane >> 4;
    const bf16_t* Ab = p ? qb : kb;
    bf16x8 af[4];
#pragma unroll
    for (int ks = 0; ks < 4; ++ks) af[ks] = *(const bf16x8*)(Ab + (it * 16 + fr) * 136 + ks * 32 + 8 * g);
    bf16_t* qkf = (bf16_t*)(lds + 102400);
    bf16_t* qkb = (bf16_t*)(lds + 102400 + 8192);
#pragma unroll
    for (int jt = 0; jt < 4; ++jt) {
      f32x4 acc = (f32x4){0.f, 0.f, 0.f, 0.f};
#pragma unroll
      for (int ks = 0; ks < 4; ++ks) {
        const bf16x8 bfr = *(const bf16x8*)(kb + (jt * 16 + fr) * 136 + ks * 32 + 8 * g);
        acc = __builtin_amdgcn_mfma_f32_16x16x32_bf16(af[ks], bfr, acc, 0, 0, 0);
      }
      const int j = jt * 16 + fr;
      const float gfj = sc[128 + j], gbj = sc[192 + j];
#pragma unroll
      for (int r = 0; r < 4; ++r) {
        const int i = it * 16 + 4 * g + r;
        const float val = acc[r];
        const float ef = __expf(fminf(sc[128 + i] - gfj, 0.f)), eb = __expf(fminf(sc[192 + i] - gbj, 0.f));
        if (p == 0) {
          Mf[i * MS + j] = (_Float16)((j < i) ? -(sc[i] * val * ef) : 0.f);
          Mb[i * MS + j] = (_Float16)((j > i) ? -(sc[64 + i] * val * eb) : 0.f);
        } else {
          const int jp = perm_inv(j);
          qkf[i * 64 + jp] = f2bf((j <= i) ? val * ef : 0.f);
          qkb[i * 64 + jp] = f2bf((j >= i) ? val * eb : 0.f);
        }
      }
    }
  }
  __syncthreads();
  const int wu = __builtin_amdgcn_readfirstlane(t >> 6);
  if (wu < 2) {
    const int d = wu, I = lane >> 4, cu = lane & 15;
    int rsel = d ? 15 : 0, rst = d ? -1 : 1;
    asm volatile("" : "+v"(rsel), "+v"(rst));
    const _Float16* Mi = (d ? Mb : Mf) + (16 * I) * MS + 16 * I;
    float tc[16];
#pragma unroll
    for (int u = 0; u < 16; ++u) {
      float a = (u == cu) ? 1.f : 0.f;
#pragma unroll
      for (int v = 0; v < u; ++v) a += (float)Mi[(rsel + rst * u) * MS + (rsel + rst * v)] * tc[v];
      tc[u] = a;
    }
#pragma unroll
    for (int u = 0; u < 16; ++u) Tm[((d * 4 + I) * 16 + (rsel + rst * u)) * TS + (rsel + rst * cu)] = (_Float16)tc[u];
  } else {
    const int tt = t - 128;
    for (int q = tt; q < 1024; q += 384) {
      { const int i = q >> 4, s = (q >> 2) & 3, g = q & 3;
        const u32x2 lo = *(const u32x2*)(qb + i * 136 + 32 * s + 4 * g), hi = *(const u32x2*)(qb + i * 136 + 32 * s + 16 + 4 * g);
        *(u32x4*)(pre + PRE_QP + (size_t)(i * 128 + 32 * s + 8 * g) * 2) = (u32x4){lo.x, lo.y, hi.x, hi.y}; }
      { const int dk = q >> 3, s2 = (q >> 2) & 1, g = q & 3;
        unsigned short e[8];
#pragma unroll
        for (int jj = 0; jj < 8; ++jj) e[jj] = kb[(32 * s2 + 16 * (jj >> 2) + 4 * g + (jj & 3)) * 136 + dk];
        u32x4 o; o.x = (unsigned)e[0] | ((unsigned)e[1] << 16); o.y = (unsigned)e[2] | ((unsigned)e[3] << 16); o.z = (unsigned)e[4] | ((unsigned)e[5] << 16); o.w = (unsigned)e[6] | ((unsigned)e[7] << 16);
        *(u32x4*)(pre + PRE_KTP + (size_t)(dk * 64 + 32 * s2 + 8 * g) * 2) = o; }
    }
    {
      const int e = tt, d = e / 192, rem = e % 192, k3 = rem >> 6, i = rem & 63;
      const float glast = d ? sc[192] : sc[128 + 63], gci = sc[128 + d * 64 + i];
      const float v = k3 == 0 ? expf(gci) : (k3 == 1 ? expf(glast - gci) : expf(glast));
      ((float*)(pre + PRE_DIR0 + d * PRE_DIRSZ + PRE_SC))[k3 * 64 + i] = v;
    }
  }
  __syncthreads();
  {
    const int d = wu >> 2, wq = wu & 3, kind = wq >> 1, fr = lane & 15, g = lane >> 4;
    const _Float16* Mi = d ? Mb : Mf;
    f16x4 Tf[4], Mg[4][4];
#pragma unroll
    for (int s2 = 0; s2 < 4; ++s2) {
      const int P = d ? 3 - s2 : s2;
      Tf[s2] = *(const f16x4*)(Tm + ((d * 4 + P) * 16 + fr) * TS + 4 * g);
#pragma unroll
      for (int b2 = 0; b2 < s2; ++b2) { const int Pb = d ? 3 - b2 : b2; Mg[s2][b2] = *(const f16x4*)(Mi + (16 * P + fr) * MS + 16 * Pb + 4 * g); }
    }
    f32x4 acc[4][4];
    {
      float beta[4][4];
#pragma unroll
      for (int s2 = 0; s2 < 4; ++s2)
#pragma unroll
        for (int r = 0; r < 4; ++r) beta[s2][r] = sc[(kind ? 256 : 0) + d * 64 + 16 * (d ? 3 - s2 : s2) + 4 * g + r];
#pragma unroll
      for (int tl = 0; tl < 4; ++tl) {
        const int col = 16 * ((4 * wq + tl) & 7) + fr;
#pragma unroll
        for (int s2 = 0; s2 < 4; ++s2)
#pragma unroll
          for (int r = 0; r < 4; ++r) {
            const int i = 16 * (d ? 3 - s2 : s2) + 4 * g + r;
            acc[tl][s2][r] = beta[s2][r] * (kind ? bf2f(kb[i * 136 + col]) : vf[i * 128 + col]);
          }
      }
    }
    __syncthreads();
    unsigned char* outd = lds + 34816 + d * 32768;
#define H4(x) __builtin_convertvector(x, f16x4)
#define MF16(a, b, c) __builtin_amdgcn_mfma_f32_16x16x16f16(a, b, c, 0, 0, 0)
#pragma unroll
    for (int tl = 0; tl < 4; ++tl) {
      const f32x4 z4 = (f32x4){0.f, 0.f, 0.f, 0.f};
      f32x4 X[4];
      X[0] = MF16(Tf[0], H4(acc[tl][0]), z4);
      { const f16x4 hx = H4(X[0]); acc[tl][1] = MF16(Mg[1][0], hx, acc[tl][1]); acc[tl][2] = MF16(Mg[2][0], hx, acc[tl][2]); acc[tl][3] = MF16(Mg[3][0], hx, acc[tl][3]); }
      X[1] = MF16(Tf[1], H4(acc[tl][1]), z4);
      { const f16x4 hx = H4(X[1]); acc[tl][2] = MF16(Mg[2][1], hx, acc[tl][2]); acc[tl][3] = MF16(Mg[3][1], hx, acc[tl][3]); }
      X[2] = MF16(Tf[2], H4(acc[tl][2]), z4);
      { const f16x4 hx = H4(X[2]); acc[tl][3] = MF16(Mg[3][2], hx, acc[tl][3]); }
      X[3] = MF16(Tf[3], H4(acc[tl][3]), z4);
      if (kind == 0) {
        const int wv = 4 * wq + tl;
#pragma unroll
        for (int s2 = 0; s2 < 4; ++s2) {
          u32x2 pk; pk.x = pack_bf16(X[s2][0], X[s2][1]); pk.y = pack_bf16(X[s2][2], X[s2][3]);
          *(u32x2*)(outd + 16384 + ((wv * 4 + (d ? 3 - s2 : s2)) * 64 + lane) * 8) = pk;
        }
      } else {
        const int kp = perm_inv(16 * (4 * wq + tl - 8) + fr);
        bf16_t* nw = (bf16_t*)outd + kp;
#pragma unroll
        for (int s2 = 0; s2 < 4; ++s2)
#pragma unroll
          for (int r = 0; r < 4; ++r) nw[(16 * (d ? 3 - s2 : s2) + 4 * g + r) * 128] = f2bf(-X[s2][r]);
      }
    }
#undef H4
#undef MF16
  }
  __syncthreads();
  for (int k = 0; k < 8; ++k) {
    const int q = t + 512 * k, d = q >> 11, wi = q & 2047;
    *(u32x4*)(pre + PRE_DIR0 + d * PRE_DIRSZ + wi * 16) = *(const u32x4*)(lds + 34816 + q * 16);
  }
  for (int k = 0; k < 2; ++k) {
    const int q = t + 512 * k, d = q >> 9, wi = q & 511;
    *(u32x4*)(pre + PRE_DIR0 + d * PRE_DIRSZ + PRE_QKP + wi * 16) = *(const u32x4*)(lds + 102400 + q * 16);
  }
  __syncthreads();
}

__global__ __launch_bounds__(512, 2) void k_pre(const bf16_t* __restrict__ QKV, const float* __restrict__ LOG, const float* __restrict__ cw,
                                                const float* __restrict__ a_log, const float* __restrict__ dt_bias, unsigned char* __restrict__ PRE) {
  extern __shared__ __attribute__((aligned(16))) unsigned char smem[];
  for (int item = blockIdx.x; item < 768; item += gridDim.x) pre_item(item, QKV, LOG, cw, a_log, dt_bias, PRE, smem);
}

#define SCAN_OT (2 * SCAN_BUF)
#undef SCAN_LDS
#define SCAN_LDS (2 * SCAN_BUF + 8 * 2048)
__device__ __forceinline__ void scan_item(int b, int h, int d, int chunk0, int nc, int half, bool write_state, const unsigned char* __restrict__ PRE, const float* __restrict__ s_in,
                                          bf16_t* __restrict__ OB, float* __restrict__ s_out, unsigned char* lds) {
  int t_ = threadIdx.x; asm volatile("" : "+v"(t_));
  const int t = t_, lane = t & 63, w = t >> 6, fr = lane & 15, g = lane >> 4;
  const bool active = half < 0 || w < 4;
  const int dvw = half < 0 ? w : half * 4 + (w & 3), dv = 16 * dvw + fr;
  f32x4 S[8];
  if (s_in == nullptr) {
#pragma unroll
    for (int m = 0; m < 8; ++m) S[m] = (f32x4){0.f, 0.f, 0.f, 0.f};
  } else {
#pragma unroll
    for (int m = 0; m < 8; ++m)
#pragma unroll
      for (int r = 0; r < 4; ++r) S[m][r] = s_in[(16 * m + 4 * g + r) * 128 + dv];
  }
  unsigned soff[7], doff[7];
#pragma unroll
  for (int k = 0; k < 7; ++k) {
    const int q = t + 512 * k;
    if (k < 2) { const int row = q >> 4, c = q & 15; soff[k] = PRE_DIR0 + PRE_NW + q * 16; doff[k] = row * 256 + ((c ^ (row & 15)) << 4); }
    else if (k < 4) { const int q2 = q - 1024, row = q2 >> 4, c = q2 & 15; soff[k] = PRE_QP + q2 * 16; doff[k] = 16384 + row * 256 + ((c ^ (row & 15)) << 4); }
    else if (k < 5) { const int q2 = q - 2048, row = q2 >> 3, c = q2 & 7; soff[k] = PRE_DIR0 + PRE_QKP + q2 * 16; doff[k] = 32768 + row * 128 + ((c ^ ((row >> 1) & 7)) << 4); }
    else { const int q2 = q - 2560, row = q2 >> 3, c = q2 & 7; soff[k] = PRE_KTP + q2 * 16; doff[k] = 40960 + row * 128 + ((c ^ ((row >> 1) & 7)) << 4); }
    if (k < 2 || k == 4) soff[k] += d * PRE_DIRSZ;
  }
  const unsigned soff7 = PRE_DIR0 + d * PRE_DIRSZ + PRE_SC + t * 16, doff7 = 57344 + t * 16;
  const unsigned upoff = PRE_DIR0 + d * PRE_DIRSZ + PRE_UP + ((dvw * 4) * 64 + lane) * 8;
  u32x4 st[7]; u32x4 st7 = (u32x4){0u, 0u, 0u, 0u}; u32x2 up[4];
  {
    const int cidx = chunk0 + (d ? nc - 1 : 0);
    const unsigned char* pre = PRE + (size_t)(cidx * 4 + h) * PRE_ITEM;
#pragma unroll
    for (int k = 0; k < 7; ++k) st[k] = *(const u32x4*)(pre + soff[k]);
    if (t < 48) st7 = *(const u32x4*)(pre + soff7);
#pragma unroll
    for (int m = 0; m < 4; ++m) up[m] = *(const u32x2*)(pre + upoff + m * 512);
#pragma unroll
    for (int k = 0; k < 7; ++k) *(u32x4*)(lds + doff[k]) = st[k];
    if (t < 48) *(u32x4*)(lds + doff7) = st7;
  }
  __syncthreads();
  bf16_t* ot = (bf16_t*)(lds + SCAN_OT + w * 2048);
  for (int step = 0; step < nc; ++step) {
    const int cidx = chunk0 + (d ? nc - 1 - step : step);
    const unsigned char* B = lds + (step & 1) * SCAN_BUF;
    const bool more = step + 1 < nc;
    f32x4 a1[4], a2[4];
#pragma unroll
    for (int m = 0; m < 4; ++m) {
      a1[m] = (f32x4){__uint_as_float(up[m].x << 16), __uint_as_float(up[m].x & 0xffff0000u), __uint_as_float(up[m].y << 16), __uint_as_float(up[m].y & 0xffff0000u)};
      a2[m] = (f32x4){0.f, 0.f, 0.f, 0.f};
    }
    if (more) {
      const int cn = chunk0 + (d ? nc - 2 - step : step + 1);
      const unsigned char* pre = PRE + (size_t)(cn * 4 + h) * PRE_ITEM;
#pragma unroll
      for (int k = 0; k < 7; ++k) st[k] = *(const u32x4*)(pre + soff[k]);
      if (t < 48) st7 = *(const u32x4*)(pre + soff7);
#pragma unroll
      for (int m = 0; m < 4; ++m) up[m] = *(const u32x2*)(pre + upoff + m * 512);
    }
    if (active) {
      const float* SC = (const float*)(B + 57344);
      const float gt = SC[128];
      bf16x8 Sb[4];
#pragma unroll
      for (int s = 0; s < 4; ++s) Sb[s] = pack8(S[2 * s], S[2 * s + 1]);
#pragma unroll
      for (int m = 0; m < 8; ++m) S[m] = S[m] * gt;
      {
        bf16x8 fa[2][4], fq[2][4];
#pragma unroll
        for (int m = 0; m < 4; ++m) {
          fa[0][m] = *(const bf16x8*)(B + (16 * m + fr) * 256 + (((0 + g) ^ fr) << 4));
          fq[0][m] = *(const bf16x8*)(B + 16384 + (16 * m + fr) * 256 + (((0 + g) ^ fr) << 4));
        }
#pragma unroll
        for (int s = 0; s < 4; ++s) {
          if (s < 3) {
#pragma unroll
            for (int m = 0; m < 4; ++m) {
              fa[(s + 1) & 1][m] = *(const bf16x8*)(B + (16 * m + fr) * 256 + (((4 * (s + 1) + g) ^ fr) << 4));
              fq[(s + 1) & 1][m] = *(const bf16x8*)(B + 16384 + (16 * m + fr) * 256 + (((4 * (s + 1) + g) ^ fr) << 4));
            }
          }
#pragma unroll
          for (int m = 0; m < 4; ++m) a1[m] = __builtin_amdgcn_mfma_f32_16x16x32_bf16(fa[s & 1][m], Sb[s], a1[m], 0, 0, 0);
#pragma unroll
          for (int m = 0; m < 4; ++m) a2[m] = __builtin_amdgcn_mfma_f32_16x16x32_bf16(fq[s & 1][m], Sb[s], a2[m], 0, 0, 0);
        }
      }
      bf16x8 Vb[2], Vs[2];
#pragma unroll
      for (int s = 0; s < 2; ++s) Vb[s] = pack8(a1[2 * s], a1[2 * s + 1]);
#pragma unroll
      for (int m = 0; m < 4; ++m) { const f32x4 e = *(const f32x4*)(SC + 64 + 16 * m + 4 * g); a1[m] = a1[m] * e; }
#pragma unroll
      for (int s = 0; s < 2; ++s) Vs[s] = pack8(a1[2 * s], a1[2 * s + 1]);
      {
        bf16x8 fk[2][8];
#pragma unroll
        for (int s = 0; s < 2; ++s)
#pragma unroll
          for (int m = 0; m < 8; ++m) fk[s][m] = *(const bf16x8*)(B + 40960 + (16 * m + fr) * 128 + (((4 * s + g) ^ (fr >> 1)) << 4));
#pragma unroll
        for (int s = 0; s < 2; ++s)
#pragma unroll
          for (int m = 0; m < 8; ++m) S[m] = __builtin_amdgcn_mfma_f32_16x16x32_bf16(fk[s][m], Vs[s], S[m], 0, 0, 0);
      }
#pragma unroll
      for (int m = 0; m < 4; ++m) { const f32x4 e = *(const f32x4*)(SC + 16 * m + 4 * g); a2[m] = a2[m] * e; }
#pragma unroll
      for (int s = 0; s < 2; ++s)
#pragma unroll
        for (int m = 0; m < 4; ++m) {
          const bf16x8 fa = *(const bf16x8*)(B + 32768 + (16 * m + fr) * 128 + (((4 * s + g) ^ (fr >> 1)) << 4));
          a2[m] = __builtin_amdgcn_mfma_f32_16x16x32_bf16(fa, Vb[s], a2[m], 0, 0, 0);
        }
#pragma unroll
      for (int m = 0; m < 4; ++m)
#pragma unroll
        for (int r = 0; r < 4; ++r) ot[(16 * m + 4 * g + r) * 16 + fr] = f2bf(a2[m][r]);
      {
        bf16_t* op = OB + ((size_t)d * NTOK + (size_t)cidx * 64) * 512 + h * 128 + 16 * dvw;
#pragma unroll
        for (int k = 0; k < 2; ++k) {
          const int q = lane + 64 * k, row = q >> 1, hf = q & 1;
          *(u32x4*)(op + (size_t)row * 512 + hf * 8) = *(const u32x4*)(ot + row * 16 + hf * 8);
        }
      }
    }
    if (more) {
      unsigned char* Bn = lds + ((step + 1) & 1) * SCAN_BUF;
#pragma unroll
      for (int k = 0; k < 7; ++k) *(u32x4*)(Bn + doff[k]) = st[k];
      if (t < 48) *(u32x4*)(Bn + doff7) = st7;
    }
    __syncthreads();
  }
  if (write_state && active) {
#pragma unroll
    for (int m = 0; m < 8; ++m)
#pragma unroll
      for (int r = 0; r < 4; ++r) s_out[(16 * m + 4 * g + r) * 128 + dv] = S[m][r];
  }
}

__device__ __forceinline__ void scan_dispatch(int i, const unsigned char* PRE, const float* state_in, bf16_t* OB, float* state_out, int layer, unsigned char* lds) {
#ifdef LAT_FULL
  if (i < 32) {
    if (i >= 16) return;
    const int q = i, half = -1, b = q >> 3, h = (q >> 1) & 3, d = q & 1;
#else
  if (i < 32) {
    const int q = i >> 1, half = i & 1, b = q >> 3, h = (q >> 1) & 3, d = q & 1;
#endif
    scan_item(b, h, d, 128 + b * 32, 32, half, false, PRE, state_in + ((((size_t)b * 2 + layer) * 2 + d) * 4 + h) * 16384, OB, nullptr, lds);
  } else {
    const int sid = i - 32, b = sid >> 3, h = (sid >> 1) & 3, d = sid & 1;
    scan_item(b, h, d, b * 4, 4, -1, true, PRE, nullptr, OB, state_out + ((((size_t)b * 2 + layer) * 2 + d) * 4 + h) * 16384, lds);
  }
}

__global__ __launch_bounds__(512, 2) void k_scan2(const unsigned char* __restrict__ PRE, const float* __restrict__ state_in, bf16_t* __restrict__ OB,
                                                  float* __restrict__ state_out, int layer) {
  extern __shared__ __attribute__((aligned(16))) unsigned char smem[];
  for (int i = blockIdx.x; i < 288; i += gridDim.x) scan_dispatch(i, PRE, state_in, OB, state_out, layer, smem);
}
#define XB_TMO      128
#define XB_XCNT(j)  (256  + 64 * (j))
#define XB_XSUB(j)  (1280 + 64 * (j))
#define XB_XGEN(j)  (2304 + 64 * (j))
#define XB_TOP      3328
#define XB_TOPGEN   3392
#define XCD_BAR_WORDS 3456
#define XB_SPIN_CAP (1u << 18)
#define LAS __attribute__((address_space(3)))

__device__ __forceinline__ unsigned xb_ld(unsigned* p)              { return __hip_atomic_load(p, __ATOMIC_RELAXED, __HIP_MEMORY_SCOPE_AGENT); }
__device__ __forceinline__ unsigned xb_add(unsigned* p, unsigned v) { return __hip_atomic_fetch_add(p, v, __ATOMIC_RELAXED, __HIP_MEMORY_SCOPE_AGENT); }
__device__ __forceinline__ unsigned xb_xcc_id() { return (unsigned)__builtin_amdgcn_s_getreg((3 << 11) | 20) & 0xFu; }
#define XB_SPIN(cond, bar) do { unsigned _sp = 0; while (cond) { __builtin_amdgcn_s_sleep(1); \
    if ((++_sp & 255u) == 0u) { if (xb_ld(&(bar)[XB_TMO])) break; if (_sp > XB_SPIN_CAP) { atomicAdd(&(bar)[XB_TMO], 1u); break; } } } } while (0)

struct XcdBarrier {
    unsigned* bar; unsigned x;
    volatile LAS unsigned* st;
};

__device__ __forceinline__ XcdBarrier xcd_barrier_post(unsigned* bar, volatile LAS unsigned* st) {
    XcdBarrier b; b.bar = bar; b.x = xb_xcc_id(); b.st = st;
    if (threadIdx.x == 0) (void)xb_add(&bar[XB_XCNT(b.x)], 1u);
    return b;
}
__device__ __forceinline__ void xcd_barrier_complete(unsigned* bar, unsigned x, unsigned& nloc, unsigned& nx) {
    const unsigned G = gridDim.x * gridDim.y * gridDim.z;
    unsigned sum, cnt, mine, sp = 0u;
    for (;;) {
        sum = 0u; cnt = 0u; mine = 0u;
#pragma unroll
        for (unsigned j = 0; j < 16; ++j) { const unsigned c = xb_ld(&bar[XB_XCNT(j)]); sum += c; cnt += (c > 0u) ? 1u : 0u; mine = (j == x) ? c : mine; }
        if (sum == G) break;
        __builtin_amdgcn_s_sleep(1);
        if ((++sp & 255u) == 0u) { if (xb_ld(&bar[XB_TMO])) break; if (sp > XB_SPIN_CAP) { atomicAdd(&bar[XB_TMO], 1u); break; } }
    }
    nloc = mine > 0u ? mine : 1u; nx = cnt > 0u ? cnt : 1u;
}

__device__ __forceinline__ void xcd_barrier(const XcdBarrier& b) {
    asm volatile("s_waitcnt vmcnt(0)" ::: "memory");
    __syncthreads();
    if (threadIdx.x == 0) {
        unsigned* bar = b.bar;
        __builtin_amdgcn_s_waitcnt(0);
        unsigned nloc = b.st[0], nx = b.st[1];
        if (nloc == 0u) { xcd_barrier_complete(bar, b.x, nloc, nx); b.st[0] = nloc; b.st[1] = nx; }
        const unsigned old = xb_add(&bar[XB_XSUB(b.x)], 1u);
        const unsigned gen = old / nloc;
        if (old + 1u == (gen + 1u) * nloc) {
            __builtin_amdgcn_fence(__ATOMIC_RELEASE, "agent");
            asm volatile("s_waitcnt vmcnt(0)" ::: "memory");
            const unsigned og = xb_add(&bar[XB_TOP], 1u);
            const unsigned tg = og / nx;
            if (og + 1u == (tg + 1u) * nx) xb_add(&bar[XB_TOPGEN], 1u);
            else XB_SPIN(xb_ld(&bar[XB_TOPGEN]) == tg, bar);
            __builtin_amdgcn_fence(__ATOMIC_ACQUIRE, "agent");
            xb_add(&bar[XB_XGEN(b.x)], 1u);
            asm volatile("s_waitcnt vmcnt(0)" ::: "memory");
        } else {
            XB_SPIN(xb_ld(&bar[XB_XGEN(b.x)]) == gen, bar);
            __builtin_amdgcn_fence(__ATOMIC_ACQUIRE, "agent");
            asm volatile("s_waitcnt vmcnt(0)" ::: "memory");
        }
    }
    __syncthreads();
}


#include <hip/hip_cooperative_groups.h>
namespace cg = cooperative_groups;

#define MEGA_LDS_MAIN 143360
#define MEGA_LDS (MEGA_LDS_MAIN + 16)
#define WS_X 0ull
#define WS_WTA (WS_X + (size_t)NTOK * 1024 * 4)
#define WS_WTB (WS_WTA + (size_t)WT_LAYER * 2)
#define WS_QKV (WS_WTB + (size_t)2816 * 1024 * 2)
#define WS_REST (WS_QKV + (size_t)NTOK * NQKV * 2)
#define WS_PRE (WS_REST + (size_t)NTOK * NREST * 2)
#define WS_MIXB (WS_PRE + (size_t)768 * PRE_ITEM)
#define WS_MODS (WS_MIXB + (size_t)NTOK * 1024 * 2)
#define WS_AV (WS_MODS + 2 * 3 * 6144 * 4)
#define WS_BIN (WS_AV + 2 * 2 * 3 * 1024 * 4)
#define WS_BGU (WS_BIN + 2 * 3 * NCOLS * 4)
#define WS_BLOG (WS_BGU + 2 * 3 * 2 * FFH * 4)
#define WS_ROWSS (WS_BLOG + 2 * 3 * 16 * 4 + 128)
#define WS_LOG (WS_ROWSS + 5 * NTOK * 4)
#define WS_BAR (WS_LOG + (size_t)NTOK * 16 * 4)
#define WS_WLT (WS_BAR + 16384)
#define WS_POS (WS_WLT + 2 * 16 * 1024 * 2)
#define WS_SLOT (WS_POS + 96 * 512 * 4)
#define WS_END (WS_SLOT + 48 * 4 * 256 * 4)
struct MP {
  const float *x_prompt, *x_sample, *state_delta, *c, *c_ctx, *w_in, *conv_w, *a_log, *dt_bias, *delta_norm_g, *sgu_norm_g, *w_spatial, *b_spatial,
      *w_pool, *pool_scale, *w_out, *norm1_g, *norm2_g, *w_mod, *b_mod, *w_gu, *w_down, *norm_f;
  float* out; unsigned char* ws;
  __device__ __forceinline__ float* X_() const { return (float*)(ws + WS_X); }
  __device__ __forceinline__ bf16_t* WTA_() const { return (bf16_t*)(ws + WS_WTA); }
  __device__ __forceinline__ bf16_t* WTB_() const { return (bf16_t*)(ws + WS_WTB); }
  __device__ __forceinline__ bf16_t* QKV_() const { return (bf16_t*)(ws + WS_QKV); }
  __device__ __forceinline__ bf16_t* REST_() const { return (bf16_t*)(ws + WS_REST); }
  __device__ __forceinline__ unsigned char* PRE_() const { return ws + WS_PRE; }
  __device__ __forceinline__ bf16_t* MIXB_() const { return (bf16_t*)(ws + WS_MIXB); }
  __device__ __forceinline__ float* mods_() const { return (float*)(ws + WS_MODS); }
  __device__ __forceinline__ float* AV_() const { return (float*)(ws + WS_AV); }
  __device__ __forceinline__ float* BIN_() const { return (float*)(ws + WS_BIN); }
  __device__ __forceinline__ float* BGU_() const { return (float*)(ws + WS_BGU); }
  __device__ __forceinline__ float* BLOG_() const { return (float*)(ws + WS_BLOG); }
  __device__ __forceinline__ float* rowss_() const { return (float*)(ws + WS_ROWSS); }
  __device__ __forceinline__ float* LOG_() const { return (float*)(ws + WS_LOG); }
  __device__ __forceinline__ unsigned* bar_() const { return (unsigned*)(ws + WS_BAR); }
  __device__ __forceinline__ bf16_t* WLT_() const { return (bf16_t*)(ws + WS_WLT); }
  __device__ __forceinline__ float* POS_() const { return (float*)(ws + WS_POS); }
  __device__ __forceinline__ float* SLOT_() const { return (float*)(ws + WS_SLOT); }
};

__device__ __forceinline__ void gemv3_item(const float* __restrict__ W, int ld, int ncols, const float* vec  , float* red  ,
                                           const float* __restrict__ bias, float* __restrict__ o0, float* __restrict__ o1, float* __restrict__ o2, int t) {
  const int col = t & 63, ds = t >> 6;
  float a0 = 0.f, a1 = 0.f, a2 = 0.f;
  if (col < ncols) {
    const float* w = W + (size_t)(ds * 128) * ld + col;
#pragma unroll 16
    for (int d = 0; d < 128; ++d) { const float wv = w[(size_t)d * ld]; const int dd = ds * 128 + d; a0 += vec[dd] * wv; a1 += vec[1024 + dd] * wv; a2 += vec[2048 + dd] * wv; }
  }
  red[(ds * 3 + 0) * 64 + col] = a0; red[(ds * 3 + 1) * 64 + col] = a1; red[(ds * 3 + 2) * 64 + col] = a2;
  __syncthreads();
  if (t < 192) {
    const int s = t >> 6, cc = t & 63;
    float v = 0.f;
#pragma unroll
    for (int k = 0; k < 8; ++k) v += red[(k * 3 + s) * 64 + cc];
    if (cc < ncols) { v += bias ? bias[cc] : 0.f; (s == 0 ? o0 : (s == 1 ? o1 : o2))[cc] = v; }
  }
  __syncthreads();
}

__device__ __forceinline__ void wtile(const MP& p, int l, int r  , bf16_t* wt_in, bf16_t* wt_rest, float* tile, int tt) {
  const float* ml = p.mods_() + l * 3 * 6144;
  if (r < 704) { const int kt = r / 44, jt = r % 44; transpose_tile(p.w_in + (size_t)l * 1024 * INC, INC, win_srccol(jt * 64), wt_in, 1024, jt * 64, kt * 64, tile, tt, ml, p.BIN_() + l * 3 * NCOLS, NCOLS); return; }
  r -= 704;
  if (r < 256) { const int kt = r / 16, jt = r % 16; transpose_tile(p.w_out + (size_t)l * 1024 * 1024, 1024, jt * 64, wt_rest + WT_OUT, 1024, jt * 64, kt * 64, tile, tt, nullptr, nullptr, 0); return; }
  r -= 256;
  if (r < 1408) { const int kt = r / 88, jt = r % 88; transpose_tile(p.w_gu + (size_t)l * 1024 * 2 * FFH, 2 * FFH, wgu_srccol(jt * 64), wt_rest + WT_GU, 1024, jt * 64, kt * 64, tile, tt, ml + 3072, p.BGU_() + l * 3 * 2 * FFH, 2 * FFH); return; }
  r -= 1408;
  { const int kt = r / 16, jt = r % 16; transpose_tile(p.w_down + (size_t)l * FFH * 1024, 1024, jt * 64, wt_rest + WT_DOWN, FFH, jt * 64, kt * 64, tile, tt, nullptr, nullptr, 0); }
}

__device__ __forceinline__ void wtiles(const MP& p, int l, int r_lo, int r_hi, int jb, int njb, unsigned char* smem) {
  int t_ = threadIdx.x; asm volatile("" : "+v"(t_)); const int t = t_;
  float* tile = (float*)smem + (t >> 8) * (64 * 65);
  for (int it = jb; it < (r_hi - r_lo) / 2; it += njb) wtile(p, l, r_lo + it * 2 + (t >> 8), p.WTA_() + WT_IN, p.WTA_(), tile, t & 255);
}

__device__ __forceinline__ void phase_prep0(const MP& p, int bid, int nb, unsigned char* smem, bool tiles) {
  int t_ = threadIdx.x; asm volatile("" : "+v"(t_)); const int t = t_;
  if (!tiles) for (int i = bid * 512 + t; i < 4 * NTOK; i += nb * 512) p.rowss_()[NTOK + i] = 0.f;
  if (!tiles) for (int i = bid * 512 + t; i < 2 * 3 * NCOLS + 2 * 3 * 2 * FFH; i += nb * 512) p.BIN_()[i] = 0.f;
  if (!tiles) for (int i = bid * 512 + t; i < 96 * 512; i += nb * 512) {
    const int rc = i >> 9, dd = i & 511, jj = dd & 255;
    const float omega = 1.0f / powf(10000.0f, (float)jj / 256.0f);
    const float ang = (float)(rc < 32 ? rc : rc - 32) * omega;
    p.POS_()[i] = (dd & 256) ? cosf(ang) : sinf(ang);
  }
  if (!tiles) for (int i = bid * 512 + t; i < 2 * 16 * 1024; i += nb * 512) { const int l = i >> 14, j = (i >> 10) & 15, d = i & 1023; p.WLT_()[i] = f2bf(p.w_in[((size_t)l * 1024 + d) * INC + 2048 + j]); }
  float* vec = (float*)smem; float* red = vec + 3072; float* tile = (float*)(smem + 32768) + (t >> 8) * (64 * 65);
  const int NMOD = 192, NPAIR = 704 / 2;
  for (int it = bid; it < (tiles ? NMOD + NPAIR : NMOD); it += nb) {
    if (it < NMOD) { if (tiles) continue;
      const int l = it / 96, cgp = it % 96;
      for (int i = t; i < 1024; i += 512) { vec[i] = silu_f(p.c_ctx[i]); vec[1024 + i] = silu_f(p.c[i]); vec[2048 + i] = silu_f(p.c[1024 + i]); }
      __syncthreads();
      float* m = p.mods_() + l * 3 * 6144 + cgp * 64;
      gemv3_item(p.w_mod + (size_t)l * 1024 * 6144 + cgp * 64, 6144, 64, vec, red, p.b_mod + l * 6144 + cgp * 64, m, m + 6144, m + 2 * 6144, t);
    } else {
      const int r = (it - NMOD) * 2 + (t >> 8);
      wtile(p, 0, r, p.WTA_() + WT_IN, p.WTA_(), tile, t & 255);
    }
  }
}

__device__ __forceinline__ void phase_vecs(const MP& p, int bid, int nb, unsigned char* smem) {
  int t_ = threadIdx.x; asm volatile("" : "+v"(t_)); const int t = t_;
  float* vec = (float*)smem; float* red = vec + 3072;
  for (int i = bid * 512 + t; i < 2 * 2 * 1024; i += nb * 512) {
    const int l = i >> 11, n = (i >> 10) & 1, d = i & 1023;
    const float g = n ? p.norm2_g[l * 1024 + d] : p.norm1_g[l * 1024 + d];
#pragma unroll
    for (int s = 0; s < 3; ++s) p.AV_()[((l * 2 + n) * 3 + s) * 1024 + d] = g * (1.f + p.mods_()[(l * 3 + s) * 6144 + (n ? 4096 : 1024) + d]);
  }
  const int N_IN = 44, N_GU = 88;
  for (int it = bid; it < 2; it += nb) {
    const int l = it, r = N_IN + N_GU;
    const int sh_off = (r >= N_IN && r < N_IN + N_GU) ? 3072 : 0;
    for (int i = t; i < 1024; i += 512) {
#pragma unroll
      for (int s = 0; s < 3; ++s) vec[s * 1024 + i] = p.mods_()[(l * 3 + s) * 6144 + sh_off + i];
    }
    __syncthreads();
    if (r < N_IN) { float* o = p.BIN_() + l * 3 * NCOLS + r * 64; gemv3_item(p.w_in + (size_t)l * 1024 * INC + win_srccol(r * 64), INC, 64, vec, red, nullptr, o, o + NCOLS, o + 2 * NCOLS, t); }
    else if (r < N_IN + N_GU) { const int j0 = (r - N_IN) * 64; float* o = p.BGU_() + l * 3 * 2 * FFH + j0; gemv3_item(p.w_gu + (size_t)l * 1024 * 2 * FFH + wgu_srccol(j0), 2 * FFH, 64, vec, red, nullptr, o, o + 2 * FFH, o + 4 * FFH, t); }
    else { float* o = p.BLOG_() + l * 3 * 16; gemv3_item(p.w_in + (size_t)l * 1024 * INC + 2048, INC, 16, vec, red, nullptr, o, o + 16, o + 32, t); }
  }
}

__device__ __forceinline__ void prepx_row(const MP& p, int r, int lane) {
  const int seg = seg_of_row(r);
  float ss = 0.f;
#pragma unroll
  for (int i = 0; i < 4; ++i) {
    const int d = i * 256 + lane * 4;
    f32x4 v;
    if (r < NCTX) v = *(const f32x4*)(p.x_prompt + (size_t)r * 1024 + d);
    else {
      const int rl = r - NCTX, pp = rl & 2047, row = pp >> 6, col = pp & 63;
      v = *(const f32x4*)(p.x_sample + (size_t)rl * 1024 + d);
      const f32x4 e = *(const f32x4*)(p.POS_() + (d < 512 ? row * 512 + d : (32 + col) * 512 + (d - 512)));
      v = v + e;
    }
    *(f32x4*)(p.X_() + (size_t)r * 1024 + d) = v;
    ss += (v[0] * v[0] + v[1] * v[1]) + (v[2] * v[2] + v[3] * v[3]);
    const f32x4 g1 = *(const f32x4*)(p.norm1_g + d), sc1 = *(const f32x4*)(p.mods_() + seg * 6144 + 1024 + d);
    const f32x4 a = g1 * (1.f + sc1);
    u32x2 w; w.x = pack_bf16(v[0] * a[0], v[1] * a[1]); w.y = pack_bf16(v[2] * a[2], v[3] * a[3]);
    *(u32x2*)((bf16_t*)p.PRE_() + (size_t)r * 1024 + d) = w;
  }
  ss = wave_sum(ss);
  if (lane == 0) p.rowss_()[r] = ss;
}

__device__ __forceinline__ void phase_logits(const MP& p, int l, int bid, int nb, unsigned char* smem) {
  int tl = threadIdx.x; asm volatile("" : "+v"(tl)); const int t = tl, lane = tl & 63, w = tl >> 6, fr = lane & 15, g = lane >> 4;
  bf16_t* wl = (bf16_t*)smem;
  const bf16_t* XA = (const bf16_t*)p.PRE_();
  for (int q = t; q < 2048; q += 512) { const int j = q >> 7, c = q & 127; *(u32x4*)(wl + j * 1032 + c * 8) = *(const u32x4*)(p.WLT_() + (size_t)l * 16 * 1024 + j * 1024 + c * 8); }
  __syncthreads();
  for (int rg = bid * 8 + w; rg < NTOK / 16; rg += nb * 8) {
    const int row0 = rg * 16;
    const bf16_t* arow = XA + (size_t)(row0 + fr) * 1024 + 8 * g;
    bf16x8 af[32];
#pragma unroll
    for (int ks = 0; ks < 32; ++ks) af[ks] = *(const bf16x8*)(arow + 32 * ks);
    f32x4 acc0 = (f32x4){0.f, 0.f, 0.f, 0.f}, acc1 = acc0;
#pragma unroll
    for (int ks = 0; ks < 32; ks += 2) {
      const bf16x8 b0 = *(const bf16x8*)(wl + fr * 1032 + 32 * ks + 8 * g), b1 = *(const bf16x8*)(wl + fr * 1032 + 32 * (ks + 1) + 8 * g);
      acc0 = __builtin_amdgcn_mfma_f32_16x16x32_bf16(af[ks], b0, acc0, 0, 0, 0);
      acc1 = __builtin_amdgcn_mfma_f32_16x16x32_bf16(af[ks + 1], b1, acc1, 0, 0, 0);
    }
    const int seg = seg_of_row(row0);
    const float bias = p.BLOG_()[l * 3 * 16 + seg * 16 + fr];
#pragma unroll
    for (int r = 0; r < 4; ++r) {
      const int row = row0 + 4 * g + r;
      const float rinv = rsqrtf(p.rowss_()[(2 * l) * NTOK + row] * (1.0f / 1024.0f) + 1e-6f);
      p.LOG_()[(size_t)row * 16 + fr] = (acc0[r] + acc1[r]) * rinv + bias;
    }
  }
  __syncthreads();
}

__device__ __forceinline__ void delta_post_row(const MP& p, int l, int r, int lane) {
  const bf16_t* OB = p.QKV_();
  const u32x4 of = *(const u32x4*)(OB + (size_t)r * 512 + lane * 8), ob = *(const u32x4*)(OB + ((size_t)NTOK + r) * 512 + lane * 8);
  const u32x4 zz = *(const u32x4*)(p.REST_() + (size_t)r * NREST + lane * 8);
  float o[8]; float ss = 0.f;
#pragma unroll
  for (int e = 0; e < 8; ++e) {
    const unsigned wf = of[e >> 1], wb = ob[e >> 1];
    o[e] = __uint_as_float((e & 1) ? (wf & 0xffff0000u) : (wf << 16)) + __uint_as_float((e & 1) ? (wb & 0xffff0000u) : (wb << 16));
    ss += o[e] * o[e];
  }
  ss += __shfl_xor(ss, 1); ss += __shfl_xor(ss, 2); ss += __shfl_xor(ss, 4); ss += __shfl_xor(ss, 8);
  const float rn = rsqrtf(ss * (1.0f / 128.0f) + 1e-6f);
  const float* ng = p.delta_norm_g + l * 128 + (lane & 15) * 8;
  float y[8];
#pragma unroll
  for (int e = 0; e < 8; ++e) {
    const unsigned wz = zz[e >> 1];
    const float z = __uint_as_float((e & 1) ? (wz & 0xffff0000u) : (wz << 16));
    y[e] = o[e] * rn * ng[e] * silu_fast(z);
  }
  u32x4 w; w.x = pack_bf16(y[0], y[1]); w.y = pack_bf16(y[2], y[3]); w.z = pack_bf16(y[4], y[5]); w.w = pack_bf16(y[6], y[7]);
  *(u32x4*)(p.MIXB_() + (size_t)r * 1024 + lane * 8) = w;
}

__device__ __forceinline__ void sgu_pair(const MP& p, int l, int item0, unsigned char* smem) {
  int tl = threadIdx.x; asm volatile("" : "+v"(tl)); const int t = tl & 255, lane = tl & 63, w = __builtin_amdgcn_readfirstlane(tl >> 6), hb = w >> 2, wl = w & 3, fr = lane & 15, g4 = lane >> 4;
  const int item = item0 + hb, ch = item >> 2, g = item & 3;
  const bf16_t* REST = p.REST_(); const float* norm_g = p.sgu_norm_g + l * 256 + g * 64;
  const float* w_s = p.w_spatial + ((size_t)l * 4 + g) * 128 * 128; const float* b_s = p.b_spatial + (l * 4 + g) * 128;
  const int r0 = ch * 128;
  bf16_t* vnT = (bf16_t*)(smem + hb * 35840);
  bf16_t* ut = (bf16_t*)(smem + hb * 35840 + 17408);
  const int s_ = t >> 1, q2 = t & 1;
  const bf16_t* vrow = REST + (size_t)(r0 + s_) * NREST + 768 + g * 64 + q2 * 32;
  u32x4 vv[4];
#pragma unroll
  for (int k = 0; k < 4; ++k) vv[k] = *(const u32x4*)(vrow + 8 * k);
  u32x4 uu[4];
#pragma unroll
  for (int k = 0; k < 4; ++k) { const int q = t + 256 * k, row = q >> 3, c8 = q & 7; uu[k] = *(const u32x4*)(REST + (size_t)(r0 + row) * NREST + 512 + g * 64 + c8 * 8); }
  f32x4 wa[2][4][2];
#pragma unroll
  for (int mt = 0; mt < 2; ++mt) {
    const float* wrow = w_s + (size_t)(wl * 32 + mt * 16 + fr) * 128 + 8 * g4;
#pragma unroll
    for (int ks = 0; ks < 4; ++ks) { wa[mt][ks][0] = *(const f32x4*)(wrow + 32 * ks); wa[mt][ks][1] = *(const f32x4*)(wrow + 32 * ks + 4); }
  }
  {
    float val[32]; float ss = 0.f;
#pragma unroll
    for (int e = 0; e < 32; ++e) {
      const unsigned wv = vv[e >> 3][(e & 7) >> 1];
      val[e] = gelu_fast(__uint_as_float((e & 1) ? (wv & 0xffff0000u) : (wv << 16))); ss += val[e] * val[e];
    }
    ss += __shfl_xor(ss, 1);
    const float rinv = rsqrtf(ss * (1.0f / 64.0f) + 1e-6f);
#pragma unroll
    for (int e = 0; e < 32; ++e) vnT[(q2 * 32 + e) * 136 + s_] = f2bf(val[e] * rinv * norm_g[q2 * 32 + e]);
#pragma unroll
    for (int k = 0; k < 4; ++k) { const int q = t + 256 * k, row = q >> 3, c8 = q & 7; *(u32x4*)(ut + row * 72 + c8 * 8) = uu[k]; }
  }
  __syncthreads();
#pragma unroll
  for (int mt = 0; mt < 2; ++mt) {
    bf16x8 af[4];
#pragma unroll
    for (int ks = 0; ks < 4; ++ks) af[ks] = pack8(wa[mt][ks][0], wa[mt][ks][1]);
    f32x4 acc[4];
#pragma unroll
    for (int nt = 0; nt < 4; ++nt) {
      acc[nt] = (f32x4){0.f, 0.f, 0.f, 0.f};
#pragma unroll
      for (int ks = 0; ks < 4; ++ks) {
        const bf16x8 bfr = *(const bf16x8*)(vnT + (nt * 16 + fr) * 136 + 32 * ks + 8 * g4);
        acc[nt] = __builtin_amdgcn_mfma_f32_16x16x32_bf16(af[ks], bfr, acc[nt], 0, 0, 0);
      }
    }
#pragma unroll
    for (int r = 0; r < 4; ++r) {
      const int tt = wl * 32 + mt * 16 + 4 * g4 + r;
      const float bb = b_s[tt];
#pragma unroll
      for (int nt = 0; nt < 4; ++nt) { bf16_t* e = ut + tt * 72 + nt * 16 + fr; *e = f2bf(gelu_fast(bf2f(*e)) * (acc[nt][r] + bb)); }
    }
  }
  __syncthreads();
#pragma unroll
  for (int k = 0; k < 4; ++k) { const int q = t + 256 * k, row = q >> 3, c8 = q & 7; *(u32x4*)(p.MIXB_() + (size_t)(r0 + row) * 1024 + 512 + g * 64 + c8 * 8) = *(const u32x4*)(ut + row * 72 + c8 * 8); }
  __syncthreads();
}

__device__ __forceinline__ void pool_item(const MP& p, int l, int blk, unsigned char* smem) {
  int tl = threadIdx.x; asm volatile("" : "+v"(tl)); const int t = tl, lane = tl & 63, w = __builtin_amdgcn_readfirstlane(tl >> 6), fr = lane & 15, g4 = lane >> 4;
  const bf16_t* REST = p.REST_(); const float* w_pool = p.w_pool + (size_t)l * 4 * 64 * 64; const float* scale = p.pool_scale + l * 256;
  const int r0 = blk * 64;
  int seg0, seglen;
  if (r0 < NCTX) { seg0 = r0 & ~255; seglen = 256; } else { seg0 = r0; seglen = 64; }
  bf16_t* xs = (bf16_t*)smem;
  bf16_t* dm = (bf16_t*)(smem + 42240);
  bf16_t* wT = (bf16_t*)(smem + 42240 + 36864);
  u32x4 xv[5];
#pragma unroll
  for (int k = 0; k < 5; ++k) {
    const int q = t + 512 * k, lr = q >> 5, c8 = q & 31, row = r0 - 8 + lr;
    xv[k] = (u32x4){0u, 0u, 0u, 0u};
    if (row >= seg0 && row < seg0 + seglen) xv[k] = *(const u32x4*)(REST + (size_t)row * NREST + 1024 + c8 * 8);
  }
  f32x4 wv[8];
#pragma unroll
  for (int k = 0; k < 8; ++k) wv[k] = *(const f32x4*)(w_pool + (size_t)(t + 512 * k) * 4);
#pragma unroll
  for (int k = 0; k < 5; ++k) { const int q = t + 512 * k, lr = q >> 5, c8 = q & 31; *(u32x4*)(xs + lr * 264 + c8 * 8) = xv[k]; }
#pragma unroll
  for (int k = 0; k < 8; ++k) {
    const int q = t + 512 * k, i = q >> 10, c = (q >> 4) & 63, d4 = (q & 15) * 4;
#pragma unroll
    for (int e = 0; e < 4; ++e) wT[(i * 64 + d4 + e) * 72 + c] = f2bf(wv[k][e]);
  }
  __syncthreads();
  {
    const int c = t & 255, i = c >> 6, win = 2 << i, ph = t >> 8, hw = win >> 1;
    const int xoff = seg0 - r0 + 8;
    int pos = r0 + ph * 32 - seg0;
    int lo = max(pos - hw, 0), hi = min(pos + hw, seglen);
    float s = 0.f;
    for (int q = lo; q < hi; ++q) s += bf2f(xs[(q + xoff) * 264 + c]);
#pragma unroll 4
    for (int pp = ph * 32; pp < ph * 32 + 32; ++pp) {
      dm[(i * 64 + pp) * 72 + (c & 63)] = f2bf(s * __builtin_amdgcn_rcpf((float)(hi - lo)) - bf2f(xs[(pp + 8) * 264 + c]));
      ++pos;
      const int lo2 = max(pos - hw, 0), hi2 = min(pos + hw, seglen);
      if (hi2 > hi) s += bf2f(xs[(hi + xoff) * 264 + c]);
      if (lo2 > lo) s -= bf2f(xs[(lo + xoff) * 264 + c]);
      lo = lo2; hi = hi2;
    }
  }
  __syncthreads();
  {
    const int i = w >> 1;
    bf16x8 bfr[4][2];
#pragma unroll
    for (int nt = 0; nt < 4; ++nt)
#pragma unroll
      for (int ks = 0; ks < 2; ++ks) bfr[nt][ks] = *(const bf16x8*)(wT + (i * 64 + nt * 16 + fr) * 72 + 32 * ks + 8 * g4);
#pragma unroll
    for (int pt2 = 0; pt2 < 2; ++pt2) {
      const int pt = (w & 1) * 2 + pt2;
      bf16x8 af[2];
#pragma unroll
      for (int ks = 0; ks < 2; ++ks) af[ks] = *(const bf16x8*)(dm + (i * 64 + pt * 16 + fr) * 72 + 32 * ks + 8 * g4);
#pragma unroll
      for (int nt = 0; nt < 4; ++nt) {
        f32x4 acc = (f32x4){0.f, 0.f, 0.f, 0.f};
#pragma unroll
        for (int ks = 0; ks < 2; ++ks) acc = __builtin_amdgcn_mfma_f32_16x16x32_bf16(af[ks], bfr[nt][ks], acc, 0, 0, 0);
        const float sc = scale[i * 64 + nt * 16 + fr];
#pragma unroll
        for (int r = 0; r < 4; ++r) xs[(pt * 16 + 4 * g4 + r) * 264 + i * 64 + nt * 16 + fr] = f2bf(acc[r] * sc);
      }
    }
  }
  __syncthreads();
#pragma unroll
  for (int k = 0; k < 4; ++k) { const int q = t + 512 * k, row = q >> 5, c8 = q & 31; *(u32x4*)(p.MIXB_() + (size_t)(r0 + row) * 1024 + 768 + c8 * 8) = *(const u32x4*)(xs + row * 264 + c8 * 8); }
  __syncthreads();
}

__device__ __forceinline__ void final_row(const MP& p, int r, int lane) {
  const float rinv = rsqrtf(p.rowss_()[4 * NTOK + r] * (1.0f / 1024.0f) + 1e-6f);
#pragma unroll
  for (int i = 0; i < 4; ++i) {
    const int d = i * 256 + lane * 4;
    const f32x4 v = *(const f32x4*)(p.X_() + (size_t)r * 1024 + d), gg = *(const f32x4*)(p.norm_f + d);
    *(f32x4*)(p.out + (size_t)r * 1024 + d) = v * rinv * gg;
  }
}

#ifndef REPEAT
#define REPEAT 0
#endif
#define REP_CAT2(a, b) a##b
#define REP_CAT(a, b) REP_CAT2(a, b)
#define REP(k) for (int REP_CAT(rep_, __LINE__) = 0; REP_CAT(rep_, __LINE__) < 1 + ((REPEAT >> (k)) & 1); ++REP_CAT(rep_, __LINE__))
#ifndef USE_CG_SYNC
#define USE_CG_SYNC 0
#endif
#if USE_CG_SYNC
#define GRID_SYNC() grid.sync()
#else
#define GRID_SYNC() do { REP(21) { XcdBarrier xb2; xb2.bar = p.bar_(); xb2.x = xb_xcc_id(); xb2.st = xst; xcd_barrier(xb2); } } while (0)
#endif

__global__ __launch_bounds__(512, 2) void mega(MP p) {
  extern __shared__ __attribute__((aligned(16))) unsigned char smem[];
#if USE_CG_SYNC
  cg::grid_group grid = cg::this_grid();
#else
  volatile LAS unsigned* xst = (volatile LAS unsigned*)((LAS unsigned char*)smem + MEGA_LDS_MAIN);
  if (threadIdx.x == 0) { xst[0] = 0u; xst[1] = 0u; }
  __syncthreads();
  (void)xcd_barrier_post(p.bar_(), xst);
#endif
  const int bid = blockIdx.x, nb = gridDim.x;
  bf16_t* XA = (bf16_t*)p.PRE_(); bf16_t* ACT = p.QKV_(); bf16_t* OB = p.QKV_();
  float* states_out = p.out + (size_t)NTOK * 1024;

  REP(0) phase_prep0(p, bid, nb, smem, false);
  GRID_SYNC();
  REP(1) { phase_prep0(p, bid, nb, smem, true); phase_vecs(p, bid, nb, smem); }
  REP(2) { int tl = threadIdx.x; asm volatile("" : "+v"(tl)); const int lane = tl & 63, w = tl >> 6;
    for (int r = bid * 8 + w; r < NTOK; r += nb * 8) prepx_row(p, r, lane); }
  GRID_SYNC();
  for (int l = 0; l < 2; ++l) {
#define TL_DECL int tl = threadIdx.x; asm volatile("" : "+v"(tl)); const int t = tl, lane = tl & 63, w = tl >> 6; (void)t; (void)lane; (void)w
    const float* ml = p.mods_() + l * 3 * 6144;
    float* rs1 = p.rowss_() + (2 * l) * NTOK; float* rs2 = p.rowss_() + (2 * l + 1) * NTOK; float* rs3 = p.rowss_() + (2 * l + 2) * NTOK;
    const float* A2 = p.AV_() + (l * 2 + 1) * 3 * 1024; const float* A1n = p.AV_() + (2 + 0) * 3 * 1024;
    REP(4) {
      pg8::Gemm g; g.A = XA; g.Bt = p.WTA_() + WT_IN; g.M = NTOK; g.N = NCOLS; g.K = 1024;
      EpiIn E{p.QKV_(), p.REST_(), rs1, p.BIN_() + l * 3 * NCOLS};
      pg8::StaticOrder S; S.init(g.M, g.N, nb, bid);
      pg8::gemm_phase<EpiIn, pg8::StaticOrder, true, true>((PG8_LAS unsigned char*)smem, g, S, E);
    }
    REP(3) if (bid >= 16) {
      phase_logits(p, l, bid - 16, nb - 16, smem);
      wtiles(p, l, 704, 2368, bid - 16, nb - 16, smem);
    }
    GRID_SYNC();
    REP(5) for (int item = bid; item < 768; item += nb) pre_item(item, p.QKV_(), p.LOG_(), p.conv_w + (size_t)l * 3 * NQKV, p.a_log + l * 8, p.dt_bias + l * 8, p.PRE_(), smem);
    GRID_SYNC();
    REP(6) { if (bid < 32) { REP(13) scan_dispatch(bid, p.PRE_(), p.state_delta, OB, states_out, l, smem); }
             else { REP(14) for (int i = bid - 32; i < 256; i += nb - 32) scan_dispatch(32 + i, p.PRE_(), p.state_delta, OB, states_out, l, smem); } }
    REP(12) if (bid >= 32) {
      for (int it = bid - 32; it < 192; it += nb - 32) sgu_pair(p, l, 2 * it, smem);
      for (int it = bid - 32; it < 192; it += nb - 32) pool_item(p, l, it, smem);
    }
    GRID_SYNC();
    REP(7) { TL_DECL; for (int r = bid * 8 + w; r < NTOK; r += nb * 8) delta_post_row(p, l, r, lane); }
    GRID_SYNC();
    {
      pg8::Gemm g; g.A = p.MIXB_(); g.Bt = p.WTA_() + WT_OUT; g.M = NTOK; g.N = 1024; g.K = 1024;
      EpiRes E{p.X_(), ml + 2048, rs2, XA, A2};
      pg8::StaticOrder S; S.init(g.M, g.N, nb, bid);
      pg8::gemm_phase<EpiRes, pg8::StaticOrder, true, true>((PG8_LAS unsigned char*)smem, g, S, E);
    }
    if (bid >= 192) wtiles(p, l, 2368, 3072, bid - 192, nb - 192, smem);
    GRID_SYNC();
    REP(9) {
      pg8::Gemm g; g.A = XA; g.Bt = p.WTA_() + WT_GU; g.M = NTOK; g.N = 2 * FFH; g.K = 1024;
      EpiGu E{ACT, rs2, p.BGU_() + l * 3 * 2 * FFH};
      GuOrder S; S.init(nb, bid, -1);
      pg8::gemm_phase<EpiGu, GuOrder, true, true>((PG8_LAS unsigned char*)smem, g, S, E);
    }
    GRID_SYNC();
    unsigned* gu_flag = p.bar_() + 3712 + l * 64;
#define GU_DEFERRED() do { for (int e = bid - 192; e < 48 - GU_DEFER_PM0; e += nb - 192) { \
      pg8::Gemm g; g.A = XA; g.Bt = p.WTA_() + WT_GU; g.M = NTOK; g.N = 2 * FFH; g.K = 1024; \
      EpiGu E{ACT, rs2, p.BGU_() + l * 3 * 2 * FFH}; \
      GuOrder S; S.init(nb, bid, GU_DEFER_PM0 + e); \
      pg8::gemm_phase<EpiGu, GuOrder, true, true>((PG8_LAS unsigned char*)smem, g, S, E); \
      asm volatile("s_waitcnt vmcnt(0)" ::: "memory"); \
      __syncthreads();                                                           \
      if (threadIdx.x == 0) { \
        __builtin_amdgcn_fence(__ATOMIC_RELEASE, "agent");                       \
        asm volatile("s_waitcnt vmcnt(0)" ::: "memory"); \
        __hip_atomic_store(gu_flag + GU_DEFER_PM0 + e, 1u, __ATOMIC_RELAXED, __HIP_MEMORY_SCOPE_AGENT); \
      } \
      __syncthreads(); } } while (0)
    if (l == 0) {
      pg8::Gemm g; g.A = ACT; g.Bt = p.WTA_() + WT_DOWN; g.M = NTOK; g.N = 1024; g.K = FFH;
      EpiRes E{p.X_(), ml + 5120, rs3, XA, A1n};
      DownOrder S; S.S.init(g.M, g.N, nb, bid); S.flag = gu_flag;
      pg8::gemm_phase<EpiRes, DownOrder, true, true>((PG8_LAS unsigned char*)smem, g, S, E);
      if (bid >= 192) { GU_DEFERRED(); wtiles(p, 1, 0, 704, bid - 192, nb - 192, smem); }
      GRID_SYNC();
    } else {
      pg8::Gemm g; g.A = ACT; g.Bt = p.WTA_() + WT_DOWN; g.M = NTOK; g.N = 1024; g.K = FFH;
      EpiResFinal E{p.X_(), ml + 5120, p.out, p.norm_f, p.SLOT_(), p.bar_() + 3584};
      DownOrder S; S.S.init(g.M, g.N, nb, bid); S.flag = gu_flag;
      pg8::gemm_phase<EpiResFinal, DownOrder, false, true>((PG8_LAS unsigned char*)smem, g, S, E);
      if (bid >= 192) GU_DEFERRED();
    }
  }
}

extern "C" void kernel_launch(void* const* d_in, const int* in_sizes, int n_in, void* d_out, int out_size, void* d_ws, size_t ws_size,
                              hipStream_t stream) {
  static int grid_blocks = 0;
  if (!grid_blocks) {
    int dev = 0, cus = 0, per_cu = 0;
    (void)hipGetDevice(&dev);
    (void)hipDeviceGetAttribute(&cus, hipDeviceAttributeMultiprocessorCount, dev);
    (void)hipFuncSetAttribute((const void*)mega, hipFuncAttributeMaxDynamicSharedMemorySize, MEGA_LDS);
    (void)hipOccupancyMaxActiveBlocksPerMultiprocessor(&per_cu, (const void*)mega, 512, MEGA_LDS);
    if (per_cu < 1) { fprintf(stderr, "occupancy query says %d blocks per CU\n", per_cu); per_cu = 1; }
    if (per_cu > 1) per_cu = 1;
    grid_blocks = cus * per_cu;
    if (grid_blocks > 256) grid_blocks = 256;
  }
  MP p; memset(&p, 0, sizeof p);
  const float** ins = (const float**)&p;
  for (int i = 0; i < 23; ++i) ins[i] = (const float*)d_in[i];
  p.out = (float*)d_out;
  p.ws = (unsigned char*)d_ws;
  if (WS_END > ws_size) { fprintf(stderr, "workspace too small: need %zu have %zu\n", (size_t)WS_END, ws_size); return; }
  (void)hipMemsetAsync((char*)d_ws + WS_BAR, 0, 16384, stream);
  void* args[] = {&p};
  hipError_t e = hipLaunchCooperativeKernel((const void*)mega, dim3(grid_blocks), dim3(512), args, MEGA_LDS, stream);
  if (e != hipSuccess) fprintf(stderr, "cooperative launch failed: %s (grid %d)\n", hipGetErrorString(e), grid_blocks);
}
```

```cpp
#include <hip/hip_runtime.h>
#include <math.h>
#include <cstdio>
#include <cstring>

#define NTOK 12288
#define NCTX 8192
#define DM 1024
#define INC 2832
#define FFH 2816
#define NQKV 1536
#define NREST 1280
#define NCOLS 2816

typedef unsigned short bf16_t;
typedef float f32x2_cv __attribute__((ext_vector_type(2)));
typedef __bf16 bf16x2_cv __attribute__((ext_vector_type(2)));
__device__ __forceinline__ unsigned pack_bf16(float lo, float hi) { return __builtin_bit_cast(unsigned, __builtin_convertvector((f32x2_cv){lo, hi}, bf16x2_cv)); }
__device__ __forceinline__ bf16_t f2bf(float f) { return (bf16_t)(pack_bf16(f, 0.f) & 0xffffu); }
__device__ __forceinline__ float bf2f(bf16_t b) { return __uint_as_float(((unsigned)b) << 16); }
__device__ __forceinline__ float silu_f(float x) { return x / (1.f + expf(-x)); }
__device__ __forceinline__ float silu_fast(float x) { return x * __builtin_amdgcn_rcpf(1.f + __expf(-x)); }
__device__ __forceinline__ float gelu_fast(float x) { const float u = 1.5957691216057308f * (x + 0.044715f * x * x * x); return x * __builtin_amdgcn_rcpf(1.f + __expf(-u)); }
__device__ __forceinline__ float sigmoid_f(float x) { return 1.f / (1.f + expf(-x)); }
__device__ __forceinline__ float gelu_f(float x) { return 0.5f * x * (1.f + tanhf(0.7978845608028654f * (x + 0.044715f * x * x * x))); }
__device__ __forceinline__ float softplus_f(float x) { return x > 20.f ? x : log1pf(expf(x)); }
__device__ __forceinline__ int seg_of_row(int r) { return r < NCTX ? 0 : 1 + ((r - NCTX) >> 11); }
__device__ __forceinline__ float wave_sum(float v) {
#pragma unroll
  for (int o = 32; o > 0; o >>= 1) v += __shfl_xor(v, o);
  return v;
}
namespace pg8 {
#define PG8_LAS __attribute__((address_space(3)))
typedef unsigned short bf16_t;
typedef short bf16x8 __attribute__((ext_vector_type(8)));
typedef float f32x4 __attribute__((ext_vector_type(4)));
typedef unsigned u32x4 __attribute__((ext_vector_type(4)));
constexpr int BM = 256, BK = 64, HALF = 128, HTB = HALF * BK * 2  , STAGE_BYTES = 8 * HTB, NXCD = 8, WGM = 8;

__host__ __device__ __forceinline__ int lds_byte(int r, int c) { const int st = (r >> 4) * 2 + (c >> 5), rr = r & 15, cc = c & 31, ob = rr * 64 + cc * 2; return st * 1024 + (ob ^ (((ob >> 9) & 1) << 5)); }
__host__ __device__ __forceinline__ void stage_rc(int b, int& R, int& C) { const int st = b / 1024, sb = b % 1024, swz = sb ^ (((sb >> 9) & 1) << 5); R = (st >> 1) * 16 + swz / 64; C = (st & 1) * 32 + (swz % 64) / 2; }
__host__ __device__ __forceinline__ int perm32(int rho) { const int n = rho >> 4, i = rho & 15; return 8 * (i >> 2) + 4 * n + (i & 3); }

struct Unit { int pm, pn; };
struct Gemm { const bf16_t* A; const bf16_t* Bt; int M, N, K; };

struct StaticOrder {
    int nM, nN, nwg, G, c;
    __host__ __device__ void init(int M, int N, int G_, int c_) { nM = M / BM; nN = N / BM; nwg = nM * nN; G = G_; c = c_; }
    __host__ __device__ bool next(int i, Unit& u) const {
        const long L = (long)i * G + c; if (L >= nwg) return false;
        int wgid = (int)L; { const int q = nwg / NXCD, r = nwg % NXCD, xcd = wgid % NXCD, off = wgid / NXCD; wgid = (xcd < r ? xcd * (q + 1) : r * (q + 1) + (xcd - r) * q) + off; }
        const int nig = WGM * nN, gid = wgid / nig, fm = gid * WGM, gsz = (nM - fm) < WGM ? (nM - fm) : WGM;
        u.pm = fm + ((wgid % nig) % gsz); u.pn = (wgid % nig) / gsz; return true;
    }
    __device__ __forceinline__ void a_ready(const Unit&) const {}
    __device__ __forceinline__ void done(const Unit&) const {}
    static constexpr bool KWAIT = false;
    __device__ __forceinline__ bool k_wait(const Unit&) const { return false; }
};

__device__ __forceinline__ unsigned cvt_pk_bf16(float lo, float hi) { return ::pack_bf16(lo, hi); }
template <class Epi, class Sched, bool ALIGN_EPI = false, bool SP2 = false>
__device__ __forceinline__ void gemm_phase(PG8_LAS unsigned char* lds, const Gemm g, const Sched& S, const Epi& E) {
    int tid_ = threadIdx.x; asm volatile("" : "+v"(tid_));
    const int tid = tid_, wid = __builtin_amdgcn_readfirstlane(tid >> 6), lane = tid & 63, wr = wid >> 2, wc = wid & 3, fr = lane & 15, fq = lane >> 4;
    const int K = g.K, nt = K / BK;
    unsigned voffA[2], voffB[2];
#pragma unroll
    for (int i = 0; i < 2; ++i) { int R, C; stage_rc(tid * 16 + i * 8192, R, C); const int Rb = Epi::PERM ? ((R & ~31) + perm32(R & 31)) : R;
        voffA[i] = (unsigned)(R * K + C) * 2u; voffB[i] = (unsigned)(Rb * K + C) * 2u; }
    const size_t kstep = (size_t)(BK * 2);
    const size_t hstep = (size_t)HALF * K * 2;
    const size_t tstep = 2 * hstep;
    const unsigned ldsw = (unsigned)wid * 1024u;
    const int aoff = lds_byte(wr * 64 + fr, fq * 8), boff = lds_byte(wc * 32 + fr, fq * 8);
#define PG8_SA(b, h) (((b) * 2 + (h)) * HTB)
#define PG8_SB(b, h) ((4 + (b) * 2 + (h)) * HTB)
#define PG8_STAGE(bufoff, gbase, voff) do { _Pragma("unroll") for (int _i = 0; _i < 2; ++_i) \
        __builtin_amdgcn_global_load_lds((const unsigned*)((const char*)(gbase) + (voff)[_i]), (PG8_LAS unsigned*)(lds + (bufoff) + ldsw + _i * 8192), 16, 0, 0); } while (0)
#define PG8_STAGE_SC1(bufoff, gbase, voff) do { _Pragma("unroll") for (int _i = 0; _i < 2; ++_i) \
        __builtin_amdgcn_global_load_lds((const unsigned*)((const char*)(gbase) + (voff)[_i]), (PG8_LAS unsigned*)(lds + (bufoff) + ldsw + _i * 8192), 16, 0, 16); } while (0)
#define PG8_STAGE_A(dep, bufoff, gbase) do { if constexpr (Sched::KWAIT) { if (dep) PG8_STAGE_SC1(bufoff, gbase, voffA); else PG8_STAGE(bufoff, gbase, voffA); } else PG8_STAGE(bufoff, gbase, voffA); } while (0)
#define PG8_LDA(dst, b, h) do { _Pragma("unroll") for (int m = 0; m < 4; ++m) _Pragma("unroll") for (int k = 0; k < 2; ++k) dst[m][k] = *(const PG8_LAS bf16x8*)(lds + PG8_SA(b, h) + aoff + m * 2048 + k * 1024); } while (0)
#define PG8_LDB(dst, b, h) do { _Pragma("unroll") for (int n = 0; n < 2; ++n) _Pragma("unroll") for (int k = 0; k < 2; ++k) dst[n][k] = *(const PG8_LAS bf16x8*)(lds + PG8_SB(b, h) + boff + n * 2048 + k * 1024); } while (0)
#define PG8_MMA(ai, bj, At, Bt) do { __builtin_amdgcn_s_setprio(1); _Pragma("unroll") for (int m = 0; m < 4; ++m) _Pragma("unroll") for (int n = 0; n < 2; ++n) _Pragma("unroll") for (int k = 0; k < 2; ++k) \
        acc[ai][bj][m][n] = __builtin_amdgcn_mfma_f32_16x16x32_bf16(Bt[n][k], At[m][k], acc[ai][bj][m][n], 0, 0, 0); PG8_XMMA(ai, bj, At); __builtin_amdgcn_s_setprio(0); } while (0)
#ifdef XMMA
#define PG8_XMMA(ai, bj, At) do { _Pragma("unroll") for (int m = 0; m < 4; ++m) _Pragma("unroll") for (int n = 0; n < 2; ++n) acc[ai][bj][m][n] = __builtin_amdgcn_mfma_f32_16x16x32_bf16(zerov, At[m][0], acc[ai][bj][m][n], 0, 0, 0); } while (0)
#else
#define PG8_XMMA(ai, bj, At) do { } while (0)
#endif
#define PG8_WAIT_V(n) asm volatile("s_waitcnt vmcnt(" #n ")" ::: "memory")
#define PG8_WAIT_L(n) asm volatile("s_waitcnt lgkmcnt(" #n ")" ::: "memory")
#define PG8_BAR __builtin_amdgcn_s_barrier()
#define PG8_SCHED __builtin_amdgcn_sched_barrier(0)
    Unit cur, nxt; int ui = 0;
    if (!S.next(0, cur)) return;
    f32x4 acc[2][2][4][2];
#pragma unroll
    for (int a = 0; a < 2; ++a)
#pragma unroll
        for (int b = 0; b < 2; ++b)
#pragma unroll
            for (int m = 0; m < 4; ++m)
#pragma unroll
                for (int n = 0; n < 2; ++n) acc[a][b][m][n] = (f32x4){0.f, 0.f, 0.f, 0.f};
    bf16x8 At[4][2], B0[2][2], B1[2][2];
#ifdef XMMA
    bf16x8 zerov = (bf16x8){0, 0, 0, 0, 0, 0, 0, 0}; asm volatile("" : "+v"(zerov));
#endif
    const char* cA = (const char*)g.A + (size_t)cur.pm * tstep; const char* cB = (const char*)g.Bt + (size_t)cur.pn * tstep;
    S.a_ready(cur);
    if constexpr (SP2) {
        PG8_STAGE(PG8_SB(0, 0), cB, voffB); PG8_STAGE(PG8_SB(0, 1), cB + hstep, voffB); PG8_STAGE(PG8_SA(0, 0), cA, voffA); PG8_STAGE(PG8_SA(0, 1), cA + hstep, voffA);
        if (wr == 1) PG8_BAR;
        PG8_WAIT_V(2); PG8_BAR;
        PG8_STAGE(PG8_SB(1, 0), cB + kstep, voffB); PG8_STAGE(PG8_SA(1, 0), cA + kstep, voffA); PG8_STAGE(PG8_SB(1, 1), cB + hstep + kstep, voffB);
        PG8_WAIT_V(6); PG8_BAR;
    } else {
        PG8_STAGE(PG8_SB(0, 0), cB, voffB); PG8_STAGE(PG8_SA(0, 0), cA, voffA); PG8_STAGE(PG8_SB(0, 1), cB + hstep, voffB); PG8_STAGE(PG8_SA(0, 1), cA + hstep, voffA);
        if (wr == 1) PG8_BAR;
        PG8_WAIT_V(4); PG8_BAR;
        PG8_STAGE(PG8_SB(1, 0), cB + kstep, voffB); PG8_STAGE(PG8_SA(1, 0), cA + kstep, voffA); PG8_STAGE(PG8_SB(1, 1), cB + hstep + kstep, voffB);
        PG8_WAIT_V(6); PG8_BAR;
    }
    static_assert(!Sched::KWAIT || SP2, "KWAIT schedulers: SP2 loop only");
    bool dep_unit = false;
    for (;;) {
        const bool has_next = S.next(ui + 1, nxt);
        const char* nA = has_next ? (const char*)g.A + (size_t)nxt.pm * tstep : cA; const char* nB = has_next ? (const char*)g.Bt + (size_t)nxt.pn * tstep : cB;
        for (int t = 0; t < nt; t += 2) {
            bool dep23 = false, dep1 = false;
            if constexpr (Sched::KWAIT) { if (t == nt - 4) dep_unit = S.k_wait(cur); dep23 = dep_unit && (t == nt - 4); dep1 = dep_unit && (t == nt - 2); }
            const bool last = (t == nt - 2);
            const char* a1 = cA + (size_t)(t + 1) * kstep;
            const char* a2 = last ? nA : cA + (size_t)(t + 2) * kstep; const char* b2 = last ? nB : cB + (size_t)(t + 2) * kstep;
            const char* a3 = a2 + kstep; const char* b3 = b2 + kstep;
            if (last && has_next) S.a_ready(nxt);
            if constexpr (SP2) {
            PG8_LDB(B0, 0, 0); PG8_LDB(B1, 0, 1); PG8_SCHED; PG8_LDA(At, 0, 0); PG8_STAGE_A(dep1, PG8_SA(1, 1), a1 + hstep);
            PG8_WAIT_V(8); PG8_WAIT_L(0); PG8_BAR; PG8_MMA(0, 0, At, B0); PG8_MMA(0, 1, At, B1); PG8_BAR; PG8_SCHED;
            PG8_LDA(At, 0, 1); PG8_STAGE(PG8_SB(0, 0), b2, voffB); PG8_STAGE(PG8_SB(0, 1), b2 + hstep, voffB); PG8_STAGE_A(dep23, PG8_SA(0, 0), a2);
            PG8_WAIT_V(8); PG8_WAIT_L(0); PG8_BAR; PG8_MMA(1, 0, At, B0); PG8_MMA(1, 1, At, B1); PG8_BAR; PG8_SCHED;
            PG8_LDB(B0, 1, 0); PG8_LDB(B1, 1, 1); PG8_SCHED; PG8_LDA(At, 1, 0); PG8_STAGE_A(dep23, PG8_SA(0, 1), a2 + hstep);
            PG8_WAIT_V(8); PG8_WAIT_L(0); PG8_BAR; PG8_MMA(0, 0, At, B0); PG8_MMA(0, 1, At, B1); PG8_BAR; PG8_SCHED;
            PG8_LDA(At, 1, 1); PG8_STAGE(PG8_SB(1, 0), b3, voffB); PG8_STAGE(PG8_SB(1, 1), b3 + hstep, voffB); PG8_STAGE_A(dep23, PG8_SA(1, 0), a3);
            PG8_WAIT_V(8); PG8_WAIT_L(0); PG8_BAR; PG8_MMA(1, 0, At, B0); PG8_MMA(1, 1, At, B1); PG8_BAR; PG8_SCHED;
            } else {
            PG8_LDB(B0, 0, 0); PG8_SCHED; PG8_LDA(At, 0, 0); PG8_STAGE(PG8_SA(1, 1), a1 + hstep, voffA);
            PG8_WAIT_L(8); PG8_BAR; PG8_WAIT_L(0); PG8_MMA(0, 0, At, B0); PG8_BAR; PG8_SCHED;
            PG8_LDB(B1, 0, 1); PG8_STAGE(PG8_SB(0, 0), b2, voffB);
            PG8_BAR; PG8_WAIT_L(0); PG8_MMA(0, 1, At, B1); PG8_BAR;
            PG8_LDA(At, 0, 1); PG8_STAGE(PG8_SA(0, 0), a2, voffA);
            PG8_BAR; PG8_WAIT_L(0); PG8_MMA(1, 0, At, B0); PG8_BAR; PG8_SCHED;
            PG8_STAGE(PG8_SB(0, 1), b2 + hstep, voffB);
            PG8_WAIT_V(6); PG8_BAR; PG8_MMA(1, 1, At, B1); PG8_BAR;
            PG8_LDB(B0, 1, 0); PG8_SCHED; PG8_LDA(At, 1, 0); PG8_STAGE(PG8_SA(0, 1), a2 + hstep, voffA);
            PG8_WAIT_L(8); PG8_BAR; PG8_WAIT_L(0); PG8_MMA(0, 0, At, B0); PG8_BAR; PG8_SCHED;
            PG8_LDB(B1, 1, 1); PG8_STAGE(PG8_SB(1, 0), b3, voffB);
            PG8_BAR; PG8_WAIT_L(0); PG8_MMA(0, 1, At, B1); PG8_BAR;
            PG8_LDA(At, 1, 1); PG8_STAGE(PG8_SA(1, 0), a3, voffA);
            PG8_BAR; PG8_WAIT_L(0); PG8_MMA(1, 0, At, B0); PG8_BAR; PG8_SCHED;
            PG8_STAGE(PG8_SB(1, 1), b3 + hstep, voffB);
            PG8_WAIT_V(6); PG8_BAR; PG8_MMA(1, 1, At, B1); PG8_BAR;
            }
        }
        if constexpr (ALIGN_EPI) { if (wr == 0) PG8_BAR; }
        if constexpr (!Epi::AFTER_DRAIN) { E(acc, cur, wr, wc, fr, fq); S.done(cur); }
        if (!has_next) break;
#pragma unroll
        for (int a = 0; a < 2; ++a)
#pragma unroll
            for (int b = 0; b < 2; ++b)
#pragma unroll
                for (int m = 0; m < 4; ++m)
#pragma unroll
                    for (int n = 0; n < 2; ++n) acc[a][b][m][n] = (f32x4){0.f, 0.f, 0.f, 0.f};
        cur = nxt; cA = nA; cB = nB; ++ui;
        if constexpr (ALIGN_EPI) { if (wr == 1) PG8_BAR; }
    }
    PG8_WAIT_V(0);
    if constexpr (!ALIGN_EPI) { if (wr == 0) PG8_BAR; }
    PG8_BAR;
    if constexpr (Epi::AFTER_DRAIN) { E.fused(acc, cur, wr, wc, fr, fq, lds, wid, lane); S.done(cur); }
#undef PG8_SA
#undef PG8_SB
#undef PG8_STAGE
#undef PG8_STAGE_SC1
#undef PG8_STAGE_A
#undef PG8_LDA
#undef PG8_LDB
#undef PG8_MMA
#undef PG8_XMMA
#undef PG8_WAIT_V
#undef PG8_WAIT_L
#undef PG8_BAR
#undef PG8_SCHED
}
}

using pg8::f32x4; using pg8::u32x4; using pg8::Unit; using pg8::HALF; using pg8::BM;
typedef unsigned u32x2 __attribute__((ext_vector_type(2)));

struct EpiIn {
  static constexpr bool PERM = true, AFTER_DRAIN = false;
  bf16_t* qkv; bf16_t* rest; const float* rowss; const float* bias;
  __device__ __forceinline__ void operator()(const f32x4 (&acc)[2][2][4][2], const Unit& u, int wr, int wc, int fr, int fq) const {
    const int row0 = u.pm * BM + wr * 64 + fr;
    const int seg = seg_of_row(u.pm * BM);
    int colt = u.pn * BM; bf16_t* base = qkv; int ldc = NQKV;
    if (colt >= NQKV) { base = rest; ldc = NREST; colt -= NQKV; }
    const int col0 = colt + wc * 32 + 8 * fq, bcol0 = seg * NCOLS + u.pn * BM + wc * 32 + 8 * fq;
    f32x4 bv[2][2];
#pragma unroll
    for (int bj = 0; bj < 2; ++bj)
#pragma unroll
      for (int n = 0; n < 2; ++n) bv[bj][n] = *(const f32x4*)(bias + bcol0 + bj * HALF + 4 * n);
#pragma unroll
    for (int ai = 0; ai < 2; ++ai)
#pragma unroll
      for (int m = 0; m < 4; ++m) {
        const int r = row0 + ai * HALF + m * 16;
        const float rinv = rsqrtf(rowss[r] * (1.0f / 1024.0f) + 1e-6f);
        bf16_t* rowp = base + (size_t)r * ldc + col0;
#pragma unroll
        for (int bj = 0; bj < 2; ++bj) {
          const f32x4 v0 = acc[ai][bj][m][0] * rinv + bv[bj][0], v1 = acc[ai][bj][m][1] * rinv + bv[bj][1];
          u32x4 w; w.x = pg8::cvt_pk_bf16(v0[0], v0[1]); w.y = pg8::cvt_pk_bf16(v0[2], v0[3]); w.z = pg8::cvt_pk_bf16(v1[0], v1[1]); w.w = pg8::cvt_pk_bf16(v1[2], v1[3]);
          *(u32x4*)(rowp + bj * HALF) = w;
        }
      }
  }
};

struct EpiRes {
  static constexpr bool PERM = false, AFTER_DRAIN = false;
  float* X; const float* gate; float* rowss; bf16_t* xa; const float* An;
  __device__ __forceinline__ void operator()(const f32x4 (&acc)[2][2][4][2], const Unit& u, int wr, int wc, int fr, int fq) const {
    const int row0 = u.pm * BM + wr * 64 + fr, col0 = u.pn * BM + wc * 32 + 4 * fq;
    const int seg = seg_of_row(u.pm * BM);
    f32x4 gv[2][2], av[2][2];
#pragma unroll
    for (int bj = 0; bj < 2; ++bj)
#pragma unroll
      for (int n = 0; n < 2; ++n) {
        gv[bj][n] = *(const f32x4*)(gate + seg * 6144 + col0 + bj * HALF + n * 16);
        av[bj][n] = xa ? *(const f32x4*)(An + seg * 1024 + col0 + bj * HALF + n * 16) : (f32x4){0.f, 0.f, 0.f, 0.f};
      }
#pragma unroll
    for (int ai = 0; ai < 2; ++ai)
#pragma unroll
      for (int m = 0; m < 4; ++m) {
        const int r = row0 + ai * HALF + m * 16;
        float* xrow = X + (size_t)r * 1024 + col0;
        float ss = 0.f;
#pragma unroll
        for (int bj = 0; bj < 2; ++bj)
#pragma unroll
          for (int n = 0; n < 2; ++n) {
            const f32x4 xo = *(const f32x4*)(xrow + bj * HALF + n * 16);
            const f32x4 xn = xo + gv[bj][n] * acc[ai][bj][m][n];
            *(f32x4*)(xrow + bj * HALF + n * 16) = xn;
            ss += (xn[0] * xn[0] + xn[1] * xn[1]) + (xn[2] * xn[2] + xn[3] * xn[3]);
            if (xa) {
              const f32x4 t = xn * av[bj][n];
              u32x2 w; w.x = pg8::cvt_pk_bf16(t[0], t[1]); w.y = pg8::cvt_pk_bf16(t[2], t[3]);
              *(u32x2*)(xa + (size_t)r * 1024 + col0 + bj * HALF + n * 16) = w;
            }
          }
        ss += __shfl_xor(ss, 16); ss += __shfl_xor(ss, 32);
        if (fq == 0) atomicAdd(rowss + r, ss);
      }
  }
};

struct EpiGu {
  static constexpr bool PERM = true, AFTER_DRAIN = false;
  bf16_t* act; const float* rowss; const float* bias;
  __device__ __forceinline__ void operator()(const f32x4 (&acc)[2][2][4][2], const Unit& u, int wr, int wc, int fr, int fq) const {
    const int row0 = u.pm * BM + wr * 64 + fr;
    const int seg = seg_of_row(u.pm * BM);
    const int hid0 = u.pn * HALF + wc * 32 + 8 * fq, bcol0 = seg * (2 * FFH) + u.pn * BM + wc * 32 + 8 * fq;
    f32x4 bv[2][2];
#pragma unroll
    for (int bj = 0; bj < 2; ++bj)
#pragma unroll
      for (int n = 0; n < 2; ++n) bv[bj][n] = *(const f32x4*)(bias + bcol0 + bj * HALF + 4 * n);
#pragma unroll
    for (int ai = 0; ai < 2; ++ai)
#pragma unroll
      for (int m = 0; m < 4; ++m) {
        const int r = row0 + ai * HALF + m * 16;
        const float rinv = rsqrtf(rowss[r] * (1.0f / 1024.0f) + 1e-6f);
        float o[8];
#pragma unroll
        for (int n = 0; n < 2; ++n) {
          const f32x4 g = acc[ai][0][m][n] * rinv + bv[0][n], up = acc[ai][1][m][n] * rinv + bv[1][n];
#pragma unroll
          for (int j = 0; j < 4; ++j) o[n * 4 + j] = g[j] * __builtin_amdgcn_rcpf(1.f + __expf(-g[j])) * up[j];
        }
        u32x4 w; w.x = pg8::cvt_pk_bf16(o[0], o[1]); w.y = pg8::cvt_pk_bf16(o[2], o[3]); w.z = pg8::cvt_pk_bf16(o[4], o[5]); w.w = pg8::cvt_pk_bf16(o[6], o[7]);
        *(u32x4*)(act + (size_t)r * FFH + hid0) = w;
      }
  }
};


struct EpiResFinal {
  static constexpr bool PERM = false, AFTER_DRAIN = true;
  const float* X; const float* gate; float* out; const float* normf; float* slots; unsigned* cnt;
  __device__ __forceinline__ void operator()(const f32x4 (&)[2][2][4][2], const Unit&, int, int, int, int) const {}
  __device__ __forceinline__ void fused(f32x4 (&acc)[2][2][4][2], const Unit& u, int wr, int wc, int fr, int fq, PG8_LAS unsigned char* lds, int wid, int lane) const {
    PG8_LAS float* P = (PG8_LAS float*)lds;
    PG8_LAS float* R = (PG8_LAS float*)(lds + 4096);
    const int row0 = u.pm * BM + wr * 64 + fr, col0 = u.pn * BM + wc * 32 + 4 * fq;
    const int seg = seg_of_row(u.pm * BM);
    f32x4 gv[2][2];
#pragma unroll
    for (int bj = 0; bj < 2; ++bj)
#pragma unroll
      for (int n = 0; n < 2; ++n) gv[bj][n] = *(const f32x4*)(gate + seg * 6144 + col0 + bj * HALF + n * 16);
#pragma unroll
    for (int ai = 0; ai < 2; ++ai)
#pragma unroll
      for (int m = 0; m < 4; ++m) {
        const int r = row0 + ai * HALF + m * 16;
        const float* xrow = X + (size_t)r * 1024 + col0;
        float ss = 0.f;
#pragma unroll
        for (int bj = 0; bj < 2; ++bj)
#pragma unroll
          for (int n = 0; n < 2; ++n) {
            const f32x4 xo = *(const f32x4*)(xrow + bj * HALF + n * 16);
            const f32x4 xn = xo + gv[bj][n] * acc[ai][bj][m][n];
            acc[ai][bj][m][n] = xn;
            ss += (xn[0] * xn[0] + xn[1] * xn[1]) + (xn[2] * xn[2] + xn[3] * xn[3]);
          }
        ss += __shfl_xor(ss, 16); ss += __shfl_xor(ss, 32);
        if (fq == 0) P[(ai * HALF + wr * 64 + m * 16 + fr) * 4 + wc] = ss;
      }
    __syncthreads();
    const int tid = wid * 64 + lane;
    if (tid < 256) {
      const float s = (P[tid * 4 + 0] + P[tid * 4 + 1]) + (P[tid * 4 + 2] + P[tid * 4 + 3]);
      __hip_atomic_store(slots + (size_t)(u.pm * 4 + u.pn) * 256 + tid, s, __ATOMIC_RELAXED, __HIP_MEMORY_SCOPE_AGENT);
    }
    asm volatile("s_waitcnt vmcnt(0)" ::: "memory");
    __syncthreads();
    if (tid == 0) {
      (void)__hip_atomic_fetch_add(cnt + u.pm, 1u, __ATOMIC_RELAXED, __HIP_MEMORY_SCOPE_AGENT);
      unsigned sp = 0u;
      while (__hip_atomic_load(cnt + u.pm, __ATOMIC_RELAXED, __HIP_MEMORY_SCOPE_AGENT) < 4u) { __builtin_amdgcn_s_sleep(1); if (++sp > (1u << 22)) break; }
      __builtin_amdgcn_fence(__ATOMIC_ACQUIRE, "agent");
      asm volatile("s_waitcnt vmcnt(0)" ::: "memory");
    }
    __syncthreads();
    if (tid < 256) {
      float tot = 0.f;
#pragma unroll
      for (int k = 0; k < 4; ++k) tot += __hip_atomic_load(slots + (size_t)(u.pm * 4 + k) * 256 + tid, __ATOMIC_RELAXED, __HIP_MEMORY_SCOPE_AGENT);
      R[tid] = rsqrtf(tot * (1.0f / 1024.0f) + 1e-6f);
    }
    __syncthreads();
    f32x4 nf[2][2];
#pragma unroll
    for (int bj = 0; bj < 2; ++bj)
#pragma unroll
      for (int n = 0; n < 2; ++n) nf[bj][n] = *(const f32x4*)(normf + col0 + bj * HALF + n * 16);
#pragma unroll
    for (int ai = 0; ai < 2; ++ai)
#pragma unroll
      for (int m = 0; m < 4; ++m) {
        const int lr = ai * HALF + wr * 64 + m * 16 + fr;
        const float rinv = R[lr];
        float* orow = out + (size_t)(u.pm * BM + lr) * 1024 + col0;
#pragma unroll
        for (int bj = 0; bj < 2; ++bj)
#pragma unroll
          for (int n = 0; n < 2; ++n) *(f32x4*)(orow + bj * HALF + n * 16) = acc[ai][bj][m][n] * rinv * nf[bj][n];
      }
  }
};

#define GU_DEFER_PM0 16
struct GuOrder {
  static constexpr bool KWAIT = false;
  pg8::StaticOrder S; int solo;
  __device__ __forceinline__ void init(int G, int c, int solo_) { S.nM = NTOK / pg8::BM; S.nN = 21; S.nwg = S.nM * 21; S.G = G; S.c = c; solo = solo_; }
  __device__ __forceinline__ bool next(int i, pg8::Unit& u) const {
    if (solo >= 0) { if (i) return false; u.pm = solo; u.pn = 21; return true; }
    if (S.next(i, u)) return true;
    const long L = (long)i * S.G + S.c - S.nwg;
    if (L < GU_DEFER_PM0) { u.pm = (int)L; u.pn = 21; return true; }
    return false;
  }
  __device__ __forceinline__ void a_ready(const pg8::Unit&) const {}
  __device__ __forceinline__ void done(const pg8::Unit&) const {}
  __device__ __forceinline__ bool k_wait(const pg8::Unit&) const { return false; }
};
#ifndef DOWN_KWAIT
#define DOWN_KWAIT true
#endif
struct DownOrder {
  static constexpr bool KWAIT = DOWN_KWAIT;
  pg8::StaticOrder S; unsigned* flag;
  __device__ __forceinline__ bool next(int i, pg8::Unit& u) const { return S.next(i, u); }
  __device__ __forceinline__ void a_ready(const pg8::Unit&) const {}
  __device__ __forceinline__ void done(const pg8::Unit&) const {}
  __device__ __forceinline__ bool k_wait(const pg8::Unit& u) const {
    if (u.pm < GU_DEFER_PM0) return false;
    unsigned sp = 0u;
    while (__builtin_amdgcn_readfirstlane(__hip_atomic_load(flag + u.pm, __ATOMIC_RELAXED, __HIP_MEMORY_SCOPE_AGENT)) == 0u) { __builtin_amdgcn_s_sleep(1); if (++sp > (1u << 22)) break; }
    asm volatile("" ::: "memory");
    return true;
  }
};

__device__ __forceinline__ int win_srccol(int j) { return j < 2048 ? j : j + 16; }
__device__ __forceinline__ int wgu_srccol(int j) { const int pn = j >> 8, w = j & 255; return w < 128 ? pn * 128 + w : FFH + pn * 128 + (w - 128); }

__device__ __forceinline__ void transpose_tile(const float* __restrict__ src, int ldsrc, int srccol0, bf16_t* __restrict__ dst, int K, int j0, int k0, float* tile, int t,
                                               const float* __restrict__ shv, float* __restrict__ bias, int bstride) {
  const int jl = t & 63, kg = t >> 6;
#pragma unroll
  for (int i = 0; i < 16; ++i) { const int k = kg * 16 + i; tile[jl * 65 + k] = src[(size_t)(k0 + k) * ldsrc + srccol0 + jl]; }
  __syncthreads();
  if (shv) {
    float a0 = 0.f, a1 = 0.f, a2 = 0.f;
#pragma unroll
    for (int i = 0; i < 16; ++i) { const int k = kg * 16 + i; const float wv = tile[jl * 65 + k]; a0 += shv[k0 + k] * wv; a1 += shv[6144 + k0 + k] * wv; a2 += shv[2 * 6144 + k0 + k] * wv; }
    atomicAdd(bias + j0 + jl, a0); atomicAdd(bias + bstride + j0 + jl, a1); atomicAdd(bias + 2 * bstride + j0 + jl, a2);
  }
  const int j = t >> 2, kc = (t & 3) * 16;
  const float* s = tile + j * 65 + kc;
  u32x4 o0, o1;
  o0.x = pack_bf16(s[0], s[1]); o0.y = pack_bf16(s[2], s[3]); o0.z = pack_bf16(s[4], s[5]); o0.w = pack_bf16(s[6], s[7]);
  o1.x = pack_bf16(s[8], s[9]); o1.y = pack_bf16(s[10], s[11]); o1.z = pack_bf16(s[12], s[13]); o1.w = pack_bf16(s[14], s[15]);
  bf16_t* d = dst + (size_t)(j0 + j) * K + k0 + kc;
  *(u32x4*)d = o0; *(u32x4*)(d + 8) = o1;
  __syncthreads();
}

#define WT_IN 0
#define WT_OUT (2816 * 1024)
#define WT_GU (WT_OUT + 1024 * 1024)
#define WT_DOWN (WT_GU + 5632 * 1024)
#define WT_LAYER (WT_DOWN + 1024 * 2816)


#define PRE_QP 0
#define PRE_KTP 16384
#define PRE_DIR0 32768
#define PRE_DIRSZ 41984
#define PRE_NW 0
#define PRE_UP 16384
#define PRE_QKP 32768
#define PRE_SC 40960
#define PRE_ITEM 116736
#define PRE_LDS 118784
#define SCAN_BUF 58368
#define SCAN_LDS (2 * SCAN_BUF)

using pg8::bf16x8;
__device__ __forceinline__ int perm_inv(int x) { return (x & ~31) | (((x >> 2) & 3) << 3) | (((x >> 4) & 1) << 2) | (x & 3); }
__device__ __forceinline__ bf16x8 pack8(const f32x4& x, const f32x4& y) {
  u32x4 w; w.x = pg8::cvt_pk_bf16(x[0], x[1]); w.y = pg8::cvt_pk_bf16(x[2], x[3]); w.z = pg8::cvt_pk_bf16(y[0], y[1]); w.w = pg8::cvt_pk_bf16(y[2], y[3]);
  return __builtin_bit_cast(bf16x8, w);
}

__device__ __forceinline__ void pre_item(int item, const bf16_t* __restrict__ QKV, const float* __restrict__ LOG, const float* __restrict__ cw,
                                         const float* __restrict__ a_log, const float* __restrict__ dt_bias, unsigned char* __restrict__ PRE,
                                         unsigned char* lds) {
  int t_ = threadIdx.x; asm volatile("" : "+v"(t_));
  const int t = t_, lane = t & 63, w = t >> 6;
  const int c = item >> 2, h = item & 3, r0 = c * 64;
  bf16_t* qb = (bf16_t*)lds; bf16_t* kb = (bf16_t*)(lds + 17408); float* vf = (float*)(lds + 34816);
  typedef _Float16 f16x4 __attribute__((ext_vector_type(4)));
  constexpr int MS = 72, TS = 20;
  _Float16* Mf = (_Float16*)(lds + 67584); _Float16* Mb = (_Float16*)(lds + 67584 + 64 * MS * 2); _Float16* Tm = (_Float16*)(lds + 67584 + 2 * 64 * MS * 2); float* sc = (float*)(lds + 100352);
  unsigned char* pre = PRE + (size_t)item * PRE_ITEM;
  float lg_b = 0.f, lg_a = 0.f;
  if (w < 2) { lg_b = LOG[(size_t)(r0 + lane) * 16 + w * 4 + h]; lg_a = LOG[(size_t)(r0 + lane) * 16 + 8 + w * 4 + h]; }
  {
    const int i = t >> 3, cg = t & 7, r = r0 + i;
    int s0, len;
    if (r < NCTX) { s0 = r & ~255; len = 256; } else { s0 = NCTX + ((r - NCTX) & ~2047); len = 2048; }
    const int tt = r - s0; const bool hp = tt > 0, hn = tt < len - 1;
#pragma unroll
    for (int x = 0; x < 3; ++x) {
      const int cb = x * 512 + h * 128 + cg * 16;
      const bf16_t* p0 = QKV + (size_t)r * NQKV + cb;
      u32x4 m0 = (u32x4){0u, 0u, 0u, 0u}, m1 = m0, n0 = m0, n1 = m0;
      const u32x4 c0 = *(const u32x4*)p0, c1 = *(const u32x4*)(p0 + 8);
      if (hp) { m0 = *(const u32x4*)(p0 - NQKV); m1 = *(const u32x4*)(p0 - NQKV + 8); }
      if (hn) { n0 = *(const u32x4*)(p0 + NQKV); n1 = *(const u32x4*)(p0 + NQKV + 8); }
      float val[16]; float ss = 0.f;
#pragma unroll
      for (int e = 0; e < 16; ++e) {
        const unsigned wm = (e < 8 ? m0 : m1)[(e & 7) >> 1], wc = (e < 8 ? c0 : c1)[(e & 7) >> 1], wn = (e < 8 ? n0 : n1)[(e & 7) >> 1];
        const float xm = __uint_as_float((e & 1) ? (wm & 0xffff0000u) : (wm << 16));
        const float xc = __uint_as_float((e & 1) ? (wc & 0xffff0000u) : (wc << 16));
        const float xn = __uint_as_float((e & 1) ? (wn & 0xffff0000u) : (wn << 16));
        const float y = cw[cb + e] * xm + cw[NQKV + cb + e] * xc + cw[2 * NQKV + cb + e] * xn;
        val[e] = silu_fast(y); ss += val[e] * val[e];
      }
      if (x < 2) {
        ss += __shfl_xor(ss, 1); ss += __shfl_xor(ss, 2); ss += __shfl_xor(ss, 4);
        const float rn = rsqrtf(ss + 1e-6f) * (x == 0 ? 0.08838834764831845f : 1.0f);
        bf16_t* dst = (x == 0 ? qb : kb) + i * 136 + cg * 16;
        u32x4 o0, o1;
        o0.x = pack_bf16(val[0] * rn, val[1] * rn); o0.y = pack_bf16(val[2] * rn, val[3] * rn); o0.z = pack_bf16(val[4] * rn, val[5] * rn); o0.w = pack_bf16(val[6] * rn, val[7] * rn);
        o1.x = pack_bf16(val[8] * rn, val[9] * rn); o1.y = pack_bf16(val[10] * rn, val[11] * rn); o1.z = pack_bf16(val[12] * rn, val[13] * rn); o1.w = pack_bf16(val[14] * rn, val[15] * rn);
        *(u32x4*)dst = o0; *(u32x4*)(dst + 8) = o1;
      } else {
        float* dst = vf + i * 128 + cg * 16;
#pragma unroll
        for (int e = 0; e < 16; e += 4) *(f32x4*)(dst + e) = (f32x4){val[e], val[e + 1], val[e + 2], val[e + 3]};
      }
    }
  }
  if (w < 2) {
    const int i = lane, d = w;
    const float beta = sigmoid_f(lg_b);
    const float g = -expf(a_log[d * 4 + h]) * softplus_f(lg_a + dt_bias[d * 4 + h]);
    float s = g;
#pragma unroll
    for (int o = 1; o < 64; o <<= 1) {
      const float nb = d == 0 ? __shfl_up(s, o) : __shfl_down(s, o);
      const bool ok = d == 0 ? (lane >= o) : (lane + o < 64);
      if (ok) s += nb;
    }
    sc[d * 64 + i] = beta; sc[128 + d * 64 + i] = s; sc[256 + d * 64 + i] = beta * expf(s);
  }
  __syncthreads();
  {
    const int p = w >> 2, it = w & 3, fr = lane & 15, g = lane >> 4;
    const bf16_t* Ab = p ? qb : kb;
    bf16x8 af[4];
#pragma unroll
    for (int ks = 0; ks < 4; ++ks) af[ks] = *(const bf16x8*)(Ab + (it * 16 + fr) * 136 + ks * 32 + 8 * g);
    bf16_t* qkf = (bf16_t*)(lds + 102400);
    bf16_t* qkb = (bf16_t*)(lds + 102400 + 8192);
#pragma unroll
    for (int jt = 0; jt < 4; ++jt) {
      f32x4 acc = (f32x4){0.f, 0.f, 0.f, 0.f};
#pragma unroll
      for (int ks = 0; ks < 4; ++ks) {
        const bf16x8 bfr = *(const bf16x8*)(kb + (jt * 16 + fr) * 136 + ks * 32 + 8 * g);
        acc = __builtin_amdgcn_mfma_f32_16x16x32_bf16(af[ks], bfr, acc, 0, 0, 0);
      }
      const int j = jt * 16 + fr;
      const float gfj = sc[128 + j], gbj = sc[192 + j];
#pragma unroll
      for (int r = 0; r < 4; ++r) {
        const int i = it * 16 + 4 * g + r;
        const float val = acc[r];
        const float ef = __expf(fminf(sc[128 + i] - gfj, 0.f)), eb = __expf(fminf(sc[192 + i] - gbj, 0.f));
        if (p == 0) {
          Mf[i * MS + j] = (_Float16)((j < i) ? -(sc[i] * val * ef) : 0.f);
          Mb[i * MS + j] = (_Float16)((j > i) ? -(sc[64 + i] * val * eb) : 0.f);
        } else {
          const int jp = perm_inv(j);
          qkf[i * 64 + jp] = f2bf((j <= i) ? val * ef : 0.f);
          qkb[i * 64 + jp] = f2bf((j >= i) ? val * eb : 0.f);
        }
      }
    }
  }
  __syncthreads();
  const int wu = __builtin_amdgcn_readfirstlane(t >> 6);
  if (wu < 2) {
    const int d = wu, I = lane >> 4, cu = lane & 15;
    int rsel = d ? 15 : 0, rst = d ? -1 : 1;
    asm volatile("" : "+v"(rsel), "+v"(rst));
    const _Float16* Mi = (d ? Mb : Mf) + (16 * I) * MS + 16 * I;
    float tc[16];
#pragma unroll
    for (int u = 0; u < 16; ++u) {
      float a = (u == cu) ? 1.f : 0.f;
#pragma unroll
      for (int v = 0; v < u; ++v) a += (float)Mi[(rsel + rst * u) * MS + (rsel + rst * v)] * tc[v];
      tc[u] = a;
    }
#pragma unroll
    for (int u = 0; u < 16; ++u) Tm[((d * 4 + I) * 16 + (rsel + rst * u)) * TS + (rsel + rst * cu)] = (_Float16)tc[u];
  } else {
    const int tt = t - 128;
    for (int q = tt; q < 1024; q += 384) {
      { const int i = q >> 4, s = (q >> 2) & 3, g = q & 3;
        const u32x2 lo = *(const u32x2*)(qb + i * 136 + 32 * s + 4 * g), hi = *(const u32x2*)(qb + i * 136 + 32 * s + 16 + 4 * g);
        *(u32x4*)(pre + PRE_QP + (size_t)(i * 128 + 32 * s + 8 * g) * 2) = (u32x4){lo.x, lo.y, hi.x, hi.y}; }
      { const int dk = q >> 3, s2 = (q >> 2) & 1, g = q & 3;
        unsigned short e[8];
#pragma unroll
        for (int jj = 0; jj < 8; ++jj) e[jj] = kb[(32 * s2 + 16 * (jj >> 2) + 4 * g + (jj & 3)) * 136 + dk];
        u32x4 o; o.x = (unsigned)e[0] | ((unsigned)e[1] << 16); o.y = (unsigned)e[2] | ((unsigned)e[3] << 16); o.z = (unsigned)e[4] | ((unsigned)e[5] << 16); o.w = (unsigned)e[6] | ((unsigned)e[7] << 16);
        *(u32x4*)(pre + PRE_KTP + (size_t)(dk * 64 + 32 * s2 + 8 * g) * 2) = o; }
    }
    {
      const int e = tt, d = e / 192, rem = e % 192, k3 = rem >> 6, i = rem & 63;
      const float glast = d ? sc[192] : sc[128 + 63], gci = sc[128 + d * 64 + i];
      const float v = k3 == 0 ? expf(gci) : (k3 == 1 ? expf(glast - gci) : expf(glast));
      ((float*)(pre + PRE_DIR0 + d * PRE_DIRSZ + PRE_SC))[k3 * 64 + i] = v;
    }
  }
  __syncthreads();
  {
    const int d = wu >> 2, wq = wu & 3, kind = wq >> 1, fr = lane & 15, g = lane >> 4;
    const _Float16* Mi = d ? Mb : Mf;
    f16x4 Tf[4], Mg[4][4];
#pragma unroll
    for (int s2 = 0; s2 < 4; ++s2) {
      const int P = d ? 3 - s2 : s2;
      Tf[s2] = *(const f16x4*)(Tm + ((d * 4 + P) * 16 + fr) * TS + 4 * g);
#pragma unroll
      for (int b2 = 0; b2 < s2; ++b2) { const int Pb = d ? 3 - b2 : b2; Mg[s2][b2] = *(const f16x4*)(Mi + (16 * P + fr) * MS + 16 * Pb + 4 * g); }
    }
    f32x4 acc[4][4];
    {
      float beta[4][4];
#pragma unroll
      for (int s2 = 0; s2 < 4; ++s2)
#pragma unroll
        for (int r = 0; r < 4; ++r) beta[s2][r] = sc[(kind ? 256 : 0) + d * 64 + 16 * (d ? 3 - s2 : s2) + 4 * g + r];
#pragma unroll
      for (int tl = 0; tl < 4; ++tl) {
        const int col = 16 * ((4 * wq + tl) & 7) + fr;
#pragma unroll
        for (int s2 = 0; s2 < 4; ++s2)
#pragma unroll
          for (int r = 0; r < 4; ++r) {
            const int i = 16 * (d ? 3 - s2 : s2) + 4 * g + r;
            acc[tl][s2][r] = beta[s2][r] * (kind ? bf2f(kb[i * 136 + col]) : vf[i * 128 + col]);
          }
      }
    }
    __syncthreads();
    unsigned char* outd = lds + 34816 + d * 32768;
#define H4(x) __builtin_convertvector(x, f16x4)
#define MF16(a, b, c) __builtin_amdgcn_mfma_f32_16x16x16f16(a, b, c, 0, 0, 0)
#pragma unroll
    for (int tl = 0; tl < 4; ++tl) {
      const f32x4 z4 = (f32x4){0.f, 0.f, 0.f, 0.f};
      f32x4 X[4];
      X[0] = MF16(Tf[0], H4(acc[tl][0]), z4);
      { const f16x4 hx = H4(X[0]); acc[tl][1] = MF16(Mg[1][0], hx, acc[tl][1]); acc[tl][2] = MF16(Mg[2][0], hx, acc[tl][2]); acc[tl][3] = MF16(Mg[3][0], hx, acc[tl][3]); }
      X[1] = MF16(Tf[1], H4(acc[tl][1]), z4);
      { const f16x4 hx = H4(X[1]); acc[tl][2] = MF16(Mg[2][1], hx, acc[tl][2]); acc[tl][3] = MF16(Mg[3][1], hx, acc[tl][3]); }
      X[2] = MF16(Tf[2], H4(acc[tl][2]), z4);
      { const f16x4 hx = H4(X[2]); acc[tl][3] = MF16(Mg[3][2], hx, acc[tl][3]); }
      X[3] = MF16(Tf[3], H4(acc[tl][3]), z4);
      if (kind == 0) {
        const int wv = 4 * wq + tl;
#pragma unroll
        for (int s2 = 0; s2 < 4; ++s2) {
          u32x2 pk; pk.x = pack_bf16(X[s2][0], X[s2][1]); pk.y = pack_bf16(X[s2][2], X[s2][3]);
          *(u32x2*)(outd + 16384 + ((wv * 4 + (d ? 3 - s2 : s2)) * 64 + lane) * 8) = pk;
        }
      } else {
        const int kp = perm_inv(16 * (4 * wq + tl - 8) + fr);
        bf16_t* nw = (bf16_t*)outd + kp;
#pragma unroll
        for (int s2 = 0; s2 < 4; ++s2)
#pragma unroll
          for (int r = 0; r < 4; ++r) nw[(16 * (d ? 3 - s2 : s2) + 4 * g + r) * 128] = f2bf(-X[s2][r]);
      }
    }
#undef H4
#undef MF16
  }
  __syncthreads();
  for (int k = 0; k < 8; ++k) {
    const int q = t + 512 * k, d = q >> 11, wi = q & 2047;
    *(u32x4*)(pre + PRE_DIR0 + d * PRE_DIRSZ + wi * 16) = *(const u32x4*)(lds + 34816 + q * 16);
  }
  for (int k = 0; k < 2; ++k) {
    const int q = t + 512 * k, d = q >> 9, wi = q & 511;
    *(u32x4*)(pre + PRE_DIR0 + d * PRE_DIRSZ + PRE_QKP + wi * 16) = *(const u32x4*)(lds + 102400 + q * 16);
  }
  __syncthreads();
}

__global__ __launch_bounds__(512, 2) void k_pre(const bf16_t* __restrict__ QKV, const float* __restrict__ LOG, const float* __restrict__ cw,
                                                const float* __restrict__ a_log, const float* __restrict__ dt_bias, unsigned char* __restrict__ PRE) {
  extern __shared__ __attribute__((aligned(16))) unsigned char smem[];
  for (int item = blockIdx.x; item < 768; item += gridDim.x) pre_item(item, QKV, LOG, cw, a_log, dt_bias, PRE, smem);
}

#define SCAN_OT (2 * SCAN_BUF)
#undef SCAN_LDS
#define SCAN_LDS (2 * SCAN_BUF + 8 * 2048)
__device__ __forceinline__ void scan_item(int b, int h, int d, int chunk0, int nc, int half, bool write_state, const unsigned char* __restrict__ PRE, const float* __restrict__ s_in,
                                          bf16_t* __restrict__ OB, float* __restrict__ s_out, unsigned char* lds) {
  int t_ = threadIdx.x; asm volatile("" : "+v"(t_));
  const int t = t_, lane = t & 63, w = t >> 6, fr = lane & 15, g = lane >> 4;
  const bool active = half < 0 || w < 4;
  const int dvw = half < 0 ? w : half * 4 + (w & 3), dv = 16 * dvw + fr;
  f32x4 S[8];
  if (s_in == nullptr) {
#pragma unroll
    for (int m = 0; m < 8; ++m) S[m] = (f32x4){0.f, 0.f, 0.f, 0.f};
  } else {
#pragma unroll
    for (int m = 0; m < 8; ++m)
#pragma unroll
      for (int r = 0; r < 4; ++r) S[m][r] = s_in[(16 * m + 4 * g + r) * 128 + dv];
  }
  unsigned soff[7], doff[7];
#pragma unroll
  for (int k = 0; k < 7; ++k) {
    const int q = t + 512 * k;
    if (k < 2) { const int row = q >> 4, c = q & 15; soff[k] = PRE_DIR0 + PRE_NW + q * 16; doff[k] = row * 256 + ((c ^ (row & 15)) << 4); }
    else if (k < 4) { const int q2 = q - 1024, row = q2 >> 4, c = q2 & 15; soff[k] = PRE_QP + q2 * 16; doff[k] = 16384 + row * 256 + ((c ^ (row & 15)) << 4); }
    else if (k < 5) { const int q2 = q - 2048, row = q2 >> 3, c = q2 & 7; soff[k] = PRE_DIR0 + PRE_QKP + q2 * 16; doff[k] = 32768 + row * 128 + ((c ^ ((row >> 1) & 7)) << 4); }
    else { const int q2 = q - 2560, row = q2 >> 3, c = q2 & 7; soff[k] = PRE_KTP + q2 * 16; doff[k] = 40960 + row * 128 + ((c ^ ((row >> 1) & 7)) << 4); }
    if (k < 2 || k == 4) soff[k] += d * PRE_DIRSZ;
  }
  const unsigned soff7 = PRE_DIR0 + d * PRE_DIRSZ + PRE_SC + t * 16, doff7 = 57344 + t * 16;
  const unsigned upoff = PRE_DIR0 + d * PRE_DIRSZ + PRE_UP + ((dvw * 4) * 64 + lane) * 8;
  u32x4 st[7]; u32x4 st7 = (u32x4){0u, 0u, 0u, 0u}; u32x2 up[4];
  {
    const int cidx = chunk0 + (d ? nc - 1 : 0);
    const unsigned char* pre = PRE + (size_t)(cidx * 4 + h) * PRE_ITEM;
#pragma unroll
    for (int k = 0; k < 7; ++k) st[k] = *(const u32x4*)(pre + soff[k]);
    if (t < 48) st7 = *(const u32x4*)(pre + soff7);
#pragma unroll
    for (int m = 0; m < 4; ++m) up[m] = *(const u32x2*)(pre + upoff + m * 512);
#pragma unroll
    for (int k = 0; k < 7; ++k) *(u32x4*)(lds + doff[k]) = st[k];
    if (t < 48) *(u32x4*)(lds + doff7) = st7;
  }
  __syncthreads();
  bf16_t* ot = (bf16_t*)(lds + SCAN_OT + w * 2048);
  for (int step = 0; step < nc; ++step) {
    const int cidx = chunk0 + (d ? nc - 1 - step : step);
    const unsigned char* B = lds + (step & 1) * SCAN_BUF;
    const bool more = step + 1 < nc;
    f32x4 a1[4], a2[4];
#pragma unroll
    for (int m = 0; m < 4; ++m) {
      a1[m] = (f32x4){__uint_as_float(up[m].x << 16), __uint_as_float(up[m].x & 0xffff0000u), __uint_as_float(up[m].y << 16), __uint_as_float(up[m].y & 0xffff0000u)};
      a2[m] = (f32x4){0.f, 0.f, 0.f, 0.f};
    }
    if (more) {
      const int cn = chunk0 + (d ? nc - 2 - step : step + 1);
      const unsigned char* pre = PRE + (size_t)(cn * 4 + h) * PRE_ITEM;
#pragma unroll
      for (int k = 0; k < 7; ++k) st[k] = *(const u32x4*)(pre + soff[k]);
      if (t < 48) st7 = *(const u32x4*)(pre + soff7);
#pragma unroll
      for (int m = 0; m < 4; ++m) up[m] = *(const u32x2*)(pre + upoff + m * 512);
    }
    if (active) {
      const float* SC = (const float*)(B + 57344);
      const float gt = SC[128];
      bf16x8 Sb[4];
#pragma unroll
      for (int s = 0; s < 4; ++s) Sb[s] = pack8(S[2 * s], S[2 * s + 1]);
#pragma unroll
      for (int m = 0; m < 8; ++m) S[m] = S[m] * gt;
      {
        bf16x8 fa[2][4], fq[2][4];
#pragma unroll
        for (int m = 0; m < 4; ++m) {
          fa[0][m] = *(const bf16x8*)(B + (16 * m + fr) * 256 + (((0 + g) ^ fr) << 4));
          fq[0][m] = *(const bf16x8*)(B + 16384 + (16 * m + fr) * 256 + (((0 + g) ^ fr) << 4));
        }
#pragma unroll
        for (int s = 0; s < 4; ++s) {
          if (s < 3) {
#pragma unroll
            for (int m = 0; m < 4; ++m) {
              fa[(s + 1) & 1][m] = *(const bf16x8*)(B + (16 * m + fr) * 256 + (((4 * (s + 1) + g) ^ fr) << 4));
              fq[(s + 1) & 1][m] = *(const bf16x8*)(B + 16384 + (16 * m + fr) * 256 + (((4 * (s + 1) + g) ^ fr) << 4));
            }
          }
#pragma unroll
          for (int m = 0; m < 4; ++m) a1[m] = __builtin_amdgcn_mfma_f32_16x16x32_bf16(fa[s & 1][m], Sb[s], a1[m], 0, 0, 0);
#pragma unroll
          for (int m = 0; m < 4; ++m) a2[m] = __builtin_amdgcn_mfma_f32_16x16x32_bf16(fq[s & 1][m], Sb[s], a2[m], 0, 0, 0);
        }
      }
      bf16x8 Vb[2], Vs[2];
#pragma unroll
      for (int s = 0; s < 2; ++s) Vb[s] = pack8(a1[2 * s], a1[2 * s + 1]);
#pragma unroll
      for (int m = 0; m < 4; ++m) { const f32x4 e = *(const f32x4*)(SC + 64 + 16 * m + 4 * g); a1[m] = a1[m] * e; }
#pragma unroll
      for (int s = 0; s < 2; ++s) Vs[s] = pack8(a1[2 * s], a1[2 * s + 1]);
      {
        bf16x8 fk[2][8];
#pragma unroll
        for (int s = 0; s < 2; ++s)
#pragma unroll
          for (int m = 0; m < 8; ++m) fk[s][m] = *(const bf16x8*)(B + 40960 + (16 * m + fr) * 128 + (((4 * s + g) ^ (fr >> 1)) << 4));
#pragma unroll
        for (int s = 0; s < 2; ++s)
#pragma unroll
          for (int m = 0; m < 8; ++m) S[m] = __builtin_amdgcn_mfma_f32_16x16x32_bf16(fk[s][m], Vs[s], S[m], 0, 0, 0);
      }
#pragma unroll
      for (int m = 0; m < 4; ++m) { const f32x4 e = *(const f32x4*)(SC + 16 * m + 4 * g); a2[m] = a2[m] * e; }
#pragma unroll
      for (int s = 0; s < 2; ++s)
#pragma unroll
        for (int m = 0; m < 4; ++m) {
          const bf16x8 fa = *(const bf16x8*)(B + 32768 + (16 * m + fr) * 128 + (((4 * s + g) ^ (fr >> 1)) << 4));
          a2[m] = __builtin_amdgcn_mfma_f32_16x16x32_bf16(fa, Vb[s], a2[m], 0, 0, 0);
        }
#pragma unroll
      for (int m = 0; m < 4; ++m)
#pragma unroll
        for (int r = 0; r < 4; ++r) ot[(16 * m + 4 * g + r) * 16 + fr] = f2bf(a2[m][r]);
      {
        bf16_t* op = OB + ((size_t)d * NTOK + (size_t)cidx * 64) * 512 + h * 128 + 16 * dvw;
#pragma unroll
        for (int k = 0; k < 2; ++k) {
          const int q = lane + 64 * k, row = q >> 1, hf = q & 1;
          *(u32x4*)(op + (size_t)row * 512 + hf * 8) = *(const u32x4*)(ot + row * 16 + hf * 8);
        }
      }
    }
    if (more) {
      unsigned char* Bn = lds + ((step + 1) & 1) * SCAN_BUF;
#pragma unroll
      for (int k = 0; k < 7; ++k) *(u32x4*)(Bn + doff[k]) = st[k];
      if (t < 48) *(u32x4*)(Bn + doff7) = st7;
    }
    __syncthreads();
  }
  if (write_state && active) {
#pragma unroll
    for (int m = 0; m < 8; ++m)
#pragma unroll
      for (int r = 0; r < 4; ++r) s_out[(16 * m + 4 * g + r) * 128 + dv] = S[m][r];
  }
}

__device__ __forceinline__ void scan_item_lat(int b, int h, int d, int chunk0, int nc, int half, const unsigned char* __restrict__ PRE, const float* __restrict__ s_in,
                                              bf16_t* __restrict__ OB, unsigned char* lds) {
  int t_ = threadIdx.x; asm volatile("" : "+v"(t_));
  const int t = t_, lane = t & 63, fr = lane & 15, g = lane >> 4;
  const int wu = __builtin_amdgcn_readfirstlane(t >> 6);
  (void)b;
#define LAT_CIDX(step) (chunk0 + (d ? nc - 1 - (step) : (step)))
  if (wu >= 4) {
    const int tt = t - 256;
    unsigned soff[14], doff[14];
#pragma unroll
    for (int k = 0; k < 14; ++k) {
      const int q = tt + 256 * k;
      if (k < 4) { const int row = q >> 4, c = q & 15; soff[k] = PRE_DIR0 + d * PRE_DIRSZ + PRE_NW + q * 16; doff[k] = row * 256 + ((c ^ (row & 15)) << 4); }
      else if (k < 8) { const int q2 = q - 1024, row = q2 >> 4, c = q2 & 15; soff[k] = PRE_QP + q2 * 16; doff[k] = 16384 + row * 256 + ((c ^ (row & 15)) << 4); }
      else if (k < 10) { const int q2 = q - 2048, row = q2 >> 3, c = q2 & 7; soff[k] = PRE_DIR0 + d * PRE_DIRSZ + PRE_QKP + q2 * 16; doff[k] = 32768 + row * 128 + ((c ^ ((row >> 1) & 7)) << 4); }
      else { const int q2 = q - 2560, row = q2 >> 3, c = q2 & 7; soff[k] = PRE_KTP + q2 * 16; doff[k] = 40960 + row * 128 + ((c ^ ((row >> 1) & 7)) << 4); }
    }
    const unsigned soffS = PRE_DIR0 + d * PRE_DIRSZ + PRE_SC + tt * 16, doffS = 57344 + tt * 16;
    u32x4 ra[14], rb[14], sa = (u32x4){0u, 0u, 0u, 0u}, sb = sa;
#define LAT_LOAD(R, RS, step) do { const unsigned char* pre_ = PRE + (size_t)(LAT_CIDX(step) * 4 + h) * PRE_ITEM; \
      _Pragma("unroll") for (int k = 0; k < 14; ++k) R[k] = *(const u32x4*)(pre_ + soff[k]); if (tt < 48) RS = *(const u32x4*)(pre_ + soffS); } while (0)
#define LAT_WRITE(R, RS, buf) do { unsigned char* B_ = lds + (buf) * SCAN_BUF; \
      _Pragma("unroll") for (int k = 0; k < 14; ++k) *(u32x4*)(B_ + doff[k]) = R[k]; if (tt < 48) *(u32x4*)(B_ + doffS) = RS; } while (0)
    LAT_LOAD(ra, sa, 0); LAT_LOAD(rb, sb, 1);
    LAT_WRITE(ra, sa, 0);
    __syncthreads();
    for (int step = 0; step < nc; step += 2) {
      if (step + 2 < nc) LAT_LOAD(ra, sa, step + 2);
      LAT_WRITE(rb, sb, 1);
      __syncthreads();
      if (step + 3 < nc) LAT_LOAD(rb, sb, step + 3);
      if (step + 2 < nc) LAT_WRITE(ra, sa, 0);
      __syncthreads();
    }
#undef LAT_LOAD
#undef LAT_WRITE
  } else {
    const int w = wu, dvw = half * 4 + w, dv = 16 * dvw + fr;
    f32x4 S[8];
#pragma unroll
    for (int m = 0; m < 8; ++m)
#pragma unroll
      for (int r = 0; r < 4; ++r) S[m][r] = s_in[(16 * m + 4 * g + r) * 128 + dv];
    const unsigned upoff = PRE_DIR0 + d * PRE_DIRSZ + PRE_UP + ((dvw * 4) * 64 + lane) * 8;
    u32x2 upa[4], upb[4];
#define LAT_UP(U, step) do { const unsigned char* pre_ = PRE + (size_t)(LAT_CIDX(step) * 4 + h) * PRE_ITEM; _Pragma("unroll") for (int m = 0; m < 4; ++m) U[m] = *(const u32x2*)(pre_ + upoff + m * 512); } while (0)
    LAT_UP(upa, 0); LAT_UP(upb, 1);
    bf16_t* ot = (bf16_t*)(lds + SCAN_OT + w * 2048);
    __syncthreads();
#define LAT_STEP(UP, step, bufi) do { \
      const int cidx = LAT_CIDX(step); const unsigned char* B = lds + (bufi) * SCAN_BUF; \
      f32x4 a1[4], a2[4]; \
      _Pragma("unroll") for (int m = 0; m < 4; ++m) { \
        a1[m] = (f32x4){__uint_as_float(UP[m].x << 16), __uint_as_float(UP[m].x & 0xffff0000u), __uint_as_float(UP[m].y << 16), __uint_as_float(UP[m].y & 0xffff0000u)}; \
        a2[m] = (f32x4){0.f, 0.f, 0.f, 0.f}; } \
      if ((step) + 2 < nc) LAT_UP(UP, (step) + 2); \
      const float* SC = (const float*)(B + 57344); \
      const float gt = SC[128]; \
      bf16x8 Sb[4]; \
      _Pragma("unroll") for (int s = 0; s < 4; ++s) Sb[s] = pack8(S[2 * s], S[2 * s + 1]); \
      _Pragma("unroll") for (int m = 0; m < 8; ++m) S[m] = S[m] * gt; \
      { bf16x8 fa[2][4], fq[2][4]; \
        _Pragma("unroll") for (int m = 0; m < 4; ++m) { \
          fa[0][m] = *(const bf16x8*)(B + (16 * m + fr) * 256 + (((0 + g) ^ fr) << 4)); \
          fq[0][m] = *(const bf16x8*)(B + 16384 + (16 * m + fr) * 256 + (((0 + g) ^ fr) << 4)); } \
        _Pragma("unroll") for (int s = 0; s < 4; ++s) { \
          if (s < 3) { _Pragma("unroll") for (int m = 0; m < 4; ++m) { \
              fa[(s + 1) & 1][m] = *(const bf16x8*)(B + (16 * m + fr) * 256 + (((4 * (s + 1) + g) ^ fr) << 4)); \
              fq[(s + 1) & 1][m] = *(const bf16x8*)(B + 16384 + (16 * m + fr) * 256 + (((4 * (s + 1) + g) ^ fr) << 4)); } } \
          _Pragma("unroll") for (int m = 0; m < 4; ++m) a1[m] = __builtin_amdgcn_mfma_f32_16x16x32_bf16(fa[s & 1][m], Sb[s], a1[m], 0, 0, 0); \
          _Pragma("unroll") for (int m = 0; m < 4; ++m) a2[m] = __builtin_amdgcn_mfma_f32_16x16x32_bf16(fq[s & 1][m], Sb[s], a2[m], 0, 0, 0); } } \
      bf16x8 Vb[2], Vs[2]; \
      _Pragma("unroll") for (int s = 0; s < 2; ++s) Vb[s] = pack8(a1[2 * s], a1[2 * s + 1]); \
      _Pragma("unroll") for (int m = 0; m < 4; ++m) { const f32x4 e = *(const f32x4*)(SC + 64 + 16 * m + 4 * g); a1[m] = a1[m] * e; } \
      _Pragma("unroll") for (int s = 0; s < 2; ++s) Vs[s] = pack8(a1[2 * s], a1[2 * s + 1]); \
      { bf16x8 fk[2][8]; \
        _Pragma("unroll") for (int s = 0; s < 2; ++s) _Pragma("unroll") for (int m = 0; m < 8; ++m) fk[s][m] = *(const bf16x8*)(B + 40960 + (16 * m + fr) * 128 + (((4 * s + g) ^ (fr >> 1)) << 4)); \
        _Pragma("unroll") for (int s = 0; s < 2; ++s) _Pragma("unroll") for (int m = 0; m < 8; ++m) S[m] = __builtin_amdgcn_mfma_f32_16x16x32_bf16(fk[s][m], Vs[s], S[m], 0, 0, 0); } \
      _Pragma("unroll") for (int m = 0; m < 4; ++m) { const f32x4 e = *(const f32x4*)(SC + 16 * m + 4 * g); a2[m] = a2[m] * e; } \
      _Pragma("unroll") for (int s = 0; s < 2; ++s) _Pragma("unroll") for (int m = 0; m < 4; ++m) { \
          const bf16x8 fa2 = *(const bf16x8*)(B + 32768 + (16 * m + fr) * 128 + (((4 * s + g) ^ (fr >> 1)) << 4)); \
          a2[m] = __builtin_amdgcn_mfma_f32_16x16x32_bf16(fa2, Vb[s], a2[m], 0, 0, 0); } \
      _Pragma("unroll") for (int m = 0; m < 4; ++m) _Pragma("unroll") for (int r = 0; r < 4; ++r) ot[(16 * m + 4 * g + r) * 16 + fr] = f2bf(a2[m][r]); \
      { bf16_t* op = OB + ((size_t)d * NTOK + (size_t)cidx * 64) * 512 + h * 128 + 16 * dvw; \
        _Pragma("unroll") for (int k = 0; k < 2; ++k) { const int q = lane + 64 * k, row = q >> 1, hf = q & 1; \
          *(u32x4*)(op + (size_t)row * 512 + hf * 8) = *(const u32x4*)(ot + row * 16 + hf * 8); } } \
      __syncthreads(); } while (0)
    for (int step = 0; step < nc; step += 2) { LAT_STEP(upa, step, 0); LAT_STEP(upb, step + 1, 1); }
#undef LAT_STEP
#undef LAT_UP
  }
#undef LAT_CIDX
}

__device__ __forceinline__ void scan_dispatch(int i, const unsigned char* PRE, const float* state_in, bf16_t* OB, float* state_out, int layer, unsigned char* lds) {
#ifdef LAT_FULL
  if (i < 32) {
    if (i >= 16) return;
    const int q = i, half = -1, b = q >> 3, h = (q >> 1) & 3, d = q & 1;
#else
  if (i < 32) {
    const int q = i >> 1, half = i & 1, b = q >> 3, h = (q >> 1) & 3, d = q & 1;
#endif
#ifdef LAT_FULL
    scan_item(b, h, d, 128 + b * 32, 32, half, false, PRE, state_in + ((((size_t)b * 2 + layer) * 2 + d) * 4 + h) * 16384, OB, nullptr, lds);
#else
    scan_item_lat(b, h, d, 128 + b * 32, 32, half, PRE, state_in + ((((size_t)b * 2 + layer) * 2 + d) * 4 + h) * 16384, OB, lds);
#endif
  } else {
    const int sid = i - 32, b = sid >> 3, h = (sid >> 1) & 3, d = sid & 1;
    scan_item(b, h, d, b * 4, 4, -1, true, PRE, nullptr, OB, state_out + ((((size_t)b * 2 + layer) * 2 + d) * 4 + h) * 16384, lds);
  }
}

__global__ __launch_bounds__(512, 2) void k_scan2(const unsigned char* __restrict__ PRE, const float* __restrict__ state_in, bf16_t* __restrict__ OB,
                                                  float* __restrict__ state_out, int layer) {
  extern __shared__ __attribute__((aligned(16))) unsigned char smem[];
  for (int i = blockIdx.x; i < 288; i += gridDim.x) scan_dispatch(i, PRE, state_in, OB, state_out, layer, smem);
}
#define XB_TMO      128
#define XB_XCNT(j)  (256  + 64 * (j))
#define XB_XSUB(j)  (1280 + 64 * (j))
#define XB_XGEN(j)  (2304 + 64 * (j))
#define XB_TOP      3328
#define XB_TOPGEN   3392
#define XCD_BAR_WORDS 3456
#define XB_SPIN_CAP (1u << 18)
#define LAS __attribute__((address_space(3)))

__device__ __forceinline__ unsigned xb_ld(unsigned* p)              { return __hip_atomic_load(p, __ATOMIC_RELAXED, __HIP_MEMORY_SCOPE_AGENT); }
__device__ __forceinline__ unsigned xb_add(unsigned* p, unsigned v) { return __hip_atomic_fetch_add(p, v, __ATOMIC_RELAXED, __HIP_MEMORY_SCOPE_AGENT); }
__device__ __forceinline__ unsigned xb_xcc_id() { return (unsigned)__builtin_amdgcn_s_getreg((3 << 11) | 20) & 0xFu; }
#define XB_SPIN(cond, bar) do { unsigned _sp = 0; while (cond) { __builtin_amdgcn_s_sleep(1); \
    if ((++_sp & 255u) == 0u) { if (xb_ld(&(bar)[XB_TMO])) break; if (_sp > XB_SPIN_CAP) { atomicAdd(&(bar)[XB_TMO], 1u); break; } } } } while (0)

struct XcdBarrier {
    unsigned* bar; unsigned x;
    volatile LAS unsigned* st;
};

__device__ __forceinline__ XcdBarrier xcd_barrier_post(unsigned* bar, volatile LAS unsigned* st) {
    XcdBarrier b; b.bar = bar; b.x = xb_xcc_id(); b.st = st;
    if (threadIdx.x == 0) (void)xb_add(&bar[XB_XCNT(b.x)], 1u);
    return b;
}
__device__ __forceinline__ void xcd_barrier_complete(unsigned* bar, unsigned x, unsigned& nloc, unsigned& nx) {
    const unsigned G = gridDim.x * gridDim.y * gridDim.z;
    unsigned sum, cnt, mine, sp = 0u;
    for (;;) {
        sum = 0u; cnt = 0u; mine = 0u;
#pragma unroll
        for (unsigned j = 0; j < 16; ++j) { const unsigned c = xb_ld(&bar[XB_XCNT(j)]); sum += c; cnt += (c > 0u) ? 1u : 0u; mine = (j == x) ? c : mine; }
        if (sum == G) break;
        __builtin_amdgcn_s_sleep(1);
        if ((++sp & 255u) == 0u) { if (xb_ld(&bar[XB_TMO])) break; if (sp > XB_SPIN_CAP) { atomicAdd(&bar[XB_TMO], 1u); break; } }
    }
    nloc = mine > 0u ? mine : 1u; nx = cnt > 0u ? cnt : 1u;
}

__device__ __forceinline__ void xcd_barrier(const XcdBarrier& b) {
    asm volatile("s_waitcnt vmcnt(0)" ::: "memory");
    __syncthreads();
    if (threadIdx.x == 0) {
        unsigned* bar = b.bar;
        __builtin_amdgcn_s_waitcnt(0);
        unsigned nloc = b.st[0], nx = b.st[1];
        if (nloc == 0u) { xcd_barrier_complete(bar, b.x, nloc, nx); b.st[0] = nloc; b.st[1] = nx; }
        const unsigned old = xb_add(&bar[XB_XSUB(b.x)], 1u);
        const unsigned gen = old / nloc;
        if (old + 1u == (gen + 1u) * nloc) {
            __builtin_amdgcn_fence(__ATOMIC_RELEASE, "agent");
            asm volatile("s_waitcnt vmcnt(0)" ::: "memory");
            const unsigned og = xb_add(&bar[XB_TOP], 1u);
            const unsigned tg = og / nx;
            if (og + 1u == (tg + 1u) * nx) xb_add(&bar[XB_TOPGEN], 1u);
            else XB_SPIN(xb_ld(&bar[XB_TOPGEN]) == tg, bar);
            __builtin_amdgcn_fence(__ATOMIC_ACQUIRE, "agent");
            xb_add(&bar[XB_XGEN(b.x)], 1u);
            asm volatile("s_waitcnt vmcnt(0)" ::: "memory");
        } else {
            XB_SPIN(xb_ld(&bar[XB_XGEN(b.x)]) == gen, bar);
            __builtin_amdgcn_fence(__ATOMIC_ACQUIRE, "agent");
            asm volatile("s_waitcnt vmcnt(0)" ::: "memory");
        }
    }
    __syncthreads();
}


#include <hip/hip_cooperative_groups.h>
namespace cg = cooperative_groups;

#define MEGA_LDS_MAIN 143360
#define MEGA_LDS (MEGA_LDS_MAIN + 16)
#define WS_X 0ull
#define WS_WTA (WS_X + (size_t)NTOK * 1024 * 4)
#define WS_WTB (WS_WTA + (size_t)WT_LAYER * 2)
#define WS_QKV (WS_WTB + (size_t)2816 * 1024 * 2)
#define WS_REST (WS_QKV + (size_t)NTOK * NQKV * 2)
#define WS_PRE (WS_REST + (size_t)NTOK * NREST * 2)
#define WS_MIXB (WS_PRE + (size_t)768 * PRE_ITEM)
#define WS_MODS (WS_MIXB + (size_t)NTOK * 1024 * 2)
#define WS_AV (WS_MODS + 2 * 3 * 6144 * 4)
#define WS_BIN (WS_AV + 2 * 2 * 3 * 1024 * 4)
#define WS_BGU (WS_BIN + 2 * 3 * NCOLS * 4)
#define WS_BLOG (WS_BGU + 2 * 3 * 2 * FFH * 4)
#define WS_ROWSS (WS_BLOG + 2 * 3 * 16 * 4 + 128)
#define WS_LOG (WS_ROWSS + 5 * NTOK * 4)
#define WS_BAR (WS_LOG + (size_t)NTOK * 16 * 4)
#define WS_WLT (WS_BAR + 16384)
#define WS_POS (WS_WLT + 2 * 16 * 1024 * 2)
#define WS_SLOT (WS_POS + 96 * 512 * 4)
#define WS_END (WS_SLOT + 48 * 4 * 256 * 4)
struct MP {
  const float *x_prompt, *x_sample, *state_delta, *c, *c_ctx, *w_in, *conv_w, *a_log, *dt_bias, *delta_norm_g, *sgu_norm_g, *w_spatial, *b_spatial,
      *w_pool, *pool_scale, *w_out, *norm1_g, *norm2_g, *w_mod, *b_mod, *w_gu, *w_down, *norm_f;
  float* out; unsigned char* ws;
  __device__ __forceinline__ float* X_() const { return (float*)(ws + WS_X); }
  __device__ __forceinline__ bf16_t* WTA_() const { return (bf16_t*)(ws + WS_WTA); }
  __device__ __forceinline__ bf16_t* WTB_() const { return (bf16_t*)(ws + WS_WTB); }
  __device__ __forceinline__ bf16_t* QKV_() const { return (bf16_t*)(ws + WS_QKV); }
  __device__ __forceinline__ bf16_t* REST_() const { return (bf16_t*)(ws + WS_REST); }
  __device__ __forceinline__ unsigned char* PRE_() const { return ws + WS_PRE; }
  __device__ __forceinline__ bf16_t* MIXB_() const { return (bf16_t*)(ws + WS_MIXB); }
  __device__ __forceinline__ float* mods_() const { return (float*)(ws + WS_MODS); }
  __device__ __forceinline__ float* AV_() const { return (float*)(ws + WS_AV); }
  __device__ __forceinline__ float* BIN_() const { return (float*)(ws + WS_BIN); }
  __device__ __forceinline__ float* BGU_() const { return (float*)(ws + WS_BGU); }
  __device__ __forceinline__ float* BLOG_() const { return (float*)(ws + WS_BLOG); }
  __device__ __forceinline__ float* rowss_() const { return (float*)(ws + WS_ROWSS); }
  __device__ __forceinline__ float* LOG_() const { return (float*)(ws + WS_LOG); }
  __device__ __forceinline__ unsigned* bar_() const { return (unsigned*)(ws + WS_BAR); }
  __device__ __forceinline__ bf16_t* WLT_() const { return (bf16_t*)(ws + WS_WLT); }
  __device__ __forceinline__ float* POS_() const { return (float*)(ws + WS_POS); }
  __device__ __forceinline__ float* SLOT_() const { return (float*)(ws + WS_SLOT); }
};

__device__ __forceinline__ void gemv3_item(const float* __restrict__ W, int ld, int ncols, const float* vec  , float* red  ,
                                           const float* __restrict__ bias, float* __restrict__ o0, float* __restrict__ o1, float* __restrict__ o2, int t) {
  const int col = t & 63, ds = t >> 6;
  float a0 = 0.f, a1 = 0.f, a2 = 0.f;
  if (col < ncols) {
    const float* w = W + (size_t)(ds * 128) * ld + col;
#pragma unroll 16
    for (int d = 0; d < 128; ++d) { const float wv = w[(size_t)d * ld]; const int dd = ds * 128 + d; a0 += vec[dd] * wv; a1 += vec[1024 + dd] * wv; a2 += vec[2048 + dd] * wv; }
  }
  red[(ds * 3 + 0) * 64 + col] = a0; red[(ds * 3 + 1) * 64 + col] = a1; red[(ds * 3 + 2) * 64 + col] = a2;
  __syncthreads();
  if (t < 192) {
    const int s = t >> 6, cc = t & 63;
    float v = 0.f;
#pragma unroll
    for (int k = 0; k < 8; ++k) v += red[(k * 3 + s) * 64 + cc];
    if (cc < ncols) { v += bias ? bias[cc] : 0.f; (s == 0 ? o0 : (s == 1 ? o1 : o2))[cc] = v; }
  }
  __syncthreads();
}

__device__ __forceinline__ void wtile(const MP& p, int l, int r  , bf16_t* wt_in, bf16_t* wt_rest, float* tile, int tt) {
  const float* ml = p.mods_() + l * 3 * 6144;
  if (r < 704) { const int kt = r / 44, jt = r % 44; transpose_tile(p.w_in + (size_t)l * 1024 * INC, INC, win_srccol(jt * 64), wt_in, 1024, jt * 64, kt * 64, tile, tt, ml, p.BIN_() + l * 3 * NCOLS, NCOLS); return; }
  r -= 704;
  if (r < 256) { const int kt = r / 16, jt = r % 16; transpose_tile(p.w_out + (size_t)l * 1024 * 1024, 1024, jt * 64, wt_rest + WT_OUT, 1024, jt * 64, kt * 64, tile, tt, nullptr, nullptr, 0); return; }
  r -= 256;
  if (r < 1408) { const int kt = r / 88, jt = r % 88; transpose_tile(p.w_gu + (size_t)l * 1024 * 2 * FFH, 2 * FFH, wgu_srccol(jt * 64), wt_rest + WT_GU, 1024, jt * 64, kt * 64, tile, tt, ml + 3072, p.BGU_() + l * 3 * 2 * FFH, 2 * FFH); return; }
  r -= 1408;
  { const int kt = r / 16, jt = r % 16; transpose_tile(p.w_down + (size_t)l * FFH * 1024, 1024, jt * 64, wt_rest + WT_DOWN, FFH, jt * 64, kt * 64, tile, tt, nullptr, nullptr, 0); }
}

__device__ __forceinline__ void wtiles(const MP& p, int l, int r_lo, int r_hi, int jb, int njb, unsigned char* smem) {
  int t_ = threadIdx.x; asm volatile("" : "+v"(t_)); const int t = t_;
  float* tile = (float*)smem + (t >> 8) * (64 * 65);
  for (int it = jb; it < (r_hi - r_lo) / 2; it += njb) wtile(p, l, r_lo + it * 2 + (t >> 8), p.WTA_() + WT_IN, p.WTA_(), tile, t & 255);
}

__device__ __forceinline__ void phase_prep0(const MP& p, int bid, int nb, unsigned char* smem, bool tiles) {
  int t_ = threadIdx.x; asm volatile("" : "+v"(t_)); const int t = t_;
  if (!tiles) for (int i = bid * 512 + t; i < 4 * NTOK; i += nb * 512) p.rowss_()[NTOK + i] = 0.f;
  if (!tiles) for (int i = bid * 512 + t; i < 2 * 3 * NCOLS + 2 * 3 * 2 * FFH; i += nb * 512) p.BIN_()[i] = 0.f;
  if (!tiles) for (int i = bid * 512 + t; i < 96 * 512; i += nb * 512) {
    const int rc = i >> 9, dd = i & 511, jj = dd & 255;
    const float omega = 1.0f / powf(10000.0f, (float)jj / 256.0f);
    const float ang = (float)(rc < 32 ? rc : rc - 32) * omega;
    p.POS_()[i] = (dd & 256) ? cosf(ang) : sinf(ang);
  }
  if (!tiles) for (int i = bid * 512 + t; i < 2 * 16 * 1024; i += nb * 512) { const int l = i >> 14, j = (i >> 10) & 15, d = i & 1023; p.WLT_()[i] = f2bf(p.w_in[((size_t)l * 1024 + d) * INC + 2048 + j]); }
  float* vec = (float*)smem; float* red = vec + 3072; float* tile = (float*)(smem + 32768) + (t >> 8) * (64 * 65);
  const int NMOD = 192, NPAIR = 704 / 2;
  for (int it = bid; it < (tiles ? NMOD + NPAIR : NMOD); it += nb) {
    if (it < NMOD) { if (tiles) continue;
      const int l = it / 96, cgp = it % 96;
      for (int i = t; i < 1024; i += 512) { vec[i] = silu_f(p.c_ctx[i]); vec[1024 + i] = silu_f(p.c[i]); vec[2048 + i] = silu_f(p.c[1024 + i]); }
      __syncthreads();
      float* m = p.mods_() + l * 3 * 6144 + cgp * 64;
      gemv3_item(p.w_mod + (size_t)l * 1024 * 6144 + cgp * 64, 6144, 64, vec, red, p.b_mod + l * 6144 + cgp * 64, m, m + 6144, m + 2 * 6144, t);
    } else {
      const int r = (it - NMOD) * 2 + (t >> 8);
      wtile(p, 0, r, p.WTA_() + WT_IN, p.WTA_(), tile, t & 255);
    }
  }
}

__device__ __forceinline__ void phase_vecs(const MP& p, int bid, int nb, unsigned char* smem) {
  int t_ = threadIdx.x; asm volatile("" : "+v"(t_)); const int t = t_;
  float* vec = (float*)smem; float* red = vec + 3072;
  for (int i = bid * 512 + t; i < 2 * 2 * 1024; i += nb * 512) {
    const int l = i >> 11, n = (i >> 10) & 1, d = i & 1023;
    const float g = n ? p.norm2_g[l * 1024 + d] : p.norm1_g[l * 1024 + d];
#pragma unroll
    for (int s = 0; s < 3; ++s) p.AV_()[((l * 2 + n) * 3 + s) * 1024 + d] = g * (1.f + p.mods_()[(l * 3 + s) * 6144 + (n ? 4096 : 1024) + d]);
  }
  const int N_IN = 44, N_GU = 88;
  for (int it = bid; it < 2; it += nb) {
    const int l = it, r = N_IN + N_GU;
    const int sh_off = (r >= N_IN && r < N_IN + N_GU) ? 3072 : 0;
    for (int i = t; i < 1024; i += 512) {
#pragma unroll
      for (int s = 0; s < 3; ++s) vec[s * 1024 + i] = p.mods_()[(l * 3 + s) * 6144 + sh_off + i];
    }
    __syncthreads();
    if (r < N_IN) { float* o = p.BIN_() + l * 3 * NCOLS + r * 64; gemv3_item(p.w_in + (size_t)l * 1024 * INC + win_srccol(r * 64), INC, 64, vec, red, nullptr, o, o + NCOLS, o + 2 * NCOLS, t); }
    else if (r < N_IN + N_GU) { const int j0 = (r - N_IN) * 64; float* o = p.BGU_() + l * 3 * 2 * FFH + j0; gemv3_item(p.w_gu + (size_t)l * 1024 * 2 * FFH + wgu_srccol(j0), 2 * FFH, 64, vec, red, nullptr, o, o + 2 * FFH, o + 4 * FFH, t); }
    else { float* o = p.BLOG_() + l * 3 * 16; gemv3_item(p.w_in + (size_t)l * 1024 * INC + 2048, INC, 16, vec, red, nullptr, o, o + 16, o + 32, t); }
  }
}

__device__ __forceinline__ void prepx_row(const MP& p, int r, int lane) {
  const int seg = seg_of_row(r);
  float ss = 0.f;
#pragma unroll
  for (int i = 0; i < 4; ++i) {
    const int d = i * 256 + lane * 4;
    f32x4 v;
    if (r < NCTX) v = *(const f32x4*)(p.x_prompt + (size_t)r * 1024 + d);
    else {
      const int rl = r - NCTX, pp = rl & 2047, row = pp >> 6, col = pp & 63;
      v = *(const f32x4*)(p.x_sample + (size_t)rl * 1024 + d);
      const f32x4 e = *(const f32x4*)(p.POS_() + (d < 512 ? row * 512 + d : (32 + col) * 512 + (d - 512)));
      v = v + e;
    }
    *(f32x4*)(p.X_() + (size_t)r * 1024 + d) = v;
    ss += (v[0] * v[0] + v[1] * v[1]) + (v[2] * v[2] + v[3] * v[3]);
    const f32x4 g1 = *(const f32x4*)(p.norm1_g + d), sc1 = *(const f32x4*)(p.mods_() + seg * 6144 + 1024 + d);
    const f32x4 a = g1 * (1.f + sc1);
    u32x2 w; w.x = pack_bf16(v[0] * a[0], v[1] * a[1]); w.y = pack_bf16(v[2] * a[2], v[3] * a[3]);
    *(u32x2*)((bf16_t*)p.PRE_() + (size_t)r * 1024 + d) = w;
  }
  ss = wave_sum(ss);
  if (lane == 0) p.rowss_()[r] = ss;
}

__device__ __forceinline__ void phase_logits(const MP& p, int l, int bid, int nb, unsigned char* smem) {
  int tl = threadIdx.x; asm volatile("" : "+v"(tl)); const int t = tl, lane = tl & 63, w = tl >> 6, fr = lane & 15, g = lane >> 4;
  bf16_t* wl = (bf16_t*)smem;
  const bf16_t* XA = (const bf16_t*)p.PRE_();
  for (int q = t; q < 2048; q += 512) { const int j = q >> 7, c = q & 127; *(u32x4*)(wl + j * 1032 + c * 8) = *(const u32x4*)(p.WLT_() + (size_t)l * 16 * 1024 + j * 1024 + c * 8); }
  __syncthreads();
  for (int rg = bid * 8 + w; rg < NTOK / 16; rg += nb * 8) {
    const int row0 = rg * 16;
    const bf16_t* arow = XA + (size_t)(row0 + fr) * 1024 + 8 * g;
    bf16x8 af[32];
#pragma unroll
    for (int ks = 0; ks < 32; ++ks) af[ks] = *(const bf16x8*)(arow + 32 * ks);
    f32x4 acc0 = (f32x4){0.f, 0.f, 0.f, 0.f}, acc1 = acc0;
#pragma unroll
    for (int ks = 0; ks < 32; ks += 2) {
      const bf16x8 b0 = *(const bf16x8*)(wl + fr * 1032 + 32 * ks + 8 * g), b1 = *(const bf16x8*)(wl + fr * 1032 + 32 * (ks + 1) + 8 * g);
      acc0 = __builtin_amdgcn_mfma_f32_16x16x32_bf16(af[ks], b0, acc0, 0, 0, 0);
      acc1 = __builtin_amdgcn_mfma_f32_16x16x32_bf16(af[ks + 1], b1, acc1, 0, 0, 0);
    }
    const int seg = seg_of_row(row0);
    const float bias = p.BLOG_()[l * 3 * 16 + seg * 16 + fr];
#pragma unroll
    for (int r = 0; r < 4; ++r) {
      const int row = row0 + 4 * g + r;
      const float rinv = rsqrtf(p.rowss_()[(2 * l) * NTOK + row] * (1.0f / 1024.0f) + 1e-6f);
      p.LOG_()[(size_t)row * 16 + fr] = (acc0[r] + acc1[r]) * rinv + bias;
    }
  }
  __syncthreads();
}

__device__ __forceinline__ void delta_post_row(const MP& p, int l, int r, int lane) {
  const bf16_t* OB = p.QKV_();
  const u32x4 of = *(const u32x4*)(OB + (size_t)r * 512 + lane * 8), ob = *(const u32x4*)(OB + ((size_t)NTOK + r) * 512 + lane * 8);
  const u32x4 zz = *(const u32x4*)(p.REST_() + (size_t)r * NREST + lane * 8);
  float o[8]; float ss = 0.f;
#pragma unroll
  for (int e = 0; e < 8; ++e) {
    const unsigned wf = of[e >> 1], wb = ob[e >> 1];
    o[e] = __uint_as_float((e & 1) ? (wf & 0xffff0000u) : (wf << 16)) + __uint_as_float((e & 1) ? (wb & 0xffff0000u) : (wb << 16));
    ss += o[e] * o[e];
  }
  ss += __shfl_xor(ss, 1); ss += __shfl_xor(ss, 2); ss += __shfl_xor(ss, 4); ss += __shfl_xor(ss, 8);
  const float rn = rsqrtf(ss * (1.0f / 128.0f) + 1e-6f);
  const float* ng = p.delta_norm_g + l * 128 + (lane & 15) * 8;
  float y[8];
#pragma unroll
  for (int e = 0; e < 8; ++e) {
    const unsigned wz = zz[e >> 1];
    const float z = __uint_as_float((e & 1) ? (wz & 0xffff0000u) : (wz << 16));
    y[e] = o[e] * rn * ng[e] * silu_fast(z);
  }
  u32x4 w; w.x = pack_bf16(y[0], y[1]); w.y = pack_bf16(y[2], y[3]); w.z = pack_bf16(y[4], y[5]); w.w = pack_bf16(y[6], y[7]);
  *(u32x4*)(p.MIXB_() + (size_t)r * 1024 + lane * 8) = w;
}

__device__ __forceinline__ void sgu_pair(const MP& p, int l, int item0, unsigned char* smem) {
  int tl = threadIdx.x; asm volatile("" : "+v"(tl)); const int t = tl & 255, lane = tl & 63, w = __builtin_amdgcn_readfirstlane(tl >> 6), hb = w >> 2, wl = w & 3, fr = lane & 15, g4 = lane >> 4;
  const int item = item0 + hb, ch = item >> 2, g = item & 3;
  const bf16_t* REST = p.REST_(); const float* norm_g = p.sgu_norm_g + l * 256 + g * 64;
  const float* w_s = p.w_spatial + ((size_t)l * 4 + g) * 128 * 128; const float* b_s = p.b_spatial + (l * 4 + g) * 128;
  const int r0 = ch * 128;
  bf16_t* vnT = (bf16_t*)(smem + hb * 35840);
  bf16_t* ut = (bf16_t*)(smem + hb * 35840 + 17408);
  const int s_ = t >> 1, q2 = t & 1;
  const bf16_t* vrow = REST + (size_t)(r0 + s_) * NREST + 768 + g * 64 + q2 * 32;
  u32x4 vv[4];
#pragma unroll
  for (int k = 0; k < 4; ++k) vv[k] = *(const u32x4*)(vrow + 8 * k);
  u32x4 uu[4];
#pragma unroll
  for (int k = 0; k < 4; ++k) { const int q = t + 256 * k, row = q >> 3, c8 = q & 7; uu[k] = *(const u32x4*)(REST + (size_t)(r0 + row) * NREST + 512 + g * 64 + c8 * 8); }
  f32x4 wa[2][4][2];
#pragma unroll
  for (int mt = 0; mt < 2; ++mt) {
    const float* wrow = w_s + (size_t)(wl * 32 + mt * 16 + fr) * 128 + 8 * g4;
#pragma unroll
    for (int ks = 0; ks < 4; ++ks) { wa[mt][ks][0] = *(const f32x4*)(wrow + 32 * ks); wa[mt][ks][1] = *(const f32x4*)(wrow + 32 * ks + 4); }
  }
  {
    float val[32]; float ss = 0.f;
#pragma unroll
    for (int e = 0; e < 32; ++e) {
      const unsigned wv = vv[e >> 3][(e & 7) >> 1];
      val[e] = gelu_fast(__uint_as_float((e & 1) ? (wv & 0xffff0000u) : (wv << 16))); ss += val[e] * val[e];
    }
    ss += __shfl_xor(ss, 1);
    const float rinv = rsqrtf(ss * (1.0f / 64.0f) + 1e-6f);
#pragma unroll
    for (int e = 0; e < 32; ++e) vnT[(q2 * 32 + e) * 136 + s_] = f2bf(val[e] * rinv * norm_g[q2 * 32 + e]);
#pragma unroll
    for (int k = 0; k < 4; ++k) { const int q = t + 256 * k, row = q >> 3, c8 = q & 7; *(u32x4*)(ut + row * 72 + c8 * 8) = uu[k]; }
  }
  __syncthreads();
#pragma unroll
  for (int mt = 0; mt < 2; ++mt) {
    bf16x8 af[4];
#pragma unroll
    for (int ks = 0; ks < 4; ++ks) af[ks] = pack8(wa[mt][ks][0], wa[mt][ks][1]);
    f32x4 acc[4];
#pragma unroll
    for (int nt = 0; nt < 4; ++nt) {
      acc[nt] = (f32x4){0.f, 0.f, 0.f, 0.f};
#pragma unroll
      for (int ks = 0; ks < 4; ++ks) {
        const bf16x8 bfr = *(const bf16x8*)(vnT + (nt * 16 + fr) * 136 + 32 * ks + 8 * g4);
        acc[nt] = __builtin_amdgcn_mfma_f32_16x16x32_bf16(af[ks], bfr, acc[nt], 0, 0, 0);
      }
    }
#pragma unroll
    for (int r = 0; r < 4; ++r) {
      const int tt = wl * 32 + mt * 16 + 4 * g4 + r;
      const float bb = b_s[tt];
#pragma unroll
      for (int nt = 0; nt < 4; ++nt) { bf16_t* e = ut + tt * 72 + nt * 16 + fr; *e = f2bf(gelu_fast(bf2f(*e)) * (acc[nt][r] + bb)); }
    }
  }
  __syncthreads();
#pragma unroll
  for (int k = 0; k < 4; ++k) { const int q = t + 256 * k, row = q >> 3, c8 = q & 7; *(u32x4*)(p.MIXB_() + (size_t)(r0 + row) * 1024 + 512 + g * 64 + c8 * 8) = *(const u32x4*)(ut + row * 72 + c8 * 8); }
  __syncthreads();
}

__device__ __forceinline__ void pool_item(const MP& p, int l, int blk, unsigned char* smem) {
  int tl = threadIdx.x; asm volatile("" : "+v"(tl)); const int t = tl, lane = tl & 63, w = __builtin_amdgcn_readfirstlane(tl >> 6), fr = lane & 15, g4 = lane >> 4;
  const bf16_t* REST = p.REST_(); const float* w_pool = p.w_pool + (size_t)l * 4 * 64 * 64; const float* scale = p.pool_scale + l * 256;
  const int r0 = blk * 64;
  int seg0, seglen;
  if (r0 < NCTX) { seg0 = r0 & ~255; seglen = 256; } else { seg0 = r0; seglen = 64; }
  bf16_t* xs = (bf16_t*)smem;
  bf16_t* dm = (bf16_t*)(smem + 42240);
  bf16_t* wT = (bf16_t*)(smem + 42240 + 36864);
  u32x4 xv[5];
#pragma unroll
  for (int k = 0; k < 5; ++k) {
    const int q = t + 512 * k, lr = q >> 5, c8 = q & 31, row = r0 - 8 + lr;
    xv[k] = (u32x4){0u, 0u, 0u, 0u};
    if (row >= seg0 && row < seg0 + seglen) xv[k] = *(const u32x4*)(REST + (size_t)row * NREST + 1024 + c8 * 8);
  }
  f32x4 wv[8];
#pragma unroll
  for (int k = 0; k < 8; ++k) wv[k] = *(const f32x4*)(w_pool + (size_t)(t + 512 * k) * 4);
#pragma unroll
  for (int k = 0; k < 5; ++k) { const int q = t + 512 * k, lr = q >> 5, c8 = q & 31; *(u32x4*)(xs + lr * 264 + c8 * 8) = xv[k]; }
#pragma unroll
  for (int k = 0; k < 8; ++k) {
    const int q = t + 512 * k, i = q >> 10, c = (q >> 4) & 63, d4 = (q & 15) * 4;
#pragma unroll
    for (int e = 0; e < 4; ++e) wT[(i * 64 + d4 + e) * 72 + c] = f2bf(wv[k][e]);
  }
  __syncthreads();
  {
    const int c = t & 255, i = c >> 6, win = 2 << i, ph = t >> 8, hw = win >> 1;
    const int xoff = seg0 - r0 + 8;
    int pos = r0 + ph * 32 - seg0;
    int lo = max(pos - hw, 0), hi = min(pos + hw, seglen);
    float s = 0.f;
    for (int q = lo; q < hi; ++q) s += bf2f(xs[(q + xoff) * 264 + c]);
#pragma unroll 4
    for (int pp = ph * 32; pp < ph * 32 + 32; ++pp) {
      dm[(i * 64 + pp) * 72 + (c & 63)] = f2bf(s * __builtin_amdgcn_rcpf((float)(hi - lo)) - bf2f(xs[(pp + 8) * 264 + c]));
      ++pos;
      const int lo2 = max(pos - hw, 0), hi2 = min(pos + hw, seglen);
      if (hi2 > hi) s += bf2f(xs[(hi + xoff) * 264 + c]);
      if (lo2 > lo) s -= bf2f(xs[(lo + xoff) * 264 + c]);
      lo = lo2; hi = hi2;
    }
  }
  __syncthreads();
  {
    const int i = w >> 1;
    bf16x8 bfr[4][2];
#pragma unroll
    for (int nt = 0; nt < 4; ++nt)
#pragma unroll
      for (int ks = 0; ks < 2; ++ks) bfr[nt][ks] = *(const bf16x8*)(wT + (i * 64 + nt * 16 + fr) * 72 + 32 * ks + 8 * g4);
#pragma unroll
    for (int pt2 = 0; pt2 < 2; ++pt2) {
      const int pt = (w & 1) * 2 + pt2;
      bf16x8 af[2];
#pragma unroll
      for (int ks = 0; ks < 2; ++ks) af[ks] = *(const bf16x8*)(dm + (i * 64 + pt * 16 + fr) * 72 + 32 * ks + 8 * g4);
#pragma unroll
      for (int nt = 0; nt < 4; ++nt) {
        f32x4 acc = (f32x4){0.f, 0.f, 0.f, 0.f};
#pragma unroll
        for (int ks = 0; ks < 2; ++ks) acc = __builtin_amdgcn_mfma_f32_16x16x32_bf16(af[ks], bfr[nt][ks], acc, 0, 0, 0);
        const float sc = scale[i * 64 + nt * 16 + fr];
#pragma unroll
        for (int r = 0; r < 4; ++r) xs[(pt * 16 + 4 * g4 + r) * 264 + i * 64 + nt * 16 + fr] = f2bf(acc[r] * sc);
      }
    }
  }
  __syncthreads();
#pragma unroll
  for (int k = 0; k < 4; ++k) { const int q = t + 512 * k, row = q >> 5, c8 = q & 31; *(u32x4*)(p.MIXB_() + (size_t)(r0 + row) * 1024 + 768 + c8 * 8) = *(const u32x4*)(xs + row * 264 + c8 * 8); }
  __syncthreads();
}

__device__ __forceinline__ void final_row(const MP& p, int r, int lane) {
  const float rinv = rsqrtf(p.rowss_()[4 * NTOK + r] * (1.0f / 1024.0f) + 1e-6f);
#pragma unroll
  for (int i = 0; i < 4; ++i) {
    const int d = i * 256 + lane * 4;
    const f32x4 v = *(const f32x4*)(p.X_() + (size_t)r * 1024 + d), gg = *(const f32x4*)(p.norm_f + d);
    *(f32x4*)(p.out + (size_t)r * 1024 + d) = v * rinv * gg;
  }
}

#ifndef REPEAT
#define REPEAT 0
#endif
#define REP_CAT2(a, b) a##b
#define REP_CAT(a, b) REP_CAT2(a, b)
#define REP(k) for (int REP_CAT(rep_, __LINE__) = 0; REP_CAT(rep_, __LINE__) < 1 + ((REPEAT >> (k)) & 1); ++REP_CAT(rep_, __LINE__))
#ifndef USE_CG_SYNC
#define USE_CG_SYNC 0
#endif
#if USE_CG_SYNC
#define GRID_SYNC() grid.sync()
#else
#define GRID_SYNC() do { REP(21) { XcdBarrier xb2; xb2.bar = p.bar_(); xb2.x = xb_xcc_id(); xb2.st = xst; xcd_barrier(xb2); } } while (0)
#endif

__global__ __launch_bounds__(512, 2) void mega(MP p) {
  extern __shared__ __attribute__((aligned(16))) unsigned char smem[];
#if USE_CG_SYNC
  cg::grid_group grid = cg::this_grid();
#else
  volatile LAS unsigned* xst = (volatile LAS unsigned*)((LAS unsigned char*)smem + MEGA_LDS_MAIN);
  if (threadIdx.x == 0) { xst[0] = 0u; xst[1] = 0u; }
  __syncthreads();
  (void)xcd_barrier_post(p.bar_(), xst);
#endif
  const int bid = blockIdx.x, nb = gridDim.x;
  bf16_t* XA = (bf16_t*)p.PRE_(); bf16_t* ACT = p.QKV_(); bf16_t* OB = p.QKV_();
  float* states_out = p.out + (size_t)NTOK * 1024;

  REP(0) phase_prep0(p, bid, nb, smem, false);
  GRID_SYNC();
  REP(1) { phase_prep0(p, bid, nb, smem, true); phase_vecs(p, bid, nb, smem); }
  REP(2) { int tl = threadIdx.x; asm volatile("" : "+v"(tl)); const int lane = tl & 63, w = tl >> 6;
    for (int r = bid * 8 + w; r < NTOK; r += nb * 8) prepx_row(p, r, lane); }
  GRID_SYNC();
  for (int l = 0; l < 2; ++l) {
#define TL_DECL int tl = threadIdx.x; asm volatile("" : "+v"(tl)); const int t = tl, lane = tl & 63, w = tl >> 6; (void)t; (void)lane; (void)w
    const float* ml = p.mods_() + l * 3 * 6144;
    float* rs1 = p.rowss_() + (2 * l) * NTOK; float* rs2 = p.rowss_() + (2 * l + 1) * NTOK; float* rs3 = p.rowss_() + (2 * l + 2) * NTOK;
    const float* A2 = p.AV_() + (l * 2 + 1) * 3 * 1024; const float* A1n = p.AV_() + (2 + 0) * 3 * 1024;
    REP(4) {
      pg8::Gemm g; g.A = XA; g.Bt = p.WTA_() + WT_IN; g.M = NTOK; g.N = NCOLS; g.K = 1024;
      EpiIn E{p.QKV_(), p.REST_(), rs1, p.BIN_() + l * 3 * NCOLS};
      pg8::StaticOrder S; S.init(g.M, g.N, nb, bid);
      pg8::gemm_phase<EpiIn, pg8::StaticOrder, true, true>((PG8_LAS unsigned char*)smem, g, S, E);
    }
    REP(3) if (bid >= 16) {
      phase_logits(p, l, bid - 16, nb - 16, smem);
      wtiles(p, l, 704, 2368, bid - 16, nb - 16, smem);
    }
    GRID_SYNC();
    REP(5) for (int item = bid; item < 768; item += nb) pre_item(item, p.QKV_(), p.LOG_(), p.conv_w + (size_t)l * 3 * NQKV, p.a_log + l * 8, p.dt_bias + l * 8, p.PRE_(), smem);
    GRID_SYNC();
    REP(6) { if (bid < 32) { REP(13) scan_dispatch(bid, p.PRE_(), p.state_delta, OB, states_out, l, smem); }
             else { REP(14) for (int i = bid - 32; i < 256; i += nb - 32) scan_dispatch(32 + i, p.PRE_(), p.state_delta, OB, states_out, l, smem); } }
    REP(12) if (bid >= 32) {
      for (int it = bid - 32; it < 192; it += nb - 32) sgu_pair(p, l, 2 * it, smem);
      for (int it = bid - 32; it < 192; it += nb - 32) pool_item(p, l, it, smem);
    }
    GRID_SYNC();
    REP(7) { TL_DECL; for (int r = bid * 8 + w; r < NTOK; r += nb * 8) delta_post_row(p, l, r, lane); }
    GRID_SYNC();
    {
      pg8::Gemm g; g.A = p.MIXB_(); g.Bt = p.WTA_() + WT_OUT; g.M = NTOK; g.N = 1024; g.K = 1024;
      EpiRes E{p.X_(), ml + 2048, rs2, XA, A2};
      pg8::StaticOrder S; S.init(g.M, g.N, nb, bid);
      pg8::gemm_phase<EpiRes, pg8::StaticOrder, true, true>((PG8_LAS unsigned char*)smem, g, S, E);
    }
    if (bid >= 192) wtiles(p, l, 2368, 3072, bid - 192, nb - 192, smem);
    GRID_SYNC();
    REP(9) {
      pg8::Gemm g; g.A = XA; g.Bt = p.WTA_() + WT_GU; g.M = NTOK; g.N = 2 * FFH; g.K = 1024;
      EpiGu E{ACT, rs2, p.BGU_() + l * 3 * 2 * FFH};
      GuOrder S; S.init(nb, bid, -1);
      pg8::gemm_phase<EpiGu, GuOrder, true, true>((PG8_LAS unsigned char*)smem, g, S, E);
    }
    GRID_SYNC();
    unsigned* gu_flag = p.bar_() + 3712 + l * 64;
#define GU_DEFERRED() do { for (int e = bid - 192; e < 48 - GU_DEFER_PM0; e += nb - 192) { \
      pg8::Gemm g; g.A = XA; g.Bt = p.WTA_() + WT_GU; g.M = NTOK; g.N = 2 * FFH; g.K = 1024; \
      EpiGu E{ACT, rs2, p.BGU_() + l * 3 * 2 * FFH}; \
      GuOrder S; S.init(nb, bid, GU_DEFER_PM0 + e); \
      pg8::gemm_phase<EpiGu, GuOrder, true, true>((PG8_LAS unsigned char*)smem, g, S, E); \
      asm volatile("s_waitcnt vmcnt(0)" ::: "memory"); \
      __syncthreads();                                                           \
      if (threadIdx.x == 0) { \
        __builtin_amdgcn_fence(__ATOMIC_RELEASE, "agent");                       \
        asm volatile("s_waitcnt vmcnt(0)" ::: "memory"); \
        __hip_atomic_store(gu_flag + GU_DEFER_PM0 + e, 1u, __ATOMIC_RELAXED, __HIP_MEMORY_SCOPE_AGENT); \
      } \
      __syncthreads(); } } while (0)
    if (l == 0) {
      pg8::Gemm g; g.A = ACT; g.Bt = p.WTA_() + WT_DOWN; g.M = NTOK; g.N = 1024; g.K = FFH;
      EpiRes E{p.X_(), ml + 5120, rs3, XA, A1n};
      DownOrder S; S.S.init(g.M, g.N, nb, bid); S.flag = gu_flag;
      pg8::gemm_phase<EpiRes, DownOrder, true, true>((PG8_LAS unsigned char*)smem, g, S, E);
      if (bid >= 192) { GU_DEFERRED(); wtiles(p, 1, 0, 704, bid - 192, nb - 192, smem); }
      GRID_SYNC();
    } else {
      pg8::Gemm g; g.A = ACT; g.Bt = p.WTA_() + WT_DOWN; g.M = NTOK; g.N = 1024; g.K = FFH;
      EpiResFinal E{p.X_(), ml + 5120, p.out, p.norm_f, p.SLOT_(), p.bar_() + 3584};
      DownOrder S; S.S.init(g.M, g.N, nb, bid); S.flag = gu_flag;
      pg8::gemm_phase<EpiResFinal, DownOrder, false, true>((PG8_LAS unsigned char*)smem, g, S, E);
      if (bid >= 192) GU_DEFERRED();
    }
  }
}

extern "C" void kernel_launch(void* const* d_in, const int* in_sizes, int n_in, void* d_out, int out_size, void* d_ws, size_t ws_size,
                              hipStream_t stream) {
  static int grid_blocks = 0;
  if (!grid_blocks) {
    int dev = 0, cus = 0, per_cu = 0;
    (void)hipGetDevice(&dev);
    (void)hipDeviceGetAttribute(&cus, hipDeviceAttributeMultiprocessorCount, dev);
    (void)hipFuncSetAttribute((const void*)mega, hipFuncAttributeMaxDynamicSharedMemorySize, MEGA_LDS);
    (void)hipOccupancyMaxActiveBlocksPerMultiprocessor(&per_cu, (const void*)mega, 512, MEGA_LDS);
    if (per_cu < 1) { fprintf(stderr, "occupancy query says %d blocks per CU\n", per_cu); per_cu = 1; }
    if (per_cu > 1) per_cu = 1;
    grid_blocks = cus * per_cu;
    if (grid_blocks > 256) grid_blocks = 256;
  }
  MP p; memset(&p, 0, sizeof p);
  const float** ins = (const float**)&p;
  for (int i = 0; i < 23; ++i) ins[i] = (const float*)d_in[i];
  p.out = (float*)d_out;
  p.ws = (unsigned char*)d_ws;
  if (WS_END > ws_size) { fprintf(stderr, "workspace too small: need %zu have %zu\n", (size_t)WS_END, ws_size); return; }
  (void)hipMemsetAsync((char*)d_ws + WS_BAR, 0, 16384, stream);
  void* args[] = {&p};
  hipError_t e = hipLaunchCooperativeKernel((const void*)mega, dim3(grid_blocks), dim3(512), args, MEGA_LDS, stream);
  if (e != hipSuccess) fprintf(stderr, "cooperative launch failed: %s (grid %d)\n", hipGetErrorString(e), grid_blocks);
}
```

```cpp
#include <hip/hip_runtime.h>
#include <math.h>
#include <cstdio>
#include <cstring>

#define NTOK 12288
#define NCTX 8192
#define DM 1024
#define INC 2832
#define FFH 2816
#define NQKV 1536
#define NREST 1280
#define NCOLS 2816

typedef unsigned short bf16_t;
typedef float f32x2_cv __attribute__((ext_vector_type(2)));
typedef __bf16 bf16x2_cv __attribute__((ext_vector_type(2)));
__device__ __forceinline__ unsigned pack_bf16(float lo, float hi) { return __builtin_bit_cast(unsigned, __builtin_convertvector((f32x2_cv){lo, hi}, bf16x2_cv)); }
__device__ __forceinline__ bf16_t f2bf(float f) { return (bf16_t)(pack_bf16(f, 0.f) & 0xffffu); }
__device__ __forceinline__ float bf2f(bf16_t b) { return __uint_as_float(((unsigned)b) << 16); }
__device__ __forceinline__ float silu_f(float x) { return x / (1.f + expf(-x)); }
__device__ __forceinline__ float silu_fast(float x) { return x * __builtin_amdgcn_rcpf(1.f + __expf(-x)); }
__device__ __forceinline__ float gelu_fast(float x) { const float u = 1.5957691216057308f * (x + 0.044715f * x * x * x); return x * __builtin_amdgcn_rcpf(1.f + __expf(-u)); }
__device__ __forceinline__ float sigmoid_f(float x) { return 1.f / (1.f + expf(-x)); }
__device__ __forceinline__ float gelu_f(float x) { return 0.5f * x * (1.f + tanhf(0.7978845608028654f * (x + 0.044715f * x * x * x))); }
__device__ __forceinline__ float softplus_f(float x) { return x > 20.f ? x : log1pf(expf(x)); }
__device__ __forceinline__ int seg_of_row(int r) { return r < NCTX ? 0 : 1 + ((r - NCTX) >> 11); }
__device__ __forceinline__ float wave_sum(float v) {
#pragma unroll
  for (int o = 32; o > 0; o >>= 1) v += __shfl_xor(v, o);
  return v;
}
namespace pg8 {
#define PG8_LAS __attribute__((address_space(3)))
typedef unsigned short bf16_t;
typedef short bf16x8 __attribute__((ext_vector_type(8)));
typedef float f32x4 __attribute__((ext_vector_type(4)));
typedef unsigned u32x4 __attribute__((ext_vector_type(4)));
constexpr int BM = 256, BK = 64, HALF = 128, HTB = HALF * BK * 2  , STAGE_BYTES = 8 * HTB, NXCD = 8, WGM = 8;

__host__ __device__ __forceinline__ int lds_byte(int r, int c) { const int st = (r >> 4) * 2 + (c >> 5), rr = r & 15, cc = c & 31, ob = rr * 64 + cc * 2; return st * 1024 + (ob ^ (((ob >> 9) & 1) << 5)); }
__host__ __device__ __forceinline__ void stage_rc(int b, int& R, int& C) { const int st = b / 1024, sb = b % 1024, swz = sb ^ (((sb >> 9) & 1) << 5); R = (st >> 1) * 16 + swz / 64; C = (st & 1) * 32 + (swz % 64) / 2; }
__host__ __device__ __forceinline__ int perm32(int rho) { const int n = rho >> 4, i = rho & 15; return 8 * (i >> 2) + 4 * n + (i & 3); }

struct Unit { int pm, pn; };
struct Gemm { const bf16_t* A; const bf16_t* Bt; int M, N, K; };

struct StaticOrder {
    int nM, nN, nwg, G, c;
    __host__ __device__ void init(int M, int N, int G_, int c_) { nM = M / BM; nN = N / BM; nwg = nM * nN; G = G_; c = c_; }
    __host__ __device__ bool next(int i, Unit& u) const {
        const long L = (long)i * G + c; if (L >= nwg) return false;
        int wgid = (int)L; { const int q = nwg / NXCD, r = nwg % NXCD, xcd = wgid % NXCD, off = wgid / NXCD; wgid = (xcd < r ? xcd * (q + 1) : r * (q + 1) + (xcd - r) * q) + off; }
        const int nig = WGM * nN, gid = wgid / nig, fm = gid * WGM, gsz = (nM - fm) < WGM ? (nM - fm) : WGM;
        u.pm = fm + ((wgid % nig) % gsz); u.pn = (wgid % nig) / gsz; return true;
    }
    __device__ __forceinline__ void a_ready(const Unit&) const {}
    __device__ __forceinline__ void done(const Unit&) const {}
    static constexpr bool KWAIT = false;
    __device__ __forceinline__ bool k_wait(const Unit&) const { return false; }
};

__device__ __forceinline__ unsigned cvt_pk_bf16(float lo, float hi) { return ::pack_bf16(lo, hi); }
template <class Epi, class Sched, bool ALIGN_EPI = false, bool SP2 = false>
__device__ __forceinline__ void gemm_phase(PG8_LAS unsigned char* lds, const Gemm g, const Sched& S, const Epi& E) {
    int tid_ = threadIdx.x; asm volatile("" : "+v"(tid_));
    const int tid = tid_, wid = __builtin_amdgcn_readfirstlane(tid >> 6), lane = tid & 63, wr = wid >> 2, wc = wid & 3, fr = lane & 15, fq = lane >> 4;
    const int K = g.K, nt = K / BK;
    unsigned voffA[2], voffB[2];
#pragma unroll
    for (int i = 0; i < 2; ++i) { int R, C; stage_rc(tid * 16 + i * 8192, R, C); const int Rb = Epi::PERM ? ((R & ~31) + perm32(R & 31)) : R;
        voffA[i] = (unsigned)(R * K + C) * 2u; voffB[i] = (unsigned)(Rb * K + C) * 2u; }
    const size_t kstep = (size_t)(BK * 2);
    const size_t hstep = (size_t)HALF * K * 2;
    const size_t tstep = 2 * hstep;
    const unsigned ldsw = (unsigned)wid * 1024u;
    const int aoff = lds_byte(wr * 64 + fr, fq * 8), boff = lds_byte(wc * 32 + fr, fq * 8);
#define PG8_SA(b, h) (((b) * 2 + (h)) * HTB)
#define PG8_SB(b, h) ((4 + (b) * 2 + (h)) * HTB)
#define PG8_STAGE(bufoff, gbase, voff) do { _Pragma("unroll") for (int _i = 0; _i < 2; ++_i) \
        __builtin_amdgcn_global_load_lds((const unsigned*)((const char*)(gbase) + (voff)[_i]), (PG8_LAS unsigned*)(lds + (bufoff) + ldsw + _i * 8192), 16, 0, 0); } while (0)
#define PG8_STAGE_SC1(bufoff, gbase, voff) do { _Pragma("unroll") for (int _i = 0; _i < 2; ++_i) \
        __builtin_amdgcn_global_load_lds((const unsigned*)((const char*)(gbase) + (voff)[_i]), (PG8_LAS unsigned*)(lds + (bufoff) + ldsw + _i * 8192), 16, 0, 16); } while (0)
#define PG8_STAGE_A(dep, bufoff, gbase) do { if constexpr (Sched::KWAIT) { if (dep) PG8_STAGE_SC1(bufoff, gbase, voffA); else PG8_STAGE(bufoff, gbase, voffA); } else PG8_STAGE(bufoff, gbase, voffA); } while (0)
#define PG8_LDA(dst, b, h) do { _Pragma("unroll") for (int m = 0; m < 4; ++m) _Pragma("unroll") for (int k = 0; k < 2; ++k) dst[m][k] = *(const PG8_LAS bf16x8*)(lds + PG8_SA(b, h) + aoff + m * 2048 + k * 1024); } while (0)
#define PG8_LDB(dst, b, h) do { _Pragma("unroll") for (int n = 0; n < 2; ++n) _Pragma("unroll") for (int k = 0; k < 2; ++k) dst[n][k] = *(const PG8_LAS bf16x8*)(lds + PG8_SB(b, h) + boff + n * 2048 + k * 1024); } while (0)
#define PG8_MMA(ai, bj, At, Bt) do { __builtin_amdgcn_s_setprio(1); _Pragma("unroll") for (int m = 0; m < 4; ++m) _Pragma("unroll") for (int n = 0; n < 2; ++n) _Pragma("unroll") for (int k = 0; k < 2; ++k) \
        acc[ai][bj][m][n] = __builtin_amdgcn_mfma_f32_16x16x32_bf16(Bt[n][k], At[m][k], acc[ai][bj][m][n], 0, 0, 0); PG8_XMMA(ai, bj, At); __builtin_amdgcn_s_setprio(0); } while (0)
#ifdef XMMA
#define PG8_XMMA(ai, bj, At) do { _Pragma("unroll") for (int m = 0; m < 4; ++m) _Pragma("unroll") for (int n = 0; n < 2; ++n) acc[ai][bj][m][n] = __builtin_amdgcn_mfma_f32_16x16x32_bf16(zerov, At[m][0], acc[ai][bj][m][n], 0, 0, 0); } while (0)
#else
#define PG8_XMMA(ai, bj, At) do { } while (0)
#endif
#define PG8_WAIT_V(n) asm volatile("s_waitcnt vmcnt(" #n ")" ::: "memory")
#define PG8_WAIT_L(n) asm volatile("s_waitcnt lgkmcnt(" #n ")" ::: "memory")
#define PG8_BAR __builtin_amdgcn_s_barrier()
#define PG8_SCHED __builtin_amdgcn_sched_barrier(0)
    Unit cur, nxt; int ui = 0;
    if (!S.next(0, cur)) return;
    f32x4 acc[2][2][4][2];
#pragma unroll
    for (int a = 0; a < 2; ++a)
#pragma unroll
        for (int b = 0; b < 2; ++b)
#pragma unroll
            for (int m = 0; m < 4; ++m)
#pragma unroll
                for (int n = 0; n < 2; ++n) acc[a][b][m][n] = (f32x4){0.f, 0.f, 0.f, 0.f};
    bf16x8 At[4][2], B0[2][2], B1[2][2];
#ifdef XMMA
    bf16x8 zerov = (bf16x8){0, 0, 0, 0, 0, 0, 0, 0}; asm volatile("" : "+v"(zerov));
#endif
    const char* cA = (const char*)g.A + (size_t)cur.pm * tstep; const char* cB = (const char*)g.Bt + (size_t)cur.pn * tstep;
    S.a_ready(cur);
    if constexpr (SP2) {
        PG8_STAGE(PG8_SB(0, 0), cB, voffB); PG8_STAGE(PG8_SB(0, 1), cB + hstep, voffB); PG8_STAGE(PG8_SA(0, 0), cA, voffA); PG8_STAGE(PG8_SA(0, 1), cA + hstep, voffA);
        if (wr == 1) PG8_BAR;
        PG8_WAIT_V(2); PG8_BAR;
        PG8_STAGE(PG8_SB(1, 0), cB + kstep, voffB); PG8_STAGE(PG8_SA(1, 0), cA + kstep, voffA); PG8_STAGE(PG8_SB(1, 1), cB + hstep + kstep, voffB);
        PG8_WAIT_V(6); PG8_BAR;
    } else {
        PG8_STAGE(PG8_SB(0, 0), cB, voffB); PG8_STAGE(PG8_SA(0, 0), cA, voffA); PG8_STAGE(PG8_SB(0, 1), cB + hstep, voffB); PG8_STAGE(PG8_SA(0, 1), cA + hstep, voffA);
        if (wr == 1) PG8_BAR;
        PG8_WAIT_V(4); PG8_BAR;
        PG8_STAGE(PG8_SB(1, 0), cB + kstep, voffB); PG8_STAGE(PG8_SA(1, 0), cA + kstep, voffA); PG8_STAGE(PG8_SB(1, 1), cB + hstep + kstep, voffB);
        PG8_WAIT_V(6); PG8_BAR;
    }
    static_assert(!Sched::KWAIT || SP2, "KWAIT schedulers: SP2 loop only");
    bool dep_unit = false;
    for (;;) {
        const bool has_next = S.next(ui + 1, nxt);
        const char* nA = has_next ? (const char*)g.A + (size_t)nxt.pm * tstep : cA; const char* nB = has_next ? (const char*)g.Bt + (size_t)nxt.pn * tstep : cB;
        for (int t = 0; t < nt; t += 2) {
            bool dep23 = false, dep1 = false;
            if constexpr (Sched::KWAIT) { if (t == nt - 4) dep_unit = S.k_wait(cur); dep23 = dep_unit && (t == nt - 4); dep1 = dep_unit && (t == nt - 2); }
            const bool last = (t == nt - 2);
            const char* a1 = cA + (size_t)(t + 1) * kstep;
            const char* a2 = last ? nA : cA + (size_t)(t + 2) * kstep; const char* b2 = last ? nB : cB + (size_t)(t + 2) * kstep;
            const char* a3 = a2 + kstep; const char* b3 = b2 + kstep;
            if (last && has_next) S.a_ready(nxt);
            if constexpr (SP2) {
            PG8_LDB(B0, 0, 0); PG8_LDB(B1, 0, 1); PG8_SCHED; PG8_LDA(At, 0, 0); PG8_STAGE_A(dep1, PG8_SA(1, 1), a1 + hstep);
            PG8_WAIT_V(8); PG8_WAIT_L(0); PG8_BAR; PG8_MMA(0, 0, At, B0); PG8_MMA(0, 1, At, B1); PG8_BAR; PG8_SCHED;
            PG8_LDA(At, 0, 1); PG8_STAGE(PG8_SB(0, 0), b2, voffB); PG8_STAGE(PG8_SB(0, 1), b2 + hstep, voffB); PG8_STAGE_A(dep23, PG8_SA(0, 0), a2);
            PG8_WAIT_V(8); PG8_WAIT_L(0); PG8_BAR; PG8_MMA(1, 0, At, B0); PG8_MMA(1, 1, At, B1); PG8_BAR; PG8_SCHED;
            PG8_LDB(B0, 1, 0); PG8_LDB(B1, 1, 1); PG8_SCHED; PG8_LDA(At, 1, 0); PG8_STAGE_A(dep23, PG8_SA(0, 1), a2 + hstep);
            PG8_WAIT_V(8); PG8_WAIT_L(0); PG8_BAR; PG8_MMA(0, 0, At, B0); PG8_MMA(0, 1, At, B1); PG8_BAR; PG8_SCHED;
            PG8_LDA(At, 1, 1); PG8_STAGE(PG8_SB(1, 0), b3, voffB); PG8_STAGE(PG8_SB(1, 1), b3 + hstep, voffB); PG8_STAGE_A(dep23, PG8_SA(1, 0), a3);
            PG8_WAIT_V(8); PG8_WAIT_L(0); PG8_BAR; PG8_MMA(1, 0, At, B0); PG8_MMA(1, 1, At, B1); PG8_BAR; PG8_SCHED;
            } else {
            PG8_LDB(B0, 0, 0); PG8_SCHED; PG8_LDA(At, 0, 0); PG8_STAGE(PG8_SA(1, 1), a1 + hstep, voffA);
            PG8_WAIT_L(8); PG8_BAR; PG8_WAIT_L(0); PG8_MMA(0, 0, At, B0); PG8_BAR; PG8_SCHED;
            PG8_LDB(B1, 0, 1); PG8_STAGE(PG8_SB(0, 0), b2, voffB);
            PG8_BAR; PG8_WAIT_L(0); PG8_MMA(0, 1, At, B1); PG8_BAR;
            PG8_LDA(At, 0, 1); PG8_STAGE(PG8_SA(0, 0), a2, voffA);
            PG8_BAR; PG8_WAIT_L(0); PG8_MMA(1, 0, At, B0); PG8_BAR; PG8_SCHED;
            PG8_STAGE(PG8_SB(0, 1), b2 + hstep, voffB);
            PG8_WAIT_V(6); PG8_BAR; PG8_MMA(1, 1, At, B1); PG8_BAR;
            PG8_LDB(B0, 1, 0); PG8_SCHED; PG8_LDA(At, 1, 0); PG8_STAGE(PG8_SA(0, 1), a2 + hstep, voffA);
            PG8_WAIT_L(8); PG8_BAR; PG8_WAIT_L(0); PG8_MMA(0, 0, At, B0); PG8_BAR; PG8_SCHED;
            PG8_LDB(B1, 1, 1); PG8_STAGE(PG8_SB(1, 0), b3, voffB);
            PG8_BAR; PG8_WAIT_L(0); PG8_MMA(0, 1, At, B1); PG8_BAR;
            PG8_LDA(At, 1, 1); PG8_STAGE(PG8_SA(1, 0), a3, voffA);
            PG8_BAR; PG8_WAIT_L(0); PG8_MMA(1, 0, At, B0); PG8_BAR; PG8_SCHED;
            PG8_STAGE(PG8_SB(1, 1), b3 + hstep, voffB);
            PG8_WAIT_V(6); PG8_BAR; PG8_MMA(1, 1, At, B1); PG8_BAR;
            }
        }
        if constexpr (ALIGN_EPI) { if (wr == 0) PG8_BAR; }
        if constexpr (!Epi::AFTER_DRAIN) { E(acc, cur, wr, wc, fr, fq); S.done(cur); }
        if (!has_next) break;
#pragma unroll
        for (int a = 0; a < 2; ++a)
#pragma unroll
            for (int b = 0; b < 2; ++b)
#pragma unroll
                for (int m = 0; m < 4; ++m)
#pragma unroll
                    for (int n = 0; n < 2; ++n) acc[a][b][m][n] = (f32x4){0.f, 0.f, 0.f, 0.f};
        cur = nxt; cA = nA; cB = nB; ++ui;
        if constexpr (ALIGN_EPI) { if (wr == 1) PG8_BAR; }
    }
    PG8_WAIT_V(0);
    if constexpr (!ALIGN_EPI) { if (wr == 0) PG8_BAR; }
    PG8_BAR;
    if constexpr (Epi::AFTER_DRAIN) { E.fused(acc, cur, wr, wc, fr, fq, lds, wid, lane); S.done(cur); }
#undef PG8_SA
#undef PG8_SB
#undef PG8_STAGE
#undef PG8_STAGE_SC1
#undef PG8_STAGE_A
#undef PG8_LDA
#undef PG8_LDB
#undef PG8_MMA
#undef PG8_XMMA
#undef PG8_WAIT_V
#undef PG8_WAIT_L
#undef PG8_BAR
#undef PG8_SCHED
}
}

using pg8::f32x4; using pg8::u32x4; using pg8::Unit; using pg8::HALF; using pg8::BM;
typedef unsigned u32x2 __attribute__((ext_vector_type(2)));

struct EpiIn {
  static constexpr bool PERM = true, AFTER_DRAIN = false;
  bf16_t* qkv; bf16_t* rest; const float* rowss; const float* bias;
  __device__ __forceinline__ void operator()(const f32x4 (&acc)[2][2][4][2], const Unit& u, int wr, int wc, int fr, int fq) const {
    const int row0 = u.pm * BM + wr * 64 + fr;
    const int seg = seg_of_row(u.pm * BM);
    int colt = u.pn * BM; bf16_t* base = qkv; int ldc = NQKV;
    if (colt >= NQKV) { base = rest; ldc = NREST; colt -= NQKV; }
    const int col0 = colt + wc * 32 + 8 * fq, bcol0 = seg * NCOLS + u.pn * BM + wc * 32 + 8 * fq;
    f32x4 bv[2][2];
#pragma unroll
    for (int bj = 0; bj < 2; ++bj)
#pragma unroll
      for (int n = 0; n < 2; ++n) bv[bj][n] = *(const f32x4*)(bias + bcol0 + bj * HALF + 4 * n);
#pragma unroll
    for (int ai = 0; ai < 2; ++ai)
#pragma unroll
      for (int m = 0; m < 4; ++m) {
        const int r = row0 + ai * HALF + m * 16;
        const float rinv = rsqrtf(rowss[r] * (1.0f / 1024.0f) + 1e-6f);
        bf16_t* rowp = base + (size_t)r * ldc + col0;
#pragma unroll
        for (int bj = 0; bj < 2; ++bj) {
          const f32x4 v0 = acc[ai][bj][m][0] * rinv + bv[bj][0], v1 = acc[ai][bj][m][1] * rinv + bv[bj][1];
          u32x4 w; w.x = pg8::cvt_pk_bf16(v0[0], v0[1]); w.y = pg8::cvt_pk_bf16(v0[2], v0[3]); w.z = pg8::cvt_pk_bf16(v1[0], v1[1]); w.w = pg8::cvt_pk_bf16(v1[2], v1[3]);
          *(u32x4*)(rowp + bj * HALF) = w;
        }
      }
  }
};

struct EpiRes {
  static constexpr bool PERM = false, AFTER_DRAIN = false;
  float* X; const float* gate; float* rowss; bf16_t* xa; const float* An;
  __device__ __forceinline__ void operator()(const f32x4 (&acc)[2][2][4][2], const Unit& u, int wr, int wc, int fr, int fq) const {
    const int row0 = u.pm * BM + wr * 64 + fr, col0 = u.pn * BM + wc * 32 + 4 * fq;
    const int seg = seg_of_row(u.pm * BM);
    f32x4 gv[2][2], av[2][2];
#pragma unroll
    for (int bj = 0; bj < 2; ++bj)
#pragma unroll
      for (int n = 0; n < 2; ++n) {
        gv[bj][n] = *(const f32x4*)(gate + seg * 6144 + col0 + bj * HALF + n * 16);
        av[bj][n] = xa ? *(const f32x4*)(An + seg * 1024 + col0 + bj * HALF + n * 16) : (f32x4){0.f, 0.f, 0.f, 0.f};
      }
#pragma unroll
    for (int ai = 0; ai < 2; ++ai)
#pragma unroll
      for (int m = 0; m < 4; ++m) {
        const int r = row0 + ai * HALF + m * 16;
        float* xrow = X + (size_t)r * 1024 + col0;
        float ss = 0.f;
#pragma unroll
        for (int bj = 0; bj < 2; ++bj)
#pragma unroll
          for (int n = 0; n < 2; ++n) {
            const f32x4 xo = *(const f32x4*)(xrow + bj * HALF + n * 16);
            const f32x4 xn = xo + gv[bj][n] * acc[ai][bj][m][n];
            *(f32x4*)(xrow + bj * HALF + n * 16) = xn;
            ss += (xn[0] * xn[0] + xn[1] * xn[1]) + (xn[2] * xn[2] + xn[3] * xn[3]);
            if (xa) {
              const f32x4 t = xn * av[bj][n];
              u32x2 w; w.x = pg8::cvt_pk_bf16(t[0], t[1]); w.y = pg8::cvt_pk_bf16(t[2], t[3]);
              *(u32x2*)(xa + (size_t)r * 1024 + col0 + bj * HALF + n * 16) = w;
            }
          }
        ss += __shfl_xor(ss, 16); ss += __shfl_xor(ss, 32);
        if (fq == 0) atomicAdd(rowss + r, ss);
      }
  }
};

struct EpiGu {
  static constexpr bool PERM = true, AFTER_DRAIN = false;
  bf16_t* act; const float* rowss; const float* bias;
  __device__ __forceinline__ void operator()(const f32x4 (&acc)[2][2][4][2], const Unit& u, int wr, int wc, int fr, int fq) const {
    const int row0 = u.pm * BM + wr * 64 + fr;
    const int seg = seg_of_row(u.pm * BM);
    const int hid0 = u.pn * HALF + wc * 32 + 8 * fq, bcol0 = seg * (2 * FFH) + u.pn * BM + wc * 32 + 8 * fq;
    f32x4 bv[2][2];
#pragma unroll
    for (int bj = 0; bj < 2; ++bj)
#pragma unroll
      for (int n = 0; n < 2; ++n) bv[bj][n] = *(const f32x4*)(bias + bcol0 + bj * HALF + 4 * n);
#pragma unroll
    for (int ai = 0; ai < 2; ++ai)
#pragma unroll
      for (int m = 0; m < 4; ++m) {
        const int r = row0 + ai * HALF + m * 16;
        const float rinv = rsqrtf(rowss[r] * (1.0f / 1024.0f) + 1e-6f);
        float o[8];
#pragma unroll
        for (int n = 0; n < 2; ++n) {
          const f32x4 g = acc[ai][0][m][n] * rinv + bv[0][n], up = acc[ai][1][m][n] * rinv + bv[1][n];
#pragma unroll
          for (int j = 0; j < 4; ++j) o[n * 4 + j] = g[j] * __builtin_amdgcn_rcpf(1.f + __expf(-g[j])) * up[j];
        }
        u32x4 w; w.x = pg8::cvt_pk_bf16(o[0], o[1]); w.y = pg8::cvt_pk_bf16(o[2], o[3]); w.z = pg8::cvt_pk_bf16(o[4], o[5]); w.w = pg8::cvt_pk_bf16(o[6], o[7]);
        *(u32x4*)(act + (size_t)r * FFH + hid0) = w;
      }
  }
};


struct EpiResFinal {
  static constexpr bool PERM = false, AFTER_DRAIN = true;
  const float* X; const float* gate; float* out; const float* normf; float* slots; unsigned* cnt;
  __device__ __forceinline__ void operator()(const f32x4 (&)[2][2][4][2], const Unit&, int, int, int, int) const {}
  __device__ __forceinline__ void fused(f32x4 (&acc)[2][2][4][2], const Unit& u, int wr, int wc, int fr, int fq, PG8_LAS unsigned char* lds, int wid, int lane) const {
    PG8_LAS float* P = (PG8_LAS float*)lds;
    PG8_LAS float* R = (PG8_LAS float*)(lds + 4096);
    const int row0 = u.pm * BM + wr * 64 + fr, col0 = u.pn * BM + wc * 32 + 4 * fq;
    const int seg = seg_of_row(u.pm * BM);
    f32x4 gv[2][2];
#pragma unroll
    for (int bj = 0; bj < 2; ++bj)
#pragma unroll
      for (int n = 0; n < 2; ++n) gv[bj][n] = *(const f32x4*)(gate + seg * 6144 + col0 + bj * HALF + n * 16);
#pragma unroll
    for (int ai = 0; ai < 2; ++ai)
#pragma unroll
      for (int m = 0; m < 4; ++m) {
        const int r = row0 + ai * HALF + m * 16;
        const float* xrow = X + (size_t)r * 1024 + col0;
        float ss = 0.f;
#pragma unroll
        for (int bj = 0; bj < 2; ++bj)
#pragma unroll
          for (int n = 0; n < 2; ++n) {
            const f32x4 xo = *(const f32x4*)(xrow + bj * HALF + n * 16);
            const f32x4 xn = xo + gv[bj][n] * acc[ai][bj][m][n];
            acc[ai][bj][m][n] = xn;
            ss += (xn[0] * xn[0] + xn[1] * xn[1]) + (xn[2] * xn[2] + xn[3] * xn[3]);
          }
        ss += __shfl_xor(ss, 16); ss += __shfl_xor(ss, 32);
        if (fq == 0) P[(ai * HALF + wr * 64 + m * 16 + fr) * 4 + wc] = ss;
      }
    __syncthreads();
    const int tid = wid * 64 + lane;
    if (tid < 256) {
      const float s = (P[tid * 4 + 0] + P[tid * 4 + 1]) + (P[tid * 4 + 2] + P[tid * 4 + 3]);
      __hip_atomic_store(slots + (size_t)(u.pm * 4 + u.pn) * 256 + tid, s, __ATOMIC_RELAXED, __HIP_MEMORY_SCOPE_AGENT);
    }
    asm volatile("s_waitcnt vmcnt(0)" ::: "memory");
    __syncthreads();
    if (tid == 0) {
      (void)__hip_atomic_fetch_add(cnt + u.pm, 1u, __ATOMIC_RELAXED, __HIP_MEMORY_SCOPE_AGENT);
      unsigned sp = 0u;
      while (__hip_atomic_load(cnt + u.pm, __ATOMIC_RELAXED, __HIP_MEMORY_SCOPE_AGENT) < 4u) { __builtin_amdgcn_s_sleep(1); if (++sp > (1u << 22)) break; }
      __builtin_amdgcn_fence(__ATOMIC_ACQUIRE, "agent");
      asm volatile("s_waitcnt vmcnt(0)" ::: "memory");
    }
    __syncthreads();
    if (tid < 256) {
      float tot = 0.f;
#pragma unroll
      for (int k = 0; k < 4; ++k) tot += __hip_atomic_load(slots + (size_t)(u.pm * 4 + k) * 256 + tid, __ATOMIC_RELAXED, __HIP_MEMORY_SCOPE_AGENT);
      R[tid] = rsqrtf(tot * (1.0f / 1024.0f) + 1e-6f);
    }
    __syncthreads();
    f32x4 nf[2][2];
#pragma unroll
    for (int bj = 0; bj < 2; ++bj)
#pragma unroll
      for (int n = 0; n < 2; ++n) nf[bj][n] = *(const f32x4*)(normf + col0 + bj * HALF + n * 16);
#pragma unroll
    for (int ai = 0; ai < 2; ++ai)
#pragma unroll
      for (int m = 0; m < 4; ++m) {
        const int lr = ai * HALF + wr * 64 + m * 16 + fr;
        const float rinv = R[lr];
        float* orow = out + (size_t)(u.pm * BM + lr) * 1024 + col0;
#pragma unroll
        for (int bj = 0; bj < 2; ++bj)
#pragma unroll
          for (int n = 0; n < 2; ++n) *(f32x4*)(orow + bj * HALF + n * 16) = acc[ai][bj][m][n] * rinv * nf[bj][n];
      }
  }
};

#define GU_DEFER_PM0 16
struct GuOrder {
  static constexpr bool KWAIT = false;
  pg8::StaticOrder S; int solo;
  __device__ __forceinline__ void init(int G, int c, int solo_) { S.nM = NTOK / pg8::BM; S.nN = 21; S.nwg = S.nM * 21; S.G = G; S.c = c; solo = solo_; }
  __device__ __forceinline__ bool next(int i, pg8::Unit& u) const {
    if (solo >= 0) { if (i) return false; u.pm = solo; u.pn = 21; return true; }
    if (S.next(i, u)) return true;
    const long L = (long)i * S.G + S.c - S.nwg;
    if (L < GU_DEFER_PM0) { u.pm = (int)L; u.pn = 21; return true; }
    return false;
  }
  __device__ __forceinline__ void a_ready(const pg8::Unit&) const {}
  __device__ __forceinline__ void done(const pg8::Unit&) const {}
  __device__ __forceinline__ bool k_wait(const pg8::Unit&) const { return false; }
};
#ifndef DOWN_KWAIT
#define DOWN_KWAIT true
#endif
struct DownOrder {
  static constexpr bool KWAIT = DOWN_KWAIT;
  pg8::StaticOrder S; unsigned* flag;
  __device__ __forceinline__ bool next(int i, pg8::Unit& u) const { return S.next(i, u); }
  __device__ __forceinline__ void a_ready(const pg8::Unit&) const {}
  __device__ __forceinline__ void done(const pg8::Unit&) const {}
  __device__ __forceinline__ bool k_wait(const pg8::Unit& u) const {
    if (u.pm < GU_DEFER_PM0) return false;
    unsigned sp = 0u;
    while (__builtin_amdgcn_readfirstlane(__hip_atomic_load(flag + u.pm, __ATOMIC_RELAXED, __HIP_MEMORY_SCOPE_AGENT)) == 0u) { __builtin_amdgcn_s_sleep(1); if (++sp > (1u << 22)) break; }
    asm volatile("" ::: "memory");
    return true;
  }
};

__device__ __forceinline__ int win_srccol(int j) { return j < 2048 ? j : j + 16; }
__device__ __forceinline__ int wgu_srccol(int j) { const int pn = j >> 8, w = j & 255; return w < 128 ? pn * 128 + w : FFH + pn * 128 + (w - 128); }

struct WTile { const float* src; bf16_t* dst; const float* shv; float* bias; int ldsrc, srccol0, K, j0, k0, bstride; };
__device__ __forceinline__ void wtile_load(const WTile& d, float (&v)[16], int t) {
  const int jl = t & 63, kg = t >> 6;
#pragma unroll
  for (int i = 0; i < 16; ++i) v[i] = d.src[(size_t)(d.k0 + kg * 16 + i) * d.ldsrc + d.srccol0 + jl];
}
__device__ __forceinline__ void wtile_put(float* tile, const float (&v)[16], int t) {
  const int jl = t & 63, kg = t >> 6;
#pragma unroll
  for (int i = 0; i < 16; ++i) tile[jl * 65 + kg * 16 + i] = v[i];
}
__device__ __forceinline__ void wtile_finish(const WTile& d, const float* tile, int t) {
  const int j = t >> 2, kc = (t & 3) * 16;
  const float* s = tile + j * 65 + kc;
  float sv[16];
#pragma unroll
  for (int i = 0; i < 16; ++i) sv[i] = s[i];
  if (d.shv) {
    float a[3];
#pragma unroll
    for (int sg = 0; sg < 3; ++sg) {
      const float* sh = d.shv + sg * 6144 + d.k0 + kc;
      float acc = 0.f;
#pragma unroll
      for (int i = 0; i < 16; i += 4) { const f32x4 h4 = *(const f32x4*)(sh + i); acc += (h4[0] * sv[i] + h4[1] * sv[i + 1]) + (h4[2] * sv[i + 2] + h4[3] * sv[i + 3]); }
      acc += __shfl_xor(acc, 1); acc += __shfl_xor(acc, 2);
      a[sg] = acc;
    }
    if ((t & 3) == 0) { atomicAdd(d.bias + d.j0 + j, a[0]); atomicAdd(d.bias + d.bstride + d.j0 + j, a[1]); atomicAdd(d.bias + 2 * d.bstride + d.j0 + j, a[2]); }
  }
  u32x4 o0, o1;
  o0.x = pack_bf16(sv[0], sv[1]); o0.y = pack_bf16(sv[2], sv[3]); o0.z = pack_bf16(sv[4], sv[5]); o0.w = pack_bf16(sv[6], sv[7]);
  o1.x = pack_bf16(sv[8], sv[9]); o1.y = pack_bf16(sv[10], sv[11]); o1.z = pack_bf16(sv[12], sv[13]); o1.w = pack_bf16(sv[14], sv[15]);
  bf16_t* dd = d.dst + (size_t)(d.j0 + j) * d.K + d.k0 + kc;
  *(u32x4*)dd = o0; *(u32x4*)(dd + 8) = o1;
}

#define WT_IN 0
#define WT_OUT (2816 * 1024)
#define WT_GU (WT_OUT + 1024 * 1024)
#define WT_DOWN (WT_GU + 5632 * 1024)
#define WT_LAYER (WT_DOWN + 1024 * 2816)


#define PRE_QP 0
#define PRE_KTP 16384
#define PRE_DIR0 32768
#define PRE_DIRSZ 41984
#define PRE_NW 0
#define PRE_UP 16384
#define PRE_QKP 32768
#define PRE_SC 40960
#define PRE_ITEM 116736
#define PRE_LDS 118784
#define SCAN_BUF 58368
#define SCAN_LDS (2 * SCAN_BUF)

using pg8::bf16x8;
__device__ __forceinline__ int perm_inv(int x) { return (x & ~31) | (((x >> 2) & 3) << 3) | (((x >> 4) & 1) << 2) | (x & 3); }
__device__ __forceinline__ bf16x8 pack8(const f32x4& x, const f32x4& y) {
  u32x4 w; w.x = pg8::cvt_pk_bf16(x[0], x[1]); w.y = pg8::cvt_pk_bf16(x[2], x[3]); w.z = pg8::cvt_pk_bf16(y[0], y[1]); w.w = pg8::cvt_pk_bf16(y[2], y[3]);
  return __builtin_bit_cast(bf16x8, w);
}

__device__ __forceinline__ void pre_item(int item, const bf16_t* __restrict__ QKV, const float* __restrict__ LOG, const float* __restrict__ cw,
                                         const float* __restrict__ a_log, const float* __restrict__ dt_bias, unsigned char* __restrict__ PRE,
                                         unsigned char* lds) {
  int t_ = threadIdx.x; asm volatile("" : "+v"(t_));
  const int t = t_, lane = t & 63, w = t >> 6;
  const int c = item >> 2, h = item & 3, r0 = c * 64;
  bf16_t* qb = (bf16_t*)lds; bf16_t* kb = (bf16_t*)(lds + 17408); float* vf = (float*)(lds + 34816);
  typedef _Float16 f16x4 __attribute__((ext_vector_type(4)));
  constexpr int MS = 72, TS = 20;
  _Float16* Mf = (_Float16*)(lds + 67584); _Float16* Mb = (_Float16*)(lds + 67584 + 64 * MS * 2); _Float16* Tm = (_Float16*)(lds + 67584 + 2 * 64 * MS * 2); float* sc = (float*)(lds + 100352);
  unsigned char* pre = PRE + (size_t)item * PRE_ITEM;
  float lg_b = 0.f, lg_a = 0.f;
  if (w < 2) { lg_b = LOG[(size_t)(r0 + lane) * 16 + w * 4 + h]; lg_a = LOG[(size_t)(r0 + lane) * 16 + 8 + w * 4 + h]; }
  {
    const int i = t >> 3, cg = t & 7, r = r0 + i;
    int s0, len;
    if (r < NCTX) { s0 = r & ~255; len = 256; } else { s0 = NCTX + ((r - NCTX) & ~2047); len = 2048; }
    const int tt = r - s0; const bool hp = tt > 0, hn = tt < len - 1;
#pragma unroll
    for (int x = 0; x < 3; ++x) {
      const int cb = x * 512 + h * 128 + cg * 16;
      const bf16_t* p0 = QKV + (size_t)r * NQKV + cb;
      u32x4 m0 = (u32x4){0u, 0u, 0u, 0u}, m1 = m0, n0 = m0, n1 = m0;
      const u32x4 c0 = *(const u32x4*)p0, c1 = *(const u32x4*)(p0 + 8);
      if (hp) { m0 = *(const u32x4*)(p0 - NQKV); m1 = *(const u32x4*)(p0 - NQKV + 8); }
      if (hn) { n0 = *(const u32x4*)(p0 + NQKV); n1 = *(const u32x4*)(p0 + NQKV + 8); }
      float val[16]; float ss = 0.f;
#pragma unroll
      for (int e = 0; e < 16; ++e) {
        const unsigned wm = (e < 8 ? m0 : m1)[(e & 7) >> 1], wc = (e < 8 ? c0 : c1)[(e & 7) >> 1], wn = (e < 8 ? n0 : n1)[(e & 7) >> 1];
        const float xm = __uint_as_float((e & 1) ? (wm & 0xffff0000u) : (wm << 16));
        const float xc = __uint_as_float((e & 1) ? (wc & 0xffff0000u) : (wc << 16));
        const float xn = __uint_as_float((e & 1) ? (wn & 0xffff0000u) : (wn << 16));
        const float y = cw[cb + e] * xm + cw[NQKV + cb + e] * xc + cw[2 * NQKV + cb + e] * xn;
        val[e] = silu_fast(y); ss += val[e] * val[e];
      }
      if (x < 2) {
        ss += __shfl_xor(ss, 1); ss += __shfl_xor(ss, 2); ss += __shfl_xor(ss, 4);
        const float rn = rsqrtf(ss + 1e-6f) * (x == 0 ? 0.08838834764831845f : 1.0f);
        bf16_t* dst = (x == 0 ? qb : kb) + i * 136 + cg * 16;
        u32x4 o0, o1;
        o0.x = pack_bf16(val[0] * rn, val[1] * rn); o0.y = pack_bf16(val[2] * rn, val[3] * rn); o0.z = pack_bf16(val[4] * rn, val[5] * rn); o0.w = pack_bf16(val[6] * rn, val[7] * rn);
        o1.x = pack_bf16(val[8] * rn, val[9] * rn); o1.y = pack_bf16(val[10] * rn, val[11] * rn); o1.z = pack_bf16(val[12] * rn, val[13] * rn); o1.w = pack_bf16(val[14] * rn, val[15] * rn);
        *(u32x4*)dst = o0; *(u32x4*)(dst + 8) = o1;
      } else {
        float* dst = vf + i * 128 + cg * 16;
#pragma unroll
        for (int e = 0; e < 16; e += 4) *(f32x4*)(dst + e) = (f32x4){val[e], val[e + 1], val[e + 2], val[e + 3]};
      }
    }
  }
  if (w < 2) {
    const int i = lane, d = w;
    const float beta = sigmoid_f(lg_b);
    const float g = -expf(a_log[d * 4 + h]) * softplus_f(lg_a + dt_bias[d * 4 + h]);
    float s = g;
#pragma unroll
    for (int o = 1; o < 64; o <<= 1) {
      const float nb = d == 0 ? __shfl_up(s, o) : __shfl_down(s, o);
      const bool ok = d == 0 ? (lane >= o) : (lane + o < 64);
      if (ok) s += nb;
    }
    sc[d * 64 + i] = beta; sc[128 + d * 64 + i] = s; sc[256 + d * 64 + i] = beta * expf(s);
  }
  __syncthreads();
  {
    const int p = w >> 2, it = w & 3, fr = lane & 15, g = lane >> 4;
    const bf16_t* Ab = p ? qb : kb;
    bf16x8 af[4];
#pragma unroll
    for (int ks = 0; ks < 4; ++ks) af[ks] = *(const bf16x8*)(Ab + (it * 16 + fr) * 136 + ks * 32 + 8 * g);
    bf16_t* qkf = (bf16_t*)(lds + 102400);
    bf16_t* qkb = (bf16_t*)(lds + 102400 + 8192);
#pragma unroll
    for (int jt = 0; jt < 4; ++jt) {
      f32x4 acc = (f32x4){0.f, 0.f, 0.f, 0.f};
#pragma unroll
      for (int ks = 0; ks < 4; ++ks) {
        const bf16x8 bfr = *(const bf16x8*)(kb + (jt * 16 + fr) * 136 + ks * 32 + 8 * g);
        acc = __builtin_amdgcn_mfma_f32_16x16x32_bf16(af[ks], bfr, acc, 0, 0, 0);
      }
      const int j = jt * 16 + fr;
      const float gfj = sc[128 + j], gbj = sc[192 + j];
#pragma unroll
      for (int r = 0; r < 4; ++r) {
        const int i = it * 16 + 4 * g + r;
        const float val = acc[r];
        const float ef = __expf(fminf(sc[128 + i] - gfj, 0.f)), eb = __expf(fminf(sc[192 + i] - gbj, 0.f));
        if (p == 0) {
          Mf[i * MS + j] = (_Float16)((j < i) ? -(sc[i] * val * ef) : 0.f);
          Mb[i * MS + j] = (_Float16)((j > i) ? -(sc[64 + i] * val * eb) : 0.f);
        } else {
          const int jp = perm_inv(j);
          qkf[i * 64 + jp] = f2bf((j <= i) ? val * ef : 0.f);
          qkb[i * 64 + jp] = f2bf((j >= i) ? val * eb : 0.f);
        }
      }
    }
  }
  __syncthreads();
  const int wu = __builtin_amdgcn_readfirstlane(t >> 6);
  if (wu < 2) {
    const int d = wu, I = lane >> 4, cu = lane & 15;
    int rsel = d ? 15 : 0, rst = d ? -1 : 1;
    asm volatile("" : "+v"(rsel), "+v"(rst));
    const _Float16* Mi = (d ? Mb : Mf) + (16 * I) * MS + 16 * I;
    float tc[16];
#pragma unroll
    for (int u = 0; u < 16; ++u) {
      float a = (u == cu) ? 1.f : 0.f;
#pragma unroll
      for (int v = 0; v < u; ++v) a += (float)Mi[(rsel + rst * u) * MS + (rsel + rst * v)] * tc[v];
      tc[u] = a;
    }
#pragma unroll
    for (int u = 0; u < 16; ++u) Tm[((d * 4 + I) * 16 + (rsel + rst * u)) * TS + (rsel + rst * cu)] = (_Float16)tc[u];
  } else {
    const int tt = t - 128;
    for (int q = tt; q < 1024; q += 384) {
      { const int i = q >> 4, s = (q >> 2) & 3, g = q & 3;
        const u32x2 lo = *(const u32x2*)(qb + i * 136 + 32 * s + 4 * g), hi = *(const u32x2*)(qb + i * 136 + 32 * s + 16 + 4 * g);
        *(u32x4*)(pre + PRE_QP + (size_t)(i * 128 + 32 * s + 8 * g) * 2) = (u32x4){lo.x, lo.y, hi.x, hi.y}; }
      { const int dk = q >> 3, s2 = (q >> 2) & 1, g = q & 3;
        unsigned short e[8];
#pragma unroll
        for (int jj = 0; jj < 8; ++jj) e[jj] = kb[(32 * s2 + 16 * (jj >> 2) + 4 * g + (jj & 3)) * 136 + dk];
        u32x4 o; o.x = (unsigned)e[0] | ((unsigned)e[1] << 16); o.y = (unsigned)e[2] | ((unsigned)e[3] << 16); o.z = (unsigned)e[4] | ((unsigned)e[5] << 16); o.w = (unsigned)e[6] | ((unsigned)e[7] << 16);
        *(u32x4*)(pre + PRE_KTP + (size_t)(dk * 64 + 32 * s2 + 8 * g) * 2) = o; }
    }
    {
      const int e = tt, d = e / 192, rem = e % 192, k3 = rem >> 6, i = rem & 63;
      const float glast = d ? sc[192] : sc[128 + 63], gci = sc[128 + d * 64 + i];
      const float v = k3 == 0 ? expf(gci) : (k3 == 1 ? expf(glast - gci) : expf(glast));
      ((float*)(pre + PRE_DIR0 + d * PRE_DIRSZ + PRE_SC))[k3 * 64 + i] = v;
    }
  }
  __syncthreads();
  {
    const int d = wu >> 2, wq = wu & 3, kind = wq >> 1, fr = lane & 15, g = lane >> 4;
    const _Float16* Mi = d ? Mb : Mf;
    f16x4 Tf[4], Mg[4][4];
#pragma unroll
    for (int s2 = 0; s2 < 4; ++s2) {
      const int P = d ? 3 - s2 : s2;
      Tf[s2] = *(const f16x4*)(Tm + ((d * 4 + P) * 16 + fr) * TS + 4 * g);
#pragma unroll
      for (int b2 = 0; b2 < s2; ++b2) { const int Pb = d ? 3 - b2 : b2; Mg[s2][b2] = *(const f16x4*)(Mi + (16 * P + fr) * MS + 16 * Pb + 4 * g); }
    }
    f32x4 acc[4][4];
    {
      float beta[4][4];
#pragma unroll
      for (int s2 = 0; s2 < 4; ++s2)
#pragma unroll
        for (int r = 0; r < 4; ++r) beta[s2][r] = sc[(kind ? 256 : 0) + d * 64 + 16 * (d ? 3 - s2 : s2) + 4 * g + r];
#pragma unroll
      for (int tl = 0; tl < 4; ++tl) {
        const int col = 16 * ((4 * wq + tl) & 7) + fr;
#pragma unroll
        for (int s2 = 0; s2 < 4; ++s2)
#pragma unroll
          for (int r = 0; r < 4; ++r) {
            const int i = 16 * (d ? 3 - s2 : s2) + 4 * g + r;
            acc[tl][s2][r] = beta[s2][r] * (kind ? bf2f(kb[i * 136 + col]) : vf[i * 128 + col]);
          }
      }
    }
    __syncthreads();
    unsigned char* outd = lds + 34816 + d * 32768;
#define H4(x) __builtin_convertvector(x, f16x4)
#define MF16(a, b, c) __builtin_amdgcn_mfma_f32_16x16x16f16(a, b, c, 0, 0, 0)
#pragma unroll
    for (int tl = 0; tl < 4; ++tl) {
      const f32x4 z4 = (f32x4){0.f, 0.f, 0.f, 0.f};
      f32x4 X[4];
      X[0] = MF16(Tf[0], H4(acc[tl][0]), z4);
      { const f16x4 hx = H4(X[0]); acc[tl][1] = MF16(Mg[1][0], hx, acc[tl][1]); acc[tl][2] = MF16(Mg[2][0], hx, acc[tl][2]); acc[tl][3] = MF16(Mg[3][0], hx, acc[tl][3]); }
      X[1] = MF16(Tf[1], H4(acc[tl][1]), z4);
      { const f16x4 hx = H4(X[1]); acc[tl][2] = MF16(Mg[2][1], hx, acc[tl][2]); acc[tl][3] = MF16(Mg[3][1], hx, acc[tl][3]); }
      X[2] = MF16(Tf[2], H4(acc[tl][2]), z4);
      { const f16x4 hx = H4(X[2]); acc[tl][3] = MF16(Mg[3][2], hx, acc[tl][3]); }
      X[3] = MF16(Tf[3], H4(acc[tl][3]), z4);
      if (kind == 0) {
        const int wv = 4 * wq + tl;
#pragma unroll
        for (int s2 = 0; s2 < 4; ++s2) {
          u32x2 pk; pk.x = pack_bf16(X[s2][0], X[s2][1]); pk.y = pack_bf16(X[s2][2], X[s2][3]);
          *(u32x2*)(outd + 16384 + ((wv * 4 + (d ? 3 - s2 : s2)) * 64 + lane) * 8) = pk;
        }
      } else {
        const int kp = perm_inv(16 * (4 * wq + tl - 8) + fr);
        bf16_t* nw = (bf16_t*)outd + kp;
#pragma unroll
        for (int s2 = 0; s2 < 4; ++s2)
#pragma unroll
          for (int r = 0; r < 4; ++r) nw[(16 * (d ? 3 - s2 : s2) + 4 * g + r) * 128] = f2bf(-X[s2][r]);
      }
    }
#undef H4
#undef MF16
  }
  __syncthreads();
  for (int k = 0; k < 8; ++k) {
    const int q = t + 512 * k, d = q >> 11, wi = q & 2047;
    *(u32x4*)(pre + PRE_DIR0 + d * PRE_DIRSZ + wi * 16) = *(const u32x4*)(lds + 34816 + q * 16);
  }
  for (int k = 0; k < 2; ++k) {
    const int q = t + 512 * k, d = q >> 9, wi = q & 511;
    *(u32x4*)(pre + PRE_DIR0 + d * PRE_DIRSZ + PRE_QKP + wi * 16) = *(const u32x4*)(lds + 102400 + q * 16);
  }
  __syncthreads();
}

__global__ __launch_bounds__(512, 2) void k_pre(const bf16_t* __restrict__ QKV, const float* __restrict__ LOG, const float* __restrict__ cw,
                                                const float* __restrict__ a_log, const float* __restrict__ dt_bias, unsigned char* __restrict__ PRE) {
  extern __shared__ __attribute__((aligned(16))) unsigned char smem[];
  for (int item = blockIdx.x; item < 768; item += gridDim.x) pre_item(item, QKV, LOG, cw, a_log, dt_bias, PRE, smem);
}

#define SCAN_OT (2 * SCAN_BUF)
#undef SCAN_LDS
#define SCAN_LDS (2 * SCAN_BUF + 8 * 2048)
__device__ __forceinline__ void scan_item(int b, int h, int d, int chunk0, int nc, int half, bool write_state, const unsigned char* __restrict__ PRE, const float* __restrict__ s_in,
                                          bf16_t* __restrict__ OB, float* __restrict__ s_out, unsigned char* lds) {
  int t_ = threadIdx.x; asm volatile("" : "+v"(t_));
  const int t = t_, lane = t & 63, w = t >> 6, fr = lane & 15, g = lane >> 4;
  const bool active = half < 0 || w < 4;
  const int dvw = half < 0 ? w : half * 4 + (w & 3), dv = 16 * dvw + fr;
  f32x4 S[8];
  if (s_in == nullptr) {
#pragma unroll
    for (int m = 0; m < 8; ++m) S[m] = (f32x4){0.f, 0.f, 0.f, 0.f};
  } else {
#pragma unroll
    for (int m = 0; m < 8; ++m)
#pragma unroll
      for (int r = 0; r < 4; ++r) S[m][r] = s_in[(16 * m + 4 * g + r) * 128 + dv];
  }
  unsigned soff[7], doff[7];
#pragma unroll
  for (int k = 0; k < 7; ++k) {
    const int q = t + 512 * k;
    if (k < 2) { const int row = q >> 4, c = q & 15; soff[k] = PRE_DIR0 + PRE_NW + q * 16; doff[k] = row * 256 + ((c ^ (row & 15)) << 4); }
    else if (k < 4) { const int q2 = q - 1024, row = q2 >> 4, c = q2 & 15; soff[k] = PRE_QP + q2 * 16; doff[k] = 16384 + row * 256 + ((c ^ (row & 15)) << 4); }
    else if (k < 5) { const int q2 = q - 2048, row = q2 >> 3, c = q2 & 7; soff[k] = PRE_DIR0 + PRE_QKP + q2 * 16; doff[k] = 32768 + row * 128 + ((c ^ ((row >> 1) & 7)) << 4); }
    else { const int q2 = q - 2560, row = q2 >> 3, c = q2 & 7; soff[k] = PRE_KTP + q2 * 16; doff[k] = 40960 + row * 128 + ((c ^ ((row >> 1) & 7)) << 4); }
    if (k < 2 || k == 4) soff[k] += d * PRE_DIRSZ;
  }
  const unsigned soff7 = PRE_DIR0 + d * PRE_DIRSZ + PRE_SC + t * 16, doff7 = 57344 + t * 16;
  const unsigned upoff = PRE_DIR0 + d * PRE_DIRSZ + PRE_UP + ((dvw * 4) * 64 + lane) * 8;
  u32x4 st[7]; u32x4 st7 = (u32x4){0u, 0u, 0u, 0u}; u32x2 up[4];
  {
    const int cidx = chunk0 + (d ? nc - 1 : 0);
    const unsigned char* pre = PRE + (size_t)(cidx * 4 + h) * PRE_ITEM;
#pragma unroll
    for (int k = 0; k < 7; ++k) st[k] = *(const u32x4*)(pre + soff[k]);
    if (t < 48) st7 = *(const u32x4*)(pre + soff7);
#pragma unroll
    for (int m = 0; m < 4; ++m) up[m] = *(const u32x2*)(pre + upoff + m * 512);
#pragma unroll
    for (int k = 0; k < 7; ++k) *(u32x4*)(lds + doff[k]) = st[k];
    if (t < 48) *(u32x4*)(lds + doff7) = st7;
  }
  __syncthreads();
  bf16_t* ot = (bf16_t*)(lds + SCAN_OT + w * 2048);
  for (int step = 0; step < nc; ++step) {
    const int cidx = chunk0 + (d ? nc - 1 - step : step);
    const unsigned char* B = lds + (step & 1) * SCAN_BUF;
    const bool more = step + 1 < nc;
    f32x4 a1[4], a2[4];
#pragma unroll
    for (int m = 0; m < 4; ++m) {
      a1[m] = (f32x4){__uint_as_float(up[m].x << 16), __uint_as_float(up[m].x & 0xffff0000u), __uint_as_float(up[m].y << 16), __uint_as_float(up[m].y & 0xffff0000u)};
      a2[m] = (f32x4){0.f, 0.f, 0.f, 0.f};
    }
    if (more) {
      const int cn = chunk0 + (d ? nc - 2 - step : step + 1);
      const unsigned char* pre = PRE + (size_t)(cn * 4 + h) * PRE_ITEM;
#pragma unroll
      for (int k = 0; k < 7; ++k) st[k] = *(const u32x4*)(pre + soff[k]);
      if (t < 48) st7 = *(const u32x4*)(pre + soff7);
#pragma unroll
      for (int m = 0; m < 4; ++m) up[m] = *(const u32x2*)(pre + upoff + m * 512);
    }
    if (active) {
      const float* SC = (const float*)(B + 57344);
      const float gt = SC[128];
      bf16x8 Sb[4];
#pragma unroll
      for (int s = 0; s < 4; ++s) Sb[s] = pack8(S[2 * s], S[2 * s + 1]);
#pragma unroll
      for (int m = 0; m < 8; ++m) S[m] = S[m] * gt;
      {
        bf16x8 fa[2][4], fq[2][4];
#pragma unroll
        for (int m = 0; m < 4; ++m) {
          fa[0][m] = *(const bf16x8*)(B + (16 * m + fr) * 256 + (((0 + g) ^ fr) << 4));
          fq[0][m] = *(const bf16x8*)(B + 16384 + (16 * m + fr) * 256 + (((0 + g) ^ fr) << 4));
        }
#pragma unroll
        for (int s = 0; s < 4; ++s) {
          if (s < 3) {
#pragma unroll
            for (int m = 0; m < 4; ++m) {
              fa[(s + 1) & 1][m] = *(const bf16x8*)(B + (16 * m + fr) * 256 + (((4 * (s + 1) + g) ^ fr) << 4));
              fq[(s + 1) & 1][m] = *(const bf16x8*)(B + 16384 + (16 * m + fr) * 256 + (((4 * (s + 1) + g) ^ fr) << 4));
            }
          }
#pragma unroll
          for (int m = 0; m < 4; ++m) a1[m] = __builtin_amdgcn_mfma_f32_16x16x32_bf16(fa[s & 1][m], Sb[s], a1[m], 0, 0, 0);
#pragma unroll
          for (int m = 0; m < 4; ++m) a2[m] = __builtin_amdgcn_mfma_f32_16x16x32_bf16(fq[s & 1][m], Sb[s], a2[m], 0, 0, 0);
        }
      }
      bf16x8 Vb[2], Vs[2];
#pragma unroll
      for (int s = 0; s < 2; ++s) Vb[s] = pack8(a1[2 * s], a1[2 * s + 1]);
#pragma unroll
      for (int m = 0; m < 4; ++m) { const f32x4 e = *(const f32x4*)(SC + 64 + 16 * m + 4 * g); a1[m] = a1[m] * e; }
#pragma unroll
      for (int s = 0; s < 2; ++s) Vs[s] = pack8(a1[2 * s], a1[2 * s + 1]);
      {
        bf16x8 fk[2][8];
#pragma unroll
        for (int s = 0; s < 2; ++s)
#pragma unroll
          for (int m = 0; m < 8; ++m) fk[s][m] = *(const bf16x8*)(B + 40960 + (16 * m + fr) * 128 + (((4 * s + g) ^ (fr >> 1)) << 4));
#pragma unroll
        for (int s = 0; s < 2; ++s)
#pragma unroll
          for (int m = 0; m < 8; ++m) S[m] = __builtin_amdgcn_mfma_f32_16x16x32_bf16(fk[s][m], Vs[s], S[m], 0, 0, 0);
      }
#pragma unroll
      for (int m = 0; m < 4; ++m) { const f32x4 e = *(const f32x4*)(SC + 16 * m + 4 * g); a2[m] = a2[m] * e; }
#pragma unroll
      for (int s = 0; s < 2; ++s)
#pragma unroll
        for (int m = 0; m < 4; ++m) {
          const bf16x8 fa = *(const bf16x8*)(B + 32768 + (16 * m + fr) * 128 + (((4 * s + g) ^ (fr >> 1)) << 4));
          a2[m] = __builtin_amdgcn_mfma_f32_16x16x32_bf16(fa, Vb[s], a2[m], 0, 0, 0);
        }
#pragma unroll
      for (int m = 0; m < 4; ++m)
#pragma unroll
        for (int r = 0; r < 4; ++r) ot[(16 * m + 4 * g + r) * 16 + fr] = f2bf(a2[m][r]);
      {
        bf16_t* op = OB + ((size_t)d * NTOK + (size_t)cidx * 64) * 512 + h * 128 + 16 * dvw;
#pragma unroll
        for (int k = 0; k < 2; ++k) {
          const int q = lane + 64 * k, row = q >> 1, hf = q & 1;
          *(u32x4*)(op + (size_t)row * 512 + hf * 8) = *(const u32x4*)(ot + row * 16 + hf * 8);
        }
      }
    }
    if (more) {
      unsigned char* Bn = lds + ((step + 1) & 1) * SCAN_BUF;
#pragma unroll
      for (int k = 0; k < 7; ++k) *(u32x4*)(Bn + doff[k]) = st[k];
      if (t < 48) *(u32x4*)(Bn + doff7) = st7;
    }
    __syncthreads();
  }
  if (write_state && active) {
#pragma unroll
    for (int m = 0; m < 8; ++m)
#pragma unroll
      for (int r = 0; r < 4; ++r) s_out[(16 * m + 4 * g + r) * 128 + dv] = S[m][r];
  }
}

__device__ __forceinline__ void scan_item_lat(int b, int h, int d, int chunk0, int nc, int half, const unsigned char* __restrict__ PRE, const float* __restrict__ s_in,
                                              bf16_t* __restrict__ OB, unsigned char* lds) {
  int t_ = threadIdx.x; asm volatile("" : "+v"(t_));
  const int t = t_, lane = t & 63, fr = lane & 15, g = lane >> 4;
  const int wu = __builtin_amdgcn_readfirstlane(t >> 6);
  (void)b;
#define LAT_CIDX(step) (chunk0 + (d ? nc - 1 - (step) : (step)))
  if (wu >= 4) {
    const int tt = t - 256;
    unsigned soff[14], doff[14];
#pragma unroll
    for (int k = 0; k < 14; ++k) {
      const int q = tt + 256 * k;
      if (k < 4) { const int row = q >> 4, c = q & 15; soff[k] = PRE_DIR0 + d * PRE_DIRSZ + PRE_NW + q * 16; doff[k] = row * 256 + ((c ^ (row & 15)) << 4); }
      else if (k < 8) { const int q2 = q - 1024, row = q2 >> 4, c = q2 & 15; soff[k] = PRE_QP + q2 * 16; doff[k] = 16384 + row * 256 + ((c ^ (row & 15)) << 4); }
      else if (k < 10) { const int q2 = q - 2048, row = q2 >> 3, c = q2 & 7; soff[k] = PRE_DIR0 + d * PRE_DIRSZ + PRE_QKP + q2 * 16; doff[k] = 32768 + row * 128 + ((c ^ ((row >> 1) & 7)) << 4); }
      else { const int q2 = q - 2560, row = q2 >> 3, c = q2 & 7; soff[k] = PRE_KTP + q2 * 16; doff[k] = 40960 + row * 128 + ((c ^ ((row >> 1) & 7)) << 4); }
    }
    const unsigned soffS = PRE_DIR0 + d * PRE_DIRSZ + PRE_SC + tt * 16, doffS = 57344 + tt * 16;
    u32x4 ra[14], rb[14], sa = (u32x4){0u, 0u, 0u, 0u}, sb = sa;
#define LAT_LOAD(R, RS, step) do { const unsigned char* pre_ = PRE + (size_t)(LAT_CIDX(step) * 4 + h) * PRE_ITEM; \
      _Pragma("unroll") for (int k = 0; k < 14; ++k) R[k] = *(const u32x4*)(pre_ + soff[k]); if (tt < 48) RS = *(const u32x4*)(pre_ + soffS); } while (0)
#define LAT_WRITE(R, RS, buf) do { unsigned char* B_ = lds + (buf) * SCAN_BUF; \
      _Pragma("unroll") for (int k = 0; k < 14; ++k) *(u32x4*)(B_ + doff[k]) = R[k]; if (tt < 48) *(u32x4*)(B_ + doffS) = RS; } while (0)
    LAT_LOAD(ra, sa, 0); LAT_LOAD(rb, sb, 1);
    LAT_WRITE(ra, sa, 0);
    __syncthreads();
    for (int step = 0; step < nc; step += 2) {
      if (step + 2 < nc) LAT_LOAD(ra, sa, step + 2);
      LAT_WRITE(rb, sb, 1);
      __syncthreads();
      if (step + 3 < nc) LAT_LOAD(rb, sb, step + 3);
      if (step + 2 < nc) LAT_WRITE(ra, sa, 0);
      __syncthreads();
    }
#undef LAT_LOAD
#undef LAT_WRITE
  } else {
    const int w = wu, dvw = half * 4 + w, dv = 16 * dvw + fr;
    f32x4 S[8];
#pragma unroll
    for (int m = 0; m < 8; ++m)
#pragma unroll
      for (int r = 0; r < 4; ++r) S[m][r] = s_in[(16 * m + 4 * g + r) * 128 + dv];
    const unsigned upoff = PRE_DIR0 + d * PRE_DIRSZ + PRE_UP + ((dvw * 4) * 64 + lane) * 8;
    u32x2 upa[4], upb[4];
#define LAT_UP(U, step) do { const unsigned char* pre_ = PRE + (size_t)(LAT_CIDX(step) * 4 + h) * PRE_ITEM; _Pragma("unroll") for (int m = 0; m < 4; ++m) U[m] = *(const u32x2*)(pre_ + upoff + m * 512); } while (0)
    LAT_UP(upa, 0); LAT_UP(upb, 1);
    bf16_t* ot = (bf16_t*)(lds + SCAN_OT + w * 2048);
    __syncthreads();
#define LAT_STEP(UP, step, bufi) do { \
      const int cidx = LAT_CIDX(step); const unsigned char* B = lds + (bufi) * SCAN_BUF; \
      f32x4 a1[4], a2[4]; \
      _Pragma("unroll") for (int m = 0; m < 4; ++m) { \
        a1[m] = (f32x4){__uint_as_float(UP[m].x << 16), __uint_as_float(UP[m].x & 0xffff0000u), __uint_as_float(UP[m].y << 16), __uint_as_float(UP[m].y & 0xffff0000u)}; \
        a2[m] = (f32x4){0.f, 0.f, 0.f, 0.f}; } \
      if ((step) + 2 < nc) LAT_UP(UP, (step) + 2); \
      const float* SC = (const float*)(B + 57344); \
      const float gt = SC[128]; \
      bf16x8 Sb[4]; \
      _Pragma("unroll") for (int s = 0; s < 4; ++s) Sb[s] = pack8(S[2 * s], S[2 * s + 1]); \
      _Pragma("unroll") for (int m = 0; m < 8; ++m) S[m] = S[m] * gt; \
      { bf16x8 fa[2][4], fq[2][4]; \
        _Pragma("unroll") for (int m = 0; m < 4; ++m) { \
          fa[0][m] = *(const bf16x8*)(B + (16 * m + fr) * 256 + (((0 + g) ^ fr) << 4)); \
          fq[0][m] = *(const bf16x8*)(B + 16384 + (16 * m + fr) * 256 + (((0 + g) ^ fr) << 4)); } \
        _Pragma("unroll") for (int s = 0; s < 4; ++s) { \
          if (s < 3) { _Pragma("unroll") for (int m = 0; m < 4; ++m) { \
              fa[(s + 1) & 1][m] = *(const bf16x8*)(B + (16 * m + fr) * 256 + (((4 * (s + 1) + g) ^ fr) << 4)); \
              fq[(s + 1) & 1][m] = *(const bf16x8*)(B + 16384 + (16 * m + fr) * 256 + (((4 * (s + 1) + g) ^ fr) << 4)); } } \
          _Pragma("unroll") for (int m = 0; m < 4; ++m) a1[m] = __builtin_amdgcn_mfma_f32_16x16x32_bf16(fa[s & 1][m], Sb[s], a1[m], 0, 0, 0); \
          _Pragma("unroll") for (int m = 0; m < 4; ++m) a2[m] = __builtin_amdgcn_mfma_f32_16x16x32_bf16(fq[s & 1][m], Sb[s], a2[m], 0, 0, 0); } } \
      bf16x8 Vb[2], Vs[2]; \
      _Pragma("unroll") for (int s = 0; s < 2; ++s) Vb[s] = pack8(a1[2 * s], a1[2 * s + 1]); \
      _Pragma("unroll") for (int m = 0; m < 4; ++m) { const f32x4 e = *(const f32x4*)(SC + 64 + 16 * m + 4 * g); a1[m] = a1[m] * e; } \
      _Pragma("unroll") for (int s = 0; s < 2; ++s) Vs[s] = pack8(a1[2 * s], a1[2 * s + 1]); \
      { bf16x8 fk[2][8]; \
        _Pragma("unroll") for (int s = 0; s < 2; ++s) _Pragma("unroll") for (int m = 0; m < 8; ++m) fk[s][m] = *(const bf16x8*)(B + 40960 + (16 * m + fr) * 128 + (((4 * s + g) ^ (fr >> 1)) << 4)); \
        _Pragma("unroll") for (int s = 0; s < 2; ++s) _Pragma("unroll") for (int m = 0; m < 8; ++m) S[m] = __builtin_amdgcn_mfma_f32_16x16x32_bf16(fk[s][m], Vs[s], S[m], 0, 0, 0); } \
      _Pragma("unroll") for (int m = 0; m < 4; ++m) { const f32x4 e = *(const f32x4*)(SC + 16 * m + 4 * g); a2[m] = a2[m] * e; } \
      _Pragma("unroll") for (int s = 0; s < 2; ++s) _Pragma("unroll") for (int m = 0; m < 4; ++m) { \
          const bf16x8 fa2 = *(const bf16x8*)(B + 32768 + (16 * m + fr) * 128 + (((4 * s + g) ^ (fr >> 1)) << 4)); \
          a2[m] = __builtin_amdgcn_mfma_f32_16x16x32_bf16(fa2, Vb[s], a2[m], 0, 0, 0); } \
      _Pragma("unroll") for (int m = 0; m < 4; ++m) _Pragma("unroll") for (int r = 0; r < 4; ++r) ot[(16 * m + 4 * g + r) * 16 + fr] = f2bf(a2[m][r]); \
      { bf16_t* op = OB + ((size_t)d * NTOK + (size_t)cidx * 64) * 512 + h * 128 + 16 * dvw; \
        _Pragma("unroll") for (int k = 0; k < 2; ++k) { const int q = lane + 64 * k, row = q >> 1, hf = q & 1; \
          *(u32x4*)(op + (size_t)row * 512 + hf * 8) = *(const u32x4*)(ot + row * 16 + hf * 8); } } \
      __syncthreads(); } while (0)
    for (int step = 0; step < nc; step += 2) { LAT_STEP(upa, step, 0); LAT_STEP(upb, step + 1, 1); }
#undef LAT_STEP
#undef LAT_UP
  }
#undef LAT_CIDX
}

__device__ __forceinline__ void scan_dispatch(int i, const unsigned char* PRE, const float* state_in, bf16_t* OB, float* state_out, int layer, unsigned char* lds) {
#ifdef LAT_FULL
  if (i < 32) {
    if (i >= 16) return;
    const int q = i, half = -1, b = q >> 3, h = (q >> 1) & 3, d = q & 1;
#else
  if (i < 32) {
    const int q = i >> 1, half = i & 1, b = q >> 3, h = (q >> 1) & 3, d = q & 1;
#endif
#ifdef LAT_FULL
    scan_item(b, h, d, 128 + b * 32, 32, half, false, PRE, state_in + ((((size_t)b * 2 + layer) * 2 + d) * 4 + h) * 16384, OB, nullptr, lds);
#else
    scan_item_lat(b, h, d, 128 + b * 32, 32, half, PRE, state_in + ((((size_t)b * 2 + layer) * 2 + d) * 4 + h) * 16384, OB, lds);
#endif
  } else {
    const int sid = i - 32, b = sid >> 3, h = (sid >> 1) & 3, d = sid & 1;
    scan_item(b, h, d, b * 4, 4, -1, true, PRE, nullptr, OB, state_out + ((((size_t)b * 2 + layer) * 2 + d) * 4 + h) * 16384, lds);
  }
}

__global__ __launch_bounds__(512, 2) void k_scan2(const unsigned char* __restrict__ PRE, const float* __restrict__ state_in, bf16_t* __restrict__ OB,
                                                  float* __restrict__ state_out, int layer) {
  extern __shared__ __attribute__((aligned(16))) unsigned char smem[];
  for (int i = blockIdx.x; i < 288; i += gridDim.x) scan_dispatch(i, PRE, state_in, OB, state_out, layer, smem);
}
#define XB_TMO      128
#define XB_XCNT(j)  (256  + 64 * (j))
#define XB_XSUB(j)  (1280 + 64 * (j))
#define XB_XGEN(j)  (2304 + 64 * (j))
#define XB_TOP      3328
#define XB_TOPGEN   3392
#define XCD_BAR_WORDS 3456
#define XB_SPIN_CAP (1u << 18)
#define LAS __attribute__((address_space(3)))

__device__ __forceinline__ unsigned xb_ld(unsigned* p)              { return __hip_atomic_load(p, __ATOMIC_RELAXED, __HIP_MEMORY_SCOPE_AGENT); }
__device__ __forceinline__ unsigned xb_add(unsigned* p, unsigned v) { return __hip_atomic_fetch_add(p, v, __ATOMIC_RELAXED, __HIP_MEMORY_SCOPE_AGENT); }
__device__ __forceinline__ unsigned xb_xcc_id() { return (unsigned)__builtin_amdgcn_s_getreg((3 << 11) | 20) & 0xFu; }
#define XB_SPIN(cond, bar) do { unsigned _sp = 0; while (cond) { __builtin_amdgcn_s_sleep(1); \
    if ((++_sp & 255u) == 0u) { if (xb_ld(&(bar)[XB_TMO])) break; if (_sp > XB_SPIN_CAP) { atomicAdd(&(bar)[XB_TMO], 1u); break; } } } } while (0)

struct XcdBarrier {
    unsigned* bar; unsigned x;
    volatile LAS unsigned* st;
};

__device__ __forceinline__ XcdBarrier xcd_barrier_post(unsigned* bar, volatile LAS unsigned* st) {
    XcdBarrier b; b.bar = bar; b.x = xb_xcc_id(); b.st = st;
    if (threadIdx.x == 0) (void)xb_add(&bar[XB_XCNT(b.x)], 1u);
    return b;
}
__device__ __forceinline__ void xcd_barrier_complete(unsigned* bar, unsigned x, unsigned& nloc, unsigned& nx) {
    const unsigned G = gridDim.x * gridDim.y * gridDim.z;
    unsigned sum, cnt, mine, sp = 0u;
    for (;;) {
        sum = 0u; cnt = 0u; mine = 0u;
#pragma unroll
        for (unsigned j = 0; j < 16; ++j) { const unsigned c = xb_ld(&bar[XB_XCNT(j)]); sum += c; cnt += (c > 0u) ? 1u : 0u; mine = (j == x) ? c : mine; }
        if (sum == G) break;
        __builtin_amdgcn_s_sleep(1);
        if ((++sp & 255u) == 0u) { if (xb_ld(&bar[XB_TMO])) break; if (sp > XB_SPIN_CAP) { atomicAdd(&bar[XB_TMO], 1u); break; } }
    }
    nloc = mine > 0u ? mine : 1u; nx = cnt > 0u ? cnt : 1u;
}

__device__ __forceinline__ void xcd_barrier(const XcdBarrier& b) {
    asm volatile("s_waitcnt vmcnt(0)" ::: "memory");
    __syncthreads();
    if (threadIdx.x == 0) {
        unsigned* bar = b.bar;
        __builtin_amdgcn_s_waitcnt(0);
        unsigned nloc = b.st[0], nx = b.st[1];
        if (nloc == 0u) { xcd_barrier_complete(bar, b.x, nloc, nx); b.st[0] = nloc; b.st[1] = nx; }
        const unsigned old = xb_add(&bar[XB_XSUB(b.x)], 1u);
        const unsigned gen = old / nloc;
        if (old + 1u == (gen + 1u) * nloc) {
            __builtin_amdgcn_fence(__ATOMIC_RELEASE, "agent");
            asm volatile("s_waitcnt vmcnt(0)" ::: "memory");
            const unsigned og = xb_add(&bar[XB_TOP], 1u);
            const unsigned tg = og / nx;
            if (og + 1u == (tg + 1u) * nx) xb_add(&bar[XB_TOPGEN], 1u);
            else XB_SPIN(xb_ld(&bar[XB_TOPGEN]) == tg, bar);
            __builtin_amdgcn_fence(__ATOMIC_ACQUIRE, "agent");
            xb_add(&bar[XB_XGEN(b.x)], 1u);
            asm volatile("s_waitcnt vmcnt(0)" ::: "memory");
        } else {
            XB_SPIN(xb_ld(&bar[XB_XGEN(b.x)]) == gen, bar);
            __builtin_amdgcn_fence(__ATOMIC_ACQUIRE, "agent");
            asm volatile("s_waitcnt vmcnt(0)" ::: "memory");
        }
    }
    __syncthreads();
}


#include <hip/hip_cooperative_groups.h>
namespace cg = cooperative_groups;

#define MEGA_LDS_MAIN 143360
#define MEGA_LDS (MEGA_LDS_MAIN + 16)
#define WS_X 0ull
#define WS_WTA (WS_X + (size_t)NTOK * 1024 * 4)
#define WS_WTB (WS_WTA + (size_t)WT_LAYER * 2)
#define WS_QKV (WS_WTB + (size_t)2816 * 1024 * 2)
#define WS_REST (WS_QKV + (size_t)NTOK * NQKV * 2)
#define WS_PRE (WS_REST + (size_t)NTOK * NREST * 2)
#define WS_MIXB (WS_PRE + (size_t)768 * PRE_ITEM)
#define WS_MODS (WS_MIXB + (size_t)NTOK * 1024 * 2)
#define WS_AV (WS_MODS + 2 * 3 * 6144 * 4)
#define WS_BIN (WS_AV + 2 * 2 * 3 * 1024 * 4)
#define WS_BGU (WS_BIN + 2 * 3 * NCOLS * 4)
#define WS_BLOG (WS_BGU + 2 * 3 * 2 * FFH * 4)
#define WS_ROWSS (WS_BLOG + 2 * 3 * 16 * 4 + 128)
#define WS_LOG (WS_ROWSS + 5 * NTOK * 4)
#define WS_BAR (WS_LOG + (size_t)NTOK * 16 * 4)
#define WS_WLT (WS_BAR + 16384)
#define WS_POS (WS_WLT + 2 * 16 * 1024 * 2)
#define WS_SLOT (WS_POS + 96 * 512 * 4)
#define WS_END (WS_SLOT + 48 * 4 * 256 * 4)
struct MP {
  const float *x_prompt, *x_sample, *state_delta, *c, *c_ctx, *w_in, *conv_w, *a_log, *dt_bias, *delta_norm_g, *sgu_norm_g, *w_spatial, *b_spatial,
      *w_pool, *pool_scale, *w_out, *norm1_g, *norm2_g, *w_mod, *b_mod, *w_gu, *w_down, *norm_f;
  float* out; unsigned char* ws;
  __device__ __forceinline__ float* X_() const { return (float*)(ws + WS_X); }
  __device__ __forceinline__ bf16_t* WTA_() const { return (bf16_t*)(ws + WS_WTA); }
  __device__ __forceinline__ bf16_t* WTB_() const { return (bf16_t*)(ws + WS_WTB); }
  __device__ __forceinline__ bf16_t* QKV_() const { return (bf16_t*)(ws + WS_QKV); }
  __device__ __forceinline__ bf16_t* REST_() const { return (bf16_t*)(ws + WS_REST); }
  __device__ __forceinline__ unsigned char* PRE_() const { return ws + WS_PRE; }
  __device__ __forceinline__ bf16_t* MIXB_() const { return (bf16_t*)(ws + WS_MIXB); }
  __device__ __forceinline__ float* mods_() const { return (float*)(ws + WS_MODS); }
  __device__ __forceinline__ float* AV_() const { return (float*)(ws + WS_AV); }
  __device__ __forceinline__ float* BIN_() const { return (float*)(ws + WS_BIN); }
  __device__ __forceinline__ float* BGU_() const { return (float*)(ws + WS_BGU); }
  __device__ __forceinline__ float* BLOG_() const { return (float*)(ws + WS_BLOG); }
  __device__ __forceinline__ float* rowss_() const { return (float*)(ws + WS_ROWSS); }
  __device__ __forceinline__ float* LOG_() const { return (float*)(ws + WS_LOG); }
  __device__ __forceinline__ unsigned* bar_() const { return (unsigned*)(ws + WS_BAR); }
  __device__ __forceinline__ bf16_t* WLT_() const { return (bf16_t*)(ws + WS_WLT); }
  __device__ __forceinline__ float* POS_() const { return (float*)(ws + WS_POS); }
  __device__ __forceinline__ float* SLOT_() const { return (float*)(ws + WS_SLOT); }
};

__device__ __forceinline__ void gemv3_item(const float* __restrict__ W, int ld, int ncols, const float* vec  , float* red  ,
                                           const float* __restrict__ bias, float* __restrict__ o0, float* __restrict__ o1, float* __restrict__ o2, int t) {
  const int col = t & 63, ds = t >> 6;
  float a0 = 0.f, a1 = 0.f, a2 = 0.f;
  if (col < ncols) {
    const float* w = W + (size_t)(ds * 128) * ld + col;
#pragma unroll 16
    for (int d = 0; d < 128; ++d) { const float wv = w[(size_t)d * ld]; const int dd = ds * 128 + d; a0 += vec[dd] * wv; a1 += vec[1024 + dd] * wv; a2 += vec[2048 + dd] * wv; }
  }
  red[(ds * 3 + 0) * 64 + col] = a0; red[(ds * 3 + 1) * 64 + col] = a1; red[(ds * 3 + 2) * 64 + col] = a2;
  __syncthreads();
  if (t < 192) {
    const int s = t >> 6, cc = t & 63;
    float v = 0.f;
#pragma unroll
    for (int k = 0; k < 8; ++k) v += red[(k * 3 + s) * 64 + cc];
    if (cc < ncols) { v += bias ? bias[cc] : 0.f; (s == 0 ? o0 : (s == 1 ? o1 : o2))[cc] = v; }
  }
  __syncthreads();
}

__device__ __forceinline__ WTile wtile_desc(const MP& p, int l, int r, bf16_t* wt_in, bf16_t* wt_rest) {
  const float* ml = p.mods_() + l * 3 * 6144;
  WTile d;
  if (r < 704) { const int kt = r / 44, jt = r % 44; d.src = p.w_in + (size_t)l * 1024 * INC; d.ldsrc = INC; d.srccol0 = win_srccol(jt * 64); d.dst = wt_in; d.K = 1024; d.j0 = jt * 64; d.k0 = kt * 64; d.shv = ml; d.bias = p.BIN_() + l * 3 * NCOLS; d.bstride = NCOLS; return d; }
  r -= 704;
  if (r < 256) { const int kt = r / 16, jt = r % 16; d.src = p.w_out + (size_t)l * 1024 * 1024; d.ldsrc = 1024; d.srccol0 = jt * 64; d.dst = wt_rest + WT_OUT; d.K = 1024; d.j0 = jt * 64; d.k0 = kt * 64; d.shv = nullptr; d.bias = nullptr; d.bstride = 0; return d; }
  r -= 256;
  if (r < 1408) { const int kt = r / 88, jt = r % 88; d.src = p.w_gu + (size_t)l * 1024 * 2 * FFH; d.ldsrc = 2 * FFH; d.srccol0 = wgu_srccol(jt * 64); d.dst = wt_rest + WT_GU; d.K = 1024; d.j0 = jt * 64; d.k0 = kt * 64; d.shv = ml + 3072; d.bias = p.BGU_() + l * 3 * 2 * FFH; d.bstride = 2 * FFH; return d; }
  r -= 1408;
  { const int kt = r / 16, jt = r % 16; d.src = p.w_down + (size_t)l * FFH * 1024; d.ldsrc = 1024; d.srccol0 = jt * 64; d.dst = wt_rest + WT_DOWN; d.K = FFH; d.j0 = jt * 64; d.k0 = kt * 64; d.shv = nullptr; d.bias = nullptr; d.bstride = 0; return d; }
}

__device__ __forceinline__ void wtiles(const MP& p, int l, int r_lo, int r_hi, int jb, int njb, unsigned char* smem) {
  int t_ = threadIdx.x; asm volatile("" : "+v"(t_)); const int t = t_, tt = t & 255;
  float* tile0 = (float*)smem + (t >> 8) * (2 * 64 * 65); float* tile1 = tile0 + 64 * 65;
  for (int it = jb; it < (r_hi - r_lo) / 4; it += njb) {
    const int r = r_lo + it * 4 + (t >> 8) * 2;
    const WTile d0 = wtile_desc(p, l, r, p.WTA_() + WT_IN, p.WTA_()), d1 = wtile_desc(p, l, r + 1, p.WTA_() + WT_IN, p.WTA_());
    float v0[16], v1[16];
    wtile_load(d0, v0, tt); wtile_load(d1, v1, tt);
    wtile_put(tile0, v0, tt); wtile_put(tile1, v1, tt);
    __syncthreads();
    wtile_finish(d0, tile0, tt); wtile_finish(d1, tile1, tt);
    __syncthreads();
  }
}

__device__ __forceinline__ void phase_prep0(const MP& p, int bid, int nb, unsigned char* smem, bool tiles) {
  int t_ = threadIdx.x; asm volatile("" : "+v"(t_)); const int t = t_;
  if (!tiles) for (int i = bid * 512 + t; i < 4 * NTOK; i += nb * 512) p.rowss_()[NTOK + i] = 0.f;
  if (!tiles) for (int i = bid * 512 + t; i < 2 * 3 * NCOLS + 2 * 3 * 2 * FFH; i += nb * 512) p.BIN_()[i] = 0.f;
  if (!tiles) for (int i = bid * 512 + t; i < 96 * 512; i += nb * 512) {
    const int rc = i >> 9, dd = i & 511, jj = dd & 255;
    const float omega = 1.0f / powf(10000.0f, (float)jj / 256.0f);
    const float ang = (float)(rc < 32 ? rc : rc - 32) * omega;
    p.POS_()[i] = (dd & 256) ? cosf(ang) : sinf(ang);
  }
  if (!tiles) for (int i = bid * 512 + t; i < 2 * 16 * 1024; i += nb * 512) { const int l = i >> 14, j = (i >> 10) & 15, d = i & 1023; p.WLT_()[i] = f2bf(p.w_in[((size_t)l * 1024 + d) * INC + 2048 + j]); }
  float* vec = (float*)smem; float* red = vec + 3072;
  const int NMOD = 192;
  if (tiles) { wtiles(p, 0, 0, 704, bid, nb, smem); return; }
  for (int it = bid; it < NMOD; it += nb) {
    const int l = it / 96, cgp = it % 96;
    for (int i = t; i < 1024; i += 512) { vec[i] = silu_f(p.c_ctx[i]); vec[1024 + i] = silu_f(p.c[i]); vec[2048 + i] = silu_f(p.c[1024 + i]); }
    __syncthreads();
    float* m = p.mods_() + l * 3 * 6144 + cgp * 64;
    gemv3_item(p.w_mod + (size_t)l * 1024 * 6144 + cgp * 64, 6144, 64, vec, red, p.b_mod + l * 6144 + cgp * 64, m, m + 6144, m + 2 * 6144, t);
  }
}

__device__ __forceinline__ void phase_vecs(const MP& p, int bid, int nb, unsigned char* smem) {
  int t_ = threadIdx.x; asm volatile("" : "+v"(t_)); const int t = t_;
  float* vec = (float*)smem; float* red = vec + 3072;
  for (int i = bid * 512 + t; i < 2 * 2 * 1024; i += nb * 512) {
    const int l = i >> 11, n = (i >> 10) & 1, d = i & 1023;
    const float g = n ? p.norm2_g[l * 1024 + d] : p.norm1_g[l * 1024 + d];
#pragma unroll
    for (int s = 0; s < 3; ++s) p.AV_()[((l * 2 + n) * 3 + s) * 1024 + d] = g * (1.f + p.mods_()[(l * 3 + s) * 6144 + (n ? 4096 : 1024) + d]);
  }
  const int N_IN = 44, N_GU = 88;
  for (int it = bid; it < 2; it += nb) {
    const int l = it, r = N_IN + N_GU;
    const int sh_off = (r >= N_IN && r < N_IN + N_GU) ? 3072 : 0;
    for (int i = t; i < 1024; i += 512) {
#pragma unroll
      for (int s = 0; s < 3; ++s) vec[s * 1024 + i] = p.mods_()[(l * 3 + s) * 6144 + sh_off + i];
    }
    __syncthreads();
    if (r < N_IN) { float* o = p.BIN_() + l * 3 * NCOLS + r * 64; gemv3_item(p.w_in + (size_t)l * 1024 * INC + win_srccol(r * 64), INC, 64, vec, red, nullptr, o, o + NCOLS, o + 2 * NCOLS, t); }
    else if (r < N_IN + N_GU) { const int j0 = (r - N_IN) * 64; float* o = p.BGU_() + l * 3 * 2 * FFH + j0; gemv3_item(p.w_gu + (size_t)l * 1024 * 2 * FFH + wgu_srccol(j0), 2 * FFH, 64, vec, red, nullptr, o, o + 2 * FFH, o + 4 * FFH, t); }
    else { float* o = p.BLOG_() + l * 3 * 16; gemv3_item(p.w_in + (size_t)l * 1024 * INC + 2048, INC, 16, vec, red, nullptr, o, o + 16, o + 32, t); }
  }
}

__device__ __forceinline__ void prepx_row(const MP& p, int r, int lane) {
  const int seg = seg_of_row(r);
  float ss = 0.f;
#pragma unroll
  for (int i = 0; i < 4; ++i) {
    const int d = i * 256 + lane * 4;
    f32x4 v;
    if (r < NCTX) v = *(const f32x4*)(p.x_prompt + (size_t)r * 1024 + d);
    else {
      const int rl = r - NCTX, pp = rl & 2047, row = pp >> 6, col = pp & 63;
      v = *(const f32x4*)(p.x_sample + (size_t)rl * 1024 + d);
      const f32x4 e = *(const f32x4*)(p.POS_() + (d < 512 ? row * 512 + d : (32 + col) * 512 + (d - 512)));
      v = v + e;
    }
    *(f32x4*)(p.X_() + (size_t)r * 1024 + d) = v;
    ss += (v[0] * v[0] + v[1] * v[1]) + (v[2] * v[2] + v[3] * v[3]);
    const f32x4 g1 = *(const f32x4*)(p.norm1_g + d), sc1 = *(const f32x4*)(p.mods_() + seg * 6144 + 1024 + d);
    const f32x4 a = g1 * (1.f + sc1);
    u32x2 w; w.x = pack_bf16(v[0] * a[0], v[1] * a[1]); w.y = pack_bf16(v[2] * a[2], v[3] * a[3]);
    *(u32x2*)((bf16_t*)p.PRE_() + (size_t)r * 1024 + d) = w;
  }
  ss = wave_sum(ss);
  if (lane == 0) p.rowss_()[r] = ss;
}

__device__ __forceinline__ void phase_logits(const MP& p, int l, int bid, int nb, unsigned char* smem) {
  int tl = threadIdx.x; asm volatile("" : "+v"(tl)); const int t = tl, lane = tl & 63, w = tl >> 6, fr = lane & 15, g = lane >> 4;
  bf16_t* wl = (bf16_t*)smem;
  const bf16_t* XA = (const bf16_t*)p.PRE_();
  for (int q = t; q < 2048; q += 512) { const int j = q >> 7, c = q & 127; *(u32x4*)(wl + j * 1032 + c * 8) = *(const u32x4*)(p.WLT_() + (size_t)l * 16 * 1024 + j * 1024 + c * 8); }
  __syncthreads();
  for (int rg = bid * 8 + w; rg < NTOK / 16; rg += nb * 8) {
    const int row0 = rg * 16;
    const bf16_t* arow = XA + (size_t)(row0 + fr) * 1024 + 8 * g;
    bf16x8 af[32];
#pragma unroll
    for (int ks = 0; ks < 32; ++ks) af[ks] = *(const bf16x8*)(arow + 32 * ks);
    f32x4 acc0 = (f32x4){0.f, 0.f, 0.f, 0.f}, acc1 = acc0;
#pragma unroll
    for (int ks = 0; ks < 32; ks += 2) {
      const bf16x8 b0 = *(const bf16x8*)(wl + fr * 1032 + 32 * ks + 8 * g), b1 = *(const bf16x8*)(wl + fr * 1032 + 32 * (ks + 1) + 8 * g);
      acc0 = __builtin_amdgcn_mfma_f32_16x16x32_bf16(af[ks], b0, acc0, 0, 0, 0);
      acc1 = __builtin_amdgcn_mfma_f32_16x16x32_bf16(af[ks + 1], b1, acc1, 0, 0, 0);
    }
    const int seg = seg_of_row(row0);
    const float bias = p.BLOG_()[l * 3 * 16 + seg * 16 + fr];
#pragma unroll
    for (int r = 0; r < 4; ++r) {
      const int row = row0 + 4 * g + r;
      const float rinv = rsqrtf(p.rowss_()[(2 * l) * NTOK + row] * (1.0f / 1024.0f) + 1e-6f);
      p.LOG_()[(size_t)row * 16 + fr] = (acc0[r] + acc1[r]) * rinv + bias;
    }
  }
  __syncthreads();
}

__device__ __forceinline__ void delta_post_row(const MP& p, int l, int r, int lane) {
  const bf16_t* OB = p.QKV_();
  const u32x4 of = *(const u32x4*)(OB + (size_t)r * 512 + lane * 8), ob = *(const u32x4*)(OB + ((size_t)NTOK + r) * 512 + lane * 8);
  const u32x4 zz = *(const u32x4*)(p.REST_() + (size_t)r * NREST + lane * 8);
  float o[8]; float ss = 0.f;
#pragma unroll
  for (int e = 0; e < 8; ++e) {
    const unsigned wf = of[e >> 1], wb = ob[e >> 1];
    o[e] = __uint_as_float((e & 1) ? (wf & 0xffff0000u) : (wf << 16)) + __uint_as_float((e & 1) ? (wb & 0xffff0000u) : (wb << 16));
    ss += o[e] * o[e];
  }
  ss += __shfl_xor(ss, 1); ss += __shfl_xor(ss, 2); ss += __shfl_xor(ss, 4); ss += __shfl_xor(ss, 8);
  const float rn = rsqrtf(ss * (1.0f / 128.0f) + 1e-6f);
  const float* ng = p.delta_norm_g + l * 128 + (lane & 15) * 8;
  float y[8];
#pragma unroll
  for (int e = 0; e < 8; ++e) {
    const unsigned wz = zz[e >> 1];
    const float z = __uint_as_float((e & 1) ? (wz & 0xffff0000u) : (wz << 16));
    y[e] = o[e] * rn * ng[e] * silu_fast(z);
  }
  u32x4 w; w.x = pack_bf16(y[0], y[1]); w.y = pack_bf16(y[2], y[3]); w.z = pack_bf16(y[4], y[5]); w.w = pack_bf16(y[6], y[7]);
  *(u32x4*)(p.MIXB_() + (size_t)r * 1024 + lane * 8) = w;
}

__device__ __forceinline__ void sgu_pair(const MP& p, int l, int item0, unsigned char* smem) {
  int tl = threadIdx.x; asm volatile("" : "+v"(tl)); const int t = tl & 255, lane = tl & 63, w = __builtin_amdgcn_readfirstlane(tl >> 6), hb = w >> 2, wl = w & 3, fr = lane & 15, g4 = lane >> 4;
  const int item = item0 + hb, ch = item >> 2, g = item & 3;
  const bf16_t* REST = p.REST_(); const float* norm_g = p.sgu_norm_g + l * 256 + g * 64;
  const float* w_s = p.w_spatial + ((size_t)l * 4 + g) * 128 * 128; const float* b_s = p.b_spatial + (l * 4 + g) * 128;
  const int r0 = ch * 128;
  bf16_t* vnT = (bf16_t*)(smem + hb * 35840);
  bf16_t* ut = (bf16_t*)(smem + hb * 35840 + 17408);
  const int s_ = t >> 1, q2 = t & 1;
  const bf16_t* vrow = REST + (size_t)(r0 + s_) * NREST + 768 + g * 64 + q2 * 32;
  u32x4 vv[4];
#pragma unroll
  for (int k = 0; k < 4; ++k) vv[k] = *(const u32x4*)(vrow + 8 * k);
  u32x4 uu[4];
#pragma unroll
  for (int k = 0; k < 4; ++k) { const int q = t + 256 * k, row = q >> 3, c8 = q & 7; uu[k] = *(const u32x4*)(REST + (size_t)(r0 + row) * NREST + 512 + g * 64 + c8 * 8); }
  f32x4 wa[2][4][2];
#pragma unroll
  for (int mt = 0; mt < 2; ++mt) {
    const float* wrow = w_s + (size_t)(wl * 32 + mt * 16 + fr) * 128 + 8 * g4;
#pragma unroll
    for (int ks = 0; ks < 4; ++ks) { wa[mt][ks][0] = *(const f32x4*)(wrow + 32 * ks); wa[mt][ks][1] = *(const f32x4*)(wrow + 32 * ks + 4); }
  }
  {
    float val[32]; float ss = 0.f;
#pragma unroll
    for (int e = 0; e < 32; ++e) {
      const unsigned wv = vv[e >> 3][(e & 7) >> 1];
      val[e] = gelu_fast(__uint_as_float((e & 1) ? (wv & 0xffff0000u) : (wv << 16))); ss += val[e] * val[e];
    }
    ss += __shfl_xor(ss, 1);
    const float rinv = rsqrtf(ss * (1.0f / 64.0f) + 1e-6f);
#pragma unroll
    for (int e = 0; e < 32; ++e) vnT[(q2 * 32 + e) * 136 + s_] = f2bf(val[e] * rinv * norm_g[q2 * 32 + e]);
#pragma unroll
    for (int k = 0; k < 4; ++k) { const int q = t + 256 * k, row = q >> 3, c8 = q & 7; *(u32x4*)(ut + row * 72 + c8 * 8) = uu[k]; }
  }
  __syncthreads();
#pragma unroll
  for (int mt = 0; mt < 2; ++mt) {
    bf16x8 af[4];
#pragma unroll
    for (int ks = 0; ks < 4; ++ks) af[ks] = pack8(wa[mt][ks][0], wa[mt][ks][1]);
    f32x4 acc[4];
#pragma unroll
    for (int nt = 0; nt < 4; ++nt) {
      acc[nt] = (f32x4){0.f, 0.f, 0.f, 0.f};
#pragma unroll
      for (int ks = 0; ks < 4; ++ks) {
        const bf16x8 bfr = *(const bf16x8*)(vnT + (nt * 16 + fr) * 136 + 32 * ks + 8 * g4);
        acc[nt] = __builtin_amdgcn_mfma_f32_16x16x32_bf16(af[ks], bfr, acc[nt], 0, 0, 0);
      }
    }
#pragma unroll
    for (int r = 0; r < 4; ++r) {
      const int tt = wl * 32 + mt * 16 + 4 * g4 + r;
      const float bb = b_s[tt];
#pragma unroll
      for (int nt = 0; nt < 4; ++nt) { bf16_t* e = ut + tt * 72 + nt * 16 + fr; *e = f2bf(gelu_fast(bf2f(*e)) * (acc[nt][r] + bb)); }
    }
  }
  __syncthreads();
#pragma unroll
  for (int k = 0; k < 4; ++k) { const int q = t + 256 * k, row = q >> 3, c8 = q & 7; *(u32x4*)(p.MIXB_() + (size_t)(r0 + row) * 1024 + 512 + g * 64 + c8 * 8) = *(const u32x4*)(ut + row * 72 + c8 * 8); }
  __syncthreads();
}

__device__ __forceinline__ void pool_item(const MP& p, int l, int blk, unsigned char* smem) {
  int tl = threadIdx.x; asm volatile("" : "+v"(tl)); const int t = tl, lane = tl & 63, w = __builtin_amdgcn_readfirstlane(tl >> 6), fr = lane & 15, g4 = lane >> 4;
  const bf16_t* REST = p.REST_(); const float* w_pool = p.w_pool + (size_t)l * 4 * 64 * 64; const float* scale = p.pool_scale + l * 256;
  const int r0 = blk * 64;
  int seg0, seglen;
  if (r0 < NCTX) { seg0 = r0 & ~255; seglen = 256; } else { seg0 = r0; seglen = 64; }
  bf16_t* xs = (bf16_t*)smem;
  bf16_t* dm = (bf16_t*)(smem + 42240);
  bf16_t* wT = (bf16_t*)(smem + 42240 + 36864);
  u32x4 xv[5];
#pragma unroll
  for (int k = 0; k < 5; ++k) {
    const int q = t + 512 * k, lr = q >> 5, c8 = q & 31, row = r0 - 8 + lr;
    xv[k] = (u32x4){0u, 0u, 0u, 0u};
    if (row >= seg0 && row < seg0 + seglen) xv[k] = *(const u32x4*)(REST + (size_t)row * NREST + 1024 + c8 * 8);
  }
  f32x4 wv[8];
#pragma unroll
  for (int k = 0; k < 8; ++k) wv[k] = *(const f32x4*)(w_pool + (size_t)(t + 512 * k) * 4);
#pragma unroll
  for (int k = 0; k < 5; ++k) { const int q = t + 512 * k, lr = q >> 5, c8 = q & 31; *(u32x4*)(xs + lr * 264 + c8 * 8) = xv[k]; }
#pragma unroll
  for (int k = 0; k < 8; ++k) {
    const int q = t + 512 * k, i = q >> 10, c = (q >> 4) & 63, d4 = (q & 15) * 4;
#pragma unroll
    for (int e = 0; e < 4; ++e) wT[(i * 64 + d4 + e) * 72 + c] = f2bf(wv[k][e]);
  }
  __syncthreads();
  {
    const int c = t & 255, i = c >> 6, win = 2 << i, ph = t >> 8, hw = win >> 1;
    const int xoff = seg0 - r0 + 8;
    int pos = r0 + ph * 32 - seg0;
    int lo = max(pos - hw, 0), hi = min(pos + hw, seglen);
    float s = 0.f;
    for (int q = lo; q < hi; ++q) s += bf2f(xs[(q + xoff) * 264 + c]);
#pragma unroll 4
    for (int pp = ph * 32; pp < ph * 32 + 32; ++pp) {
      dm[(i * 64 + pp) * 72 + (c & 63)] = f2bf(s * __builtin_amdgcn_rcpf((float)(hi - lo)) - bf2f(xs[(pp + 8) * 264 + c]));
      ++pos;
      const int lo2 = max(pos - hw, 0), hi2 = min(pos + hw, seglen);
      if (hi2 > hi) s += bf2f(xs[(hi + xoff) * 264 + c]);
      if (lo2 > lo) s -= bf2f(xs[(lo + xoff) * 264 + c]);
      lo = lo2; hi = hi2;
    }
  }
  __syncthreads();
  {
    const int i = w >> 1;
    bf16x8 bfr[4][2];
#pragma unroll
    for (int nt = 0; nt < 4; ++nt)
#pragma unroll
      for (int ks = 0; ks < 2; ++ks) bfr[nt][ks] = *(const bf16x8*)(wT + (i * 64 + nt * 16 + fr) * 72 + 32 * ks + 8 * g4);
#pragma unroll
    for (int pt2 = 0; pt2 < 2; ++pt2) {
      const int pt = (w & 1) * 2 + pt2;
      bf16x8 af[2];
#pragma unroll
      for (int ks = 0; ks < 2; ++ks) af[ks] = *(const bf16x8*)(dm + (i * 64 + pt * 16 + fr) * 72 + 32 * ks + 8 * g4);
#pragma unroll
      for (int nt = 0; nt < 4; ++nt) {
        f32x4 acc = (f32x4){0.f, 0.f, 0.f, 0.f};
#pragma unroll
        for (int ks = 0; ks < 2; ++ks) acc = __builtin_amdgcn_mfma_f32_16x16x32_bf16(af[ks], bfr[nt][ks], acc, 0, 0, 0);
        const float sc = scale[i * 64 + nt * 16 + fr];
#pragma unroll
        for (int r = 0; r < 4; ++r) xs[(pt * 16 + 4 * g4 + r) * 264 + i * 64 + nt * 16 + fr] = f2bf(acc[r] * sc);
      }
    }
  }
  __syncthreads();
#pragma unroll
  for (int k = 0; k < 4; ++k) { const int q = t + 512 * k, row = q >> 5, c8 = q & 31; *(u32x4*)(p.MIXB_() + (size_t)(r0 + row) * 1024 + 768 + c8 * 8) = *(const u32x4*)(xs + row * 264 + c8 * 8); }
  __syncthreads();
}

__device__ __forceinline__ void final_row(const MP& p, int r, int lane) {
  const float rinv = rsqrtf(p.rowss_()[4 * NTOK + r] * (1.0f / 1024.0f) + 1e-6f);
#pragma unroll
  for (int i = 0; i < 4; ++i) {
    const int d = i * 256 + lane * 4;
    const f32x4 v = *(const f32x4*)(p.X_() + (size_t)r * 1024 + d), gg = *(const f32x4*)(p.norm_f + d);
    *(f32x4*)(p.out + (size_t)r * 1024 + d) = v * rinv * gg;
  }
}

#ifndef REPEAT
#define REPEAT 0
#endif
#define REP_CAT2(a, b) a##b
#define REP_CAT(a, b) REP_CAT2(a, b)
#define REP(k) for (int REP_CAT(rep_, __LINE__) = 0; REP_CAT(rep_, __LINE__) < 1 + ((REPEAT >> (k)) & 1); ++REP_CAT(rep_, __LINE__))
#ifndef USE_CG_SYNC
#define USE_CG_SYNC 0
#endif
#if USE_CG_SYNC
#define GRID_SYNC() grid.sync()
#else
#define GRID_SYNC() do { REP(21) { XcdBarrier xb2; xb2.bar = p.bar_(); xb2.x = xb_xcc_id(); xb2.st = xst; xcd_barrier(xb2); } } while (0)
#endif

__global__ __launch_bounds__(512, 2) void mega(MP p) {
  extern __shared__ __attribute__((aligned(16))) unsigned char smem[];
#if USE_CG_SYNC
  cg::grid_group grid = cg::this_grid();
#else
  volatile LAS unsigned* xst = (volatile LAS unsigned*)((LAS unsigned char*)smem + MEGA_LDS_MAIN);
  if (threadIdx.x == 0) { xst[0] = 0u; xst[1] = 0u; }
  __syncthreads();
  (void)xcd_barrier_post(p.bar_(), xst);
#endif
  const int bid = blockIdx.x, nb = gridDim.x;
  bf16_t* XA = (bf16_t*)p.PRE_(); bf16_t* ACT = p.QKV_(); bf16_t* OB = p.QKV_();
  float* states_out = p.out + (size_t)NTOK * 1024;

  REP(0) phase_prep0(p, bid, nb, smem, false);
  GRID_SYNC();
  REP(1) { phase_prep0(p, bid, nb, smem, true); phase_vecs(p, bid, nb, smem); }
  REP(2) { int tl = threadIdx.x; asm volatile("" : "+v"(tl)); const int lane = tl & 63, w = tl >> 6;
    for (int r = bid * 8 + w; r < NTOK; r += nb * 8) prepx_row(p, r, lane); }
  GRID_SYNC();
  for (int l = 0; l < 2; ++l) {
#define TL_DECL int tl = threadIdx.x; asm volatile("" : "+v"(tl)); const int t = tl, lane = tl & 63, w = tl >> 6; (void)t; (void)lane; (void)w
    const float* ml = p.mods_() + l * 3 * 6144;
    float* rs1 = p.rowss_() + (2 * l) * NTOK; float* rs2 = p.rowss_() + (2 * l + 1) * NTOK; float* rs3 = p.rowss_() + (2 * l + 2) * NTOK;
    const float* A2 = p.AV_() + (l * 2 + 1) * 3 * 1024; const float* A1n = p.AV_() + (2 + 0) * 3 * 1024;
    REP(4) {
      pg8::Gemm g; g.A = XA; g.Bt = p.WTA_() + WT_IN; g.M = NTOK; g.N = NCOLS; g.K = 1024;
      EpiIn E{p.QKV_(), p.REST_(), rs1, p.BIN_() + l * 3 * NCOLS};
      pg8::StaticOrder S; S.init(g.M, g.N, nb, bid);
      pg8::gemm_phase<EpiIn, pg8::StaticOrder, true, true>((PG8_LAS unsigned char*)smem, g, S, E);
    }
    REP(3) if (bid >= 16) {
      phase_logits(p, l, bid - 16, nb - 16, smem);
      wtiles(p, l, 704, 2368, bid - 16, nb - 16, smem);
    }
    GRID_SYNC();
    REP(5) for (int item = bid; item < 768; item += nb) pre_item(item, p.QKV_(), p.LOG_(), p.conv_w + (size_t)l * 3 * NQKV, p.a_log + l * 8, p.dt_bias + l * 8, p.PRE_(), smem);
    GRID_SYNC();
    REP(6) { if (bid < 32) { REP(13) scan_dispatch(bid, p.PRE_(), p.state_delta, OB, states_out, l, smem); }
             else { REP(14) for (int i = bid - 32; i < 256; i += nb - 32) scan_dispatch(32 + i, p.PRE_(), p.state_delta, OB, states_out, l, smem); } }
    REP(12) if (bid >= 32) {
      for (int it = bid - 32; it < 192; it += nb - 32) sgu_pair(p, l, 2 * it, smem);
      for (int it = bid - 32; it < 192; it += nb - 32) pool_item(p, l, it, smem);
    }
    GRID_SYNC();
    REP(7) { TL_DECL; for (int r = bid * 8 + w; r < NTOK; r += nb * 8) delta_post_row(p, l, r, lane); }
    GRID_SYNC();
    {
      pg8::Gemm g; g.A = p.MIXB_(); g.Bt = p.WTA_() + WT_OUT; g.M = NTOK; g.N = 1024; g.K = 1024;
      EpiRes E{p.X_(), ml + 2048, rs2, XA, A2};
      pg8::StaticOrder S; S.init(g.M, g.N, nb, bid);
      pg8::gemm_phase<EpiRes, pg8::StaticOrder, true, true>((PG8_LAS unsigned char*)smem, g, S, E);
    }
    if (bid >= 192) wtiles(p, l, 2368, 3072, bid - 192, nb - 192, smem);
    GRID_SYNC();
    REP(9) {
      pg8::Gemm g; g.A = XA; g.Bt = p.WTA_() + WT_GU; g.M = NTOK; g.N = 2 * FFH; g.K = 1024;
      EpiGu E{ACT, rs2, p.BGU_() + l * 3 * 2 * FFH};
      GuOrder S; S.init(nb, bid, -1);
      pg8::gemm_phase<EpiGu, GuOrder, true, true>((PG8_LAS unsigned char*)smem, g, S, E);
    }
    GRID_SYNC();
    unsigned* gu_flag = p.bar_() + 3712 + l * 64;
#define GU_DEFERRED() do { for (int e = bid - 192; e < 48 - GU_DEFER_PM0; e += nb - 192) { \
      pg8::Gemm g; g.A = XA; g.Bt = p.WTA_() + WT_GU; g.M = NTOK; g.N = 2 * FFH; g.K = 1024; \
      EpiGu E{ACT, rs2, p.BGU_() + l * 3 * 2 * FFH}; \
      GuOrder S; S.init(nb, bid, GU_DEFER_PM0 + e); \
      pg8::gemm_phase<EpiGu, GuOrder, true, true>((PG8_LAS unsigned char*)smem, g, S, E); \
      asm volatile("s_waitcnt vmcnt(0)" ::: "memory"); \
      __syncthreads();                                                           \
      if (threadIdx.x == 0) { \
        __builtin_amdgcn_fence(__ATOMIC_RELEASE, "agent");                       \
        asm volatile("s_waitcnt vmcnt(0)" ::: "memory"); \
        __hip_atomic_store(gu_flag + GU_DEFER_PM0 + e, 1u, __ATOMIC_RELAXED, __HIP_MEMORY_SCOPE_AGENT); \
      } \
      __syncthreads(); } } while (0)
    if (l == 0) {
      pg8::Gemm g; g.A = ACT; g.Bt = p.WTA_() + WT_DOWN; g.M = NTOK; g.N = 1024; g.K = FFH;
      EpiRes E{p.X_(), ml + 5120, rs3, XA, A1n};
      DownOrder S; S.S.init(g.M, g.N, nb, bid); S.flag = gu_flag;
      pg8::gemm_phase<EpiRes, DownOrder, true, true>((PG8_LAS unsigned char*)smem, g, S, E);
      if (bid >= 192) { GU_DEFERRED(); wtiles(p, 1, 0, 704, bid - 192, nb - 192, smem); }
      GRID_SYNC();
    } else {
      pg8::Gemm g; g.A = ACT; g.Bt = p.WTA_() + WT_DOWN; g.M = NTOK; g.N = 1024; g.K = FFH;
      EpiResFinal E{p.X_(), ml + 5120, p.out, p.norm_f, p.SLOT_(), p.bar_() + 3584};
      DownOrder S; S.S.init(g.M, g.N, nb, bid); S.flag = gu_flag;
      pg8::gemm_phase<EpiResFinal, DownOrder, false, true>((PG8_LAS unsigned char*)smem, g, S, E);
      if (bid >= 192) GU_DEFERRED();
    }
  }
}

extern "C" void kernel_launch(void* const* d_in, const int* in_sizes, int n_in, void* d_out, int out_size, void* d_ws, size_t ws_size,
                              hipStream_t stream) {
  static int grid_blocks = 0;
  if (!grid_blocks) {
    int dev = 0, cus = 0, per_cu = 0;
    (void)hipGetDevice(&dev);
    (void)hipDeviceGetAttribute(&cus, hipDeviceAttributeMultiprocessorCount, dev);
    (void)hipFuncSetAttribute((const void*)mega, hipFuncAttributeMaxDynamicSharedMemorySize, MEGA_LDS);
    (void)hipOccupancyMaxActiveBlocksPerMultiprocessor(&per_cu, (const void*)mega, 512, MEGA_LDS);
    if (per_cu < 1) { fprintf(stderr, "occupancy query says %d blocks per CU\n", per_cu); per_cu = 1; }
    if (per_cu > 1) per_cu = 1;
    grid_blocks = cus * per_cu;
    if (grid_blocks > 256) grid_blocks = 256;
  }
  MP p; memset(&p, 0, sizeof p);
  const float** ins = (const float**)&p;
  for (int i = 0; i < 23; ++i) ins[i] = (const float*)d_in[i];
  p.out = (float*)d_out;
  p.ws = (unsigned char*)d_ws;
  if (WS_END > ws_size) { fprintf(stderr, "workspace too small: need %zu have %zu\n", (size_t)WS_END, ws_size); return; }
  (void)hipMemsetAsync((char*)d_ws + WS_BAR, 0, 16384, stream);
  void* args[] = {&p};
  hipError_t e = hipLaunchCooperativeKernel((const void*)mega, dim3(grid_blocks), dim3(512), args, MEGA_LDS, stream);
  if (e != hipSuccess) fprintf(stderr, "cooperative launch failed: %s (grid %d)\n", hipGetErrorString(e), grid_blocks);
}
```

```cpp
#include <hip/hip_runtime.h>
#include <math.h>
#include <cstdio>
#include <cstring>

#define NTOK 12288
#define NCTX 8192
#define DM 1024
#define INC 2832
#define FFH 2816
#define NQKV 1536
#define NREST 1280
#define NCOLS 2816

typedef unsigned short bf16_t;
typedef float f32x2_cv __attribute__((ext_vector_type(2)));
typedef __bf16 bf16x2_cv __attribute__((ext_vector_type(2)));
__device__ __forceinline__ unsigned pack_bf16(float lo, float hi) { return __builtin_bit_cast(unsigned, __builtin_convertvector((f32x2_cv){lo, hi}, bf16x2_cv)); }
__device__ __forceinline__ bf16_t f2bf(float f) { return (bf16_t)(pack_bf16(f, 0.f) & 0xffffu); }
__device__ __forceinline__ float bf2f(bf16_t b) { return __uint_as_float(((unsigned)b) << 16); }
__device__ __forceinline__ float silu_f(float x) { return x / (1.f + expf(-x)); }
__device__ __forceinline__ float silu_fast(float x) { return x * __builtin_amdgcn_rcpf(1.f + __expf(-x)); }
__device__ __forceinline__ float gelu_fast(float x) { const float u = 1.5957691216057308f * (x + 0.044715f * x * x * x); return x * __builtin_amdgcn_rcpf(1.f + __expf(-u)); }
__device__ __forceinline__ float sigmoid_f(float x) { return 1.f / (1.f + expf(-x)); }
__device__ __forceinline__ float gelu_f(float x) { return 0.5f * x * (1.f + tanhf(0.7978845608028654f * (x + 0.044715f * x * x * x))); }
__device__ __forceinline__ float softplus_f(float x) { return x > 20.f ? x : log1pf(expf(x)); }
__device__ __forceinline__ int seg_of_row(int r) { return r < NCTX ? 0 : 1 + ((r - NCTX) >> 11); }
__device__ __forceinline__ float wave_sum(float v) {
#pragma unroll
  for (int o = 32; o > 0; o >>= 1) v += __shfl_xor(v, o);
  return v;
}
namespace pg8 {
#define PG8_LAS __attribute__((address_space(3)))
typedef unsigned short bf16_t;
typedef short bf16x8 __attribute__((ext_vector_type(8)));
typedef float f32x4 __attribute__((ext_vector_type(4)));
typedef unsigned u32x4 __attribute__((ext_vector_type(4)));
constexpr int BM = 256, BK = 64, HALF = 128, HTB = HALF * BK * 2  , STAGE_BYTES = 8 * HTB, NXCD = 8, WGM = 8;

__host__ __device__ __forceinline__ int lds_byte(int r, int c) { const int st = (r >> 4) * 2 + (c >> 5), rr = r & 15, cc = c & 31, ob = rr * 64 + cc * 2; return st * 1024 + (ob ^ (((ob >> 9) & 1) << 5)); }
__host__ __device__ __forceinline__ void stage_rc(int b, int& R, int& C) { const int st = b / 1024, sb = b % 1024, swz = sb ^ (((sb >> 9) & 1) << 5); R = (st >> 1) * 16 + swz / 64; C = (st & 1) * 32 + (swz % 64) / 2; }
__host__ __device__ __forceinline__ int perm32(int rho) { const int n = rho >> 4, i = rho & 15; return 8 * (i >> 2) + 4 * n + (i & 3); }

struct Unit { int pm, pn; };
struct Gemm { const bf16_t* A; const bf16_t* Bt; int M, N, K; };

struct StaticOrder {
    int nM, nN, nwg, G, c;
    __host__ __device__ void init(int M, int N, int G_, int c_) { nM = M / BM; nN = N / BM; nwg = nM * nN; G = G_; c = c_; }
    __host__ __device__ bool next(int i, Unit& u) const {
        const long L = (long)i * G + c; if (L >= nwg) return false;
        int wgid = (int)L; { const int q = nwg / NXCD, r = nwg % NXCD, xcd = wgid % NXCD, off = wgid / NXCD; wgid = (xcd < r ? xcd * (q + 1) : r * (q + 1) + (xcd - r) * q) + off; }
        const int nig = WGM * nN, gid = wgid / nig, fm = gid * WGM, gsz = (nM - fm) < WGM ? (nM - fm) : WGM;
        u.pm = fm + ((wgid % nig) % gsz); u.pn = (wgid % nig) / gsz; return true;
    }
    __device__ __forceinline__ void a_ready(const Unit&) const {}
    __device__ __forceinline__ void done(const Unit&) const {}
    static constexpr bool KWAIT = false;
    __device__ __forceinline__ bool k_wait(const Unit&) const { return false; }
};

__device__ __forceinline__ unsigned cvt_pk_bf16(float lo, float hi) { return ::pack_bf16(lo, hi); }
template <class Epi, class Sched, bool ALIGN_EPI = false, bool SP2 = false>
__device__ __forceinline__ void gemm_phase(PG8_LAS unsigned char* lds, const Gemm g, const Sched& S, const Epi& E) {
    int tid_ = threadIdx.x; asm volatile("" : "+v"(tid_));
    const int tid = tid_, wid = __builtin_amdgcn_readfirstlane(tid >> 6), lane = tid & 63, wr = wid >> 2, wc = wid & 3, fr = lane & 15, fq = lane >> 4;
    const int K = g.K, nt = K / BK;
    unsigned voffA[2], voffB[2];
#pragma unroll
    for (int i = 0; i < 2; ++i) { int R, C; stage_rc(tid * 16 + i * 8192, R, C); const int Rb = Epi::PERM ? ((R & ~31) + perm32(R & 31)) : R;
        voffA[i] = (unsigned)(R * K + C) * 2u; voffB[i] = (unsigned)(Rb * K + C) * 2u; }
    const size_t kstep = (size_t)(BK * 2);
    const size_t hstep = (size_t)HALF * K * 2;
    const size_t tstep = 2 * hstep;
    const unsigned ldsw = (unsigned)wid * 1024u;
    const int aoff = lds_byte(wr * 64 + fr, fq * 8), boff = lds_byte(wc * 32 + fr, fq * 8);
#define PG8_SA(b, h) (((b) * 2 + (h)) * HTB)
#define PG8_SB(b, h) ((4 + (b) * 2 + (h)) * HTB)
#define PG8_STAGE(bufoff, gbase, voff) do { _Pragma("unroll") for (int _i = 0; _i < 2; ++_i) \
        __builtin_amdgcn_global_load_lds((const unsigned*)((const char*)(gbase) + (voff)[_i]), (PG8_LAS unsigned*)(lds + (bufoff) + ldsw + _i * 8192), 16, 0, 0); } while (0)
#define PG8_STAGE_SC1(bufoff, gbase, voff) do { _Pragma("unroll") for (int _i = 0; _i < 2; ++_i) \
        __builtin_amdgcn_global_load_lds((const unsigned*)((const char*)(gbase) + (voff)[_i]), (PG8_LAS unsigned*)(lds + (bufoff) + ldsw + _i * 8192), 16, 0, 16); } while (0)
#define PG8_STAGE_A(dep, bufoff, gbase) do { if constexpr (Sched::KWAIT) { if (dep) PG8_STAGE_SC1(bufoff, gbase, voffA); else PG8_STAGE(bufoff, gbase, voffA); } else PG8_STAGE(bufoff, gbase, voffA); } while (0)
#define PG8_LDA(dst, b, h) do { _Pragma("unroll") for (int m = 0; m < 4; ++m) _Pragma("unroll") for (int k = 0; k < 2; ++k) dst[m][k] = *(const PG8_LAS bf16x8*)(lds + PG8_SA(b, h) + aoff + m * 2048 + k * 1024); } while (0)
#define PG8_LDB(dst, b, h) do { _Pragma("unroll") for (int n = 0; n < 2; ++n) _Pragma("unroll") for (int k = 0; k < 2; ++k) dst[n][k] = *(const PG8_LAS bf16x8*)(lds + PG8_SB(b, h) + boff + n * 2048 + k * 1024); } while (0)
#define PG8_MMA(ai, bj, At, Bt) do { __builtin_amdgcn_s_setprio(1); _Pragma("unroll") for (int m = 0; m < 4; ++m) _Pragma("unroll") for (int n = 0; n < 2; ++n) _Pragma("unroll") for (int k = 0; k < 2; ++k) \
        acc[ai][bj][m][n] = __builtin_amdgcn_mfma_f32_16x16x32_bf16(Bt[n][k], At[m][k], acc[ai][bj][m][n], 0, 0, 0); PG8_XMMA(ai, bj, At); __builtin_amdgcn_s_setprio(0); } while (0)
#ifdef XMMA
#define PG8_XMMA(ai, bj, At) do { _Pragma("unroll") for (int m = 0; m < 4; ++m) _Pragma("unroll") for (int n = 0; n < 2; ++n) acc[ai][bj][m][n] = __builtin_amdgcn_mfma_f32_16x16x32_bf16(zerov, At[m][0], acc[ai][bj][m][n], 0, 0, 0); } while (0)
#else
#define PG8_XMMA(ai, bj, At) do { } while (0)
#endif
#define PG8_WAIT_V(n) asm volatile("s_waitcnt vmcnt(" #n ")" ::: "memory")
#define PG8_WAIT_L(n) asm volatile("s_waitcnt lgkmcnt(" #n ")" ::: "memory")
#define PG8_BAR __builtin_amdgcn_s_barrier()
#define PG8_SCHED __builtin_amdgcn_sched_barrier(0)
    Unit cur, nxt; int ui = 0;
    if (!S.next(0, cur)) return;
    f32x4 acc[2][2][4][2];
#pragma unroll
    for (int a = 0; a < 2; ++a)
#pragma unroll
        for (int b = 0; b < 2; ++b)
#pragma unroll
            for (int m = 0; m < 4; ++m)
#pragma unroll
                for (int n = 0; n < 2; ++n) acc[a][b][m][n] = (f32x4){0.f, 0.f, 0.f, 0.f};
    bf16x8 At[4][2], B0[2][2], B1[2][2];
#ifdef XMMA
    bf16x8 zerov = (bf16x8){0, 0, 0, 0, 0, 0, 0, 0}; asm volatile("" : "+v"(zerov));
#endif
    const char* cA = (const char*)g.A + (size_t)cur.pm * tstep; const char* cB = (const char*)g.Bt + (size_t)cur.pn * tstep;
    S.a_ready(cur);
    if constexpr (SP2) {
        PG8_STAGE(PG8_SB(0, 0), cB, voffB); PG8_STAGE(PG8_SB(0, 1), cB + hstep, voffB); PG8_STAGE(PG8_SA(0, 0), cA, voffA); PG8_STAGE(PG8_SA(0, 1), cA + hstep, voffA);
        if (wr == 1) PG8_BAR;
        PG8_WAIT_V(2); PG8_BAR;
        PG8_STAGE(PG8_SB(1, 0), cB + kstep, voffB); PG8_STAGE(PG8_SA(1, 0), cA + kstep, voffA); PG8_STAGE(PG8_SB(1, 1), cB + hstep + kstep, voffB);
        PG8_WAIT_V(6); PG8_BAR;
    } else {
        PG8_STAGE(PG8_SB(0, 0), cB, voffB); PG8_STAGE(PG8_SA(0, 0), cA, voffA); PG8_STAGE(PG8_SB(0, 1), cB + hstep, voffB); PG8_STAGE(PG8_SA(0, 1), cA + hstep, voffA);
        if (wr == 1) PG8_BAR;
        PG8_WAIT_V(4); PG8_BAR;
        PG8_STAGE(PG8_SB(1, 0), cB + kstep, voffB); PG8_STAGE(PG8_SA(1, 0), cA + kstep, voffA); PG8_STAGE(PG8_SB(1, 1), cB + hstep + kstep, voffB);
        PG8_WAIT_V(6); PG8_BAR;
    }
    static_assert(!Sched::KWAIT || SP2, "KWAIT schedulers: SP2 loop only");
    bool dep_unit = false;
    for (;;) {
        const bool has_next = S.next(ui + 1, nxt);
        const char* nA = has_next ? (const char*)g.A + (size_t)nxt.pm * tstep : cA; const char* nB = has_next ? (const char*)g.Bt + (size_t)nxt.pn * tstep : cB;
        for (int t = 0; t < nt; t += 2) {
            bool dep23 = false, dep1 = false;
            if constexpr (Sched::KWAIT) { if (t == nt - 4) dep_unit = S.k_wait(cur); dep23 = dep_unit && (t == nt - 4); dep1 = dep_unit && (t == nt - 2); }
            const bool last = (t == nt - 2);
            const char* a1 = cA + (size_t)(t + 1) * kstep;
            const char* a2 = last ? nA : cA + (size_t)(t + 2) * kstep; const char* b2 = last ? nB : cB + (size_t)(t + 2) * kstep;
            const char* a3 = a2 + kstep; const char* b3 = b2 + kstep;
            if (last && has_next) S.a_ready(nxt);
            if constexpr (SP2) {
            PG8_LDB(B0, 0, 0); PG8_LDB(B1, 0, 1); PG8_SCHED; PG8_LDA(At, 0, 0); PG8_STAGE_A(dep1, PG8_SA(1, 1), a1 + hstep);
            PG8_WAIT_V(8); PG8_WAIT_L(0); PG8_BAR; PG8_MMA(0, 0, At, B0); PG8_MMA(0, 1, At, B1); PG8_BAR; PG8_SCHED;
            PG8_LDA(At, 0, 1); PG8_STAGE(PG8_SB(0, 0), b2, voffB); PG8_STAGE(PG8_SB(0, 1), b2 + hstep, voffB); PG8_STAGE_A(dep23, PG8_SA(0, 0), a2);
            PG8_WAIT_V(8); PG8_WAIT_L(0); PG8_BAR; PG8_MMA(1, 0, At, B0); PG8_MMA(1, 1, At, B1); PG8_BAR; PG8_SCHED;
            PG8_LDB(B0, 1, 0); PG8_LDB(B1, 1, 1); PG8_SCHED; PG8_LDA(At, 1, 0); PG8_STAGE_A(dep23, PG8_SA(0, 1), a2 + hstep);
            PG8_WAIT_V(8); PG8_WAIT_L(0); PG8_BAR; PG8_MMA(0, 0, At, B0); PG8_MMA(0, 1, At, B1); PG8_BAR; PG8_SCHED;
            PG8_LDA(At, 1, 1); PG8_STAGE(PG8_SB(1, 0), b3, voffB); PG8_STAGE(PG8_SB(1, 1), b3 + hstep, voffB); PG8_STAGE_A(dep23, PG8_SA(1, 0), a3);
            PG8_WAIT_V(8); PG8_WAIT_L(0); PG8_BAR; PG8_MMA(1, 0, At, B0); PG8_MMA(1, 1, At, B1); PG8_BAR; PG8_SCHED;
            } else {
            PG8_LDB(B0, 0, 0); PG8_SCHED; PG8_LDA(At, 0, 0); PG8_STAGE(PG8_SA(1, 1), a1 + hstep, voffA);
            PG8_WAIT_L(8); PG8_BAR; PG8_WAIT_L(0); PG8_MMA(0, 0, At, B0); PG8_BAR; PG8_SCHED;
            PG8_LDB(B1, 0, 1); PG8_STAGE(PG8_SB(0, 0), b2, voffB);
            PG8_BAR; PG8_WAIT_L(0); PG8_MMA(0, 1, At, B1); PG8_BAR;
            PG8_LDA(At, 0, 1); PG8_STAGE(PG8_SA(0, 0), a2, voffA);
            PG8_BAR; PG8_WAIT_L(0); PG8_MMA(1, 0, At, B0); PG8_BAR; PG8_SCHED;
            PG8_STAGE(PG8_SB(0, 1), b2 + hstep, voffB);
            PG8_WAIT_V(6); PG8_BAR; PG8_MMA(1, 1, At, B1); PG8_BAR;
            PG8_LDB(B0, 1, 0); PG8_SCHED; PG8_LDA(At, 1, 0); PG8_STAGE(PG8_SA(0, 1), a2 + hstep, voffA);
            PG8_WAIT_L(8); PG8_BAR; PG8_WAIT_L(0); PG8_MMA(0, 0, At, B0); PG8_BAR; PG8_SCHED;
            PG8_LDB(B1, 1, 1); PG8_STAGE(PG8_SB(1, 0), b3, voffB);
            PG8_BAR; PG8_WAIT_L(0); PG8_MMA(0, 1, At, B1); PG8_BAR;
            PG8_LDA(At, 1, 1); PG8_STAGE(PG8_SA(1, 0), a3, voffA);
            PG8_BAR; PG8_WAIT_L(0); PG8_MMA(1, 0, At, B0); PG8_BAR; PG8_SCHED;
            PG8_STAGE(PG8_SB(1, 1), b3 + hstep, voffB);
            PG8_WAIT_V(6); PG8_BAR; PG8_MMA(1, 1, At, B1); PG8_BAR;
            }
        }
        if constexpr (ALIGN_EPI) { if (wr == 0) PG8_BAR; }
        if constexpr (!Epi::AFTER_DRAIN) { E(acc, cur, wr, wc, fr, fq); S.done(cur); }
        if (!has_next) break;
#pragma unroll
        for (int a = 0; a < 2; ++a)
#pragma unroll
            for (int b = 0; b < 2; ++b)
#pragma unroll
                for (int m = 0; m < 4; ++m)
#pragma unroll
                    for (int n = 0; n < 2; ++n) acc[a][b][m][n] = (f32x4){0.f, 0.f, 0.f, 0.f};
        cur = nxt; cA = nA; cB = nB; ++ui;
        if constexpr (ALIGN_EPI) { if (wr == 1) PG8_BAR; }
    }
    PG8_WAIT_V(0);
    if constexpr (!ALIGN_EPI) { if (wr == 0) PG8_BAR; }
    PG8_BAR;
    if constexpr (Epi::AFTER_DRAIN) { E.fused(acc, cur, wr, wc, fr, fq, lds, wid, lane); S.done(cur); }
#undef PG8_SA
#undef PG8_SB
#undef PG8_STAGE
#undef PG8_STAGE_SC1
#undef PG8_STAGE_A
#undef PG8_LDA
#undef PG8_LDB
#undef PG8_MMA
#undef PG8_XMMA
#undef PG8_WAIT_V
#undef PG8_WAIT_L
#undef PG8_BAR
#undef PG8_SCHED
}
}

using pg8::f32x4; using pg8::u32x4; using pg8::Unit; using pg8::HALF; using pg8::BM;
typedef unsigned u32x2 __attribute__((ext_vector_type(2)));

struct EpiIn {
  static constexpr bool PERM = true, AFTER_DRAIN = false;
  bf16_t* qkv; bf16_t* rest; const float* rowss; const float* bias;
  __device__ __forceinline__ void operator()(const f32x4 (&acc)[2][2][4][2], const Unit& u, int wr, int wc, int fr, int fq) const {
    const int row0 = u.pm * BM + wr * 64 + fr;
    const int seg = seg_of_row(u.pm * BM);
    int colt = u.pn * BM; bf16_t* base = qkv; int ldc = NQKV;
    if (colt >= NQKV) { base = rest; ldc = NREST; colt -= NQKV; }
    const int col0 = colt + wc * 32 + 8 * fq, bcol0 = seg * NCOLS + u.pn * BM + wc * 32 + 8 * fq;
    f32x4 bv[2][2];
#pragma unroll
    for (int bj = 0; bj < 2; ++bj)
#pragma unroll
      for (int n = 0; n < 2; ++n) bv[bj][n] = *(const f32x4*)(bias + bcol0 + bj * HALF + 4 * n);
#pragma unroll
    for (int ai = 0; ai < 2; ++ai)
#pragma unroll
      for (int m = 0; m < 4; ++m) {
        const int r = row0 + ai * HALF + m * 16;
        const float rinv = rsqrtf(rowss[r] * (1.0f / 1024.0f) + 1e-6f);
        bf16_t* rowp = base + (size_t)r * ldc + col0;
#pragma unroll
        for (int bj = 0; bj < 2; ++bj) {
          const f32x4 v0 = acc[ai][bj][m][0] * rinv + bv[bj][0], v1 = acc[ai][bj][m][1] * rinv + bv[bj][1];
          u32x4 w; w.x = pg8::cvt_pk_bf16(v0[0], v0[1]); w.y = pg8::cvt_pk_bf16(v0[2], v0[3]); w.z = pg8::cvt_pk_bf16(v1[0], v1[1]); w.w = pg8::cvt_pk_bf16(v1[2], v1[3]);
          *(u32x4*)(rowp + bj * HALF) = w;
        }
      }
  }
};

struct EpiRes {
  static constexpr bool PERM = false, AFTER_DRAIN = false;
  float* X; const float* gate; float* rowss; bf16_t* xa; const float* An;
  __device__ __forceinline__ void operator()(const f32x4 (&acc)[2][2][4][2], const Unit& u, int wr, int wc, int fr, int fq) const {
    const int row0 = u.pm * BM + wr * 64 + fr, col0 = u.pn * BM + wc * 32 + 4 * fq;
    const int seg = seg_of_row(u.pm * BM);
    f32x4 gv[2][2], av[2][2];
#pragma unroll
    for (int bj = 0; bj < 2; ++bj)
#pragma unroll
      for (int n = 0; n < 2; ++n) {
        gv[bj][n] = *(const f32x4*)(gate + seg * 6144 + col0 + bj * HALF + n * 16);
        av[bj][n] = xa ? *(const f32x4*)(An + seg * 1024 + col0 + bj * HALF + n * 16) : (f32x4){0.f, 0.f, 0.f, 0.f};
      }
#pragma unroll
    for (int ai = 0; ai < 2; ++ai)
#pragma unroll
      for (int m = 0; m < 4; ++m) {
        const int r = row0 + ai * HALF + m * 16;
        float* xrow = X + (size_t)r * 1024 + col0;
        float ss = 0.f;
#pragma unroll
        for (int bj = 0; bj < 2; ++bj)
#pragma unroll
          for (int n = 0; n < 2; ++n) {
            const f32x4 xo = *(const f32x4*)(xrow + bj * HALF + n * 16);
            const f32x4 xn = xo + gv[bj][n] * acc[ai][bj][m][n];
            *(f32x4*)(xrow + bj * HALF + n * 16) = xn;
            ss += (xn[0] * xn[0] + xn[1] * xn[1]) + (xn[2] * xn[2] + xn[3] * xn[3]);
            if (xa) {
              const f32x4 t = xn * av[bj][n];
              u32x2 w; w.x = pg8::cvt_pk_bf16(t[0], t[1]); w.y = pg8::cvt_pk_bf16(t[2], t[3]);
              *(u32x2*)(xa + (size_t)r * 1024 + col0 + bj * HALF + n * 16) = w;
            }
          }
        ss += __shfl_xor(ss, 16); ss += __shfl_xor(ss, 32);
        if (fq == 0) atomicAdd(rowss + r, ss);
      }
  }
};

struct EpiGu {
  static constexpr bool PERM = true, AFTER_DRAIN = false;
  bf16_t* act; const float* rowss; const float* bias;
  __device__ __forceinline__ void operator()(const f32x4 (&acc)[2][2][4][2], const Unit& u, int wr, int wc, int fr, int fq) const {
    const int row0 = u.pm * BM + wr * 64 + fr;
    const int seg = seg_of_row(u.pm * BM);
    const int hid0 = u.pn * HALF + wc * 32 + 8 * fq, bcol0 = seg * (2 * FFH) + u.pn * BM + wc * 32 + 8 * fq;
    f32x4 bv[2][2];
#pragma unroll
    for (int bj = 0; bj < 2; ++bj)
#pragma unroll
      for (int n = 0; n < 2; ++n) bv[bj][n] = *(const f32x4*)(bias + bcol0 + bj * HALF + 4 * n);
#pragma unroll
    for (int ai = 0; ai < 2; ++ai)
#pragma unroll
      for (int m = 0; m < 4; ++m) {
        const int r = row0 + ai * HALF + m * 16;
        const float rinv = rsqrtf(rowss[r] * (1.0f / 1024.0f) + 1e-6f);
        float o[8];
#pragma unroll
        for (int n = 0; n < 2; ++n) {
          const f32x4 g = acc[ai][0][m][n] * rinv + bv[0][n], up = acc[ai][1][m][n] * rinv + bv[1][n];
#pragma unroll
          for (int j = 0; j < 4; ++j) o[n * 4 + j] = g[j] * __builtin_amdgcn_rcpf(1.f + __expf(-g[j])) * up[j];
        }
        u32x4 w; w.x = pg8::cvt_pk_bf16(o[0], o[1]); w.y = pg8::cvt_pk_bf16(o[2], o[3]); w.z = pg8::cvt_pk_bf16(o[4], o[5]); w.w = pg8::cvt_pk_bf16(o[6], o[7]);
        *(u32x4*)(act + (size_t)r * FFH + hid0) = w;
      }
  }
};


struct EpiResFinal {
  static constexpr bool PERM = false, AFTER_DRAIN = true;
  const float* X; const float* gate; float* out; const float* normf; float* slots; unsigned* cnt;
  __device__ __forceinline__ void operator()(const f32x4 (&)[2][2][4][2], const Unit&, int, int, int, int) const {}
  __device__ __forceinline__ void fused(f32x4 (&acc)[2][2][4][2], const Unit& u, int wr, int wc, int fr, int fq, PG8_LAS unsigned char* lds, int wid, int lane) const {
    PG8_LAS float* P = (PG8_LAS float*)lds;
    PG8_LAS float* R = (PG8_LAS float*)(lds + 4096);
    const int row0 = u.pm * BM + wr * 64 + fr, col0 = u.pn * BM + wc * 32 + 4 * fq;
    const int seg = seg_of_row(u.pm * BM);
    f32x4 gv[2][2];
#pragma unroll
    for (int bj = 0; bj < 2; ++bj)
#pragma unroll
      for (int n = 0; n < 2; ++n) gv[bj][n] = *(const f32x4*)(gate + seg * 6144 + col0 + bj * HALF + n * 16);
#pragma unroll
    for (int ai = 0; ai < 2; ++ai)
#pragma unroll
      for (int m = 0; m < 4; ++m) {
        const int r = row0 + ai * HALF + m * 16;
        const float* xrow = X + (size_t)r * 1024 + col0;
        float ss = 0.f;
#pragma unroll
        for (int bj = 0; bj < 2; ++bj)
#pragma unroll
          for (int n = 0; n < 2; ++n) {
            const f32x4 xo = *(const f32x4*)(xrow + bj * HALF + n * 16);
            const f32x4 xn = xo + gv[bj][n] * acc[ai][bj][m][n];
            acc[ai][bj][m][n] = xn;
            ss += (xn[0] * xn[0] + xn[1] * xn[1]) + (xn[2] * xn[2] + xn[3] * xn[3]);
          }
        ss += __shfl_xor(ss, 16); ss += __shfl_xor(ss, 32);
        if (fq == 0) P[(ai * HALF + wr * 64 + m * 16 + fr) * 4 + wc] = ss;
      }
    __syncthreads();
    const int tid = wid * 64 + lane;
    if (tid < 256) {
      const float s = (P[tid * 4 + 0] + P[tid * 4 + 1]) + (P[tid * 4 + 2] + P[tid * 4 + 3]);
      __hip_atomic_store(slots + (size_t)(u.pm * 4 + u.pn) * 256 + tid, s, __ATOMIC_RELAXED, __HIP_MEMORY_SCOPE_AGENT);
    }
    asm volatile("s_waitcnt vmcnt(0)" ::: "memory");
    __syncthreads();
    if (tid == 0) {
      (void)__hip_atomic_fetch_add(cnt + u.pm, 1u, __ATOMIC_RELAXED, __HIP_MEMORY_SCOPE_AGENT);
      unsigned sp = 0u;
      while (__hip_atomic_load(cnt + u.pm, __ATOMIC_RELAXED, __HIP_MEMORY_SCOPE_AGENT) < 4u) { __builtin_amdgcn_s_sleep(1); if (++sp > (1u << 22)) break; }
      __builtin_amdgcn_fence(__ATOMIC_ACQUIRE, "agent");
      asm volatile("s_waitcnt vmcnt(0)" ::: "memory");
    }
    __syncthreads();
    if (tid < 256) {
      float tot = 0.f;
#pragma unroll
      for (int k = 0; k < 4; ++k) tot += __hip_atomic_load(slots + (size_t)(u.pm * 4 + k) * 256 + tid, __ATOMIC_RELAXED, __HIP_MEMORY_SCOPE_AGENT);
      R[tid] = rsqrtf(tot * (1.0f / 1024.0f) + 1e-6f);
    }
    __syncthreads();
    f32x4 nf[2][2];
#pragma unroll
    for (int bj = 0; bj < 2; ++bj)
#pragma unroll
      for (int n = 0; n < 2; ++n) nf[bj][n] = *(const f32x4*)(normf + col0 + bj * HALF + n * 16);
#pragma unroll
    for (int ai = 0; ai < 2; ++ai)
#pragma unroll
      for (int m = 0; m < 4; ++m) {
        const int lr = ai * HALF + wr * 64 + m * 16 + fr;
        const float rinv = R[lr];
        float* orow = out + (size_t)(u.pm * BM + lr) * 1024 + col0;
#pragma unroll
        for (int bj = 0; bj < 2; ++bj)
#pragma unroll
          for (int n = 0; n < 2; ++n) *(f32x4*)(orow + bj * HALF + n * 16) = acc[ai][bj][m][n] * rinv * nf[bj][n];
      }
  }
};

#define GU_DEFER_PM0 16
struct GuOrder {
  static constexpr bool KWAIT = false;
  pg8::StaticOrder S; int solo;
  __device__ __forceinline__ void init(int G, int c, int solo_) { S.nM = NTOK / pg8::BM; S.nN = 21; S.nwg = S.nM * 21; S.G = G; S.c = c; solo = solo_; }
  __device__ __forceinline__ bool next(int i, pg8::Unit& u) const {
    if (solo >= 0) { if (i) return false; u.pm = solo; u.pn = 21; return true; }
    if (S.next(i, u)) return true;
    const long L = (long)i * S.G + S.c - S.nwg;
    if (L < GU_DEFER_PM0) { u.pm = (int)L; u.pn = 21; return true; }
    return false;
  }
  __device__ __forceinline__ void a_ready(const pg8::Unit&) const {}
  __device__ __forceinline__ void done(const pg8::Unit&) const {}
  __device__ __forceinline__ bool k_wait(const pg8::Unit&) const { return false; }
};
#ifndef DOWN_KWAIT
#define DOWN_KWAIT true
#endif
struct DownOrder {
  static constexpr bool KWAIT = DOWN_KWAIT;
  pg8::StaticOrder S; unsigned* flag;
  __device__ __forceinline__ bool next(int i, pg8::Unit& u) const { return S.next(i, u); }
  __device__ __forceinline__ void a_ready(const pg8::Unit&) const {}
  __device__ __forceinline__ void done(const pg8::Unit&) const {}
  __device__ __forceinline__ bool k_wait(const pg8::Unit& u) const {
    if (u.pm < GU_DEFER_PM0) return false;
    unsigned sp = 0u;
    while (__builtin_amdgcn_readfirstlane(__hip_atomic_load(flag + u.pm, __ATOMIC_RELAXED, __HIP_MEMORY_SCOPE_AGENT)) == 0u) { __builtin_amdgcn_s_sleep(1); if (++sp > (1u << 22)) break; }
    asm volatile("" ::: "memory");
    return true;
  }
};

__device__ __forceinline__ int win_srccol(int j) { return j < 2048 ? j : j + 16; }
__device__ __forceinline__ int wgu_srccol(int j) { const int pn = j >> 8, w = j & 255; return w < 128 ? pn * 128 + w : FFH + pn * 128 + (w - 128); }

struct WTile { const float* src; bf16_t* dst; const float* shv; float* bias; int ldsrc, srccol0, K, j0, k0, bstride; };
__device__ __forceinline__ void wtile_load(const WTile& d, float (&v)[16], int t) {
  const int jl = t & 63, kg = t >> 6;
#pragma unroll
  for (int i = 0; i < 16; ++i) v[i] = d.src[(size_t)(d.k0 + kg * 16 + i) * d.ldsrc + d.srccol0 + jl];
}
__device__ __forceinline__ void wtile_put(float* tile, const float (&v)[16], int t) {
  const int jl = t & 63, kg = t >> 6;
#pragma unroll
  for (int i = 0; i < 16; ++i) tile[jl * 65 + kg * 16 + i] = v[i];
}
__device__ __forceinline__ void wtile_finish(const WTile& d, const float* tile, int t) {
  const int j = t >> 2, kc = (t & 3) * 16;
  const float* s = tile + j * 65 + kc;
  float sv[16];
#pragma unroll
  for (int i = 0; i < 16; ++i) sv[i] = s[i];
  if (d.shv) {
    float a[3];
#pragma unroll
    for (int sg = 0; sg < 3; ++sg) {
      const float* sh = d.shv + sg * 6144 + d.k0 + kc;
      float acc = 0.f;
#pragma unroll
      for (int i = 0; i < 16; i += 4) { const f32x4 h4 = *(const f32x4*)(sh + i); acc += (h4[0] * sv[i] + h4[1] * sv[i + 1]) + (h4[2] * sv[i + 2] + h4[3] * sv[i + 3]); }
      acc += __shfl_xor(acc, 1); acc += __shfl_xor(acc, 2);
      a[sg] = acc;
    }
    if ((t & 3) == 0) { atomicAdd(d.bias + d.j0 + j, a[0]); atomicAdd(d.bias + d.bstride + d.j0 + j, a[1]); atomicAdd(d.bias + 2 * d.bstride + d.j0 + j, a[2]); }
  }
  u32x4 o0, o1;
  o0.x = pack_bf16(sv[0], sv[1]); o0.y = pack_bf16(sv[2], sv[3]); o0.z = pack_bf16(sv[4], sv[5]); o0.w = pack_bf16(sv[6], sv[7]);
  o1.x = pack_bf16(sv[8], sv[9]); o1.y = pack_bf16(sv[10], sv[11]); o1.z = pack_bf16(sv[12], sv[13]); o1.w = pack_bf16(sv[14], sv[15]);
  bf16_t* dd = d.dst + (size_t)(d.j0 + j) * d.K + d.k0 + kc;
  *(u32x4*)dd = o0; *(u32x4*)(dd + 8) = o1;
}

#define WT_IN 0
#define WT_OUT (2816 * 1024)
#define WT_GU (WT_OUT + 1024 * 1024)
#define WT_DOWN (WT_GU + 5632 * 1024)
#define WT_LAYER (WT_DOWN + 1024 * 2816)


#define PRE_QP 0
#define PRE_KTP 16384
#define PRE_DIR0 32768
#define PRE_DIRSZ 41984
#define PRE_NW 0
#define PRE_UP 16384
#define PRE_QKP 32768
#define PRE_SC 40960
#define PRE_ITEM 116736
#define PRE_LDS 118784
#define SCAN_BUF 58368
#define SCAN_LDS (2 * SCAN_BUF)

using pg8::bf16x8;
__device__ __forceinline__ int perm_inv(int x) { return (x & ~31) | (((x >> 2) & 3) << 3) | (((x >> 4) & 1) << 2) | (x & 3); }
__device__ __forceinline__ bf16x8 pack8(const f32x4& x, const f32x4& y) {
  u32x4 w; w.x = pg8::cvt_pk_bf16(x[0], x[1]); w.y = pg8::cvt_pk_bf16(x[2], x[3]); w.z = pg8::cvt_pk_bf16(y[0], y[1]); w.w = pg8::cvt_pk_bf16(y[2], y[3]);
  return __builtin_bit_cast(bf16x8, w);
}

__device__ __forceinline__ void pre_item(int item, const bf16_t* __restrict__ QKV, const float* __restrict__ LOG, const float* __restrict__ cw,
                                         const float* __restrict__ a_log, const float* __restrict__ dt_bias, unsigned char* __restrict__ PRE,
                                         unsigned char* lds) {
  int t_ = threadIdx.x; asm volatile("" : "+v"(t_));
  const int t = t_, lane = t & 63, w = t >> 6;
  const int c = item >> 2, h = item & 3, r0 = c * 64;
  bf16_t* qb = (bf16_t*)lds; bf16_t* kb = (bf16_t*)(lds + 17408); float* vf = (float*)(lds + 34816);
  typedef _Float16 f16x4 __attribute__((ext_vector_type(4)));
  constexpr int MS = 72, TS = 20;
  _Float16* Mf = (_Float16*)(lds + 67584); _Float16* Mb = (_Float16*)(lds + 67584 + 64 * MS * 2); _Float16* Tm = (_Float16*)(lds + 67584 + 2 * 64 * MS * 2); float* sc = (float*)(lds + 100352);
  unsigned char* pre = PRE + (size_t)item * PRE_ITEM;
  float lg_b = 0.f, lg_a = 0.f;
  if (w < 2) { lg_b = LOG[(size_t)(r0 + lane) * 16 + w * 4 + h]; lg_a = LOG[(size_t)(r0 + lane) * 16 + 8 + w * 4 + h]; }
  {
    const int i = t >> 3, cg = t & 7, r = r0 + i;
    int s0, len;
    if (r < NCTX) { s0 = r & ~255; len = 256; } else { s0 = NCTX + ((r - NCTX) & ~2047); len = 2048; }
    const int tt = r - s0; const bool hp = tt > 0, hn = tt < len - 1;
#pragma unroll
    for (int x = 0; x < 3; ++x) {
      const int cb = x * 512 + h * 128 + cg * 16;
      const bf16_t* p0 = QKV + (size_t)r * NQKV + cb;
      u32x4 m0 = (u32x4){0u, 0u, 0u, 0u}, m1 = m0, n0 = m0, n1 = m0;
      const u32x4 c0 = *(const u32x4*)p0, c1 = *(const u32x4*)(p0 + 8);
      if (hp) { m0 = *(const u32x4*)(p0 - NQKV); m1 = *(const u32x4*)(p0 - NQKV + 8); }
      if (hn) { n0 = *(const u32x4*)(p0 + NQKV); n1 = *(const u32x4*)(p0 + NQKV + 8); }
      float val[16]; float ss = 0.f;
#pragma unroll
      for (int e = 0; e < 16; ++e) {
        const unsigned wm = (e < 8 ? m0 : m1)[(e & 7) >> 1], wc = (e < 8 ? c0 : c1)[(e & 7) >> 1], wn = (e < 8 ? n0 : n1)[(e & 7) >> 1];
        const float xm = __uint_as_float((e & 1) ? (wm & 0xffff0000u) : (wm << 16));
        const float xc = __uint_as_float((e & 1) ? (wc & 0xffff0000u) : (wc << 16));
        const float xn = __uint_as_float((e & 1) ? (wn & 0xffff0000u) : (wn << 16));
        const float y = cw[cb + e] * xm + cw[NQKV + cb + e] * xc + cw[2 * NQKV + cb + e] * xn;
        val[e] = silu_fast(y); ss += val[e] * val[e];
      }
      if (x < 2) {
        ss += __shfl_xor(ss, 1); ss += __shfl_xor(ss, 2); ss += __shfl_xor(ss, 4);
        const float rn = rsqrtf(ss + 1e-6f) * (x == 0 ? 0.08838834764831845f : 1.0f);
        bf16_t* dst = (x == 0 ? qb : kb) + i * 136 + cg * 16;
        u32x4 o0, o1;
        o0.x = pack_bf16(val[0] * rn, val[1] * rn); o0.y = pack_bf16(val[2] * rn, val[3] * rn); o0.z = pack_bf16(val[4] * rn, val[5] * rn); o0.w = pack_bf16(val[6] * rn, val[7] * rn);
        o1.x = pack_bf16(val[8] * rn, val[9] * rn); o1.y = pack_bf16(val[10] * rn, val[11] * rn); o1.z = pack_bf16(val[12] * rn, val[13] * rn); o1.w = pack_bf16(val[14] * rn, val[15] * rn);
        *(u32x4*)dst = o0; *(u32x4*)(dst + 8) = o1;
      } else {
        float* dst = vf + i * 128 + cg * 16;
#pragma unroll
        for (int e = 0; e < 16; e += 4) *(f32x4*)(dst + e) = (f32x4){val[e], val[e + 1], val[e + 2], val[e + 3]};
      }
    }
  }
  if (w < 2) {
    const int i = lane, d = w;
    const float beta = sigmoid_f(lg_b);
    const float g = -expf(a_log[d * 4 + h]) * softplus_f(lg_a + dt_bias[d * 4 + h]);
    float s = g;
#pragma unroll
    for (int o = 1; o < 64; o <<= 1) {
      const float nb = d == 0 ? __shfl_up(s, o) : __shfl_down(s, o);
      const bool ok = d == 0 ? (lane >= o) : (lane + o < 64);
      if (ok) s += nb;
    }
    sc[d * 64 + i] = beta; sc[128 + d * 64 + i] = s; sc[256 + d * 64 + i] = beta * expf(s);
  }
  __syncthreads();
  {
    const int p = w >> 2, it = w & 3, fr = lane & 15, g = lane >> 4;
    const bf16_t* Ab = p ? qb : kb;
    bf16x8 af[4];
#pragma unroll
    for (int ks = 0; ks < 4; ++ks) af[ks] = *(const bf16x8*)(Ab + (it * 16 + fr) * 136 + ks * 32 + 8 * g);
    bf16_t* qkf = (bf16_t*)(lds + 102400);
    bf16_t* qkb = (bf16_t*)(lds + 102400 + 8192);
#pragma unroll
    for (int jt = 0; jt < 4; ++jt) {
      f32x4 acc = (f32x4){0.f, 0.f, 0.f, 0.f};
#pragma unroll
      for (int ks = 0; ks < 4; ++ks) {
        const bf16x8 bfr = *(const bf16x8*)(kb + (jt * 16 + fr) * 136 + ks * 32 + 8 * g);
        acc = __builtin_amdgcn_mfma_f32_16x16x32_bf16(af[ks], bfr, acc, 0, 0, 0);
      }
      const int j = jt * 16 + fr;
      const float gfj = sc[128 + j], gbj = sc[192 + j];
#pragma unroll
      for (int r = 0; r < 4; ++r) {
        const int i = it * 16 + 4 * g + r;
        const float val = acc[r];
        const float ef = __expf(fminf(sc[128 + i] - gfj, 0.f)), eb = __expf(fminf(sc[192 + i] - gbj, 0.f));
        if (p == 0) {
          Mf[i * MS + j] = (_Float16)((j < i) ? -(sc[i] * val * ef) : 0.f);
          Mb[i * MS + j] = (_Float16)((j > i) ? -(sc[64 + i] * val * eb) : 0.f);
        } else {
          const int jp = perm_inv(j);
          qkf[i * 64 + jp] = f2bf((j <= i) ? val * ef : 0.f);
          qkb[i * 64 + jp] = f2bf((j >= i) ? val * eb : 0.f);
        }
      }
    }
  }
  __syncthreads();
  const int wu = __builtin_amdgcn_readfirstlane(t >> 6);
  if (wu < 2) {
    const int d = wu, I = lane >> 4, cu = lane & 15;
    int rsel = d ? 15 : 0, rst = d ? -1 : 1;
    asm volatile("" : "+v"(rsel), "+v"(rst));
    const _Float16* Mi = (d ? Mb : Mf) + (16 * I) * MS + 16 * I;
    float tc[16];
#pragma unroll
    for (int u = 0; u < 16; ++u) {
      float a = (u == cu) ? 1.f : 0.f;
#pragma unroll
      for (int v = 0; v < u; ++v) a += (float)Mi[(rsel + rst * u) * MS + (rsel + rst * v)] * tc[v];
      tc[u] = a;
    }
#pragma unroll
    for (int u = 0; u < 16; ++u) Tm[((d * 4 + I) * 16 + (rsel + rst * u)) * TS + (rsel + rst * cu)] = (_Float16)tc[u];
  } else {
    const int tt = t - 128;
    for (int q = tt; q < 1024; q += 384) {
      { const int i = q >> 4, s = (q >> 2) & 3, g = q & 3;
        const u32x2 lo = *(const u32x2*)(qb + i * 136 + 32 * s + 4 * g), hi = *(const u32x2*)(qb + i * 136 + 32 * s + 16 + 4 * g);
        *(u32x4*)(pre + PRE_QP + (size_t)(i * 128 + 32 * s + 8 * g) * 2) = (u32x4){lo.x, lo.y, hi.x, hi.y}; }
      { const int dk = q >> 3, s2 = (q >> 2) & 1, g = q & 3;
        unsigned short e[8];
#pragma unroll
        for (int jj = 0; jj < 8; ++jj) e[jj] = kb[(32 * s2 + 16 * (jj >> 2) + 4 * g + (jj & 3)) * 136 + dk];
        u32x4 o; o.x = (unsigned)e[0] | ((unsigned)e[1] << 16); o.y = (unsigned)e[2] | ((unsigned)e[3] << 16); o.z = (unsigned)e[4] | ((unsigned)e[5] << 16); o.w = (unsigned)e[6] | ((unsigned)e[7] << 16);
        *(u32x4*)(pre + PRE_KTP + (size_t)(dk * 64 + 32 * s2 + 8 * g) * 2) = o; }
    }
    {
      const int e = tt, d = e / 192, rem = e % 192, k3 = rem >> 6, i = rem & 63;
      const float glast = d ? sc[192] : sc[128 + 63], gci = sc[128 + d * 64 + i];
      const float v = k3 == 0 ? expf(gci) : (k3 == 1 ? expf(glast - gci) : expf(glast));
      ((float*)(pre + PRE_DIR0 + d * PRE_DIRSZ + PRE_SC))[k3 * 64 + i] = v;
    }
  }
  __syncthreads();
  {
    const int d = wu >> 2, wq = wu & 3, kind = wq >> 1, fr = lane & 15, g = lane >> 4;
    const _Float16* Mi = d ? Mb : Mf;
    f16x4 Tf[4], Mg[4][4];
#pragma unroll
    for (int s2 = 0; s2 < 4; ++s2) {
      const int P = d ? 3 - s2 : s2;
      Tf[s2] = *(const f16x4*)(Tm + ((d * 4 + P) * 16 + fr) * TS + 4 * g);
#pragma unroll
      for (int b2 = 0; b2 < s2; ++b2) { const int Pb = d ? 3 - b2 : b2; Mg[s2][b2] = *(const f16x4*)(Mi + (16 * P + fr) * MS + 16 * Pb + 4 * g); }
    }
    f32x4 acc[4][4];
    {
      float beta[4][4];
#pragma unroll
      for (int s2 = 0; s2 < 4; ++s2)
#pragma unroll
        for (int r = 0; r < 4; ++r) beta[s2][r] = sc[(kind ? 256 : 0) + d * 64 + 16 * (d ? 3 - s2 : s2) + 4 * g + r];
#pragma unroll
      for (int tl = 0; tl < 4; ++tl) {
        const int col = 16 * ((4 * wq + tl) & 7) + fr;
#pragma unroll
        for (int s2 = 0; s2 < 4; ++s2)
#pragma unroll
          for (int r = 0; r < 4; ++r) {
            const int i = 16 * (d ? 3 - s2 : s2) + 4 * g + r;
            acc[tl][s2][r] = beta[s2][r] * (kind ? bf2f(kb[i * 136 + col]) : vf[i * 128 + col]);
          }
      }
    }
    __syncthreads();
    unsigned char* outd = lds + 34816 + d * 32768;
#define H4(x) __builtin_convertvector(x, f16x4)
#define MF16(a, b, c) __builtin_amdgcn_mfma_f32_16x16x16f16(a, b, c, 0, 0, 0)
#pragma unroll
    for (int tl = 0; tl < 4; ++tl) {
      const f32x4 z4 = (f32x4){0.f, 0.f, 0.f, 0.f};
      f32x4 X[4];
      X[0] = MF16(Tf[0], H4(acc[tl][0]), z4);
      { const f16x4 hx = H4(X[0]); acc[tl][1] = MF16(Mg[1][0], hx, acc[tl][1]); acc[tl][2] = MF16(Mg[2][0], hx, acc[tl][2]); acc[tl][3] = MF16(Mg[3][0], hx, acc[tl][3]); }
      X[1] = MF16(Tf[1], H4(acc[tl][1]), z4);
      { const f16x4 hx = H4(X[1]); acc[tl][2] = MF16(Mg[2][1], hx, acc[tl][2]); acc[tl][3] = MF16(Mg[3][1], hx, acc[tl][3]); }
      X[2] = MF16(Tf[2], H4(acc[tl][2]), z4);
      { const f16x4 hx = H4(X[2]); acc[tl][3] = MF16(Mg[3][2], hx, acc[tl][3]); }
      X[3] = MF16(Tf[3], H4(acc[tl][3]), z4);
      if (kind == 0) {
        const int wv = 4 * wq + tl;
#pragma unroll
        for (int s2 = 0; s2 < 4; ++s2) {
          u32x2 pk; pk.x = pack_bf16(X[s2][0], X[s2][1]); pk.y = pack_bf16(X[s2][2], X[s2][3]);
          *(u32x2*)(outd + 16384 + ((wv * 4 + (d ? 3 - s2 : s2)) * 64 + lane) * 8) = pk;
        }
      } else {
        const int kp = perm_inv(16 * (4 * wq + tl - 8) + fr);
        bf16_t* nw = (bf16_t*)outd + kp;
#pragma unroll
        for (int s2 = 0; s2 < 4; ++s2)
#pragma unroll
          for (int r = 0; r < 4; ++r) nw[(16 * (d ? 3 - s2 : s2) + 4 * g + r) * 128] = f2bf(-X[s2][r]);
      }
    }
#undef H4
#undef MF16
  }
  __syncthreads();
  for (int k = 0; k < 8; ++k) {
    const int q = t + 512 * k, d = q >> 11, wi = q & 2047;
    *(u32x4*)(pre + PRE_DIR0 + d * PRE_DIRSZ + wi * 16) = *(const u32x4*)(lds + 34816 + q * 16);
  }
  for (int k = 0; k < 2; ++k) {
    const int q = t + 512 * k, d = q >> 9, wi = q & 511;
    *(u32x4*)(pre + PRE_DIR0 + d * PRE_DIRSZ + PRE_QKP + wi * 16) = *(const u32x4*)(lds + 102400 + q * 16);
  }
  __syncthreads();
}

__global__ __launch_bounds__(512, 2) void k_pre(const bf16_t* __restrict__ QKV, const float* __restrict__ LOG, const float* __restrict__ cw,
                                                const float* __restrict__ a_log, const float* __restrict__ dt_bias, unsigned char* __restrict__ PRE) {
  extern __shared__ __attribute__((aligned(16))) unsigned char smem[];
  for (int item = blockIdx.x; item < 768; item += gridDim.x) pre_item(item, QKV, LOG, cw, a_log, dt_bias, PRE, smem);
}

#define SCAN_OT (2 * SCAN_BUF)
#undef SCAN_LDS
#define SCAN_LDS (2 * SCAN_BUF + 8 * 2048)
__device__ __forceinline__ void scan_item(int b, int h, int d, int chunk0, int nc, int half, bool write_state, const unsigned char* __restrict__ PRE, const float* __restrict__ s_in,
                                          bf16_t* __restrict__ OB, float* __restrict__ s_out, unsigned char* lds) {
  int t_ = threadIdx.x; asm volatile("" : "+v"(t_));
  const int t = t_, lane = t & 63, w = t >> 6, fr = lane & 15, g = lane >> 4;
  const bool active = half < 0 || w < 4;
  const int dvw = half < 0 ? w : half * 4 + (w & 3), dv = 16 * dvw + fr;
  f32x4 S[8];
  if (s_in == nullptr) {
#pragma unroll
    for (int m = 0; m < 8; ++m) S[m] = (f32x4){0.f, 0.f, 0.f, 0.f};
  } else {
#pragma unroll
    for (int m = 0; m < 8; ++m)
#pragma unroll
      for (int r = 0; r < 4; ++r) S[m][r] = s_in[(16 * m + 4 * g + r) * 128 + dv];
  }
  unsigned soff[7], doff[7];
#pragma unroll
  for (int k = 0; k < 7; ++k) {
    const int q = t + 512 * k;
    if (k < 2) { const int row = q >> 4, c = q & 15; soff[k] = PRE_DIR0 + PRE_NW + q * 16; doff[k] = row * 256 + ((c ^ (row & 15)) << 4); }
    else if (k < 4) { const int q2 = q - 1024, row = q2 >> 4, c = q2 & 15; soff[k] = PRE_QP + q2 * 16; doff[k] = 16384 + row * 256 + ((c ^ (row & 15)) << 4); }
    else if (k < 5) { const int q2 = q - 2048, row = q2 >> 3, c = q2 & 7; soff[k] = PRE_DIR0 + PRE_QKP + q2 * 16; doff[k] = 32768 + row * 128 + ((c ^ ((row >> 1) & 7)) << 4); }
    else { const int q2 = q - 2560, row = q2 >> 3, c = q2 & 7; soff[k] = PRE_KTP + q2 * 16; doff[k] = 40960 + row * 128 + ((c ^ ((row >> 1) & 7)) << 4); }
    if (k < 2 || k == 4) soff[k] += d * PRE_DIRSZ;
  }
  const unsigned soff7 = PRE_DIR0 + d * PRE_DIRSZ + PRE_SC + t * 16, doff7 = 57344 + t * 16;
  const unsigned upoff = PRE_DIR0 + d * PRE_DIRSZ + PRE_UP + ((dvw * 4) * 64 + lane) * 8;
  u32x4 st[7]; u32x4 st7 = (u32x4){0u, 0u, 0u, 0u}; u32x2 up[4];
  {
    const int cidx = chunk0 + (d ? nc - 1 : 0);
    const unsigned char* pre = PRE + (size_t)(cidx * 4 + h) * PRE_ITEM;
#pragma unroll
    for (int k = 0; k < 7; ++k) st[k] = *(const u32x4*)(pre + soff[k]);
    if (t < 48) st7 = *(const u32x4*)(pre + soff7);
#pragma unroll
    for (int m = 0; m < 4; ++m) up[m] = *(const u32x2*)(pre + upoff + m * 512);
#pragma unroll
    for (int k = 0; k < 7; ++k) *(u32x4*)(lds + doff[k]) = st[k];
    if (t < 48) *(u32x4*)(lds + doff7) = st7;
  }
  __syncthreads();
  bf16_t* ot = (bf16_t*)(lds + SCAN_OT + w * 2048);
  for (int step = 0; step < nc; ++step) {
    const int cidx = chunk0 + (d ? nc - 1 - step : step);
    const unsigned char* B = lds + (step & 1) * SCAN_BUF;
    const bool more = step + 1 < nc;
    f32x4 a1[4], a2[4];
#pragma unroll
    for (int m = 0; m < 4; ++m) {
      a1[m] = (f32x4){__uint_as_float(up[m].x << 16), __uint_as_float(up[m].x & 0xffff0000u), __uint_as_float(up[m].y << 16), __uint_as_float(up[m].y & 0xffff0000u)};
      a2[m] = (f32x4){0.f, 0.f, 0.f, 0.f};
    }
    if (more) {
      const int cn = chunk0 + (d ? nc - 2 - step : step + 1);
      const unsigned char* pre = PRE + (size_t)(cn * 4 + h) * PRE_ITEM;
#pragma unroll
      for (int k = 0; k < 7; ++k) st[k] = *(const u32x4*)(pre + soff[k]);
      if (t < 48) st7 = *(const u32x4*)(pre + soff7);
#pragma unroll
      for (int m = 0; m < 4; ++m) up[m] = *(const u32x2*)(pre + upoff + m * 512);
    }
    if (active) {
      const float* SC = (const float*)(B + 57344);
      const float gt = SC[128];
      bf16x8 Sb[4];
#pragma unroll
      for (int s = 0; s < 4; ++s) Sb[s] = pack8(S[2 * s], S[2 * s + 1]);
#pragma unroll
      for (int m = 0; m < 8; ++m) S[m] = S[m] * gt;
      {
        bf16x8 fa[2][4], fq[2][4];
#pragma unroll
        for (int m = 0; m < 4; ++m) {
          fa[0][m] = *(const bf16x8*)(B + (16 * m + fr) * 256 + (((0 + g) ^ fr) << 4));
          fq[0][m] = *(const bf16x8*)(B + 16384 + (16 * m + fr) * 256 + (((0 + g) ^ fr) << 4));
        }
#pragma unroll
        for (int s = 0; s < 4; ++s) {
          if (s < 3) {
#pragma unroll
            for (int m = 0; m < 4; ++m) {
              fa[(s + 1) & 1][m] = *(const bf16x8*)(B + (16 * m + fr) * 256 + (((4 * (s + 1) + g) ^ fr) << 4));
              fq[(s + 1) & 1][m] = *(const bf16x8*)(B + 16384 + (16 * m + fr) * 256 + (((4 * (s + 1) + g) ^ fr) << 4));
            }
          }
#pragma unroll
          for (int m = 0; m < 4; ++m) a1[m] = __builtin_amdgcn_mfma_f32_16x16x32_bf16(fa[s & 1][m], Sb[s], a1[m], 0, 0, 0);
#pragma unroll
          for (int m = 0; m < 4; ++m) a2[m] = __builtin_amdgcn_mfma_f32_16x16x32_bf16(fq[s & 1][m], Sb[s], a2[m], 0, 0, 0);
        }
      }
      bf16x8 Vb[2], Vs[2];
#pragma unroll
      for (int s = 0; s < 2; ++s) Vb[s] = pack8(a1[2 * s], a1[2 * s + 1]);
#pragma unroll
      for (int m = 0; m < 4; ++m) { const f32x4 e = *(const f32x4*)(SC + 64 + 16 * m + 4 * g); a1[m] = a1[m] * e; }
#pragma unroll
      for (int s = 0; s < 2; ++s) Vs[s] = pack8(a1[2 * s], a1[2 * s + 1]);
      {
        bf16x8 fk[2][8];
#pragma unroll
        for (int s = 0; s < 2; ++s)
#pragma unroll
          for (int m = 0; m < 8; ++m) fk[s][m] = *(const bf16x8*)(B + 40960 + (16 * m + fr) * 128 + (((4 * s + g) ^ (fr >> 1)) << 4));
#pragma unroll
        for (int s = 0; s < 2; ++s)
#pragma unroll
          for (int m = 0; m < 8; ++m) S[m] = __builtin_amdgcn_mfma_f32_16x16x32_bf16(fk[s][m], Vs[s], S[m], 0, 0, 0);
      }
#pragma unroll
      for (int m = 0; m < 4; ++m) { const f32x4 e = *(const f32x4*)(SC + 16 * m + 4 * g); a2[m] = a2[m] * e; }
#pragma unroll
      for (int s = 0; s < 2; ++s)
#pragma unroll
        for (int m = 0; m < 4; ++m) {
          const bf16x8 fa = *(const bf16x8*)(B + 32768 + (16 * m + fr) * 128 + (((4 * s + g) ^ (fr >> 1)) << 4));
          a2[m] = __builtin_amdgcn_mfma_f32_16x16x32_bf16(fa, Vb[s], a2[m], 0, 0, 0);
        }
#pragma unroll
      for (int m = 0; m < 4; ++m)
#pragma unroll
        for (int r = 0; r < 4; ++r) ot[(16 * m + 4 * g + r) * 16 + fr] = f2bf(a2[m][r]);
      {
        bf16_t* op = OB + ((size_t)d * NTOK + (size_t)cidx * 64) * 512 + h * 128 + 16 * dvw;
#pragma unroll
        for (int k = 0; k < 2; ++k) {
          const int q = lane + 64 * k, row = q >> 1, hf = q & 1;
          *(u32x4*)(op + (size_t)row * 512 + hf * 8) = *(const u32x4*)(ot + row * 16 + hf * 8);
        }
      }
    }
    if (more) {
      unsigned char* Bn = lds + ((step + 1) & 1) * SCAN_BUF;
#pragma unroll
      for (int k = 0; k < 7; ++k) *(u32x4*)(Bn + doff[k]) = st[k];
      if (t < 48) *(u32x4*)(Bn + doff7) = st7;
    }
    __syncthreads();
  }
  if (write_state && active) {
#pragma unroll
    for (int m = 0; m < 8; ++m)
#pragma unroll
      for (int r = 0; r < 4; ++r) s_out[(16 * m + 4 * g + r) * 128 + dv] = S[m][r];
  }
}

__device__ __forceinline__ void scan_item_lat(int b, int h, int d, int chunk0, int nc, int half, const unsigned char* __restrict__ PRE, const float* __restrict__ s_in,
                                              bf16_t* __restrict__ OB, unsigned char* lds) {
  int t_ = threadIdx.x; asm volatile("" : "+v"(t_));
  const int t = t_, lane = t & 63, fr = lane & 15, g = lane >> 4;
  const int wu = __builtin_amdgcn_readfirstlane(t >> 6);
  (void)b;
#define LAT_CIDX(step) (chunk0 + (d ? nc - 1 - (step) : (step)))
  if (wu >= 4) {
    const int tt = t - 256;
    unsigned soff[14], doff[14];
#pragma unroll
    for (int k = 0; k < 14; ++k) {
      const int q = tt + 256 * k;
      if (k < 4) { const int row = q >> 4, c = q & 15; soff[k] = PRE_DIR0 + d * PRE_DIRSZ + PRE_NW + q * 16; doff[k] = row * 256 + ((c ^ (row & 15)) << 4); }
      else if (k < 8) { const int q2 = q - 1024, row = q2 >> 4, c = q2 & 15; soff[k] = PRE_QP + q2 * 16; doff[k] = 16384 + row * 256 + ((c ^ (row & 15)) << 4); }
      else if (k < 10) { const int q2 = q - 2048, row = q2 >> 3, c = q2 & 7; soff[k] = PRE_DIR0 + d * PRE_DIRSZ + PRE_QKP + q2 * 16; doff[k] = 32768 + row * 128 + ((c ^ ((row >> 1) & 7)) << 4); }
      else { const int q2 = q - 2560, row = q2 >> 3, c = q2 & 7; soff[k] = PRE_KTP + q2 * 16; doff[k] = 40960 + row * 128 + ((c ^ ((row >> 1) & 7)) << 4); }
    }
    const unsigned soffS = PRE_DIR0 + d * PRE_DIRSZ + PRE_SC + tt * 16, doffS = 57344 + tt * 16;
    u32x4 ra[14], rb[14], sa = (u32x4){0u, 0u, 0u, 0u}, sb = sa;
#define LAT_LOAD(R, RS, step) do { const unsigned char* pre_ = PRE + (size_t)(LAT_CIDX(step) * 4 + h) * PRE_ITEM; \
      _Pragma("unroll") for (int k = 0; k < 14; ++k) R[k] = *(const u32x4*)(pre_ + soff[k]); if (tt < 48) RS = *(const u32x4*)(pre_ + soffS); } while (0)
#define LAT_WRITE(R, RS, buf) do { unsigned char* B_ = lds + (buf) * SCAN_BUF; \
      _Pragma("unroll") for (int k = 0; k < 14; ++k) *(u32x4*)(B_ + doff[k]) = R[k]; if (tt < 48) *(u32x4*)(B_ + doffS) = RS; } while (0)
    LAT_LOAD(ra, sa, 0); LAT_LOAD(rb, sb, 1);
    LAT_WRITE(ra, sa, 0);
    __syncthreads();
    for (int step = 0; step < nc; step += 2) {
      if (step + 2 < nc) LAT_LOAD(ra, sa, step + 2);
      LAT_WRITE(rb, sb, 1);
      __syncthreads();
      if (step + 3 < nc) LAT_LOAD(rb, sb, step + 3);
      if (step + 2 < nc) LAT_WRITE(ra, sa, 0);
      __syncthreads();
    }
#undef LAT_LOAD
#undef LAT_WRITE
  } else {
    const int w = wu, dvw = half * 4 + w, dv = 16 * dvw + fr;
    f32x4 S[8];
#pragma unroll
    for (int m = 0; m < 8; ++m)
#pragma unroll
      for (int r = 0; r < 4; ++r) S[m][r] = s_in[(16 * m + 4 * g + r) * 128 + dv];
    const unsigned upoff = PRE_DIR0 + d * PRE_DIRSZ + PRE_UP + ((dvw * 4) * 64 + lane) * 8;
    u32x2 upa[4], upb[4];
#define LAT_UP(U, step) do { const unsigned char* pre_ = PRE + (size_t)(LAT_CIDX(step) * 4 + h) * PRE_ITEM; _Pragma("unroll") for (int m = 0; m < 4; ++m) U[m] = *(const u32x2*)(pre_ + upoff + m * 512); } while (0)
    LAT_UP(upa, 0); LAT_UP(upb, 1);
    bf16_t* ot = (bf16_t*)(lds + SCAN_OT + w * 2048);
    __syncthreads();
#define LAT_STEP(UP, step, bufi) do { \
      const int cidx = LAT_CIDX(step); const unsigned char* B = lds + (bufi) * SCAN_BUF; \
      f32x4 a1[4], a2[4]; \
      _Pragma("unroll") for (int m = 0; m < 4; ++m) { \
        a1[m] = (f32x4){__uint_as_float(UP[m].x << 16), __uint_as_float(UP[m].x & 0xffff0000u), __uint_as_float(UP[m].y << 16), __uint_as_float(UP[m].y & 0xffff0000u)}; \
        a2[m] = (f32x4){0.f, 0.f, 0.f, 0.f}; } \
      if ((step) + 2 < nc) LAT_UP(UP, (step) + 2); \
      const float* SC = (const float*)(B + 57344); \
      const float gt = SC[128]; \
      bf16x8 Sb[4]; \
      _Pragma("unroll") for (int s = 0; s < 4; ++s) Sb[s] = pack8(S[2 * s], S[2 * s + 1]); \
      _Pragma("unroll") for (int m = 0; m < 8; ++m) S[m] = S[m] * gt; \
      { bf16x8 fa[2][4], fq[2][4]; \
        _Pragma("unroll") for (int m = 0; m < 4; ++m) { \
          fa[0][m] = *(const bf16x8*)(B + (16 * m + fr) * 256 + (((0 + g) ^ fr) << 4)); \
          fq[0][m] = *(const bf16x8*)(B + 16384 + (16 * m + fr) * 256 + (((0 + g) ^ fr) << 4)); } \
        _Pragma("unroll") for (int s = 0; s < 4; ++s) { \
          if (s < 3) { _Pragma("unroll") for (int m = 0; m < 4; ++m) { \
              fa[(s + 1) & 1][m] = *(const bf16x8*)(B + (16 * m + fr) * 256 + (((4 * (s + 1) + g) ^ fr) << 4)); \
              fq[(s + 1) & 1][m] = *(const bf16x8*)(B + 16384 + (16 * m + fr) * 256 + (((4 * (s + 1) + g) ^ fr) << 4)); } } \
          _Pragma("unroll") for (int m = 0; m < 4; ++m) a1[m] = __builtin_amdgcn_mfma_f32_16x16x32_bf16(fa[s & 1][m], Sb[s], a1[m], 0, 0, 0); \
          _Pragma("unroll") for (int m = 0; m < 4; ++m) a2[m] = __builtin_amdgcn_mfma_f32_16x16x32_bf16(fq[s & 1][m], Sb[s], a2[m], 0, 0, 0); } } \
      bf16x8 Vb[2], Vs[2]; \
      _Pragma("unroll") for (int s = 0; s < 2; ++s) Vb[s] = pack8(a1[2 * s], a1[2 * s + 1]); \
      _Pragma("unroll") for (int m = 0; m < 4; ++m) { const f32x4 e = *(const f32x4*)(SC + 64 + 16 * m + 4 * g); a1[m] = a1[m] * e; } \
      _Pragma("unroll") for (int s = 0; s < 2; ++s) Vs[s] = pack8(a1[2 * s], a1[2 * s + 1]); \
      { bf16x8 fk[2][8]; \
        _Pragma("unroll") for (int s = 0; s < 2; ++s) _Pragma("unroll") for (int m = 0; m < 8; ++m) fk[s][m] = *(const bf16x8*)(B + 40960 + (16 * m + fr) * 128 + (((4 * s + g) ^ (fr >> 1)) << 4)); \
        _Pragma("unroll") for (int s = 0; s < 2; ++s) _Pragma("unroll") for (int m = 0; m < 8; ++m) S[m] = __builtin_amdgcn_mfma_f32_16x16x32_bf16(fk[s][m], Vs[s], S[m], 0, 0, 0); } \
      _Pragma("unroll") for (int m = 0; m < 4; ++m) { const f32x4 e = *(const f32x4*)(SC + 16 * m + 4 * g); a2[m] = a2[m] * e; } \
      _Pragma("unroll") for (int s = 0; s < 2; ++s) _Pragma("unroll") for (int m = 0; m < 4; ++m) { \
          const bf16x8 fa2 = *(const bf16x8*)(B + 32768 + (16 * m + fr) * 128 + (((4 * s + g) ^ (fr >> 1)) << 4)); \
          a2[m] = __builtin_amdgcn_mfma_f32_16x16x32_bf16(fa2, Vb[s], a2[m], 0, 0, 0); } \
      _Pragma("unroll") for (int m = 0; m < 4; ++m) _Pragma("unroll") for (int r = 0; r < 4; ++r) ot[(16 * m + 4 * g + r) * 16 + fr] = f2bf(a2[m][r]); \
      { bf16_t* op = OB + ((size_t)d * NTOK + (size_t)cidx * 64) * 512 + h * 128 + 16 * dvw; \
        _Pragma("unroll") for (int k = 0; k < 2; ++k) { const int q = lane + 64 * k, row = q >> 1, hf = q & 1; \
          *(u32x4*)(op + (size_t)row * 512 + hf * 8) = *(const u32x4*)(ot + row * 16 + hf * 8); } } \
      __syncthreads(); } while (0)
    for (int step = 0; step < nc; step += 2) { LAT_STEP(upa, step, 0); LAT_STEP(upb, step + 1, 1); }
#undef LAT_STEP
#undef LAT_UP
  }
#undef LAT_CIDX
}

__device__ __forceinline__ void scan_dispatch(int i, const unsigned char* PRE, const float* state_in, bf16_t* OB, float* state_out, int layer, unsigned char* lds) {
#ifdef LAT_FULL
  if (i < 32) {
    if (i >= 16) return;
    const int q = i, half = -1, b = q >> 3, h = (q >> 1) & 3, d = q & 1;
#else
  if (i < 32) {
    const int q = i >> 1, half = i & 1, b = q >> 3, h = (q >> 1) & 3, d = q & 1;
#endif
#ifdef LAT_FULL
    scan_item(b, h, d, 128 + b * 32, 32, half, false, PRE, state_in + ((((size_t)b * 2 + layer) * 2 + d) * 4 + h) * 16384, OB, nullptr, lds);
#else
    scan_item_lat(b, h, d, 128 + b * 32, 32, half, PRE, state_in + ((((size_t)b * 2 + layer) * 2 + d) * 4 + h) * 16384, OB, lds);
#endif
  } else {
    const int sid = i - 32, b = sid >> 3, h = (sid >> 1) & 3, d = sid & 1;
    scan_item(b, h, d, b * 4, 4, -1, true, PRE, nullptr, OB, state_out + ((((size_t)b * 2 + layer) * 2 + d) * 4 + h) * 16384, lds);
  }
}

__global__ __launch_bounds__(512, 2) void k_scan2(const unsigned char* __restrict__ PRE, const float* __restrict__ state_in, bf16_t* __restrict__ OB,
                                                  float* __restrict__ state_out, int layer) {
  extern __shared__ __attribute__((aligned(16))) unsigned char smem[];
  for (int i = blockIdx.x; i < 288; i += gridDim.x) scan_dispatch(i, PRE, state_in, OB, state_out, layer, smem);
}
#define XB_TMO      128
#define XB_XCNT(j)  (256  + 64 * (j))
#define XB_XSUB(j)  (1280 + 64 * (j))
#define XB_XGEN(j)  (2304 + 64 * (j))
#define XB_TOP      3328
#define XB_TOPGEN   3392
#define XCD_BAR_WORDS 3456
#define XB_SPIN_CAP (1u << 18)
#define LAS __attribute__((address_space(3)))

__device__ __forceinline__ unsigned xb_ld(unsigned* p)              { return __hip_atomic_load(p, __ATOMIC_RELAXED, __HIP_MEMORY_SCOPE_AGENT); }
__device__ __forceinline__ unsigned xb_add(unsigned* p, unsigned v) { return __hip_atomic_fetch_add(p, v, __ATOMIC_RELAXED, __HIP_MEMORY_SCOPE_AGENT); }
__device__ __forceinline__ unsigned xb_xcc_id() { return (unsigned)__builtin_amdgcn_s_getreg((3 << 11) | 20) & 0xFu; }
#define XB_SPIN(cond, bar) do { unsigned _sp = 0; while (cond) { __builtin_amdgcn_s_sleep(1); \
    if ((++_sp & 255u) == 0u) { if (xb_ld(&(bar)[XB_TMO])) break; if (_sp > XB_SPIN_CAP) { atomicAdd(&(bar)[XB_TMO], 1u); break; } } } } while (0)

struct XcdBarrier {
    unsigned* bar; unsigned x;
    volatile LAS unsigned* st;
};

__device__ __forceinline__ XcdBarrier xcd_barrier_post(unsigned* bar, volatile LAS unsigned* st) {
    XcdBarrier b; b.bar = bar; b.x = xb_xcc_id(); b.st = st;
    if (threadIdx.x == 0) (void)xb_add(&bar[XB_XCNT(b.x)], 1u);
    return b;
}
__device__ __forceinline__ void xcd_barrier_complete(unsigned* bar, unsigned x, unsigned& nloc, unsigned& nx) {
    const unsigned G = gridDim.x * gridDim.y * gridDim.z;
    unsigned sum, cnt, mine, sp = 0u;
    for (;;) {
        sum = 0u; cnt = 0u; mine = 0u;
#pragma unroll
        for (unsigned j = 0; j < 16; ++j) { const unsigned c = xb_ld(&bar[XB_XCNT(j)]); sum += c; cnt += (c > 0u) ? 1u : 0u; mine = (j == x) ? c : mine; }
        if (sum == G) break;
        __builtin_amdgcn_s_sleep(1);
        if ((++sp & 255u) == 0u) { if (xb_ld(&bar[XB_TMO])) break; if (sp > XB_SPIN_CAP) { atomicAdd(&bar[XB_TMO], 1u); break; } }
    }
    nloc = mine > 0u ? mine : 1u; nx = cnt > 0u ? cnt : 1u;
}

__device__ __forceinline__ void xcd_barrier(const XcdBarrier& b) {
    asm volatile("s_waitcnt vmcnt(0)" ::: "memory");
    __syncthreads();
    if (threadIdx.x == 0) {
        unsigned* bar = b.bar;
        __builtin_amdgcn_s_waitcnt(0);
        unsigned nloc = b.st[0], nx = b.st[1];
        if (nloc == 0u) { xcd_barrier_complete(bar, b.x, nloc, nx); b.st[0] = nloc; b.st[1] = nx; }
        const unsigned old = xb_add(&bar[XB_XSUB(b.x)], 1u);
        const unsigned gen = old / nloc;
        if (old + 1u == (gen + 1u) * nloc) {
            __builtin_amdgcn_fence(__ATOMIC_RELEASE, "agent");
            asm volatile("s_waitcnt vmcnt(0)" ::: "memory");
            const unsigned og = xb_add(&bar[XB_TOP], 1u);
            const unsigned tg = og / nx;
            if (og + 1u == (tg + 1u) * nx) xb_add(&bar[XB_TOPGEN], 1u);
            else XB_SPIN(xb_ld(&bar[XB_TOPGEN]) == tg, bar);
            __builtin_amdgcn_fence(__ATOMIC_ACQUIRE, "agent");
            xb_add(&bar[XB_XGEN(b.x)], 1u);
            asm volatile("s_waitcnt vmcnt(0)" ::: "memory");
        } else {
            XB_SPIN(xb_ld(&bar[XB_XGEN(b.x)]) == gen, bar);
            __builtin_amdgcn_fence(__ATOMIC_ACQUIRE, "agent");
            asm volatile("s_waitcnt vmcnt(0)" ::: "memory");
        }
    }
    __syncthreads();
}


#include <hip/hip_cooperative_groups.h>
namespace cg = cooperative_groups;

#define MEGA_LDS_MAIN 143360
#define MEGA_LDS (MEGA_LDS_MAIN + 16)
#define WS_X 0ull
#define WS_WTA (WS_X + (size_t)NTOK * 1024 * 4)
#define WS_WTB (WS_WTA + (size_t)WT_LAYER * 2)
#define WS_QKV (WS_WTB + (size_t)2816 * 1024 * 2)
#define WS_REST (WS_QKV + (size_t)NTOK * NQKV * 2)
#define WS_PRE (WS_REST + (size_t)NTOK * NREST * 2)
#define WS_MIXB (WS_PRE + (size_t)768 * PRE_ITEM)
#define WS_MODS (WS_MIXB + (size_t)NTOK * 1024 * 2)
#define WS_AV (WS_MODS + 2 * 3 * 6144 * 4)
#define WS_BIN (WS_AV + 2 * 2 * 3 * 1024 * 4)
#define WS_BGU (WS_BIN + 2 * 3 * NCOLS * 4)
#define WS_BLOG (WS_BGU + 2 * 3 * 2 * FFH * 4)
#define WS_ROWSS (WS_BLOG + 2 * 3 * 16 * 4 + 128)
#define WS_LOG (WS_ROWSS + 5 * NTOK * 4)
#define WS_BAR (WS_LOG + (size_t)NTOK * 16 * 4)
#define WS_WLT (WS_BAR + 16384)
#define WS_POS (WS_WLT + 2 * 16 * 1024 * 2)
#define WS_SLOT (WS_POS + 96 * 512 * 4)
#define WS_END (WS_SLOT + 48 * 4 * 256 * 4)
struct MP {
  const float *x_prompt, *x_sample, *state_delta, *c, *c_ctx, *w_in, *conv_w, *a_log, *dt_bias, *delta_norm_g, *sgu_norm_g, *w_spatial, *b_spatial,
      *w_pool, *pool_scale, *w_out, *norm1_g, *norm2_g, *w_mod, *b_mod, *w_gu, *w_down, *norm_f;
  float* out; unsigned char* ws;
  __device__ __forceinline__ float* X_() const { return (float*)(ws + WS_X); }
  __device__ __forceinline__ bf16_t* WTA_() const { return (bf16_t*)(ws + WS_WTA); }
  __device__ __forceinline__ bf16_t* WTB_() const { return (bf16_t*)(ws + WS_WTB); }
  __device__ __forceinline__ bf16_t* QKV_() const { return (bf16_t*)(ws + WS_QKV); }
  __device__ __forceinline__ bf16_t* REST_() const { return (bf16_t*)(ws + WS_REST); }
  __device__ __forceinline__ unsigned char* PRE_() const { return ws + WS_PRE; }
  __device__ __forceinline__ bf16_t* MIXB_() const { return (bf16_t*)(ws + WS_MIXB); }
  __device__ __forceinline__ float* mods_() const { return (float*)(ws + WS_MODS); }
  __device__ __forceinline__ float* AV_() const { return (float*)(ws + WS_AV); }
  __device__ __forceinline__ float* BIN_() const { return (float*)(ws + WS_BIN); }
  __device__ __forceinline__ float* BGU_() const { return (float*)(ws + WS_BGU); }
  __device__ __forceinline__ float* BLOG_() const { return (float*)(ws + WS_BLOG); }
  __device__ __forceinline__ float* rowss_() const { return (float*)(ws + WS_ROWSS); }
  __device__ __forceinline__ float* LOG_() const { return (float*)(ws + WS_LOG); }
  __device__ __forceinline__ unsigned* bar_() const { return (unsigned*)(ws + WS_BAR); }
  __device__ __forceinline__ bf16_t* WLT_() const { return (bf16_t*)(ws + WS_WLT); }
  __device__ __forceinline__ float* POS_() const { return (float*)(ws + WS_POS); }
  __device__ __forceinline__ float* SLOT_() const { return (float*)(ws + WS_SLOT); }
};

__device__ __forceinline__ void gemv3_item(const float* __restrict__ W, int ld, int ncols, const float* vec  , float* red  ,
                                           const float* __restrict__ bias, float* __restrict__ o0, float* __restrict__ o1, float* __restrict__ o2, int t) {
  const int col = t & 63, ds = t >> 6;
  float a0 = 0.f, a1 = 0.f, a2 = 0.f;
  if (col < ncols) {
    const float* w = W + (size_t)(ds * 128) * ld + col;
#pragma unroll 16
    for (int d = 0; d < 128; ++d) { const float wv = w[(size_t)d * ld]; const int dd = ds * 128 + d; a0 += vec[dd] * wv; a1 += vec[1024 + dd] * wv; a2 += vec[2048 + dd] * wv; }
  }
  red[(ds * 3 + 0) * 64 + col] = a0; red[(ds * 3 + 1) * 64 + col] = a1; red[(ds * 3 + 2) * 64 + col] = a2;
  __syncthreads();
  if (t < 192) {
    const int s = t >> 6, cc = t & 63;
    float v = 0.f;
#pragma unroll
    for (int k = 0; k < 8; ++k) v += red[(k * 3 + s) * 64 + cc];
    if (cc < ncols) { v += bias ? bias[cc] : 0.f; (s == 0 ? o0 : (s == 1 ? o1 : o2))[cc] = v; }
  }
  __syncthreads();
}

__device__ __forceinline__ WTile wtile_desc(const MP& p, int l, int r, bf16_t* wt_in, bf16_t* wt_rest) {
  const float* ml = p.mods_() + l * 3 * 6144;
  WTile d;
  if (r < 704) { const int kt = r / 44, jt = r % 44; d.src = p.w_in + (size_t)l * 1024 * INC; d.ldsrc = INC; d.srccol0 = win_srccol(jt * 64); d.dst = wt_in; d.K = 1024; d.j0 = jt * 64; d.k0 = kt * 64; d.shv = ml; d.bias = p.BIN_() + l * 3 * NCOLS; d.bstride = NCOLS; return d; }
  r -= 704;
  if (r < 256) { const int kt = r / 16, jt = r % 16; d.src = p.w_out + (size_t)l * 1024 * 1024; d.ldsrc = 1024; d.srccol0 = jt * 64; d.dst = wt_rest + WT_OUT; d.K = 1024; d.j0 = jt * 64; d.k0 = kt * 64; d.shv = nullptr; d.bias = nullptr; d.bstride = 0; return d; }
  r -= 256;
  if (r < 1408) { const int kt = r / 88, jt = r % 88; d.src = p.w_gu + (size_t)l * 1024 * 2 * FFH; d.ldsrc = 2 * FFH; d.srccol0 = wgu_srccol(jt * 64); d.dst = wt_rest + WT_GU; d.K = 1024; d.j0 = jt * 64; d.k0 = kt * 64; d.shv = ml + 3072; d.bias = p.BGU_() + l * 3 * 2 * FFH; d.bstride = 2 * FFH; return d; }
  r -= 1408;
  { const int kt = r / 16, jt = r % 16; d.src = p.w_down + (size_t)l * FFH * 1024; d.ldsrc = 1024; d.srccol0 = jt * 64; d.dst = wt_rest + WT_DOWN; d.K = FFH; d.j0 = jt * 64; d.k0 = kt * 64; d.shv = nullptr; d.bias = nullptr; d.bstride = 0; return d; }
}

__device__ __forceinline__ void wtiles(const MP& p, int l, int r_lo, int r_hi, int jb, int njb, unsigned char* smem) {
  int t_ = threadIdx.x; asm volatile("" : "+v"(t_)); const int t = t_, tt = t & 255;
  float* tile0 = (float*)smem + (t >> 8) * (2 * 64 * 65); float* tile1 = tile0 + 64 * 65;
  for (int it = jb; it < (r_hi - r_lo) / 4; it += njb) {
    const int r = r_lo + it * 4 + (t >> 8) * 2;
    const WTile d0 = wtile_desc(p, l, r, p.WTA_() + WT_IN, p.WTA_()), d1 = wtile_desc(p, l, r + 1, p.WTA_() + WT_IN, p.WTA_());
    float v0[16], v1[16];
    wtile_load(d0, v0, tt); wtile_load(d1, v1, tt);
    wtile_put(tile0, v0, tt); wtile_put(tile1, v1, tt);
    __syncthreads();
    wtile_finish(d0, tile0, tt); wtile_finish(d1, tile1, tt);
    __syncthreads();
  }
}

__device__ __forceinline__ void phase_prep0(const MP& p, int bid, int nb, unsigned char* smem, bool tiles) {
  int t_ = threadIdx.x; asm volatile("" : "+v"(t_)); const int t = t_;
  if (!tiles) for (int i = bid * 512 + t; i < 4 * NTOK; i += nb * 512) p.rowss_()[NTOK + i] = 0.f;
  if (!tiles) for (int i = bid * 512 + t; i < 2 * 3 * NCOLS + 2 * 3 * 2 * FFH; i += nb * 512) p.BIN_()[i] = 0.f;
  if (!tiles) for (int i = bid * 512 + t; i < 96 * 512; i += nb * 512) {
    const int rc = i >> 9, dd = i & 511, jj = dd & 255;
    const float omega = 1.0f / powf(10000.0f, (float)jj / 256.0f);
    const float ang = (float)(rc < 32 ? rc : rc - 32) * omega;
    p.POS_()[i] = (dd & 256) ? cosf(ang) : sinf(ang);
  }
  if (!tiles) for (int i = bid * 512 + t; i < 2 * 16 * 1024; i += nb * 512) { const int l = i >> 14, j = (i >> 10) & 15, d = i & 1023; p.WLT_()[i] = f2bf(p.w_in[((size_t)l * 1024 + d) * INC + 2048 + j]); }
  float* vec = (float*)smem; float* red = vec + 3072;
  const int NMOD = 192;
  if (tiles) { wtiles(p, 0, 0, 704, bid, nb, smem); return; }
  for (int it = bid; it < NMOD; it += nb) {
    const int l = it / 96, cgp = it % 96;
    for (int i = t; i < 1024; i += 512) { vec[i] = silu_f(p.c_ctx[i]); vec[1024 + i] = silu_f(p.c[i]); vec[2048 + i] = silu_f(p.c[1024 + i]); }
    __syncthreads();
    float* m = p.mods_() + l * 3 * 6144 + cgp * 64;
    gemv3_item(p.w_mod + (size_t)l * 1024 * 6144 + cgp * 64, 6144, 64, vec, red, p.b_mod + l * 6144 + cgp * 64, m, m + 6144, m + 2 * 6144, t);
  }
}

__device__ __forceinline__ void phase_vecs(const MP& p, int bid, int nb, unsigned char* smem) {
  int t_ = threadIdx.x; asm volatile("" : "+v"(t_)); const int t = t_;
  float* vec = (float*)smem; float* red = vec + 3072;
  for (int i = bid * 512 + t; i < 2 * 2 * 1024; i += nb * 512) {
    const int l = i >> 11, n = (i >> 10) & 1, d = i & 1023;
    const float g = n ? p.norm2_g[l * 1024 + d] : p.norm1_g[l * 1024 + d];
#pragma unroll
    for (int s = 0; s < 3; ++s) p.AV_()[((l * 2 + n) * 3 + s) * 1024 + d] = g * (1.f + p.mods_()[(l * 3 + s) * 6144 + (n ? 4096 : 1024) + d]);
  }
  const int N_IN = 44, N_GU = 88;
  for (int it = bid; it < 2; it += nb) {
    const int l = it, r = N_IN + N_GU;
    const int sh_off = (r >= N_IN && r < N_IN + N_GU) ? 3072 : 0;
    for (int i = t; i < 1024; i += 512) {
#pragma unroll
      for (int s = 0; s < 3; ++s) vec[s * 1024 + i] = p.mods_()[(l * 3 + s) * 6144 + sh_off + i];
    }
    __syncthreads();
    if (r < N_IN) { float* o = p.BIN_() + l * 3 * NCOLS + r * 64; gemv3_item(p.w_in + (size_t)l * 1024 * INC + win_srccol(r * 64), INC, 64, vec, red, nullptr, o, o + NCOLS, o + 2 * NCOLS, t); }
    else if (r < N_IN + N_GU) { const int j0 = (r - N_IN) * 64; float* o = p.BGU_() + l * 3 * 2 * FFH + j0; gemv3_item(p.w_gu + (size_t)l * 1024 * 2 * FFH + wgu_srccol(j0), 2 * FFH, 64, vec, red, nullptr, o, o + 2 * FFH, o + 4 * FFH, t); }
    else { float* o = p.BLOG_() + l * 3 * 16; gemv3_item(p.w_in + (size_t)l * 1024 * INC + 2048, INC, 16, vec, red, nullptr, o, o + 16, o + 32, t); }
  }
}

__device__ __forceinline__ void prepx_rows3(const MP& p, int r0, int lane) {
  f32x4 v[3][4];
#pragma unroll
  for (int k = 0; k < 3; ++k) {
    const int r = r0 + k;
#pragma unroll
    for (int i = 0; i < 4; ++i) {
      const int d = i * 256 + lane * 4;
      if (r < NCTX) v[k][i] = *(const f32x4*)(p.x_prompt + (size_t)r * 1024 + d);
      else v[k][i] = *(const f32x4*)(p.x_sample + (size_t)(r - NCTX) * 1024 + d);
    }
  }
  const int seg0 = seg_of_row(r0);
  f32x4 av[4];
#pragma unroll
  for (int i = 0; i < 4; ++i) { const int d = i * 256 + lane * 4; av[i] = *(const f32x4*)(p.norm1_g + d) * (1.f + *(const f32x4*)(p.mods_() + seg0 * 6144 + 1024 + d)); }
#pragma unroll
  for (int k = 0; k < 3; ++k) {
    const int r = r0 + k, seg = seg_of_row(r);
    if (seg != seg0) {
#pragma unroll
      for (int i = 0; i < 4; ++i) { const int d = i * 256 + lane * 4; av[i] = *(const f32x4*)(p.norm1_g + d) * (1.f + *(const f32x4*)(p.mods_() + seg * 6144 + 1024 + d)); }
    }
    float ss = 0.f;
#pragma unroll
    for (int i = 0; i < 4; ++i) {
      const int d = i * 256 + lane * 4;
      f32x4 x = v[k][i];
      if (r >= NCTX) {
        const int pp = (r - NCTX) & 2047, row = pp >> 6, col = pp & 63;
        x = x + *(const f32x4*)(p.POS_() + (d < 512 ? row * 512 + d : (32 + col) * 512 + (d - 512)));
      }
      *(f32x4*)(p.X_() + (size_t)r * 1024 + d) = x;
      ss += (x[0] * x[0] + x[1] * x[1]) + (x[2] * x[2] + x[3] * x[3]);
      const f32x4 a = av[i];
      u32x2 w; w.x = pack_bf16(x[0] * a[0], x[1] * a[1]); w.y = pack_bf16(x[2] * a[2], x[3] * a[3]);
      *(u32x2*)((bf16_t*)p.PRE_() + (size_t)r * 1024 + d) = w;
    }
    ss = wave_sum(ss);
    if (lane == 0) p.rowss_()[r] = ss;
  }
}

__device__ __forceinline__ void phase_logits(const MP& p, int l, int bid, int nb, unsigned char* smem) {
  int tl = threadIdx.x; asm volatile("" : "+v"(tl)); const int t = tl, lane = tl & 63, w = tl >> 6, fr = lane & 15, g = lane >> 4;
  bf16_t* wl = (bf16_t*)smem;
  const bf16_t* XA = (const bf16_t*)p.PRE_();
  for (int q = t; q < 2048; q += 512) { const int j = q >> 7, c = q & 127; *(u32x4*)(wl + j * 1032 + c * 8) = *(const u32x4*)(p.WLT_() + (size_t)l * 16 * 1024 + j * 1024 + c * 8); }
  __syncthreads();
  for (int rg = bid * 8 + w; rg < NTOK / 16; rg += nb * 8) {
    const int row0 = rg * 16;
    const bf16_t* arow = XA + (size_t)(row0 + fr) * 1024 + 8 * g;
    bf16x8 af[32];
#pragma unroll
    for (int ks = 0; ks < 32; ++ks) af[ks] = *(const bf16x8*)(arow + 32 * ks);
    f32x4 acc0 = (f32x4){0.f, 0.f, 0.f, 0.f}, acc1 = acc0;
#pragma unroll
    for (int ks = 0; ks < 32; ks += 2) {
      const bf16x8 b0 = *(const bf16x8*)(wl + fr * 1032 + 32 * ks + 8 * g), b1 = *(const bf16x8*)(wl + fr * 1032 + 32 * (ks + 1) + 8 * g);
      acc0 = __builtin_amdgcn_mfma_f32_16x16x32_bf16(af[ks], b0, acc0, 0, 0, 0);
      acc1 = __builtin_amdgcn_mfma_f32_16x16x32_bf16(af[ks + 1], b1, acc1, 0, 0, 0);
    }
    const int seg = seg_of_row(row0);
    const float bias = p.BLOG_()[l * 3 * 16 + seg * 16 + fr];
#pragma unroll
    for (int r = 0; r < 4; ++r) {
      const int row = row0 + 4 * g + r;
      const float rinv = rsqrtf(p.rowss_()[(2 * l) * NTOK + row] * (1.0f / 1024.0f) + 1e-6f);
      p.LOG_()[(size_t)row * 16 + fr] = (acc0[r] + acc1[r]) * rinv + bias;
    }
  }
  __syncthreads();
}

__device__ __forceinline__ void delta_post_rows3(const MP& p, int l, int r0, int lane) {
  const bf16_t* OB = p.QKV_();
  u32x4 of[3], ob[3], zz[3];
#pragma unroll
  for (int k = 0; k < 3; ++k) {
    const int r = r0 + k;
    of[k] = *(const u32x4*)(OB + (size_t)r * 512 + lane * 8); ob[k] = *(const u32x4*)(OB + ((size_t)NTOK + r) * 512 + lane * 8);
    zz[k] = *(const u32x4*)(p.REST_() + (size_t)r * NREST + lane * 8);
  }
  const float* ng = p.delta_norm_g + l * 128 + (lane & 15) * 8;
#pragma unroll
  for (int k = 0; k < 3; ++k) {
    const int r = r0 + k;
    float o[8]; float ss = 0.f;
#pragma unroll
    for (int e = 0; e < 8; ++e) {
      const unsigned wf = of[k][e >> 1], wb = ob[k][e >> 1];
      o[e] = __uint_as_float((e & 1) ? (wf & 0xffff0000u) : (wf << 16)) + __uint_as_float((e & 1) ? (wb & 0xffff0000u) : (wb << 16));
      ss += o[e] * o[e];
    }
    ss += __shfl_xor(ss, 1); ss += __shfl_xor(ss, 2); ss += __shfl_xor(ss, 4); ss += __shfl_xor(ss, 8);
    const float rn = rsqrtf(ss * (1.0f / 128.0f) + 1e-6f);
    float y[8];
#pragma unroll
    for (int e = 0; e < 8; ++e) {
      const unsigned wz = zz[k][e >> 1];
      const float z = __uint_as_float((e & 1) ? (wz & 0xffff0000u) : (wz << 16));
      y[e] = o[e] * rn * ng[e] * silu_fast(z);
    }
    u32x4 w; w.x = pack_bf16(y[0], y[1]); w.y = pack_bf16(y[2], y[3]); w.z = pack_bf16(y[4], y[5]); w.w = pack_bf16(y[6], y[7]);
    *(u32x4*)(p.MIXB_() + (size_t)r * 1024 + lane * 8) = w;
  }
}

__device__ __forceinline__ void sgu_pair(const MP& p, int l, int item0, unsigned char* smem) {
  int tl = threadIdx.x; asm volatile("" : "+v"(tl)); const int t = tl & 255, lane = tl & 63, w = __builtin_amdgcn_readfirstlane(tl >> 6), hb = w >> 2, wl = w & 3, fr = lane & 15, g4 = lane >> 4;
  const int item = item0 + hb, ch = item >> 2, g = item & 3;
  const bf16_t* REST = p.REST_(); const float* norm_g = p.sgu_norm_g + l * 256 + g * 64;
  const float* w_s = p.w_spatial + ((size_t)l * 4 + g) * 128 * 128; const float* b_s = p.b_spatial + (l * 4 + g) * 128;
  const int r0 = ch * 128;
  bf16_t* vnT = (bf16_t*)(smem + hb * 35840);
  bf16_t* ut = (bf16_t*)(smem + hb * 35840 + 17408);
  const int s_ = t >> 1, q2 = t & 1;
  const bf16_t* vrow = REST + (size_t)(r0 + s_) * NREST + 768 + g * 64 + q2 * 32;
  u32x4 vv[4];
#pragma unroll
  for (int k = 0; k < 4; ++k) vv[k] = *(const u32x4*)(vrow + 8 * k);
  u32x4 uu[4];
#pragma unroll
  for (int k = 0; k < 4; ++k) { const int q = t + 256 * k, row = q >> 3, c8 = q & 7; uu[k] = *(const u32x4*)(REST + (size_t)(r0 + row) * NREST + 512 + g * 64 + c8 * 8); }
  f32x4 wa[2][4][2];
#pragma unroll
  for (int mt = 0; mt < 2; ++mt) {
    const float* wrow = w_s + (size_t)(wl * 32 + mt * 16 + fr) * 128 + 8 * g4;
#pragma unroll
    for (int ks = 0; ks < 4; ++ks) { wa[mt][ks][0] = *(const f32x4*)(wrow + 32 * ks); wa[mt][ks][1] = *(const f32x4*)(wrow + 32 * ks + 4); }
  }
  {
    float val[32]; float ss = 0.f;
#pragma unroll
    for (int e = 0; e < 32; ++e) {
      const unsigned wv = vv[e >> 3][(e & 7) >> 1];
      val[e] = gelu_fast(__uint_as_float((e & 1) ? (wv & 0xffff0000u) : (wv << 16))); ss += val[e] * val[e];
    }
    ss += __shfl_xor(ss, 1);
    const float rinv = rsqrtf(ss * (1.0f / 64.0f) + 1e-6f);
#pragma unroll
    for (int e = 0; e < 32; ++e) vnT[(q2 * 32 + e) * 136 + s_] = f2bf(val[e] * rinv * norm_g[q2 * 32 + e]);
#pragma unroll
    for (int k = 0; k < 4; ++k) { const int q = t + 256 * k, row = q >> 3, c8 = q & 7; *(u32x4*)(ut + row * 72 + c8 * 8) = uu[k]; }
  }
  __syncthreads();
#pragma unroll
  for (int mt = 0; mt < 2; ++mt) {
    bf16x8 af[4];
#pragma unroll
    for (int ks = 0; ks < 4; ++ks) af[ks] = pack8(wa[mt][ks][0], wa[mt][ks][1]);
    f32x4 acc[4];
#pragma unroll
    for (int nt = 0; nt < 4; ++nt) {
      acc[nt] = (f32x4){0.f, 0.f, 0.f, 0.f};
#pragma unroll
      for (int ks = 0; ks < 4; ++ks) {
        const bf16x8 bfr = *(const bf16x8*)(vnT + (nt * 16 + fr) * 136 + 32 * ks + 8 * g4);
        acc[nt] = __builtin_amdgcn_mfma_f32_16x16x32_bf16(af[ks], bfr, acc[nt], 0, 0, 0);
      }
    }
#pragma unroll
    for (int r = 0; r < 4; ++r) {
      const int tt = wl * 32 + mt * 16 + 4 * g4 + r;
      const float bb = b_s[tt];
#pragma unroll
      for (int nt = 0; nt < 4; ++nt) { bf16_t* e = ut + tt * 72 + nt * 16 + fr; *e = f2bf(gelu_fast(bf2f(*e)) * (acc[nt][r] + bb)); }
    }
  }
  __syncthreads();
#pragma unroll
  for (int k = 0; k < 4; ++k) { const int q = t + 256 * k, row = q >> 3, c8 = q & 7; *(u32x4*)(p.MIXB_() + (size_t)(r0 + row) * 1024 + 512 + g * 64 + c8 * 8) = *(const u32x4*)(ut + row * 72 + c8 * 8); }
  __syncthreads();
}

__device__ __forceinline__ void pool_item(const MP& p, int l, int blk, unsigned char* smem) {
  int tl = threadIdx.x; asm volatile("" : "+v"(tl)); const int t = tl, lane = tl & 63, w = __builtin_amdgcn_readfirstlane(tl >> 6), fr = lane & 15, g4 = lane >> 4;
  const bf16_t* REST = p.REST_(); const float* w_pool = p.w_pool + (size_t)l * 4 * 64 * 64; const float* scale = p.pool_scale + l * 256;
  const int r0 = blk * 64;
  int seg0, seglen;
  if (r0 < NCTX) { seg0 = r0 & ~255; seglen = 256; } else { seg0 = r0; seglen = 64; }
  bf16_t* xs = (bf16_t*)smem;
  bf16_t* dm = (bf16_t*)(smem + 42240);
  bf16_t* wT = (bf16_t*)(smem + 42240 + 36864);
  u32x4 xv[5];
#pragma unroll
  for (int k = 0; k < 5; ++k) {
    const int q = t + 512 * k, lr = q >> 5, c8 = q & 31, row = r0 - 8 + lr;
    xv[k] = (u32x4){0u, 0u, 0u, 0u};
    if (row >= seg0 && row < seg0 + seglen) xv[k] = *(const u32x4*)(REST + (size_t)row * NREST + 1024 + c8 * 8);
  }
  f32x4 wv[8];
#pragma unroll
  for (int k = 0; k < 8; ++k) wv[k] = *(const f32x4*)(w_pool + (size_t)(t + 512 * k) * 4);
#pragma unroll
  for (int k = 0; k < 5; ++k) { const int q = t + 512 * k, lr = q >> 5, c8 = q & 31; *(u32x4*)(xs + lr * 264 + c8 * 8) = xv[k]; }
#pragma unroll
  for (int k = 0; k < 8; ++k) {
    const int q = t + 512 * k, i = q >> 10, c = (q >> 4) & 63, d4 = (q & 15) * 4;
#pragma unroll
    for (int e = 0; e < 4; ++e) wT[(i * 64 + d4 + e) * 72 + c] = f2bf(wv[k][e]);
  }
  __syncthreads();
  {
    const int c = t & 255, i = c >> 6, win = 2 << i, ph = t >> 8, hw = win >> 1;
    const int xoff = seg0 - r0 + 8;
    int pos = r0 + ph * 32 - seg0;
    int lo = max(pos - hw, 0), hi = min(pos + hw, seglen);
    float s = 0.f;
    for (int q = lo; q < hi; ++q) s += bf2f(xs[(q + xoff) * 264 + c]);
#pragma unroll 4
    for (int pp = ph * 32; pp < ph * 32 + 32; ++pp) {
      dm[(i * 64 + pp) * 72 + (c & 63)] = f2bf(s * __builtin_amdgcn_rcpf((float)(hi - lo)) - bf2f(xs[(pp + 8) * 264 + c]));
      ++pos;
      const int lo2 = max(pos - hw, 0), hi2 = min(pos + hw, seglen);
      if (hi2 > hi) s += bf2f(xs[(hi + xoff) * 264 + c]);
      if (lo2 > lo) s -= bf2f(xs[(lo + xoff) * 264 + c]);
      lo = lo2; hi = hi2;
    }
  }
  __syncthreads();
  {
    const int i = w >> 1;
    bf16x8 bfr[4][2];
#pragma unroll
    for (int nt = 0; nt < 4; ++nt)
#pragma unroll
      for (int ks = 0; ks < 2; ++ks) bfr[nt][ks] = *(const bf16x8*)(wT + (i * 64 + nt * 16 + fr) * 72 + 32 * ks + 8 * g4);
#pragma unroll
    for (int pt2 = 0; pt2 < 2; ++pt2) {
      const int pt = (w & 1) * 2 + pt2;
      bf16x8 af[2];
#pragma unroll
      for (int ks = 0; ks < 2; ++ks) af[ks] = *(const bf16x8*)(dm + (i * 64 + pt * 16 + fr) * 72 + 32 * ks + 8 * g4);
#pragma unroll
      for (int nt = 0; nt < 4; ++nt) {
        f32x4 acc = (f32x4){0.f, 0.f, 0.f, 0.f};
#pragma unroll
        for (int ks = 0; ks < 2; ++ks) acc = __builtin_amdgcn_mfma_f32_16x16x32_bf16(af[ks], bfr[nt][ks], acc, 0, 0, 0);
        const float sc = scale[i * 64 + nt * 16 + fr];
#pragma unroll
        for (int r = 0; r < 4; ++r) xs[(pt * 16 + 4 * g4 + r) * 264 + i * 64 + nt * 16 + fr] = f2bf(acc[r] * sc);
      }
    }
  }
  __syncthreads();
#pragma unroll
  for (int k = 0; k < 4; ++k) { const int q = t + 512 * k, row = q >> 5, c8 = q & 31; *(u32x4*)(p.MIXB_() + (size_t)(r0 + row) * 1024 + 768 + c8 * 8) = *(const u32x4*)(xs + row * 264 + c8 * 8); }
  __syncthreads();
}

__device__ __forceinline__ void final_row(const MP& p, int r, int lane) {
  const float rinv = rsqrtf(p.rowss_()[4 * NTOK + r] * (1.0f / 1024.0f) + 1e-6f);
#pragma unroll
  for (int i = 0; i < 4; ++i) {
    const int d = i * 256 + lane * 4;
    const f32x4 v = *(const f32x4*)(p.X_() + (size_t)r * 1024 + d), gg = *(const f32x4*)(p.norm_f + d);
    *(f32x4*)(p.out + (size_t)r * 1024 + d) = v * rinv * gg;
  }
}

#ifndef REPEAT
#define REPEAT 0
#endif
#define REP_CAT2(a, b) a##b
#define REP_CAT(a, b) REP_CAT2(a, b)
#define REP(k) for (int REP_CAT(rep_, __LINE__) = 0; REP_CAT(rep_, __LINE__) < 1 + ((REPEAT >> (k)) & 1); ++REP_CAT(rep_, __LINE__))
#ifndef USE_CG_SYNC
#define USE_CG_SYNC 0
#endif
#if USE_CG_SYNC
#define GRID_SYNC() grid.sync()
#else
#define GRID_SYNC() do { REP(21) { XcdBarrier xb2; xb2.bar = p.bar_(); xb2.x = xb_xcc_id(); xb2.st = xst; xcd_barrier(xb2); } } while (0)
#endif

__global__ __launch_bounds__(512, 2) void mega(MP p) {
  extern __shared__ __attribute__((aligned(16))) unsigned char smem[];
#if USE_CG_SYNC
  cg::grid_group grid = cg::this_grid();
#else
  volatile LAS unsigned* xst = (volatile LAS unsigned*)((LAS unsigned char*)smem + MEGA_LDS_MAIN);
  if (threadIdx.x == 0) { xst[0] = 0u; xst[1] = 0u; }
  __syncthreads();
  (void)xcd_barrier_post(p.bar_(), xst);
#endif
  const int bid = blockIdx.x, nb = gridDim.x;
  bf16_t* XA = (bf16_t*)p.PRE_(); bf16_t* ACT = p.QKV_(); bf16_t* OB = p.QKV_();
  float* states_out = p.out + (size_t)NTOK * 1024;

  REP(0) phase_prep0(p, bid, nb, smem, false);
  GRID_SYNC();
  REP(1) { phase_prep0(p, bid, nb, smem, true); phase_vecs(p, bid, nb, smem); }
  REP(2) { int tl = threadIdx.x; asm volatile("" : "+v"(tl)); const int lane = tl & 63, w = tl >> 6;
    for (int rg = bid * 8 + w; rg < NTOK / 3; rg += nb * 8) prepx_rows3(p, rg * 3, lane); }
  GRID_SYNC();
  for (int l = 0; l < 2; ++l) {
#define TL_DECL int tl = threadIdx.x; asm volatile("" : "+v"(tl)); const int t = tl, lane = tl & 63, w = tl >> 6; (void)t; (void)lane; (void)w
    const float* ml = p.mods_() + l * 3 * 6144;
    float* rs1 = p.rowss_() + (2 * l) * NTOK; float* rs2 = p.rowss_() + (2 * l + 1) * NTOK; float* rs3 = p.rowss_() + (2 * l + 2) * NTOK;
    const float* A2 = p.AV_() + (l * 2 + 1) * 3 * 1024; const float* A1n = p.AV_() + (2 + 0) * 3 * 1024;
    REP(4) {
      pg8::Gemm g; g.A = XA; g.Bt = p.WTA_() + WT_IN; g.M = NTOK; g.N = NCOLS; g.K = 1024;
      EpiIn E{p.QKV_(), p.REST_(), rs1, p.BIN_() + l * 3 * NCOLS};
      pg8::StaticOrder S; S.init(g.M, g.N, nb, bid);
      pg8::gemm_phase<EpiIn, pg8::StaticOrder, true, true>((PG8_LAS unsigned char*)smem, g, S, E);
    }
    REP(3) if (bid >= 16) {
      phase_logits(p, l, bid - 16, nb - 16, smem);
      wtiles(p, l, 704, 2368, bid - 16, nb - 16, smem);
    }
    GRID_SYNC();
    REP(5) for (int item = bid; item < 768; item += nb) pre_item(item, p.QKV_(), p.LOG_(), p.conv_w + (size_t)l * 3 * NQKV, p.a_log + l * 8, p.dt_bias + l * 8, p.PRE_(), smem);
    GRID_SYNC();
    REP(6) { if (bid < 32) { REP(13) scan_dispatch(bid, p.PRE_(), p.state_delta, OB, states_out, l, smem); }
             else { REP(14) for (int i = bid - 32; i < 256; i += nb - 32) scan_dispatch(32 + i, p.PRE_(), p.state_delta, OB, states_out, l, smem); } }
    REP(12) if (bid >= 32) {
      for (int it = bid - 32; it < 192; it += nb - 32) sgu_pair(p, l, 2 * it, smem);
      for (int it = bid - 32; it < 192; it += nb - 32) pool_item(p, l, it, smem);
    }
    GRID_SYNC();
    REP(7) { TL_DECL; for (int rg = bid * 8 + w; rg < NTOK / 3; rg += nb * 8) delta_post_rows3(p, l, rg * 3, lane); }
    GRID_SYNC();
    {
      pg8::Gemm g; g.A = p.MIXB_(); g.Bt = p.WTA_() + WT_OUT; g.M = NTOK; g.N = 1024; g.K = 1024;
      EpiRes E{p.X_(), ml + 2048, rs2, XA, A2};
      pg8::StaticOrder S; S.init(g.M, g.N, nb, bid);
      pg8::gemm_phase<EpiRes, pg8::StaticOrder, true, true>((PG8_LAS unsigned char*)smem, g, S, E);
    }
    if (bid >= 192) wtiles(p, l, 2368, 3072, bid - 192, nb - 192, smem);
    GRID_SYNC();
    REP(9) {
      pg8::Gemm g; g.A = XA; g.Bt = p.WTA_() + WT_GU; g.M = NTOK; g.N = 2 * FFH; g.K = 1024;
      EpiGu E{ACT, rs2, p.BGU_() + l * 3 * 2 * FFH};
      GuOrder S; S.init(nb, bid, -1);
      pg8::gemm_phase<EpiGu, GuOrder, true, true>((PG8_LAS unsigned char*)smem, g, S, E);
    }
    GRID_SYNC();
    unsigned* gu_flag = p.bar_() + 3712 + l * 64;
#define GU_DEFERRED() do { for (int e = bid - 192; e < 48 - GU_DEFER_PM0; e += nb - 192) { \
      pg8::Gemm g; g.A = XA; g.Bt = p.WTA_() + WT_GU; g.M = NTOK; g.N = 2 * FFH; g.K = 1024; \
      EpiGu E{ACT, rs2, p.BGU_() + l * 3 * 2 * FFH}; \
      GuOrder S; S.init(nb, bid, GU_DEFER_PM0 + e); \
      pg8::gemm_phase<EpiGu, GuOrder, true, true>((PG8_LAS unsigned char*)smem, g, S, E); \
      asm volatile("s_waitcnt vmcnt(0)" ::: "memory"); \
      __syncthreads();                                                           \
      if (threadIdx.x == 0) { \
        __builtin_amdgcn_fence(__ATOMIC_RELEASE, "agent");                       \
        asm volatile("s_waitcnt vmcnt(0)" ::: "memory"); \
        __hip_atomic_store(gu_flag + GU_DEFER_PM0 + e, 1u, __ATOMIC_RELAXED, __HIP_MEMORY_SCOPE_AGENT); \
      } \
      __syncthreads(); } } while (0)
    if (l == 0) {
      pg8::Gemm g; g.A = ACT; g.Bt = p.WTA_() + WT_DOWN; g.M = NTOK; g.N = 1024; g.K = FFH;
      EpiRes E{p.X_(), ml + 5120, rs3, XA, A1n};
      DownOrder S; S.S.init(g.M, g.N, nb, bid); S.flag = gu_flag;
      pg8::gemm_phase<EpiRes, DownOrder, true, true>((PG8_LAS unsigned char*)smem, g, S, E);
      if (bid >= 192) { GU_DEFERRED(); wtiles(p, 1, 0, 704, bid - 192, nb - 192, smem); }
      GRID_SYNC();
    } else {
      pg8::Gemm g; g.A = ACT; g.Bt = p.WTA_() + WT_DOWN; g.M = NTOK; g.N = 1024; g.K = FFH;
      EpiResFinal E{p.X_(), ml + 5120, p.out, p.norm_f, p.SLOT_(), p.bar_() + 3584};
      DownOrder S; S.S.init(g.M, g.N, nb, bid); S.flag = gu_flag;
      pg8::gemm_phase<EpiResFinal, DownOrder, false, true>((PG8_LAS unsigned char*)smem, g, S, E);
      if (bid >= 192) GU_DEFERRED();
    }
  }
}

extern "C" void kernel_launch(void* const* d_in, const int* in_sizes, int n_in, void* d_out, int out_size, void* d_ws, size_t ws_size,
                              hipStream_t stream) {
  static int grid_blocks = 0;
  if (!grid_blocks) {
    int dev = 0, cus = 0, per_cu = 0;
    (void)hipGetDevice(&dev);
    (void)hipDeviceGetAttribute(&cus, hipDeviceAttributeMultiprocessorCount, dev);
    (void)hipFuncSetAttribute((const void*)mega, hipFuncAttributeMaxDynamicSharedMemorySize, MEGA_LDS);
    (void)hipOccupancyMaxActiveBlocksPerMultiprocessor(&per_cu, (const void*)mega, 512, MEGA_LDS);
    if (per_cu < 1) { fprintf(stderr, "occupancy query says %d blocks per CU\n", per_cu); per_cu = 1; }
    if (per_cu > 1) per_cu = 1;
    grid_blocks = cus * per_cu;
    if (grid_blocks > 256) grid_blocks = 256;
  }
  MP p; memset(&p, 0, sizeof p);
  const float** ins = (const float**)&p;
  for (int i = 0; i < 23; ++i) ins[i] = (const float*)d_in[i];
  p.out = (float*)d_out;
  p.ws = (unsigned char*)d_ws;
  if (WS_END > ws_size) { fprintf(stderr, "workspace too small: need %zu have %zu\n", (size_t)WS_END, ws_size); return; }
  (void)hipMemsetAsync((char*)d_ws + WS_BAR, 0, 16384, stream);
  void* args[] = {&p};
  hipError_t e = hipLaunchCooperativeKernel((const void*)mega, dim3(grid_blocks), dim3(512), args, MEGA_LDS, stream);
  if (e != hipSuccess) fprintf(stderr, "cooperative launch failed: %s (grid %d)\n", hipGetErrorString(e), grid_blocks);
}
```
